# Optimizing an MI355X kernel written in HIP

```python
import math
import jax, jax.numpy as jnp
from jax import lax
import numpy as np

D_MODEL = 1024
BATCH = 2
SEQ = 8192
DEPTH = 1

DN_HEADS = 8
DN_HEAD_DIM = 128
DN_WIDTH = DN_HEADS * DN_HEAD_DIM
DN_CONV = 5
CHUNK = 64
SC_WIDTH = D_MODEL
SC_CONV = 3
N_BRANCH = 2
IN_SIZES = (3 * DN_WIDTH, DN_WIDTH, 2 * DN_HEADS, 2 * DN_HEADS, 3 * SC_WIDTH, N_BRANCH * D_MODEL)
IN_WIDTH = sum(IN_SIZES)
N_EXPERTS = 32
TOP_K = 4
D_FF = D_MODEL
SWIGLU_LIMIT = 7.0
SWIGLU_ALPHA = 1.702
MOE_BLOCK = 256
EPS = 1e-6

kernel_name = "hybrid_gdn_shortconv_moe_adaln_encoder"


def rmsnorm(x, w):
    xf = x.astype(jnp.float32)
    xf = xf * lax.rsqrt(jnp.mean(xf * xf, axis=-1, keepdims=True) + EPS)
    return (xf * w.astype(jnp.float32)).astype(x.dtype)


def l2norm(x):
    return x * lax.rsqrt(jnp.sum(x * x, axis=-1, keepdims=True) + EPS)


def dwconv_centred(x, w):
    width, ch = w.shape
    pad = width // 2
    return lax.conv_general_dilated(
        x, w[:, None, :].astype(x.dtype), window_strides=(1,), padding=[(pad, pad)],
        dimension_numbers=("NWC", "WIO", "NWC"), feature_group_count=ch)


def unit_lower_inverse(L):
    c = L.shape[-1]
    n = -L
    p = jnp.eye(c, dtype=L.dtype) + n
    npow = n
    for _ in range(int(math.log2(c)) - 1):
        npow = npow @ npow
        p = p + p @ npow
    return p


def gated_delta_rule(q, k, v, beta, g):
    bsz, nh, t, dk = q.shape
    dv = v.shape[-1]
    n = t // CHUNK
    q = q * (dk ** -0.5)
    ch = lambda a: a.reshape(bsz, nh, n, CHUNK, *a.shape[3:])
    q, k, v, beta, g = ch(q), ch(k), ch(v), ch(beta), ch(g)
    g = jnp.cumsum(g, axis=-1)
    idx = jnp.arange(CHUNK)
    incl = idx[:, None] >= idx[None, :]
    strict = idx[:, None] > idx[None, :]
    decay = jnp.exp(jnp.where(incl, g[..., :, None] - g[..., None, :], -jnp.inf))
    k_beta = k * beta[..., None]
    L = jnp.where(strict, jnp.einsum("bhnid,bhnjd->bhnij", k_beta, k) * decay, 0.0)
    t_inv = unit_lower_inverse(L)
    u = t_inv @ (v * beta[..., None])
    w = t_inv @ (k_beta * jnp.exp(g)[..., None])
    a_qk = jnp.einsum("bhnid,bhnjd->bhnij", q, k) * decay
    g_last = g[..., -1]
    k_dec = k * jnp.exp(g_last[..., None] - g)[..., None]
    q_dec = q * jnp.exp(g)[..., None]

    def step(state, xs):
        q_c, k_c, u_c, w_c, a_c, gl = xs
        v_new = u_c - w_c @ state
        o_c = q_c @ state + a_c @ v_new
        state = state * jnp.exp(gl)[..., None, None] + jnp.einsum("bhck,bhcv->bhkv", k_c, v_new)
        return state, o_c

    xs = tuple(jnp.moveaxis(a, 2, 0) for a in (q_dec, k_dec, u, w, a_qk, g_last))
    s0 = jnp.zeros((bsz, nh, dk, dv), jnp.float32)
    _, o = lax.scan(step, s0, xs)
    return jnp.moveaxis(o, 0, 2).reshape(bsz, nh, t, dv)


def hybrid_mixer(h, w_in, conv_qkv_w, a_log, dt_bias, onorm_w, w_up_a, conv_sc_w, w_out_sc, w_o):
    bsz, t, _ = h.shape
    p = h @ w_in
    cuts = np.cumsum(IN_SIZES)[:-1].tolist()
    qkv, z, b_raw, a_raw, sc, gates = jnp.split(p, cuts, axis=-1)

    qkv = jax.nn.silu(dwconv_centred(qkv, conv_qkv_w)).astype(jnp.float32)
    heads = lambda a: a.reshape(bsz, t, DN_HEADS, DN_HEAD_DIM).transpose(0, 2, 1, 3)
    q, k, v = (heads(a) for a in jnp.split(qkv, 3, axis=-1))
    q, k = l2norm(q), l2norm(k)
    beta = jax.nn.sigmoid(b_raw.astype(jnp.float32)).reshape(bsz, t, 2, DN_HEADS)
    g = -jnp.exp(a_log.astype(jnp.float32)) * jax.nn.softplus(
        a_raw.astype(jnp.float32).reshape(bsz, t, 2, DN_HEADS) + dt_bias.astype(jnp.float32))
    bh = lambda a, d: a[:, :, d].transpose(0, 2, 1)
    o_fwd = gated_delta_rule(q, k, v, bh(beta, 0), bh(g, 0))
    o_bwd = jnp.flip(gated_delta_rule(jnp.flip(q, 2), jnp.flip(k, 2), jnp.flip(v, 2),
                                      jnp.flip(bh(beta, 1), -1), jnp.flip(bh(g, 1), -1)), 2)
    o = (o_fwd + o_bwd).transpose(0, 2, 1, 3)
    o = o * lax.rsqrt(jnp.mean(o * o, axis=-1, keepdims=True) + EPS) * onorm_w.astype(jnp.float32)
    o = o.astype(h.dtype) * jax.nn.silu(z.reshape(bsz, t, DN_HEADS, DN_HEAD_DIM))
    y_a = o.reshape(bsz, t, DN_WIDTH) @ w_up_a

    b_gate, c_gate, u_in = jnp.split(sc, 3, axis=-1)
    y_b = (b_gate * dwconv_centred(c_gate * u_in, conv_sc_w)) @ w_out_sc

    g_a, g_b = jnp.split(gates, N_BRANCH, axis=-1)
    return (jax.nn.sigmoid(g_a) * y_a + jax.nn.sigmoid(g_b) * y_b) @ w_o


def moe_ffn(h, router_w, router_b, w1, b1, w2, b2):
    bsz, t, d = h.shape
    n_tok = bsz * t
    hf = h.reshape(n_tok, d)
    logits = (hf @ router_w + router_b).astype(jnp.float32)
    top_val, top_idx = lax.top_k(logits, TOP_K)
    gates = jax.nn.softmax(top_val, axis=-1)
    m = n_tok * TOP_K
    e_flat = top_idx.reshape(m)
    t_flat = jnp.repeat(jnp.arange(n_tok, dtype=jnp.int32), TOP_K)
    g_flat = gates.reshape(m)
    order = jnp.argsort(e_flat)
    e_s, t_s, g_s = e_flat[order], t_flat[order], g_flat[order]
    counts = jnp.bincount(e_flat, length=N_EXPERTS)
    padded = (counts + MOE_BLOCK - 1) // MOE_BLOCK * MOE_BLOCK
    start = jnp.cumsum(counts) - counts
    pad_end = jnp.cumsum(padded)
    pad_start = pad_end - padded
    dest = pad_start[e_s] + (jnp.arange(m) - start[e_s])
    n_blocks = -(-m // MOE_BLOCK) + N_EXPERTS
    m_pad = n_blocks * MOE_BLOCK
    tok_buf = jnp.full((m_pad,), n_tok, jnp.int32).at[dest].set(t_s)
    gate_buf = jnp.zeros((m_pad,), jnp.float32).at[dest].set(g_s)
    block_exp = jnp.minimum(
        jnp.searchsorted(pad_end, jnp.arange(n_blocks) * MOE_BLOCK, side="right"), N_EXPERTS - 1)
    h_pad = jnp.concatenate([hf, jnp.zeros((1, d), hf.dtype)], axis=0)
    xb = h_pad[tok_buf].reshape(n_blocks, MOE_BLOCK, d)

    def expert_block(args):
        x_blk, e = args
        gu = x_blk @ w1[e] + b1[e]
        gate, up = jnp.split(gu, 2, axis=-1)
        gate = jnp.minimum(gate, SWIGLU_LIMIT)
        up = jnp.clip(up, -SWIGLU_LIMIT, SWIGLU_LIMIT)
        act = gate * jax.nn.sigmoid(SWIGLU_ALPHA * gate) * (up + 1.0)
        return act @ w2[e] + b2[e]

    yb = lax.map(expert_block, (xb, block_exp)).reshape(m_pad, d)
    yb = yb * gate_buf[:, None].astype(yb.dtype)
    y = jax.ops.segment_sum(yb, tok_buf, num_segments=n_tok + 1)[:n_tok]
    return y.reshape(bsz, t, d)


def setup_inputs(seed: int = 0) -> dict:
    key = jax.random.key(seed)
    ks = jax.random.split(key, 24)
    nrm = lambda k, shape, s: jax.random.normal(k, shape, jnp.float32) * s
    dt = jnp.exp(jax.random.uniform(ks[6], (DEPTH, 2, DN_HEADS), jnp.float32,
                                    math.log(1e-3), math.log(1e-1)))
    return {
        "x": nrm(ks[0], (BATCH, SEQ, D_MODEL), 1.0),
        "c": nrm(ks[1], (BATCH, D_MODEL), 1.0),
        "ada_w": nrm(ks[2], (DEPTH, D_MODEL, 6 * D_MODEL), 0.5 * D_MODEL ** -0.5),
        "ada_b": nrm(ks[3], (DEPTH, 6 * D_MODEL), 0.02),
        "norm1_w": 1.0 + nrm(ks[4], (DEPTH, D_MODEL), 0.02),
        "w_in": nrm(ks[5], (DEPTH, D_MODEL, IN_WIDTH), D_MODEL ** -0.5),
        "conv_qkv_w": nrm(ks[7], (DEPTH, DN_CONV, 3 * DN_WIDTH), DN_CONV ** -0.5),
        "a_log": jnp.log(jax.random.uniform(ks[8], (DEPTH, 2, DN_HEADS), jnp.float32, 1.0, 16.0)),
        "dt_bias": dt + jnp.log(-jnp.expm1(-dt)),
        "onorm_w": 1.0 + nrm(ks[9], (DEPTH, DN_HEAD_DIM), 0.02),
        "w_up_a": nrm(ks[10], (DEPTH, DN_WIDTH, D_MODEL), DN_WIDTH ** -0.5),
        "conv_sc_w": nrm(ks[11], (DEPTH, SC_CONV, SC_WIDTH), SC_CONV ** -0.5),
        "w_out_sc": nrm(ks[12], (DEPTH, SC_WIDTH, D_MODEL), SC_WIDTH ** -0.5),
        "w_o": nrm(ks[13], (DEPTH, D_MODEL, D_MODEL), D_MODEL ** -0.5),
        "norm2_w": 1.0 + nrm(ks[14], (DEPTH, D_MODEL), 0.02),
        "router_w": nrm(ks[15], (DEPTH, D_MODEL, N_EXPERTS), D_MODEL ** -0.5),
        "router_b": nrm(ks[16], (DEPTH, N_EXPERTS), 0.01),
        "moe_w1": nrm(ks[17], (DEPTH, N_EXPERTS, D_MODEL, 2 * D_FF), D_MODEL ** -0.5),
        "moe_b1": nrm(ks[18], (DEPTH, N_EXPERTS, 2 * D_FF), 0.01),
        "moe_w2": nrm(ks[19], (DEPTH, N_EXPERTS, D_FF, D_MODEL), D_FF ** -0.5),
        "moe_b2": nrm(ks[20], (DEPTH, N_EXPERTS, D_MODEL), 0.01),
        "final_norm_w": 1.0 + nrm(ks[21], (D_MODEL,), 0.02),
    }


def reference(x, c, ada_w, ada_b, norm1_w, w_in, conv_qkv_w, a_log, dt_bias, onorm_w, w_up_a,
              conv_sc_w, w_out_sc, w_o, norm2_w, router_w, router_b, moe_w1, moe_b1, moe_w2,
              moe_b2, final_norm_w):
    c_act = jax.nn.silu(c)
    for l in range(DEPTH):
        mod = c_act @ ada_w[l] + ada_b[l]
        sh_m, sc_m, gt_m, sh_f, sc_f, gt_f = (m[:, None, :] for m in jnp.split(mod, 6, axis=-1))
        h = rmsnorm(x, norm1_w[l]) * (1.0 + sc_m) + sh_m
        x = x + gt_m * hybrid_mixer(h, w_in[l], conv_qkv_w[l], a_log[l], dt_bias[l], onorm_w[l],
                                    w_up_a[l], conv_sc_w[l], w_out_sc[l], w_o[l])
        h = rmsnorm(x, norm2_w[l]) * (1.0 + sc_f) + sh_f
        x = x + gt_f * moe_ffn(h, router_w[l], router_b[l], moe_w1[l], moe_b1[l], moe_w2[l], moe_b2[l])
    return rmsnorm(x, final_norm_w)
```

```cpp
#include <hip/hip_runtime.h>
#include <cstdio>
#include <cstdint>
namespace pg8 {
#define PG8_LAS __attribute__((address_space(3)))
typedef unsigned short bf16_t;
typedef short bf16x8 __attribute__((ext_vector_type(8)));
typedef float f32x4 __attribute__((ext_vector_type(4)));
typedef unsigned u32x4 __attribute__((ext_vector_type(4)));
constexpr int BM = 256, BK = 64, HALF = 128, HTB = HALF * BK * 2  , STAGE_BYTES = 8 * HTB, NXCD = 8, WGM = 8;

__host__ __device__ __forceinline__ int lds_byte(int r, int c) { const int st = (r >> 4) * 2 + (c >> 5), rr = r & 15, cc = c & 31, ob = rr * 64 + cc * 2; return st * 1024 + (ob ^ (((ob >> 9) & 1) << 5)); }
__host__ __device__ __forceinline__ void stage_rc(int b, int& R, int& C) { const int st = b / 1024, sb = b % 1024, swz = sb ^ (((sb >> 9) & 1) << 5); R = (st >> 1) * 16 + swz / 64; C = (st & 1) * 32 + (swz % 64) / 2; }
__host__ __device__ __forceinline__ int perm32(int rho) { const int n = rho >> 4, i = rho & 15; return 8 * (i >> 2) + 4 * n + (i & 3); }

struct Unit { int pm, pn; };
struct Gemm { const bf16_t* A; const bf16_t* Bt; int M, N, K; };

struct StaticOrder {
    int nM, nN, nwg, G, c;
    __host__ __device__ void init(int M, int N, int G_, int c_) { nM = M / BM; nN = N / BM; nwg = nM * nN; G = G_; c = c_; }
    __host__ __device__ bool next(int i, Unit& u) const {
        const long L = (long)i * G + c; if (L >= nwg) return false;
        int wgid = (int)L; { const int q = nwg / NXCD, r = nwg % NXCD, xcd = wgid % NXCD, off = wgid / NXCD; wgid = (xcd < r ? xcd * (q + 1) : r * (q + 1) + (xcd - r) * q) + off; }
        const int nig = WGM * nN, gid = wgid / nig, fm = gid * WGM, gsz = (nM - fm) < WGM ? (nM - fm) : WGM;
        u.pm = fm + ((wgid % nig) % gsz); u.pn = (wgid % nig) / gsz; return true;
    }
    __device__ __forceinline__ void a_ready(const Unit&) const {}
    __device__ __forceinline__ void done(const Unit&) const {}
};

__device__ __forceinline__ unsigned cvt_pk_bf16(float lo, float hi) { unsigned r; asm volatile("v_cvt_pk_bf16_f32 %0, %1, %2" : "=v"(r) : "v"(lo), "v"(hi)); return r; }
template <class Epi, class Sched, bool ALIGN_EPI = false, bool SP2 = false>
__device__ __forceinline__ void gemm_phase(PG8_LAS unsigned char* lds, const Gemm g, const Sched& S, const Epi& E) {
    const int tid = threadIdx.x, wid = __builtin_amdgcn_readfirstlane(tid >> 6), lane = tid & 63, wr = wid >> 2, wc = wid & 3, fr = lane & 15, fq = lane >> 4;
    const int K = g.K, nt = K / BK;
    unsigned voffA[2], voffB[2];
#pragma unroll
    for (int i = 0; i < 2; ++i) { int R, C; stage_rc(tid * 16 + i * 8192, R, C); const int Rb = Epi::PERM ? ((R & ~31) + perm32(R & 31)) : R;
        voffA[i] = (unsigned)(R * K + C) * 2u; voffB[i] = (unsigned)(Rb * K + C) * 2u; }
    const size_t kstep = (size_t)(BK * 2);
    const size_t hstep = (size_t)HALF * K * 2;
    const size_t tstep = 2 * hstep;
    const unsigned ldsw = (unsigned)wid * 1024u;
    const int aoff = lds_byte(wr * 64 + fr, fq * 8), boff = lds_byte(wc * 32 + fr, fq * 8);
#define PG8_SA(b, h) (((b) * 2 + (h)) * HTB)
#define PG8_SB(b, h) ((4 + (b) * 2 + (h)) * HTB)
#define PG8_STAGE(bufoff, gbase, voff) do { _Pragma("unroll") for (int _i = 0; _i < 2; ++_i) \
        __builtin_amdgcn_global_load_lds((const unsigned*)((const char*)(gbase) + (voff)[_i]), (PG8_LAS unsigned*)(lds + (bufoff) + ldsw + _i * 8192), 16, 0, 0); } while (0)
#define PG8_LDA(dst, b, h) do { _Pragma("unroll") for (int m = 0; m < 4; ++m) _Pragma("unroll") for (int k = 0; k < 2; ++k) dst[m][k] = *(const PG8_LAS bf16x8*)(lds + PG8_SA(b, h) + aoff + m * 2048 + k * 1024); } while (0)
#define PG8_LDB(dst, b, h) do { _Pragma("unroll") for (int n = 0; n < 2; ++n) _Pragma("unroll") for (int k = 0; k < 2; ++k) dst[n][k] = *(const PG8_LAS bf16x8*)(lds + PG8_SB(b, h) + boff + n * 2048 + k * 1024); } while (0)
#define PG8_MMA(ai, bj, At, Bt) do { __builtin_amdgcn_s_setprio(1); _Pragma("unroll") for (int m = 0; m < 4; ++m) _Pragma("unroll") for (int n = 0; n < 2; ++n) _Pragma("unroll") for (int k = 0; k < 2; ++k) \
        acc[ai][bj][m][n] = __builtin_amdgcn_mfma_f32_16x16x32_bf16(Bt[n][k], At[m][k], acc[ai][bj][m][n], 0, 0, 0); __builtin_amdgcn_s_setprio(0); } while (0)
#define PG8_WAIT_V(n) asm volatile("s_waitcnt vmcnt(" #n ")" ::: "memory")
#define PG8_WAIT_L(n) asm volatile("s_waitcnt lgkmcnt(" #n ")" ::: "memory")
#define PG8_BAR __builtin_amdgcn_s_barrier()
#define PG8_SCHED __builtin_amdgcn_sched_barrier(0)
    Unit cur, nxt; int ui = 0;
    if (!S.next(0, cur)) return;
    f32x4 acc[2][2][4][2];
#pragma unroll
    for (int a = 0; a < 2; ++a)
#pragma unroll
        for (int b = 0; b < 2; ++b)
#pragma unroll
            for (int m = 0; m < 4; ++m)
#pragma unroll
                for (int n = 0; n < 2; ++n) acc[a][b][m][n] = (f32x4){0.f, 0.f, 0.f, 0.f};
    bf16x8 At[4][2], B0[2][2], B1[2][2];
    const char* cA = (const char*)g.A + (size_t)cur.pm * tstep; const char* cB = (const char*)g.Bt + (size_t)cur.pn * tstep;
    S.a_ready(cur);
    if constexpr (SP2) {
        PG8_STAGE(PG8_SB(0, 0), cB, voffB); PG8_STAGE(PG8_SB(0, 1), cB + hstep, voffB); PG8_STAGE(PG8_SA(0, 0), cA, voffA); PG8_STAGE(PG8_SA(0, 1), cA + hstep, voffA);
        if (wr == 1) PG8_BAR;
        PG8_WAIT_V(2); PG8_BAR;
        PG8_STAGE(PG8_SB(1, 0), cB + kstep, voffB); PG8_STAGE(PG8_SA(1, 0), cA + kstep, voffA); PG8_STAGE(PG8_SB(1, 1), cB + hstep + kstep, voffB);
        PG8_WAIT_V(6); PG8_BAR;
    } else {
        PG8_STAGE(PG8_SB(0, 0), cB, voffB); PG8_STAGE(PG8_SA(0, 0), cA, voffA); PG8_STAGE(PG8_SB(0, 1), cB + hstep, voffB); PG8_STAGE(PG8_SA(0, 1), cA + hstep, voffA);
        if (wr == 1) PG8_BAR;
        PG8_WAIT_V(4); PG8_BAR;
        PG8_STAGE(PG8_SB(1, 0), cB + kstep, voffB); PG8_STAGE(PG8_SA(1, 0), cA + kstep, voffA); PG8_STAGE(PG8_SB(1, 1), cB + hstep + kstep, voffB);
        PG8_WAIT_V(6); PG8_BAR;
    }
    for (;;) {
        const bool has_next = S.next(ui + 1, nxt);
        const char* nA = has_next ? (const char*)g.A + (size_t)nxt.pm * tstep : cA; const char* nB = has_next ? (const char*)g.Bt + (size_t)nxt.pn * tstep : cB;
        for (int t = 0; t < nt; t += 2) {
            const bool last = (t == nt - 2);
            const char* a1 = cA + (size_t)(t + 1) * kstep;
            const char* a2 = last ? nA : cA + (size_t)(t + 2) * kstep; const char* b2 = last ? nB : cB + (size_t)(t + 2) * kstep;
            const char* a3 = a2 + kstep; const char* b3 = b2 + kstep;
            if (last && has_next) S.a_ready(nxt);
            if constexpr (SP2) {
            PG8_LDB(B0, 0, 0); PG8_LDB(B1, 0, 1); PG8_SCHED; PG8_LDA(At, 0, 0); PG8_STAGE(PG8_SA(1, 1), a1 + hstep, voffA);
            PG8_WAIT_V(8); PG8_WAIT_L(0); PG8_BAR; PG8_MMA(0, 0, At, B0); PG8_MMA(0, 1, At, B1); PG8_BAR; PG8_SCHED;
            PG8_LDA(At, 0, 1); PG8_STAGE(PG8_SB(0, 0), b2, voffB); PG8_STAGE(PG8_SB(0, 1), b2 + hstep, voffB); PG8_STAGE(PG8_SA(0, 0), a2, voffA);
            PG8_WAIT_V(8); PG8_WAIT_L(0); PG8_BAR; PG8_MMA(1, 0, At, B0); PG8_MMA(1, 1, At, B1); PG8_BAR; PG8_SCHED;
            PG8_LDB(B0, 1, 0); PG8_LDB(B1, 1, 1); PG8_SCHED; PG8_LDA(At, 1, 0); PG8_STAGE(PG8_SA(0, 1), a2 + hstep, voffA);
            PG8_WAIT_V(8); PG8_WAIT_L(0); PG8_BAR; PG8_MMA(0, 0, At, B0); PG8_MMA(0, 1, At, B1); PG8_BAR; PG8_SCHED;
            PG8_LDA(At, 1, 1); PG8_STAGE(PG8_SB(1, 0), b3, voffB); PG8_STAGE(PG8_SB(1, 1), b3 + hstep, voffB); PG8_STAGE(PG8_SA(1, 0), a3, voffA);
            PG8_WAIT_V(8); PG8_WAIT_L(0); PG8_BAR; PG8_MMA(1, 0, At, B0); PG8_MMA(1, 1, At, B1); PG8_BAR; PG8_SCHED;
            } else {
            PG8_LDB(B0, 0, 0); PG8_SCHED; PG8_LDA(At, 0, 0); PG8_STAGE(PG8_SA(1, 1), a1 + hstep, voffA);
            PG8_WAIT_L(8); PG8_BAR; PG8_WAIT_L(0); PG8_MMA(0, 0, At, B0); PG8_BAR; PG8_SCHED;
            PG8_LDB(B1, 0, 1); PG8_STAGE(PG8_SB(0, 0), b2, voffB);
            PG8_BAR; PG8_WAIT_L(0); PG8_MMA(0, 1, At, B1); PG8_BAR;
            PG8_LDA(At, 0, 1); PG8_STAGE(PG8_SA(0, 0), a2, voffA);
            PG8_BAR; PG8_WAIT_L(0); PG8_MMA(1, 0, At, B0); PG8_BAR; PG8_SCHED;
            PG8_STAGE(PG8_SB(0, 1), b2 + hstep, voffB);
            PG8_WAIT_V(6); PG8_BAR; PG8_MMA(1, 1, At, B1); PG8_BAR;
            PG8_LDB(B0, 1, 0); PG8_SCHED; PG8_LDA(At, 1, 0); PG8_STAGE(PG8_SA(0, 1), a2 + hstep, voffA);
            PG8_WAIT_L(8); PG8_BAR; PG8_WAIT_L(0); PG8_MMA(0, 0, At, B0); PG8_BAR; PG8_SCHED;
            PG8_LDB(B1, 1, 1); PG8_STAGE(PG8_SB(1, 0), b3, voffB);
            PG8_BAR; PG8_WAIT_L(0); PG8_MMA(0, 1, At, B1); PG8_BAR;
            PG8_LDA(At, 1, 1); PG8_STAGE(PG8_SA(1, 0), a3, voffA);
            PG8_BAR; PG8_WAIT_L(0); PG8_MMA(1, 0, At, B0); PG8_BAR; PG8_SCHED;
            PG8_STAGE(PG8_SB(1, 1), b3 + hstep, voffB);
            PG8_WAIT_V(6); PG8_BAR; PG8_MMA(1, 1, At, B1); PG8_BAR;
            }
        }
        if constexpr (ALIGN_EPI) { if (wr == 0) PG8_BAR; }
        if constexpr (!Epi::AFTER_DRAIN) { E(acc, cur, wr, wc, fr, fq); S.done(cur); }
        if (!has_next) break;
#pragma unroll
        for (int a = 0; a < 2; ++a)
#pragma unroll
            for (int b = 0; b < 2; ++b)
#pragma unroll
                for (int m = 0; m < 4; ++m)
#pragma unroll
                    for (int n = 0; n < 2; ++n) acc[a][b][m][n] = (f32x4){0.f, 0.f, 0.f, 0.f};
        cur = nxt; cA = nA; cB = nB; ++ui;
        if constexpr (ALIGN_EPI) { if (wr == 1) PG8_BAR; }
    }
    PG8_WAIT_V(0);
    if constexpr (!ALIGN_EPI) { if (wr == 0) PG8_BAR; }
    PG8_BAR;
    if constexpr (Epi::AFTER_DRAIN) { E.fused(acc, cur, wr, wc, fr, fq, lds, wid, lane); S.done(cur); }
#undef PG8_SA
#undef PG8_SB
#undef PG8_STAGE
#undef PG8_LDA
#undef PG8_LDB
#undef PG8_MMA
#undef PG8_WAIT_V
#undef PG8_WAIT_L
#undef PG8_BAR
#undef PG8_SCHED
}
}

#define XB_TMO      128
#define XB_XCNT(j)  (256  + 64 * (j))
#define XB_XSUB(j)  (1280 + 64 * (j))
#define XB_XGEN(j)  (2304 + 64 * (j))
#define XB_TOP      3328
#define XB_TOPGEN   3392
#define XCD_BAR_WORDS 3456
#define XB_SPIN_CAP (1u << 18)
#define LAS __attribute__((address_space(3)))

__device__ __forceinline__ unsigned xb_ld(unsigned* p)              { return __hip_atomic_load(p, __ATOMIC_RELAXED, __HIP_MEMORY_SCOPE_AGENT); }
__device__ __forceinline__ unsigned xb_add(unsigned* p, unsigned v) { return __hip_atomic_fetch_add(p, v, __ATOMIC_RELAXED, __HIP_MEMORY_SCOPE_AGENT); }
__device__ __forceinline__ unsigned xb_xcc_id() { return (unsigned)__builtin_amdgcn_s_getreg((3 << 11) | 20) & 0xFu; }
#define XB_SPIN(cond, bar) do { unsigned _sp = 0; while (cond) { __builtin_amdgcn_s_sleep(1); \
    if ((++_sp & 255u) == 0u) { if (xb_ld(&(bar)[XB_TMO])) break; if (_sp > XB_SPIN_CAP) { atomicAdd(&(bar)[XB_TMO], 1u); break; } } } } while (0)

struct XcdBarrier {
    unsigned* bar; unsigned x;
    volatile LAS unsigned* st;
};

__device__ __forceinline__ XcdBarrier xcd_barrier_post(unsigned* bar, volatile LAS unsigned* st) {
    XcdBarrier b; b.bar = bar; b.x = xb_xcc_id(); b.st = st;
    if (threadIdx.x == 0) (void)xb_add(&bar[XB_XCNT(b.x)], 1u);
    return b;
}
__device__ __forceinline__ void xcd_barrier_complete(unsigned* bar, unsigned x, unsigned& nloc, unsigned& nx) {
    const unsigned G = gridDim.x * gridDim.y * gridDim.z;
    unsigned sum, cnt, mine, sp = 0u;
    for (;;) {
        sum = 0u; cnt = 0u; mine = 0u;
#pragma unroll
        for (unsigned j = 0; j < 16; ++j) { const unsigned c = xb_ld(&bar[XB_XCNT(j)]); sum += c; cnt += (c > 0u) ? 1u : 0u; mine = (j == x) ? c : mine; }
        if (sum == G) break;
        __builtin_amdgcn_s_sleep(1);
        if ((++sp & 255u) == 0u) { if (xb_ld(&bar[XB_TMO])) break; if (sp > XB_SPIN_CAP) { atomicAdd(&bar[XB_TMO], 1u); break; } }
    }
    nloc = mine > 0u ? mine : 1u; nx = cnt > 0u ? cnt : 1u;
}

__device__ __forceinline__ void xcd_barrier(const XcdBarrier& b) {
    asm volatile("s_waitcnt vmcnt(0)" ::: "memory");
    __syncthreads();
    if (threadIdx.x == 0) {
        unsigned* bar = b.bar;
        __builtin_amdgcn_s_waitcnt(0);
        unsigned nloc = b.st[0], nx = b.st[1];
        if (nloc == 0u) { xcd_barrier_complete(bar, b.x, nloc, nx); b.st[0] = nloc; b.st[1] = nx; }
        const unsigned old = xb_add(&bar[XB_XSUB(b.x)], 1u);
        const unsigned gen = old / nloc;
        if (old + 1u == (gen + 1u) * nloc) {
            __builtin_amdgcn_fence(__ATOMIC_RELEASE, "agent");
            asm volatile("s_waitcnt vmcnt(0)" ::: "memory");
            const unsigned og = xb_add(&bar[XB_TOP], 1u);
            const unsigned tg = og / nx;
            if (og + 1u == (tg + 1u) * nx) xb_add(&bar[XB_TOPGEN], 1u);
            else XB_SPIN(xb_ld(&bar[XB_TOPGEN]) == tg, bar);
            __builtin_amdgcn_fence(__ATOMIC_ACQUIRE, "agent");
            xb_add(&bar[XB_XGEN(b.x)], 1u);
            asm volatile("s_waitcnt vmcnt(0)" ::: "memory");
        } else {
            XB_SPIN(xb_ld(&bar[XB_XGEN(b.x)]) == gen, bar);
            __builtin_amdgcn_fence(__ATOMIC_ACQUIRE, "agent");
            asm volatile("s_waitcnt vmcnt(0)" ::: "memory");
        }
    }
    __syncthreads();
}

#ifndef MK_N_LAUNCHES
#define MK_N_LAUNCHES 1
#endif
constexpr int NPHASE = 13;
constexpr int NWAVES = 8, NTHR = 512;
constexpr int D = 1024, SEQ = 8192, NTOK = 16384, NH = 8, HD = 128, CH = 64, NCHUNK = 128;
constexpr int PW = 9216;
constexpr int PC_Q = 0, PC_K = 1024, PC_V = 2048, PC_Z = 3072, PC_BG = 4096, PC_CG = 5120, PC_UI = 6144, PC_GA = 7168, PC_GB = 8192;
constexpr int INW = 9248;
constexpr int NEXP = 32, TOPK = 4, MROWS = 73728;
constexpr float EPS = 1e-6f;

constexpr size_t MiB = 1u << 20;
constexpr size_t WS_CTL = 0, CTL_ZERO_BYTES = 1 * MiB;
constexpr size_t WS_MOD = 1 * MiB;
constexpr size_t WS_WSM_T = 1 * MiB + 64 * 1024;
constexpr size_t WS_WR_T = 1 * MiB + 192 * 1024;
constexpr size_t WS_TOPI = 2 * MiB;
constexpr size_t WS_TOPG = 2 * MiB + 256 * 1024;
constexpr size_t WS_TOPP = 2 * MiB + 512 * 1024;
constexpr size_t WS_PSM = 3 * MiB;
constexpr size_t WS_GL = 5 * MiB;
constexpr size_t WS_WIN_T = 8 * MiB;
constexpr size_t WS_WUO_T = 26 * MiB;
constexpr size_t WS_WO_T = 30 * MiB;
constexpr size_t WS_W1T = 32 * MiB;
constexpr size_t WS_W2T = 160 * MiB;
constexpr size_t WS_H = 224 * MiB;
constexpr size_t WS_OD = 256 * MiB;
constexpr size_t WS_P = 320 * MiB;
constexpr size_t WS_DD = 608 * MiB;
constexpr size_t WS_END = 896 * MiB;
constexpr size_t DD_UNIT = 73728;
constexpr size_t DD_QD = 0, DD_KD = 16384, DD_W = 32768, DD_U = 49152, DD_A = 65536;
constexpr size_t WS_OASB = WS_DD, WS_M1 = WS_DD + 64 * MiB, WS_M = WS_DD + 128 * MiB;
constexpr size_t WS_XS = WS_P, WS_ACT = WS_P + 144 * MiB, WS_YS = WS_DD;
constexpr int CW_BAR = 4096;
constexpr int CW_CNT = 16384;

constexpr int LDS_BYTES = 155648;
constexpr int LDS_MISC = 152 * 1024 - 256;
constexpr int LDS_TAB = 131072;

#define GAS __attribute__((address_space(1)))
#define LAS __attribute__((address_space(3)))
typedef unsigned short bf16;
typedef float f4 __attribute__((ext_vector_type(4)));
typedef unsigned u4 __attribute__((ext_vector_type(4)));
typedef unsigned u2 __attribute__((ext_vector_type(2)));

__device__ __forceinline__ unsigned f2bf(float f) { unsigned u = __float_as_uint(f); return (u + 0x7fffu + ((u >> 16) & 1u)) >> 16; }
__device__ __forceinline__ unsigned pk2(float lo, float hi) { return f2bf(lo) | (f2bf(hi) << 16); }
__device__ __forceinline__ float bflo(unsigned w) { return __uint_as_float(w << 16); }
__device__ __forceinline__ float bfhi(unsigned w) { return __uint_as_float(w & 0xffff0000u); }
__device__ __forceinline__ float bf1(bf16 b) { return __uint_as_float(((unsigned)b) << 16); }
__device__ __forceinline__ void unpack8(const u4 w, float (&o)[8]) { o[0] = bflo(w.x); o[1] = bfhi(w.x); o[2] = bflo(w.y); o[3] = bfhi(w.y); o[4] = bflo(w.z); o[5] = bfhi(w.z); o[6] = bflo(w.w); o[7] = bfhi(w.w); }
__device__ __forceinline__ u4 pack8(const float (&o)[8]) { u4 w; w.x = pk2(o[0], o[1]); w.y = pk2(o[2], o[3]); w.z = pk2(o[4], o[5]); w.w = pk2(o[6], o[7]); return w; }
__device__ __forceinline__ float wave_sum(float v) {
#pragma unroll
    for (int o = 1; o < 64; o <<= 1) v += __shfl_xor(v, o);
    return v;
}
__device__ __forceinline__ float sigm(float x) { return 1.0f / (1.0f + __expf(-x)); }
__device__ __forceinline__ float silu(float x) { return x / (1.0f + __expf(-x)); }
__device__ __forceinline__ float softplus(float x) { return x > 20.f ? x : log1pf(expf(x)); }

struct Args { const float* in[22]; float* out; unsigned char* ws; int ph_lo, ph_hi; };

struct Frame {
    LAS unsigned char* lds;
    int tid, lane, wave, G;
    unsigned char* ws;
};

__device__ __forceinline__ void p0_transpose_item(const float* W, int ldw, int k0, int n0s, bf16* WT, size_t drow0, LAS float* scr, int lane) {
#pragma unroll 8
    for (int i = 0; i < 32; ++i) { const int kk = 2 * i + (lane >> 5); scr[kk * 33 + (lane & 31)] = W[(size_t)(k0 + kk) * ldw + n0s + (lane & 31)]; }
    asm volatile("s_waitcnt lgkmcnt(0)" ::: "memory");
    const int c = lane & 7;
#pragma unroll
    for (int j = 0; j < 4; ++j) { const int n = (lane >> 3) + 8 * j; const LAS float* s = scr + (8 * c) * 33 + n;
        u4 o; o.x = pk2(s[0 * 33], s[1 * 33]); o.y = pk2(s[2 * 33], s[3 * 33]); o.z = pk2(s[4 * 33], s[5 * 33]); o.w = pk2(s[6 * 33], s[7 * 33]);
        *(u4*)(WT + (drow0 + n) * 1024 + k0 + 8 * c) = o; }
    asm volatile("s_waitcnt lgkmcnt(0)" ::: "memory");
}

__device__ __forceinline__ void phase_p0(Frame& F, const Args& AR) {
    const float* c_in = AR.in[1]; const float* ada_w = AR.in[2]; const float* ada_b = AR.in[3];
    const float* w_in = AR.in[5];
    for (int task = blockIdx.x; task < 192; task += F.G) {
        LAS float* red = (LAS float*)(F.lds + 131072);
        const int j0 = 32 * task, col = j0 + (F.lane & 31), kh = F.lane >> 5;
        float a0 = 0.f, a1 = 0.f;
#pragma unroll 8
        for (int i = 0; i < 64; ++i) { const int k = 128 * F.wave + 2 * i + kh; const float wv = ada_w[(size_t)k * 6144 + col];
            a0 += silu(c_in[k]) * wv; a1 += silu(c_in[1024 + k]) * wv; }
        a0 += __shfl_xor(a0, 32); a1 += __shfl_xor(a1, 32);
        if (F.lane < 32) { red[(F.wave * 2 + 0) * 32 + F.lane] = a0; red[(F.wave * 2 + 1) * 32 + F.lane] = a1; }
        __syncthreads();
        if (F.tid < 64) { const int b = F.tid >> 5, cc = F.tid & 31; float s = 0.f;
#pragma unroll
            for (int w = 0; w < 8; ++w) s += red[(w * 2 + b) * 32 + cc];
            ((float*)(F.ws + WS_MOD))[b * 6144 + j0 + cc] = s + ada_b[j0 + cc]; }
        __syncthreads();
    }
    {
        const float* router_w = AR.in[15]; float* wsm = (float*)(F.ws + WS_WSM_T); float* wr = (float*)(F.ws + WS_WR_T);
        for (int idx = blockIdx.x * NTHR + F.tid; idx < 65536; idx += F.G * NTHR) { const int which = idx >> 15, r = idx & 32767, k = r >> 5, n = r & 31;
            if (which == 0) wsm[n * 1024 + k] = w_in[(size_t)k * INW + 4096 + n]; else wr[n * 1024 + k] = router_w[k * 32 + n]; }
    }
    LAS float* scr = (LAS float*)(F.lds + F.wave * 16384);
    const int gw = blockIdx.x * NWAVES + F.wave, NGW = F.G * NWAVES;
    constexpr int I_IN = 16 * 288, I_SQ = 16 * 32, I_W1 = 32 * 16 * 64, I_W2 = 32 * 16 * 32;
    constexpr int NITEMS = I_IN + 3 * I_SQ + I_W1 + I_W2;
    for (int it = gw; it < NITEMS; it += NGW) {
        int r = it;
        if (r < I_IN) { const int kb = r / 288, nb = r % 288, n0 = 32 * nb; p0_transpose_item(w_in, INW, 64 * kb, n0 + (n0 >= 4096 ? 32 : 0), (bf16*)(F.ws + WS_WIN_T), (size_t)n0, scr, F.lane); continue; } r -= I_IN;
        if (r < I_SQ) { const int kb = r / 32, nb = r % 32; p0_transpose_item(AR.in[10], 1024, 64 * kb, 32 * nb, (bf16*)(F.ws + WS_WUO_T), (size_t)(32 * nb), scr, F.lane); continue; } r -= I_SQ;
        if (r < I_SQ) { const int kb = r / 32, nb = r % 32; p0_transpose_item(AR.in[12], 1024, 64 * kb, 32 * nb, (bf16*)(F.ws + WS_WUO_T), (size_t)(1024 + 32 * nb), scr, F.lane); continue; } r -= I_SQ;
        if (r < I_SQ) { const int kb = r / 32, nb = r % 32; p0_transpose_item(AR.in[13], 1024, 64 * kb, 32 * nb, (bf16*)(F.ws + WS_WO_T), (size_t)(32 * nb), scr, F.lane); continue; } r -= I_SQ;
        if (r < I_W1) { const int e = r / 1024, q = r % 1024, kb = q / 64, nb = q % 64, n0 = 32 * nb, half = n0 >> 10, j = n0 & 1023;
            p0_transpose_item(AR.in[17] + (size_t)e * 1024 * 2048, 2048, 64 * kb, n0, (bf16*)(F.ws + WS_W1T), (size_t)e * 2048 + (size_t)((j >> 7) * 256 + half * 128 + (j & 127)), scr, F.lane); continue; } r -= I_W1;
        { const int e = r / 512, q = r % 512, kb = q / 32, nb = q % 32;
            p0_transpose_item(AR.in[19] + (size_t)e * 1024 * 1024, 1024, 64 * kb, 32 * nb, (bf16*)(F.ws + WS_W2T), (size_t)e * 1024 + (size_t)(32 * nb), scr, F.lane); }
    }
}

__device__ __forceinline__ void stage_wt(LAS float* WtL, const float* WT, int tid) {
    for (int idx = tid; idx < 32 * 256; idx += NTHR) { const int n = idx >> 8, k4 = idx & 255; const f4 v = *(const f4*)(WT + n * 1024 + 4 * k4); *(LAS f4*)(WtL + n * 1028 + 4 * k4) = v; }
}
__device__ __forceinline__ float dot32(const f4 (&v)[4], const LAS float* WtL, int lane) {
    float p[32];
#pragma unroll
    for (int n = 0; n < 32; ++n) { float s = 0.f;
#pragma unroll
        for (int j = 0; j < 4; ++j) { const f4 w = *(const LAS f4*)(WtL + n * 1028 + 256 * j + 4 * lane); s += v[j].x * w.x + v[j].y * w.y + v[j].z * w.z + v[j].w * w.w; }
        p[n] = s; if ((n & 3) == 3) asm volatile("" : "+v"(p[n - 3]), "+v"(p[n - 2]), "+v"(p[n - 1]), "+v"(p[n]) :: "memory"); }
#pragma unroll
    for (int i = 0; i < 16; ++i) { const bool hi = (lane & 32) != 0; const float send = hi ? p[i] : p[i + 16], keep = hi ? p[i + 16] : p[i]; p[i] = keep + __shfl_xor(send, 32); }
#pragma unroll
    for (int i = 0; i < 8; ++i) { const bool hi = (lane & 16) != 0; const float send = hi ? p[i] : p[i + 8], keep = hi ? p[i + 8] : p[i]; p[i] = keep + __shfl_xor(send, 16); }
#pragma unroll
    for (int i = 0; i < 4; ++i) { const bool hi = (lane & 8) != 0; const float send = hi ? p[i] : p[i + 4], keep = hi ? p[i + 4] : p[i]; p[i] = keep + __shfl_xor(send, 8); }
#pragma unroll
    for (int i = 0; i < 2; ++i) { const bool hi = (lane & 4) != 0; const float send = hi ? p[i] : p[i + 2], keep = hi ? p[i + 2] : p[i]; p[i] = keep + __shfl_xor(send, 4); }
    { const bool hi = (lane & 2) != 0; const float send = hi ? p[0] : p[1], keep = hi ? p[1] : p[0]; p[0] = keep + __shfl_xor(send, 2); }
    p[0] += __shfl_xor(p[0], 1);
    return p[0];
}

__device__ __forceinline__ void phase_p1(Frame& F, const Args& AR) {
    const float* x = AR.in[0]; const float* norm1_w = AR.in[4]; const float* mod = (const float*)(F.ws + WS_MOD);
    LAS float* WtL = (LAS float*)F.lds;
    LAS float* A1 = (LAS float*)(F.lds + 131584);
    LAS float* B1 = A1 + 2048;
    stage_wt(WtL, (const float*)(F.ws + WS_WSM_T), F.tid);
    for (int idx = F.tid; idx < 2048; idx += NTHR) { const int b = idx >> 10, k = idx & 1023; A1[idx] = norm1_w[k] * (1.0f + mod[b * 6144 + 1024 + k]); B1[idx] = mod[b * 6144 + k]; }
    __syncthreads();
    bf16* h = (bf16*)(F.ws + WS_H); float* psm = (float*)(F.ws + WS_PSM);
    const int gw = blockIdx.x * NWAVES + F.wave, NGW = F.G * NWAVES;
    for (int m = gw; m < NTOK; m += NGW) {
        const f4* xr = (const f4*)(x + (size_t)m * D) + F.lane; f4 v[4]; float ss = 0.f;
#pragma unroll
        for (int j = 0; j < 4; ++j) { v[j] = xr[64 * j]; ss += (v[j].x * v[j].x + v[j].y * v[j].y) + (v[j].z * v[j].z + v[j].w * v[j].w); }
        const float rstd = 1.0f / sqrtf(wave_sum(ss) * (1.0f / D) + EPS);
        const int b = m >> 13;
#pragma unroll
        for (int j = 0; j < 4; ++j) { const f4 a = *(const LAS f4*)(A1 + b * 1024 + 256 * j + 4 * F.lane), bb = *(const LAS f4*)(B1 + b * 1024 + 256 * j + 4 * F.lane);
            v[j] = v[j] * rstd * a + bb;
            u2 o; o.x = pk2(v[j].x, v[j].y); o.y = pk2(v[j].z, v[j].w); ((u2*)(h + (size_t)m * D))[F.lane + 64 * j] = o; }
        const float tot = dot32(v, WtL, F.lane);
        if (!(F.lane & 1)) psm[(size_t)m * 32 + (F.lane >> 1)] = tot;
    }
}

struct EpiStoreBf16 {
    static constexpr bool PERM = true, AFTER_DRAIN = false;
    bf16* O; int ldc;
    __device__ __forceinline__ void operator()(const pg8::f32x4 (&acc)[2][2][4][2], const pg8::Unit& u, int wr, int wc, int fr, int fq) const {
        const int row0 = u.pm * 256 + wr * 64 + fr, col0 = u.pn * 256 + wc * 32 + 8 * fq;
#pragma unroll
        for (int ai = 0; ai < 2; ++ai)
#pragma unroll
            for (int m = 0; m < 4; ++m) { bf16* rowp = O + (size_t)(row0 + ai * 128 + m * 16) * ldc + col0;
#pragma unroll
                for (int bj = 0; bj < 2; ++bj) { const pg8::f32x4 v0 = acc[ai][bj][m][0], v1 = acc[ai][bj][m][1];
                    u4 w; w.x = pg8::cvt_pk_bf16(v0[0], v0[1]); w.y = pg8::cvt_pk_bf16(v0[2], v0[3]); w.z = pg8::cvt_pk_bf16(v1[0], v1[1]); w.w = pg8::cvt_pk_bf16(v1[2], v1[3]);
                    *(u4*)(rowp + bj * 128) = w; } }
    }
};
struct EpiG23 {
    static constexpr bool PERM = true, AFTER_DRAIN = false;
    const bf16* P; float* M1; bf16* Mo;
    __device__ __forceinline__ void operator()(const pg8::f32x4 (&acc)[2][2][4][2], const pg8::Unit& u, int wr, int wc, int fr, int fq) const {
        const int s = u.pm >= 64 ? 1 : 0, pm = u.pm - 64 * s, pn = u.pn - 4 * s;
        const int row0 = pm * 256 + wr * 64 + fr, col0 = pn * 256 + wc * 32 + 8 * fq, gcol = (s ? PC_GB : PC_GA) + col0;
#pragma unroll
        for (int ai = 0; ai < 2; ++ai)
#pragma unroll
            for (int m = 0; m < 4; ++m) { const int row = row0 + ai * 128 + m * 16;
#pragma unroll
                for (int bj = 0; bj < 2; ++bj) { const int col = col0 + bj * 128;
                    float g[8]; unpack8(*(const u4*)(P + (size_t)row * PW + gcol + bj * 128), g);
                    const pg8::f32x4 v0 = acc[ai][bj][m][0], v1 = acc[ai][bj][m][1];
                    float o[8];
#pragma unroll
                    for (int e = 0; e < 4; ++e) { o[e] = sigm(g[e]) * v0[e]; o[4 + e] = sigm(g[4 + e]) * v1[e]; }
                    float* mp = M1 + (size_t)row * D + col;
                    if (s == 0) { *(f4*)mp = (f4){o[0], o[1], o[2], o[3]}; *(f4*)(mp + 4) = (f4){o[4], o[5], o[6], o[7]}; }
                    else { const f4 p0 = *(const f4*)mp, p1 = *(const f4*)(mp + 4);
                        u4 w; w.x = pg8::cvt_pk_bf16(p0.x + o[0], p0.y + o[1]); w.y = pg8::cvt_pk_bf16(p0.z + o[2], p0.w + o[3]); w.z = pg8::cvt_pk_bf16(p1.x + o[4], p1.y + o[5]); w.w = pg8::cvt_pk_bf16(p1.z + o[6], p1.w + o[7]);
                        *(u4*)(Mo + (size_t)row * D + col) = w; } } }
    }
};
struct OrderG23 {
    pg8::StaticOrder S;
    __device__ __forceinline__ bool next(int i, pg8::Unit& u) const { if (i >= 2) return false; pg8::Unit t; if (!S.next(0, t)) return false; u.pm = t.pm + 64 * i; u.pn = t.pn + 4 * i; return true; }
    __device__ __forceinline__ void a_ready(const pg8::Unit&) const {}
    __device__ __forceinline__ void done(const pg8::Unit&) const {}
};
struct EpiG4 {
    static constexpr bool PERM = false, AFTER_DRAIN = false;
    const float* X; const float* mod; float* X1;
    __device__ __forceinline__ void operator()(const pg8::f32x4 (&acc)[2][2][4][2], const pg8::Unit& u, int wr, int wc, int fr, int fq) const {
        const int row0 = u.pm * 256 + wr * 64 + fr, col0 = u.pn * 256 + wc * 32 + 4 * fq; const int b = u.pm >> 5;
        f4 gt[2][2];
#pragma unroll
        for (int bj = 0; bj < 2; ++bj)
#pragma unroll
            for (int n = 0; n < 2; ++n) gt[bj][n] = *(const f4*)(mod + b * 6144 + 2048 + col0 + bj * 128 + n * 16);
#pragma unroll
        for (int ai = 0; ai < 2; ++ai)
#pragma unroll
            for (int m = 0; m < 4; ++m) { const size_t off = (size_t)(row0 + ai * 128 + m * 16) * D + col0;
#pragma unroll
                for (int bj = 0; bj < 2; ++bj)
#pragma unroll
                    for (int n = 0; n < 2; ++n) { const f4 xv = *(const f4*)(X + off + bj * 128 + n * 16); const pg8::f32x4 a = acc[ai][bj][m][n];
                        *(f4*)(X1 + off + bj * 128 + n * 16) = (f4){xv.x + gt[bj][n].x * a[0], xv.y + gt[bj][n].y * a[1], xv.z + gt[bj][n].z * a[2], xv.w + gt[bj][n].w * a[3]}; } }
    }
};
struct MoeOrder {
    int nM, nN, nwg, G, c; const LAS int* blk_exp;
    __device__ __forceinline__ void init(int nblk, int nN_, int G_, int c_, const LAS int* be) { nM = nblk; nN = nN_; nwg = nM * nN; G = G_; c = c_; blk_exp = be; }
    __device__ __forceinline__ bool next(int i, pg8::Unit& u) const {
        const long L = (long)i * G + c; if (L >= nwg) return false;
        int wgid = (int)L; { const int q = nwg / 8, r = nwg % 8, xcd = wgid % 8, off = wgid / 8; wgid = (xcd < r ? xcd * (q + 1) : r * (q + 1) + (xcd - r) * q) + off; }
        const int nig = 8 * nN, gid = wgid / nig, fm = gid * 8, gsz = (nM - fm) < 8 ? (nM - fm) : 8;
        const int pm = fm + ((wgid % nig) % gsz), pnl = (wgid % nig) / gsz;
        u.pm = pm; u.pn = blk_exp[pm] * nN + pnl; return true;
    }
    __device__ __forceinline__ void a_ready(const pg8::Unit&) const {}
    __device__ __forceinline__ void done(const pg8::Unit&) const {}
};
struct EpiMoe1 {
    static constexpr bool PERM = true, AFTER_DRAIN = false;
    const float* b1; bf16* ACT;
    __device__ __forceinline__ void operator()(const pg8::f32x4 (&acc)[2][2][4][2], const pg8::Unit& u, int wr, int wc, int fr, int fq) const {
        const int e = u.pn >> 3, pnl = u.pn & 7; const int row0 = u.pm * 256 + wr * 64 + fr, j0 = pnl * 128 + wc * 32 + 8 * fq;
        const float* bg = b1 + (size_t)e * 2048 + j0; const float* bu = bg + 1024;
        const f4 bg0 = *(const f4*)bg, bg1 = *(const f4*)(bg + 4), bu0 = *(const f4*)bu, bu1 = *(const f4*)(bu + 4);
        const float bgv[8] = {bg0.x, bg0.y, bg0.z, bg0.w, bg1.x, bg1.y, bg1.z, bg1.w}, buv[8] = {bu0.x, bu0.y, bu0.z, bu0.w, bu1.x, bu1.y, bu1.z, bu1.w};
#pragma unroll
        for (int ai = 0; ai < 2; ++ai)
#pragma unroll
            for (int m = 0; m < 4; ++m) { float o[8];
#pragma unroll
                for (int e8 = 0; e8 < 8; ++e8) { const int n = e8 >> 2, q = e8 & 3;
                    float g = acc[ai][0][m][n][q] + bgv[e8], up = acc[ai][1][m][n][q] + buv[e8];
                    g = fminf(g, 7.0f); up = fminf(fmaxf(up, -7.0f), 7.0f);
                    o[e8] = g * sigm(1.702f * g) * (up + 1.0f); }
                u4 w; w.x = pg8::cvt_pk_bf16(o[0], o[1]); w.y = pg8::cvt_pk_bf16(o[2], o[3]); w.z = pg8::cvt_pk_bf16(o[4], o[5]); w.w = pg8::cvt_pk_bf16(o[6], o[7]);
                *(u4*)(ACT + (size_t)(row0 + ai * 128 + m * 16) * D + j0) = w; }
    }
};
struct EpiMoe2 {
    static constexpr bool PERM = true, AFTER_DRAIN = false;
    const float* b2; bf16* YS;
    __device__ __forceinline__ void operator()(const pg8::f32x4 (&acc)[2][2][4][2], const pg8::Unit& u, int wr, int wc, int fr, int fq) const {
        const int e = u.pn >> 2, pnl = u.pn & 3; const int row0 = u.pm * 256 + wr * 64 + fr, col0 = pnl * 256 + wc * 32 + 8 * fq;
        f4 bv[2][2];
#pragma unroll
        for (int bj = 0; bj < 2; ++bj)
#pragma unroll
            for (int n = 0; n < 2; ++n) bv[bj][n] = *(const f4*)(b2 + (size_t)e * D + col0 + bj * 128 + 4 * n);
#pragma unroll
        for (int ai = 0; ai < 2; ++ai)
#pragma unroll
            for (int m = 0; m < 4; ++m) { bf16* rowp = YS + (size_t)(row0 + ai * 128 + m * 16) * D + col0;
#pragma unroll
                for (int bj = 0; bj < 2; ++bj) { const pg8::f32x4 v0 = acc[ai][bj][m][0], v1 = acc[ai][bj][m][1];
                    u4 w; w.x = pg8::cvt_pk_bf16(v0[0] + bv[bj][0].x, v0[1] + bv[bj][0].y); w.y = pg8::cvt_pk_bf16(v0[2] + bv[bj][0].z, v0[3] + bv[bj][0].w);
                    w.z = pg8::cvt_pk_bf16(v1[0] + bv[bj][1].x, v1[1] + bv[bj][1].y); w.w = pg8::cvt_pk_bf16(v1[2] + bv[bj][1].z, v1[3] + bv[bj][1].w);
                    *(u4*)(rowp + bj * 128) = w; } }
    }
};

constexpr int QS = 129;
__device__ __forceinline__ void phase_p3(Frame& F, const Args& AR) {
    const bf16* P = (const bf16*)(F.ws + WS_P); const float* psm = (const float*)(F.ws + WS_PSM);
    const float* convw = AR.in[6]; const float* a_log = AR.in[7]; const float* dt_bias = AR.in[8];
    LAS float* qs = (LAS float*)F.lds;
    LAS float* ks = qs + 64 * QS;
    LAS float* vs = ks + 64 * QS;
    LAS float* Lm = vs + 64 * QS;
    LAS float* betaL = Lm + 2 * 4096;
    LAS float* GL = betaL + 128;
    for (int unit = blockIdx.x; unit < 2 * NH * NCHUNK; unit += F.G) {
        const int b = unit >> 10, h = (unit >> 7) & 7, c = unit & 127, t0 = c * 64; const size_t tokbase = (size_t)b * SEQ;
        int tid = F.tid; asm volatile("" : "+v"(tid));
        const int lane = tid & 63;
        if (tid < 384) {
            const int cv = tid % 48, rg = tid / 48, part = cv >> 4, ch = (cv & 15) * 8, pcol = part * 1024 + h * 128 + ch;
            float wj[5][8];
#pragma unroll
            for (int j = 0; j < 5; ++j) { const f4 w0 = *(const f4*)(convw + j * 3072 + pcol), w1 = *(const f4*)(convw + j * 3072 + pcol + 4);
                wj[j][0] = w0.x; wj[j][1] = w0.y; wj[j][2] = w0.z; wj[j][3] = w0.w; wj[j][4] = w1.x; wj[j][5] = w1.y; wj[j][6] = w1.z; wj[j][7] = w1.w; }
            u4 raw[12];
#pragma unroll
            for (int r = 0; r < 12; ++r) { const int t = t0 + 8 * rg - 2 + r; raw[r] = (t >= 0 && t < SEQ) ? *(const u4*)(P + (tokbase + t) * PW + pcol) : (u4){0u, 0u, 0u, 0u}; }
            LAS float* dst = (part == 0 ? qs : (part == 1 ? ks : vs));
#pragma unroll
            for (int i = 0; i < 8; ++i) { float acc[8];
#pragma unroll
                for (int e = 0; e < 8; ++e) acc[e] = 0.f;
#pragma unroll
                for (int j = 0; j < 5; ++j) { float xin[8]; unpack8(raw[i + j], xin);
#pragma unroll
                    for (int e = 0; e < 8; ++e) acc[e] += wj[j][e] * xin[e]; }
                float ssq = 0.f;
#pragma unroll
                for (int e = 0; e < 8; ++e) { acc[e] = silu(acc[e]); ssq += acc[e] * acc[e]; }
                ssq += __shfl_xor(ssq, 1); ssq += __shfl_xor(ssq, 2); ssq += __shfl_xor(ssq, 4); ssq += __shfl_xor(ssq, 8);
                float sc = 1.0f;
                if (part < 2) { sc = 1.0f / sqrtf(ssq + EPS); if (part == 0) sc *= 0.08838834764831845f; }
#pragma unroll
                for (int e = 0; e < 8; ++e) dst[(8 * rg + i) * QS + ch + e] = acc[e] * sc; }
        }
        if (tid < 128) {
            const int dir = tid >> 6, ii = lane, io = dir ? 63 - ii : ii; const size_t tok = tokbase + t0 + io;
            const float braw = psm[tok * 32 + dir * 8 + h], araw = psm[tok * 32 + 16 + dir * 8 + h];
            float g = -expf(a_log[dir * 8 + h]) * softplus(araw + dt_bias[dir * 8 + h]);
#pragma unroll
            for (int o = 1; o < 64; o <<= 1) { const float t = __shfl_up(g, o); if (lane >= o) g += t; }
            betaL[dir * 64 + ii] = sigm(braw); GL[dir * 64 + ii] = g;
        }
        __syncthreads();
        asm volatile("" : "+v"(tid));
        {
            const int which = tid >> 8, bid = tid & 255, bi = bid >> 4, bj = bid & 15;
            const LAS float* Aa = which ? qs : ks;
            float acc[4][4];
#pragma unroll
            for (int i = 0; i < 4; ++i)
#pragma unroll
                for (int j = 0; j < 4; ++j) acc[i][j] = 0.f;
#pragma unroll 4
            for (int d = 0; d < 128; ++d) { float a[4], bb[4];
#pragma unroll
                for (int i = 0; i < 4; ++i) { a[i] = Aa[(4 * bi + i) * QS + d]; bb[i] = ks[(4 * bj + i) * QS + d]; }
#pragma unroll
                for (int i = 0; i < 4; ++i)
#pragma unroll
                    for (int j = 0; j < 4; ++j) acc[i][j] += a[i] * bb[j]; }
            const size_t cf = ((size_t)((b * 8 + h) * 2 + 0) * 128 + c) * DD_UNIT, cb = ((size_t)((b * 8 + h) * 2 + 1) * 128 + (127 - c)) * DD_UNIT;
            if (which == 0) {
#pragma unroll
                for (int i = 0; i < 4; ++i)
#pragma unroll
                    for (int j = 0; j < 4; ++j) { const int oi = 4 * bi + i, oj = 4 * bj + j;
                        const float l0 = (oi > oj) ? betaL[oi] * acc[i][j] * expf(GL[oi] - GL[oj]) : 0.f;
                        const int ri = 63 - oi, rj = 63 - oj;
                        const float l1 = (ri > rj) ? betaL[64 + ri] * acc[i][j] * expf(GL[64 + ri] - GL[64 + rj]) : 0.f;
                        Lm[oi * 64 + oj] = l0; Lm[4096 + ri * 64 + rj] = l1; }
            } else {
                bf16* Af = (bf16*)(F.ws + WS_DD + cf + DD_A); bf16* Ab = (bf16*)(F.ws + WS_DD + cb + DD_A);
#pragma unroll
                for (int i = 0; i < 4; ++i) { const int oi = 4 * bi + i, ri = 63 - oi; float f[4], r[4];
#pragma unroll
                    for (int j = 0; j < 4; ++j) { const int oj = 4 * bj + j, rj = 63 - oj;
                        f[j] = (oi >= oj) ? acc[i][j] * expf(GL[oi] - GL[oj]) : 0.f;
                        r[j] = (ri >= rj) ? acc[i][j] * expf(GL[64 + ri] - GL[64 + rj]) : 0.f; }
                    u2 wf; wf.x = pk2(f[0], f[1]); wf.y = pk2(f[2], f[3]); *(u2*)(Af + oi * 64 + 4 * bj) = wf;
                    u2 wb; wb.x = pk2(r[3], r[2]); wb.y = pk2(r[1], r[0]); *(u2*)(Ab + ri * 64 + (60 - 4 * bj)) = wb; }
            }
        }
        __syncthreads();
        asm volatile("" : "+v"(tid));
        {
            const int dir = tid >> 8, col = tid & 255; const bool isw = col >= 128; const int cc = col & 127;
            const LAS float* Lr = Lm + dir * 4096; const LAS float* src = isw ? ks : vs;
            const size_t cu = ((size_t)((b * 8 + h) * 2 + dir) * 128 + (dir ? 127 - c : c)) * DD_UNIT;
            bf16* outp = (bf16*)(F.ws + WS_DD + cu + (isw ? DD_W : DD_U)) + cc;
            float X[64];
#pragma unroll
            for (int i = 0; i < 64; ++i) { const int io = dir ? 63 - i : i;
                float xv = betaL[dir * 64 + i] * src[io * QS + cc]; if (isw) xv *= expf(GL[dir * 64 + i]);
#pragma unroll
                for (int j = 0; j < i; ++j) xv -= Lr[i * 64 + j] * X[j];
                asm volatile("" : "+v"(xv) :: "memory"); X[i] = xv; outp[i * 128] = (bf16)f2bf(xv); }
        }
        asm volatile("" : "+v"(tid));
#pragma unroll
        for (int it = 0; it < 8; ++it) { const int item = it * NTHR + tid, dir = item >> 11, arr = (item >> 10) & 1, i = (item >> 4) & 63, cv = item & 15, io = dir ? 63 - i : i;
            const float f = arr ? expf(GL[dir * 64 + 63] - GL[dir * 64 + i]) : expf(GL[dir * 64 + i]);
            const LAS float* s = (arr ? ks : qs) + io * QS + cv * 8; float o[8];
#pragma unroll
            for (int e = 0; e < 8; ++e) o[e] = s[e] * f;
            const size_t cu = ((size_t)((b * 8 + h) * 2 + dir) * 128 + (dir ? 127 - c : c)) * DD_UNIT;
            *(u4*)((bf16*)(F.ws + WS_DD + cu + (arr ? DD_KD : DD_QD)) + i * 128 + cv * 8) = pack8(o); }
        if (tid < 2) ((float*)(F.ws + WS_GL))[((b * 8 + h) * 2 + tid) * 128 + (tid ? 127 - c : c)] = expf(GL[tid * 64 + 63]);
        __syncthreads();
    }
}

__device__ __forceinline__ void phase_p4(Frame& F, const Args& AR) {
    LAS float* wS = (LAS float*)F.lds;
    LAS float* qS = wS + 64 * QS;
    LAS float* kS = qS + 64 * QS;
    LAS float* aS = kS + 64 * QS;
    LAS float* uS = aS + 64 * 65;
    LAS float* vn = uS + 64 * 17;
    LAS float* St = vn + 64 * 17;
    const int tid = F.tid;
    for (int unit = blockIdx.x; unit < 256; unit += F.G) {
        const int chain = unit >> 3, sl = unit & 7, dir = chain & 1, bh = chain >> 1, b = bh >> 3, h = bh & 7;
        for (int idx = tid; idx < 128 * 17; idx += NTHR) St[idx] = 0.f;
        bf16* od = (bf16*)(F.ws + WS_OD) + (size_t)dir * NTOK * D;
        for (int cs = 0; cs < NCHUNK; ++cs) {
            const unsigned char* base = F.ws + WS_DD + ((size_t)chain * 128 + cs) * DD_UNIT;
#pragma unroll
            for (int r = 0; r < 2; ++r) { const int idx = tid + NTHR * r, row = idx >> 4, cv = idx & 15; float o[8];
                unpack8(*(const u4*)(base + DD_QD + (size_t)idx * 16), o);
#pragma unroll
                for (int e = 0; e < 8; ++e) qS[row * QS + cv * 8 + e] = o[e];
                unpack8(*(const u4*)(base + DD_KD + (size_t)idx * 16), o);
#pragma unroll
                for (int e = 0; e < 8; ++e) kS[row * QS + cv * 8 + e] = o[e];
                unpack8(*(const u4*)(base + DD_W + (size_t)idx * 16), o);
#pragma unroll
                for (int e = 0; e < 8; ++e) wS[row * QS + cv * 8 + e] = o[e]; }
            { const int row = tid >> 3, cv = tid & 7; float o[8]; unpack8(*(const u4*)(base + DD_A + (size_t)tid * 16), o);
#pragma unroll
                for (int e = 0; e < 8; ++e) aS[row * 65 + cv * 8 + e] = o[e]; }
            if (tid < 128) { const int row = tid >> 1, hf = tid & 1; float o[8]; unpack8(*(const u4*)(base + DD_U + ((size_t)row * 128 + 16 * sl + 8 * hf) * 2), o);
#pragma unroll
                for (int e = 0; e < 8; ++e) uS[row * 17 + 8 * hf + e] = o[e]; }
            const float egl = ((const float*)(F.ws + WS_GL))[chain * 128 + cs];
            __syncthreads();
            const int i = tid >> 3, c2 = tid & 7;
            float av0 = 0.f, av1 = 0.f, aq0 = 0.f, aq1 = 0.f;
#pragma unroll 8
            for (int d = 0; d < 128; ++d) { const float wv = wS[i * QS + d], qv = qS[i * QS + d], s0 = St[d * 17 + 2 * c2], s1 = St[d * 17 + 2 * c2 + 1];
                av0 += wv * s0; av1 += wv * s1; aq0 += qv * s0; aq1 += qv * s1; }
            vn[i * 17 + 2 * c2] = uS[i * 17 + 2 * c2] - av0; vn[i * 17 + 2 * c2 + 1] = uS[i * 17 + 2 * c2 + 1] - av1;
            __syncthreads();
#pragma unroll 8
            for (int j = 0; j < 64; ++j) { const float a = aS[i * 65 + j]; aq0 += a * vn[j * 17 + 2 * c2]; aq1 += a * vn[j * 17 + 2 * c2 + 1]; }
            { const int co = dir ? 127 - cs : cs, ro = dir ? 63 - i : i; const size_t tok = (size_t)b * SEQ + co * 64 + ro;
                *(unsigned*)(od + tok * D + h * 128 + 16 * sl + 2 * c2) = pk2(aq0, aq1); }
            { const int d = tid >> 2, c4 = tid & 3; float s[4] = {0.f, 0.f, 0.f, 0.f};
#pragma unroll 8
                for (int r = 0; r < 64; ++r) { const float kv = kS[r * QS + d];
#pragma unroll
                    for (int e = 0; e < 4; ++e) s[e] += kv * vn[r * 17 + 4 * c4 + e]; }
#pragma unroll
                for (int e = 0; e < 4; ++e) St[d * 17 + 4 * c4 + e] = St[d * 17 + 4 * c4 + e] * egl + s[e]; }
            __syncthreads();
        }
    }
}

__device__ __forceinline__ void phase_p5(Frame& F, const Args& AR) {
    const bf16* P = (const bf16*)(F.ws + WS_P); const bf16* od = (const bf16*)(F.ws + WS_OD); bf16* oasb = (bf16*)(F.ws + WS_OASB);
    const float* onorm_w = AR.in[9]; const float* convs = AR.in[11];
    const int lane = F.lane, ch = 16 * lane;
    float onw[16], cw[3][16];
#pragma unroll
    for (int e = 0; e < 16; ++e) { onw[e] = onorm_w[(ch + e) & 127];
#pragma unroll
        for (int j = 0; j < 3; ++j) cw[j][e] = convs[j * 1024 + ch + e]; }
    const int gw = blockIdx.x * NWAVES + F.wave, NGW = F.G * NWAVES;
    for (int m = gw; m < NTOK; m += NGW) {
        const int t = m & (SEQ - 1);
        float o[16], z[16], t8[8];
        unpack8(*(const u4*)(od + (size_t)m * D + ch), t8);
#pragma unroll
        for (int e = 0; e < 8; ++e) o[e] = t8[e];
        unpack8(*(const u4*)(od + (size_t)m * D + ch + 8), t8);
#pragma unroll
        for (int e = 0; e < 8; ++e) o[8 + e] = t8[e];
        unpack8(*(const u4*)(od + (size_t)(NTOK + m) * D + ch), t8);
#pragma unroll
        for (int e = 0; e < 8; ++e) o[e] += t8[e];
        unpack8(*(const u4*)(od + (size_t)(NTOK + m) * D + ch + 8), t8);
#pragma unroll
        for (int e = 0; e < 8; ++e) o[8 + e] += t8[e];
        unpack8(*(const u4*)(P + (size_t)m * PW + PC_Z + ch), t8);
#pragma unroll
        for (int e = 0; e < 8; ++e) z[e] = t8[e];
        unpack8(*(const u4*)(P + (size_t)m * PW + PC_Z + ch + 8), t8);
#pragma unroll
        for (int e = 0; e < 8; ++e) z[8 + e] = t8[e];
        float ss = 0.f;
#pragma unroll
        for (int e = 0; e < 16; ++e) ss += o[e] * o[e];
        ss += __shfl_xor(ss, 1); ss += __shfl_xor(ss, 2); ss += __shfl_xor(ss, 4);
        const float rstd = 1.0f / sqrtf(ss * (1.0f / 128.0f) + EPS);
        float r[8];
#pragma unroll
        for (int e = 0; e < 8; ++e) r[e] = o[e] * rstd * onw[e] * silu(z[e]);
        *(u4*)(oasb + (size_t)m * D + ch) = pack8(r);
#pragma unroll
        for (int e = 0; e < 8; ++e) r[e] = o[8 + e] * rstd * onw[8 + e] * silu(z[8 + e]);
        *(u4*)(oasb + (size_t)m * D + ch + 8) = pack8(r);
        float acc[16];
#pragma unroll
        for (int e = 0; e < 16; ++e) acc[e] = 0.f;
#pragma unroll
        for (int j = 0; j < 3; ++j) { const int tt = t + j - 1;
            if (tt >= 0 && tt < SEQ) { const bf16* rowp = P + (size_t)(m + j - 1) * PW; float cg[8], ui[8];
                unpack8(*(const u4*)(rowp + PC_CG + ch), cg); unpack8(*(const u4*)(rowp + PC_UI + ch), ui);
#pragma unroll
                for (int e = 0; e < 8; ++e) acc[e] += cw[j][e] * (cg[e] * ui[e]);
                unpack8(*(const u4*)(rowp + PC_CG + ch + 8), cg); unpack8(*(const u4*)(rowp + PC_UI + ch + 8), ui);
#pragma unroll
                for (int e = 0; e < 8; ++e) acc[8 + e] += cw[j][8 + e] * (cg[e] * ui[e]); } }
        float bg[8];
        unpack8(*(const u4*)(P + (size_t)m * PW + PC_BG + ch), bg);
#pragma unroll
        for (int e = 0; e < 8; ++e) r[e] = bg[e] * acc[e];
        *(u4*)(oasb + (size_t)(NTOK + m) * D + ch) = pack8(r);
        unpack8(*(const u4*)(P + (size_t)m * PW + PC_BG + ch + 8), bg);
#pragma unroll
        for (int e = 0; e < 8; ++e) r[e] = bg[e] * acc[8 + e];
        *(u4*)(oasb + (size_t)(NTOK + m) * D + ch + 8) = pack8(r);
    }
}

__device__ __forceinline__ void phase_p7(Frame& F, const Args& AR) {
    const float* x1 = (const float*)(F.ws + WS_OD); const float* norm2_w = AR.in[14]; const float* router_b = AR.in[16]; const float* mod = (const float*)(F.ws + WS_MOD);
    LAS float* WtL = (LAS float*)F.lds;
    LAS float* A1 = (LAS float*)(F.lds + 131584);
    LAS float* B1 = A1 + 2048;
    stage_wt(WtL, (const float*)(F.ws + WS_WR_T), F.tid);
    for (int idx = F.tid; idx < 2048; idx += NTHR) { const int b = idx >> 10, k = idx & 1023; A1[idx] = norm2_w[k] * (1.0f + mod[b * 6144 + 4096 + k]); B1[idx] = mod[b * 6144 + 3072 + k]; }
    __syncthreads();
    bf16* h2 = (bf16*)(F.ws + WS_H); int* topi = (int*)(F.ws + WS_TOPI); float* topg = (float*)(F.ws + WS_TOPG); int* topp = (int*)(F.ws + WS_TOPP);
    unsigned* cnt = (unsigned*)(F.ws + WS_CTL) + CW_CNT;
    const int lane = F.lane; const float rb = router_b[lane >> 1];
    const int gw = blockIdx.x * NWAVES + F.wave, NGW = F.G * NWAVES;
    for (int m = gw; m < NTOK; m += NGW) {
        const f4* xr = (const f4*)(x1 + (size_t)m * D) + lane; f4 v[4]; float ss = 0.f;
#pragma unroll
        for (int j = 0; j < 4; ++j) { v[j] = xr[64 * j]; ss += (v[j].x * v[j].x + v[j].y * v[j].y) + (v[j].z * v[j].z + v[j].w * v[j].w); }
        const float rstd = 1.0f / sqrtf(wave_sum(ss) * (1.0f / D) + EPS);
        const int b = m >> 13;
#pragma unroll
        for (int j = 0; j < 4; ++j) { const f4 a = *(const LAS f4*)(A1 + b * 1024 + 256 * j + 4 * lane), bb = *(const LAS f4*)(B1 + b * 1024 + 256 * j + 4 * lane);
            v[j] = v[j] * rstd * a + bb;
            u2 o; o.x = pk2(v[j].x, v[j].y); o.y = pk2(v[j].z, v[j].w); ((u2*)(h2 + (size_t)m * D))[lane + 64 * j] = o; }
        float val = dot32(v, WtL, lane) + rb; const int myn = lane >> 1;
        float tv[4]; int ti[4];
#pragma unroll
        for (int r = 0; r < 4; ++r) { float bv = val; int bi = myn;
#pragma unroll
            for (int o = 1; o < 64; o <<= 1) { const float ov = __shfl_xor(bv, o); const int oi = __shfl_xor(bi, o); if (ov > bv || (ov == bv && oi < bi)) { bv = ov; bi = oi; } }
            tv[r] = bv; ti[r] = bi; if (myn == bi) val = -__builtin_inff(); }
        const float e1 = __expf(tv[1] - tv[0]), e2 = __expf(tv[2] - tv[0]), e3 = __expf(tv[3] - tv[0]), inv = 1.0f / (1.0f + e1 + e2 + e3);
        if (lane < 4) { const int e = lane == 0 ? ti[0] : (lane == 1 ? ti[1] : (lane == 2 ? ti[2] : ti[3]));
            const float g = (lane == 0 ? 1.0f : (lane == 1 ? e1 : (lane == 2 ? e2 : e3))) * inv;
            const unsigned pos = __hip_atomic_fetch_add(cnt + 64 * e, 1u, __ATOMIC_RELAXED, __HIP_MEMORY_SCOPE_AGENT);
            topi[(size_t)m * 4 + lane] = e; topg[(size_t)m * 4 + lane] = g; topp[(size_t)m * 4 + lane] = (int)pos; }
    }
}

__device__ __forceinline__ int build_moe_tables(Frame& F, LAS int* tab  ) {
    const unsigned* cnt = (const unsigned*)(F.ws + WS_CTL) + CW_CNT;
    if (F.tid == 0) { int start = 0;
        for (int e = 0; e < NEXP; ++e) { const int n = (int)__hip_atomic_load(cnt + 64 * e, __ATOMIC_RELAXED, __HIP_MEMORY_SCOPE_AGENT); const int nb = (n + 255) >> 8; tab[e] = start * 256;
            for (int k = 0; k < nb; ++k) tab[64 + start + k] = e; start += nb; }
        tab[32] = start; }
    __syncthreads();
    return tab[32];
}

__device__ __forceinline__ void phase_p8(Frame& F, const Args& AR) {
    LAS int* tab = (LAS int*)(F.lds + LDS_TAB);
    build_moe_tables(F, tab);
    const bf16* h2 = (const bf16*)(F.ws + WS_H); bf16* xs = (bf16*)(F.ws + WS_XS);
    const int* topi = (const int*)(F.ws + WS_TOPI); int* topp = (int*)(F.ws + WS_TOPP);
    const int gw = blockIdx.x * NWAVES + F.wave, NGW = F.G * NWAVES;
    for (int q = gw; q < NTOK * TOPK; q += NGW) {
        const int e = topi[q], row = tab[e] + topp[q];
        const u4* src = (const u4*)(h2 + (size_t)(q >> 2) * D) + F.lane; u4* dst = (u4*)(xs + (size_t)row * D) + F.lane;
        const u4 a = src[0], b2 = src[64]; dst[0] = a; dst[64] = b2;
        if (F.lane == 0) topp[q] = row;
    }
}

__device__ __forceinline__ void phase_p9(Frame& F, const Args& AR, float* out) {
    const float* x1 = (const float*)(F.ws + WS_OD); const bf16* ys = (const bf16*)(F.ws + WS_YS); const float* mod = (const float*)(F.ws + WS_MOD); const float* fnw = AR.in[21];
    const float* topg = (const float*)(F.ws + WS_TOPG); const int* topp = (const int*)(F.ws + WS_TOPP);
    const int lane = F.lane;
    const int gw = blockIdx.x * NWAVES + F.wave, NGW = F.G * NWAVES;
    for (int m = gw; m < NTOK; m += NGW) {
        const int b = m >> 13;
        const f4 gk = *(const f4*)(topg + (size_t)m * 4); const int r0 = topp[(size_t)m * 4], r1 = topp[(size_t)m * 4 + 1], r2 = topp[(size_t)m * 4 + 2], r3 = topp[(size_t)m * 4 + 3];
        f4 v[4]; float ss = 0.f;
#pragma unroll
        for (int j = 0; j < 4; ++j) {
            const u2 y0 = ((const u2*)(ys + (size_t)r0 * D))[lane + 64 * j], y1 = ((const u2*)(ys + (size_t)r1 * D))[lane + 64 * j], y2 = ((const u2*)(ys + (size_t)r2 * D))[lane + 64 * j], y3 = ((const u2*)(ys + (size_t)r3 * D))[lane + 64 * j];
            f4 mo;
            mo.x = gk.x * bflo(y0.x) + gk.y * bflo(y1.x) + gk.z * bflo(y2.x) + gk.w * bflo(y3.x);
            mo.y = gk.x * bfhi(y0.x) + gk.y * bfhi(y1.x) + gk.z * bfhi(y2.x) + gk.w * bfhi(y3.x);
            mo.z = gk.x * bflo(y0.y) + gk.y * bflo(y1.y) + gk.z * bflo(y2.y) + gk.w * bflo(y3.y);
            mo.w = gk.x * bfhi(y0.y) + gk.y * bfhi(y1.y) + gk.z * bfhi(y2.y) + gk.w * bfhi(y3.y);
            const f4 xv = ((const f4*)(x1 + (size_t)m * D))[lane + 64 * j], gt = ((const f4*)(mod + b * 6144 + 5120))[lane + 64 * j];
            v[j] = xv + gt * mo; ss += (v[j].x * v[j].x + v[j].y * v[j].y) + (v[j].z * v[j].z + v[j].w * v[j].w); }
        const float rstd = 1.0f / sqrtf(wave_sum(ss) * (1.0f / D) + EPS);
#pragma unroll
        for (int j = 0; j < 4; ++j) { const f4 w = ((const f4*)fnw)[lane + 64 * j]; ((f4*)(out + (size_t)m * D))[lane + 64 * j] = v[j] * rstd * w; }
    }
}

__global__ void __launch_bounds__(NTHR, 2) fwd_kernel(Args args) {
    const Args& AR = args;
    extern __shared__ __attribute__((aligned(16))) unsigned char lds_raw[];
    Frame F;
    F.lds = (LAS unsigned char*)lds_raw;
    F.tid = threadIdx.x; F.lane = F.tid & 63; F.wave = __builtin_amdgcn_readfirstlane(F.tid >> 6); F.G = gridDim.x;
    F.ws = args.ws;
    volatile LAS unsigned* misc = (volatile LAS unsigned*)(F.lds + LDS_MISC);
    if (F.tid < 4) misc[F.tid] = 0u;
    __syncthreads();
    XcdBarrier bar; bar.bar = (unsigned*)(F.ws + WS_CTL) + CW_BAR; bar.x = 0; bar.st = nullptr;
    if (MK_N_LAUNCHES == 1) bar = xcd_barrier_post((unsigned*)(F.ws + WS_CTL) + CW_BAR, misc);
    const int lo = args.ph_lo, hi = args.ph_hi;
#ifndef PH_MASK
#define PH_MASK 0x1fff
#endif
#define IN(k) (((PH_MASK >> (k)) & 1) && lo <= (k) && (k) < hi)
#define SEAM(k) do { if (IN(k) && IN((k) + 1)) xcd_barrier(bar); } while (0)
    PG8_LAS unsigned char* glds = (PG8_LAS unsigned char*)lds_raw;

    if (IN(0)) { phase_p0(F, AR); } SEAM(0);
    if (IN(1)) { phase_p1(F, AR); } SEAM(1);
    if (IN(2)) {
        pg8::Gemm g{(const bf16*)(F.ws + WS_H), (const bf16*)(F.ws + WS_WIN_T), NTOK, PW, D}; pg8::StaticOrder S; S.init(NTOK, PW, F.G, (int)blockIdx.x);
        EpiStoreBf16 E{(bf16*)(F.ws + WS_P), PW};
        pg8::gemm_phase<EpiStoreBf16, pg8::StaticOrder, true, true>(glds, g, S, E);
    } SEAM(2);
    if (IN(3)) { phase_p3(F, AR); } SEAM(3);
    if (IN(4)) { phase_p4(F, AR); } SEAM(4);
    if (IN(5)) { phase_p5(F, AR); } SEAM(5);
    if (IN(6)) {
        pg8::Gemm g{(const bf16*)(F.ws + WS_OASB), (const bf16*)(F.ws + WS_WUO_T), 2 * NTOK, 2048, D}; OrderG23 S; S.S.init(NTOK, D, F.G, (int)blockIdx.x);
        EpiG23 E{(const bf16*)(F.ws + WS_P), (float*)(F.ws + WS_M1), (bf16*)(F.ws + WS_M)};
        pg8::gemm_phase<EpiG23, OrderG23, true, true>(glds, g, S, E);
    } SEAM(6);
    if (IN(7)) {
        pg8::Gemm g{(const bf16*)(F.ws + WS_M), (const bf16*)(F.ws + WS_WO_T), NTOK, D, D}; pg8::StaticOrder S; S.init(NTOK, D, F.G, (int)blockIdx.x);
        EpiG4 E{AR.in[0], (const float*)(F.ws + WS_MOD), (float*)(F.ws + WS_OD)};
        pg8::gemm_phase<EpiG4, pg8::StaticOrder, true, true>(glds, g, S, E);
    } SEAM(7);
    if (IN(8)) { phase_p7(F, AR); } SEAM(8);
    if (IN(9)) { phase_p8(F, AR); } SEAM(9);
    if (IN(10)) {
        __syncthreads();
        LAS int* tab = (LAS int*)(F.lds + LDS_TAB); const int nblk = build_moe_tables(F, tab);
        pg8::Gemm g{(const bf16*)(F.ws + WS_XS), (const bf16*)(F.ws + WS_W1T), MROWS, NEXP * 2048, D}; MoeOrder S; S.init(nblk, 8, F.G, (int)blockIdx.x, tab + 64);
        EpiMoe1 E{AR.in[18], (bf16*)(F.ws + WS_ACT)};
        pg8::gemm_phase<EpiMoe1, MoeOrder, true, true>(glds, g, S, E);
    } SEAM(10);
    if (IN(11)) {
        __syncthreads();
        LAS int* tab = (LAS int*)(F.lds + LDS_TAB); const int nblk = build_moe_tables(F, tab);
        pg8::Gemm g{(const bf16*)(F.ws + WS_ACT), (const bf16*)(F.ws + WS_W2T), MROWS, NEXP * 1024, D}; MoeOrder S; S.init(nblk, 4, F.G, (int)blockIdx.x, tab + 64);
        EpiMoe2 E{AR.in[20], (bf16*)(F.ws + WS_YS)};
        pg8::gemm_phase<EpiMoe2, MoeOrder, true, true>(glds, g, S, E);
    } SEAM(11);
    if (IN(12)) { phase_p9(F, AR, args.out); }
#undef IN
#undef SEAM
}

extern "C" void kernel_launch(void* const* d_in, const int* in_sizes, int n_in, void* d_out, int out_size, void* d_ws, size_t ws_size, hipStream_t stream) {
    static int grid = 0;
    if (grid == 0) {
        if (n_in != 22 || out_size != NTOK * D || ws_size < WS_END) { fprintf(stderr, "kernel_launch: unexpected shapes (n_in %d out %d ws %zu)\n", n_in, out_size, ws_size); grid = -1; return; }
        int dev = 0, cus = 0, per_cu = 0;
        if (hipGetDevice(&dev) != hipSuccess || hipDeviceGetAttribute(&cus, hipDeviceAttributeMultiprocessorCount, dev) != hipSuccess) { grid = -1; return; }
        if (hipFuncSetAttribute((const void*)fwd_kernel, hipFuncAttributeMaxDynamicSharedMemorySize, LDS_BYTES) != hipSuccess) { fprintf(stderr, "kernel_launch: hipFuncSetAttribute failed\n"); grid = -1; return; }
        if (hipOccupancyMaxActiveBlocksPerMultiprocessor(&per_cu, (const void*)fwd_kernel, NTHR, LDS_BYTES) != hipSuccess || per_cu < 1) { fprintf(stderr, "kernel_launch: occupancy query says %d\n", per_cu); }
        (void)hipGetLastError();
        grid = cus;
        if (grid > 256) grid = 256;
    }
    if (grid < 0) return;
    if (hipMemsetAsync((char*)d_ws + WS_CTL, 0, CTL_ZERO_BYTES, stream) != hipSuccess) return;
    Args a{};
    for (int i = 0; i < 22; ++i) a.in[i] = (const float*)d_in[i];
    a.out = (float*)d_out; a.ws = (unsigned char*)d_ws;
#if MK_N_LAUNCHES == 1
    a.ph_lo = 0; a.ph_hi = NPHASE;
    hipLaunchKernelGGL(fwd_kernel, dim3(grid), dim3(NTHR), LDS_BYTES, stream, a);
#else
    for (int ph = 0; ph < NPHASE; ++ph) { a.ph_lo = ph; a.ph_hi = ph + 1; hipLaunchKernelGGL(fwd_kernel, dim3(grid), dim3(NTHR), LDS_BYTES, stream, a); }
#endif
}
```

```cpp
#include <hip/hip_runtime.h>
#include <cstdio>
#include <cstdint>
namespace pg8 {
#define PG8_LAS __attribute__((address_space(3)))
typedef unsigned short bf16_t;
typedef short bf16x8 __attribute__((ext_vector_type(8)));
typedef float f32x4 __attribute__((ext_vector_type(4)));
typedef unsigned u32x4 __attribute__((ext_vector_type(4)));
constexpr int BM = 256, BK = 64, HALF = 128, HTB = HALF * BK * 2  , STAGE_BYTES = 8 * HTB, NXCD = 8, WGM = 8;

__host__ __device__ __forceinline__ int lds_byte(int r, int c) { const int st = (r >> 4) * 2 + (c >> 5), rr = r & 15, cc = c & 31, ob = rr * 64 + cc * 2; return st * 1024 + (ob ^ (((ob >> 9) & 1) << 5)); }
__host__ __device__ __forceinline__ void stage_rc(int b, int& R, int& C) { const int st = b / 1024, sb = b % 1024, swz = sb ^ (((sb >> 9) & 1) << 5); R = (st >> 1) * 16 + swz / 64; C = (st & 1) * 32 + (swz % 64) / 2; }
__host__ __device__ __forceinline__ int perm32(int rho) { const int n = rho >> 4, i = rho & 15; return 8 * (i >> 2) + 4 * n + (i & 3); }

struct Unit { int pm, pn; };
struct Gemm { const bf16_t* A; const bf16_t* Bt; int M, N, K; };

struct StaticOrder {
    int nM, nN, nwg, G, c;
    __host__ __device__ void init(int M, int N, int G_, int c_) { nM = M / BM; nN = N / BM; nwg = nM * nN; G = G_; c = c_; }
    __host__ __device__ bool next(int i, Unit& u) const {
        const long L = (long)i * G + c; if (L >= nwg) return false;
        int wgid = (int)L; { const int q = nwg / NXCD, r = nwg % NXCD, xcd = wgid % NXCD, off = wgid / NXCD; wgid = (xcd < r ? xcd * (q + 1) : r * (q + 1) + (xcd - r) * q) + off; }
        const int nig = WGM * nN, gid = wgid / nig, fm = gid * WGM, gsz = (nM - fm) < WGM ? (nM - fm) : WGM;
        u.pm = fm + ((wgid % nig) % gsz); u.pn = (wgid % nig) / gsz; return true;
    }
    __device__ __forceinline__ void a_ready(const Unit&) const {}
    __device__ __forceinline__ void done(const Unit&) const {}
};

__device__ __forceinline__ unsigned cvt_pk_bf16(float lo, float hi) { unsigned r; asm volatile("v_cvt_pk_bf16_f32 %0, %1, %2" : "=v"(r) : "v"(lo), "v"(hi)); return r; }
template <class Epi, class Sched, bool ALIGN_EPI = false, bool SP2 = false>
__device__ __forceinline__ void gemm_phase(PG8_LAS unsigned char* lds, const Gemm g, const Sched& S, const Epi& E) {
    const int tid = threadIdx.x, wid = __builtin_amdgcn_readfirstlane(tid >> 6), lane = tid & 63, wr = wid >> 2, wc = wid & 3, fr = lane & 15, fq = lane >> 4;
    const int K = g.K, nt = K / BK;
    unsigned voffA[2], voffB[2];
#pragma unroll
    for (int i = 0; i < 2; ++i) { int R, C; stage_rc(tid * 16 + i * 8192, R, C); const int Rb = Epi::PERM ? ((R & ~31) + perm32(R & 31)) : R;
        voffA[i] = (unsigned)(R * K + C) * 2u; voffB[i] = (unsigned)(Rb * K + C) * 2u; }
    const size_t kstep = (size_t)(BK * 2);
    const size_t hstep = (size_t)HALF * K * 2;
    const size_t tstep = 2 * hstep;
    const unsigned ldsw = (unsigned)wid * 1024u;
    const int aoff = lds_byte(wr * 64 + fr, fq * 8), boff = lds_byte(wc * 32 + fr, fq * 8);
#define PG8_SA(b, h) (((b) * 2 + (h)) * HTB)
#define PG8_SB(b, h) ((4 + (b) * 2 + (h)) * HTB)
#define PG8_STAGE(bufoff, gbase, voff) do { _Pragma("unroll") for (int _i = 0; _i < 2; ++_i) \
        __builtin_amdgcn_global_load_lds((const unsigned*)((const char*)(gbase) + (voff)[_i]), (PG8_LAS unsigned*)(lds + (bufoff) + ldsw + _i * 8192), 16, 0, 0); } while (0)
#define PG8_LDA(dst, b, h) do { _Pragma("unroll") for (int m = 0; m < 4; ++m) _Pragma("unroll") for (int k = 0; k < 2; ++k) dst[m][k] = *(const PG8_LAS bf16x8*)(lds + PG8_SA(b, h) + aoff + m * 2048 + k * 1024); } while (0)
#define PG8_LDB(dst, b, h) do { _Pragma("unroll") for (int n = 0; n < 2; ++n) _Pragma("unroll") for (int k = 0; k < 2; ++k) dst[n][k] = *(const PG8_LAS bf16x8*)(lds + PG8_SB(b, h) + boff + n * 2048 + k * 1024); } while (0)
#define PG8_MMA(ai, bj, At, Bt) do { __builtin_amdgcn_s_setprio(1); _Pragma("unroll") for (int m = 0; m < 4; ++m) _Pragma("unroll") for (int n = 0; n < 2; ++n) _Pragma("unroll") for (int k = 0; k < 2; ++k) \
        acc[ai][bj][m][n] = __builtin_amdgcn_mfma_f32_16x16x32_bf16(Bt[n][k], At[m][k], acc[ai][bj][m][n], 0, 0, 0); __builtin_amdgcn_s_setprio(0); } while (0)
#define PG8_WAIT_V(n) asm volatile("s_waitcnt vmcnt(" #n ")" ::: "memory")
#define PG8_WAIT_L(n) asm volatile("s_waitcnt lgkmcnt(" #n ")" ::: "memory")
#define PG8_BAR __builtin_amdgcn_s_barrier()
#define PG8_SCHED __builtin_amdgcn_sched_barrier(0)
    Unit cur, nxt; int ui = 0;
    if (!S.next(0, cur)) return;
    f32x4 acc[2][2][4][2];
#pragma unroll
    for (int a = 0; a < 2; ++a)
#pragma unroll
        for (int b = 0; b < 2; ++b)
#pragma unroll
            for (int m = 0; m < 4; ++m)
#pragma unroll
                for (int n = 0; n < 2; ++n) acc[a][b][m][n] = (f32x4){0.f, 0.f, 0.f, 0.f};
    bf16x8 At[4][2], B0[2][2], B1[2][2];
    const char* cA = (const char*)g.A + (size_t)cur.pm * tstep; const char* cB = (const char*)g.Bt + (size_t)cur.pn * tstep;
    S.a_ready(cur);
    if constexpr (SP2) {
        PG8_STAGE(PG8_SB(0, 0), cB, voffB); PG8_STAGE(PG8_SB(0, 1), cB + hstep, voffB); PG8_STAGE(PG8_SA(0, 0), cA, voffA); PG8_STAGE(PG8_SA(0, 1), cA + hstep, voffA);
        if (wr == 1) PG8_BAR;
        PG8_WAIT_V(2); PG8_BAR;
        PG8_STAGE(PG8_SB(1, 0), cB + kstep, voffB); PG8_STAGE(PG8_SA(1, 0), cA + kstep, voffA); PG8_STAGE(PG8_SB(1, 1), cB + hstep + kstep, voffB);
        PG8_WAIT_V(6); PG8_BAR;
    } else {
        PG8_STAGE(PG8_SB(0, 0), cB, voffB); PG8_STAGE(PG8_SA(0, 0), cA, voffA); PG8_STAGE(PG8_SB(0, 1), cB + hstep, voffB); PG8_STAGE(PG8_SA(0, 1), cA + hstep, voffA);
        if (wr == 1) PG8_BAR;
        PG8_WAIT_V(4); PG8_BAR;
        PG8_STAGE(PG8_SB(1, 0), cB + kstep, voffB); PG8_STAGE(PG8_SA(1, 0), cA + kstep, voffA); PG8_STAGE(PG8_SB(1, 1), cB + hstep + kstep, voffB);
        PG8_WAIT_V(6); PG8_BAR;
    }
    for (;;) {
        const bool has_next = S.next(ui + 1, nxt);
        const char* nA = has_next ? (const char*)g.A + (size_t)nxt.pm * tstep : cA; const char* nB = has_next ? (const char*)g.Bt + (size_t)nxt.pn * tstep : cB;
        for (int t = 0; t < nt; t += 2) {
            const bool last = (t == nt - 2);
            const char* a1 = cA + (size_t)(t + 1) * kstep;
            const char* a2 = last ? nA : cA + (size_t)(t + 2) * kstep; const char* b2 = last ? nB : cB + (size_t)(t + 2) * kstep;
            const char* a3 = a2 + kstep; const char* b3 = b2 + kstep;
            if (last && has_next) S.a_ready(nxt);
            if constexpr (SP2) {
            PG8_LDB(B0, 0, 0); PG8_LDB(B1, 0, 1); PG8_SCHED; PG8_LDA(At, 0, 0); PG8_STAGE(PG8_SA(1, 1), a1 + hstep, voffA);
            PG8_WAIT_V(8); PG8_WAIT_L(0); PG8_BAR; PG8_MMA(0, 0, At, B0); PG8_MMA(0, 1, At, B1); PG8_BAR; PG8_SCHED;
            PG8_LDA(At, 0, 1); PG8_STAGE(PG8_SB(0, 0), b2, voffB); PG8_STAGE(PG8_SB(0, 1), b2 + hstep, voffB); PG8_STAGE(PG8_SA(0, 0), a2, voffA);
            PG8_WAIT_V(8); PG8_WAIT_L(0); PG8_BAR; PG8_MMA(1, 0, At, B0); PG8_MMA(1, 1, At, B1); PG8_BAR; PG8_SCHED;
            PG8_LDB(B0, 1, 0); PG8_LDB(B1, 1, 1); PG8_SCHED; PG8_LDA(At, 1, 0); PG8_STAGE(PG8_SA(0, 1), a2 + hstep, voffA);
            PG8_WAIT_V(8); PG8_WAIT_L(0); PG8_BAR; PG8_MMA(0, 0, At, B0); PG8_MMA(0, 1, At, B1); PG8_BAR; PG8_SCHED;
            PG8_LDA(At, 1, 1); PG8_STAGE(PG8_SB(1, 0), b3, voffB); PG8_STAGE(PG8_SB(1, 1), b3 + hstep, voffB); PG8_STAGE(PG8_SA(1, 0), a3, voffA);
            PG8_WAIT_V(8); PG8_WAIT_L(0); PG8_BAR; PG8_MMA(1, 0, At, B0); PG8_MMA(1, 1, At, B1); PG8_BAR; PG8_SCHED;
            } else {
            PG8_LDB(B0, 0, 0); PG8_SCHED; PG8_LDA(At, 0, 0); PG8_STAGE(PG8_SA(1, 1), a1 + hstep, voffA);
            PG8_WAIT_L(8); PG8_BAR; PG8_WAIT_L(0); PG8_MMA(0, 0, At, B0); PG8_BAR; PG8_SCHED;
            PG8_LDB(B1, 0, 1); PG8_STAGE(PG8_SB(0, 0), b2, voffB);
            PG8_BAR; PG8_WAIT_L(0); PG8_MMA(0, 1, At, B1); PG8_BAR;
            PG8_LDA(At, 0, 1); PG8_STAGE(PG8_SA(0, 0), a2, voffA);
            PG8_BAR; PG8_WAIT_L(0); PG8_MMA(1, 0, At, B0); PG8_BAR; PG8_SCHED;
            PG8_STAGE(PG8_SB(0, 1), b2 + hstep, voffB);
            PG8_WAIT_V(6); PG8_BAR; PG8_MMA(1, 1, At, B1); PG8_BAR;
            PG8_LDB(B0, 1, 0); PG8_SCHED; PG8_LDA(At, 1, 0); PG8_STAGE(PG8_SA(0, 1), a2 + hstep, voffA);
            PG8_WAIT_L(8); PG8_BAR; PG8_WAIT_L(0); PG8_MMA(0, 0, At, B0); PG8_BAR; PG8_SCHED;
            PG8_LDB(B1, 1, 1); PG8_STAGE(PG8_SB(1, 0), b3, voffB);
            PG8_BAR; PG8_WAIT_L(0); PG8_MMA(0, 1, At, B1); PG8_BAR;
            PG8_LDA(At, 1, 1); PG8_STAGE(PG8_SA(1, 0), a3, voffA);
            PG8_BAR; PG8_WAIT_L(0); PG8_MMA(1, 0, At, B0); PG8_BAR; PG8_SCHED;
            PG8_STAGE(PG8_SB(1, 1), b3 + hstep, voffB);
            PG8_WAIT_V(6); PG8_BAR; PG8_MMA(1, 1, At, B1); PG8_BAR;
            }
        }
        if constexpr (ALIGN_EPI) { if (wr == 0) PG8_BAR; }
        if constexpr (!Epi::AFTER_DRAIN) { E(acc, cur, wr, wc, fr, fq); S.done(cur); }
        if (!has_next) break;
#pragma unroll
        for (int a = 0; a < 2; ++a)
#pragma unroll
            for (int b = 0; b < 2; ++b)
#pragma unroll
                for (int m = 0; m < 4; ++m)
#pragma unroll
                    for (int n = 0; n < 2; ++n) acc[a][b][m][n] = (f32x4){0.f, 0.f, 0.f, 0.f};
        cur = nxt; cA = nA; cB = nB; ++ui;
        if constexpr (ALIGN_EPI) { if (wr == 1) PG8_BAR; }
    }
    PG8_WAIT_V(0);
    if constexpr (!ALIGN_EPI) { if (wr == 0) PG8_BAR; }
    PG8_BAR;
    if constexpr (Epi::AFTER_DRAIN) { E.fused(acc, cur, wr, wc, fr, fq, lds, wid, lane); S.done(cur); }
#undef PG8_SA
#undef PG8_SB
#undef PG8_STAGE
#undef PG8_LDA
#undef PG8_LDB
#undef PG8_MMA
#undef PG8_WAIT_V
#undef PG8_WAIT_L
#undef PG8_BAR
#undef PG8_SCHED
}
}

#define XB_TMO      128
#define XB_XCNT(j)  (256  + 64 * (j))
#define XB_XSUB(j)  (1280 + 64 * (j))
#define XB_XGEN(j)  (2304 + 64 * (j))
#define XB_TOP      3328
#define XB_TOPGEN   3392
#define XCD_BAR_WORDS 3456
#define XB_SPIN_CAP (1u << 18)
#define LAS __attribute__((address_space(3)))

__device__ __forceinline__ unsigned xb_ld(unsigned* p)              { return __hip_atomic_load(p, __ATOMIC_RELAXED, __HIP_MEMORY_SCOPE_AGENT); }
__device__ __forceinline__ unsigned xb_add(unsigned* p, unsigned v) { return __hip_atomic_fetch_add(p, v, __ATOMIC_RELAXED, __HIP_MEMORY_SCOPE_AGENT); }
__device__ __forceinline__ unsigned xb_xcc_id() { return (unsigned)__builtin_amdgcn_s_getreg((3 << 11) | 20) & 0xFu; }
#define XB_SPIN(cond, bar) do { unsigned _sp = 0; while (cond) { __builtin_amdgcn_s_sleep(1); \
    if ((++_sp & 255u) == 0u) { if (xb_ld(&(bar)[XB_TMO])) break; if (_sp > XB_SPIN_CAP) { atomicAdd(&(bar)[XB_TMO], 1u); break; } } } } while (0)

struct XcdBarrier {
    unsigned* bar; unsigned x;
    volatile LAS unsigned* st;
};

__device__ __forceinline__ XcdBarrier xcd_barrier_post(unsigned* bar, volatile LAS unsigned* st) {
    XcdBarrier b; b.bar = bar; b.x = xb_xcc_id(); b.st = st;
    if (threadIdx.x == 0) (void)xb_add(&bar[XB_XCNT(b.x)], 1u);
    return b;
}
__device__ __forceinline__ void xcd_barrier_complete(unsigned* bar, unsigned x, unsigned& nloc, unsigned& nx) {
    const unsigned G = gridDim.x * gridDim.y * gridDim.z;
    unsigned sum, cnt, mine, sp = 0u;
    for (;;) {
        sum = 0u; cnt = 0u; mine = 0u;
#pragma unroll
        for (unsigned j = 0; j < 16; ++j) { const unsigned c = xb_ld(&bar[XB_XCNT(j)]); sum += c; cnt += (c > 0u) ? 1u : 0u; mine = (j == x) ? c : mine; }
        if (sum == G) break;
        __builtin_amdgcn_s_sleep(1);
        if ((++sp & 255u) == 0u) { if (xb_ld(&bar[XB_TMO])) break; if (sp > XB_SPIN_CAP) { atomicAdd(&bar[XB_TMO], 1u); break; } }
    }
    nloc = mine > 0u ? mine : 1u; nx = cnt > 0u ? cnt : 1u;
}

__device__ __forceinline__ void xcd_barrier(const XcdBarrier& b) {
    asm volatile("s_waitcnt vmcnt(0)" ::: "memory");
    __syncthreads();
    if (threadIdx.x == 0) {
        unsigned* bar = b.bar;
        __builtin_amdgcn_s_waitcnt(0);
        unsigned nloc = b.st[0], nx = b.st[1];
        if (nloc == 0u) { xcd_barrier_complete(bar, b.x, nloc, nx); b.st[0] = nloc; b.st[1] = nx; }
        const unsigned old = xb_add(&bar[XB_XSUB(b.x)], 1u);
        const unsigned gen = old / nloc;
        if (old + 1u == (gen + 1u) * nloc) {
            __builtin_amdgcn_fence(__ATOMIC_RELEASE, "agent");
            asm volatile("s_waitcnt vmcnt(0)" ::: "memory");
            const unsigned og = xb_add(&bar[XB_TOP], 1u);
            const unsigned tg = og / nx;
            if (og + 1u == (tg + 1u) * nx) xb_add(&bar[XB_TOPGEN], 1u);
            else XB_SPIN(xb_ld(&bar[XB_TOPGEN]) == tg, bar);
            __builtin_amdgcn_fence(__ATOMIC_ACQUIRE, "agent");
            xb_add(&bar[XB_XGEN(b.x)], 1u);
            asm volatile("s_waitcnt vmcnt(0)" ::: "memory");
        } else {
            XB_SPIN(xb_ld(&bar[XB_XGEN(b.x)]) == gen, bar);
            __builtin_amdgcn_fence(__ATOMIC_ACQUIRE, "agent");
            asm volatile("s_waitcnt vmcnt(0)" ::: "memory");
        }
    }
    __syncthreads();
}

#ifndef MK_N_LAUNCHES
#define MK_N_LAUNCHES 1
#endif
constexpr int NPHASE = 13;
constexpr int NWAVES = 8, NTHR = 512;
constexpr int D = 1024, SEQ = 8192, NTOK = 16384, NH = 8, HD = 128, CH = 64, NCHUNK = 128;
constexpr int PW = 9216;
constexpr int PC_Q = 0, PC_K = 1024, PC_V = 2048, PC_Z = 3072, PC_BG = 4096, PC_CG = 5120, PC_UI = 6144, PC_GA = 7168, PC_GB = 8192;
constexpr int INW = 9248;
constexpr int NEXP = 32, TOPK = 4, MROWS = 73728;
constexpr float EPS = 1e-6f;

constexpr size_t MiB = 1u << 20;
constexpr size_t WS_CTL = 0, CTL_ZERO_BYTES = 1 * MiB;
constexpr size_t WS_MOD = 1 * MiB;
constexpr size_t WS_WSM_T = 1 * MiB + 64 * 1024;
constexpr size_t WS_WR_T = 1 * MiB + 192 * 1024;
constexpr size_t WS_TOPI = 2 * MiB;
constexpr size_t WS_TOPG = 2 * MiB + 256 * 1024;
constexpr size_t WS_TOPP = 2 * MiB + 512 * 1024;
constexpr size_t WS_PSM = 3 * MiB;
constexpr size_t WS_GL = 5 * MiB;
constexpr size_t WS_WIN_T = 8 * MiB;
constexpr size_t WS_WUO_T = 26 * MiB;
constexpr size_t WS_WO_T = 30 * MiB;
constexpr size_t WS_W1T = 32 * MiB;
constexpr size_t WS_W2T = 160 * MiB;
constexpr size_t WS_H = 224 * MiB;
constexpr size_t WS_OD = 256 * MiB;
constexpr size_t WS_P = 320 * MiB;
constexpr size_t WS_DD = 608 * MiB;
constexpr size_t WS_END = 896 * MiB;
constexpr size_t DD_UNIT = 73728;
constexpr size_t DD_W = 0, DD_Q = 16384, DD_K = 32768, DD_A = 49152, DD_U = 57344;
constexpr size_t WS_OASB = WS_DD, WS_M1 = WS_DD + 64 * MiB, WS_M = WS_DD + 128 * MiB;
constexpr size_t WS_XS = WS_P, WS_ACT = WS_P + 144 * MiB, WS_YS = WS_DD;
constexpr int CW_BAR = 4096;
constexpr int CW_CNT = 16384;

constexpr int LDS_BYTES = 155648;
constexpr int LDS_MISC = 152 * 1024 - 256;
constexpr int LDS_TAB = 131072;

#define GAS __attribute__((address_space(1)))
#define LAS __attribute__((address_space(3)))
typedef unsigned short bf16;
typedef float f4 __attribute__((ext_vector_type(4)));
typedef unsigned u4 __attribute__((ext_vector_type(4)));
typedef unsigned u2 __attribute__((ext_vector_type(2)));

typedef __bf16 hwbf2 __attribute__((ext_vector_type(2)));
typedef float hwf2 __attribute__((ext_vector_type(2)));
__device__ __forceinline__ unsigned cvtpk(float lo, float hi) { const hwf2 v = {lo, hi}; return __builtin_bit_cast(unsigned, __builtin_convertvector(v, hwbf2)); }
__device__ __forceinline__ unsigned f2bf(float f) { unsigned u = __float_as_uint(f); return (u + 0x7fffu + ((u >> 16) & 1u)) >> 16; }
__device__ __forceinline__ unsigned pk2(float lo, float hi) { return cvtpk(lo, hi); }
__device__ __forceinline__ float bflo(unsigned w) { return __uint_as_float(w << 16); }
__device__ __forceinline__ float bfhi(unsigned w) { return __uint_as_float(w & 0xffff0000u); }
__device__ __forceinline__ float bf1(bf16 b) { return __uint_as_float(((unsigned)b) << 16); }
__device__ __forceinline__ void unpack8(const u4 w, float (&o)[8]) { o[0] = bflo(w.x); o[1] = bfhi(w.x); o[2] = bflo(w.y); o[3] = bfhi(w.y); o[4] = bflo(w.z); o[5] = bfhi(w.z); o[6] = bflo(w.w); o[7] = bfhi(w.w); }
__device__ __forceinline__ u4 pack8(const float (&o)[8]) { u4 w; w.x = pk2(o[0], o[1]); w.y = pk2(o[2], o[3]); w.z = pk2(o[4], o[5]); w.w = pk2(o[6], o[7]); return w; }
__device__ __forceinline__ float wave_sum(float v) {
#pragma unroll
    for (int o = 1; o < 64; o <<= 1) v += __shfl_xor(v, o);
    return v;
}
__device__ __forceinline__ float sigm(float x) { return 1.0f / (1.0f + __expf(-x)); }
__device__ __forceinline__ float silu(float x) { return x / (1.0f + __expf(-x)); }
__device__ __forceinline__ float softplus(float x) { return x > 20.f ? x : log1pf(expf(x)); }

struct Args { const float* in[22]; float* out; unsigned char* ws; int ph_lo, ph_hi; };

struct Frame {
    LAS unsigned char* lds;
    int tid, lane, wave, G;
    unsigned char* ws;
};

__device__ __forceinline__ void p0_transpose_item(const float* W, int ldw, int k0, int n0s, bf16* WT, size_t drow0, LAS float* scr, int lane) {
#pragma unroll 8
    for (int i = 0; i < 32; ++i) { const int kk = 2 * i + (lane >> 5); scr[kk * 33 + (lane & 31)] = W[(size_t)(k0 + kk) * ldw + n0s + (lane & 31)]; }
    asm volatile("s_waitcnt lgkmcnt(0)" ::: "memory");
    const int c = lane & 7;
#pragma unroll
    for (int j = 0; j < 4; ++j) { const int n = (lane >> 3) + 8 * j; const LAS float* s = scr + (8 * c) * 33 + n;
        u4 o; o.x = pk2(s[0 * 33], s[1 * 33]); o.y = pk2(s[2 * 33], s[3 * 33]); o.z = pk2(s[4 * 33], s[5 * 33]); o.w = pk2(s[6 * 33], s[7 * 33]);
        *(u4*)(WT + (drow0 + n) * 1024 + k0 + 8 * c) = o; }
    asm volatile("s_waitcnt lgkmcnt(0)" ::: "memory");
}

__device__ __forceinline__ void phase_p0(Frame& F, const Args& AR) {
    const float* c_in = AR.in[1]; const float* ada_w = AR.in[2]; const float* ada_b = AR.in[3];
    const float* w_in = AR.in[5];
    for (int task = blockIdx.x; task < 192; task += F.G) {
        LAS float* red = (LAS float*)(F.lds + 131072);
        const int j0 = 32 * task, col = j0 + (F.lane & 31), kh = F.lane >> 5;
        float a0 = 0.f, a1 = 0.f;
#pragma unroll 8
        for (int i = 0; i < 64; ++i) { const int k = 128 * F.wave + 2 * i + kh; const float wv = ada_w[(size_t)k * 6144 + col];
            a0 += silu(c_in[k]) * wv; a1 += silu(c_in[1024 + k]) * wv; }
        a0 += __shfl_xor(a0, 32); a1 += __shfl_xor(a1, 32);
        if (F.lane < 32) { red[(F.wave * 2 + 0) * 32 + F.lane] = a0; red[(F.wave * 2 + 1) * 32 + F.lane] = a1; }
        __syncthreads();
        if (F.tid < 64) { const int b = F.tid >> 5, cc = F.tid & 31; float s = 0.f;
#pragma unroll
            for (int w = 0; w < 8; ++w) s += red[(w * 2 + b) * 32 + cc];
            ((float*)(F.ws + WS_MOD))[b * 6144 + j0 + cc] = s + ada_b[j0 + cc]; }
        __syncthreads();
    }
    {
        const float* router_w = AR.in[15]; float* wsm = (float*)(F.ws + WS_WSM_T); float* wr = (float*)(F.ws + WS_WR_T);
        for (int idx = blockIdx.x * NTHR + F.tid; idx < 65536; idx += F.G * NTHR) { const int which = idx >> 15, r = idx & 32767, k = r >> 5, n = r & 31;
            if (which == 0) wsm[n * 1024 + k] = w_in[(size_t)k * INW + 4096 + n]; else wr[n * 1024 + k] = router_w[k * 32 + n]; }
    }
    LAS float* scr = (LAS float*)(F.lds + F.wave * 16384);
    const int gw = blockIdx.x * NWAVES + F.wave, NGW = F.G * NWAVES;
    constexpr int I_IN = 16 * 288, I_SQ = 16 * 32, I_W1 = 32 * 16 * 64, I_W2 = 32 * 16 * 32;
    constexpr int NITEMS = I_IN + 3 * I_SQ + I_W1 + I_W2;
    for (int it = gw; it < NITEMS; it += NGW) {
        int r = it;
        if (r < I_IN) { const int kb = r / 288, nb = r % 288, n0 = 32 * nb; p0_transpose_item(w_in, INW, 64 * kb, n0 + (n0 >= 4096 ? 32 : 0), (bf16*)(F.ws + WS_WIN_T), (size_t)n0, scr, F.lane); continue; } r -= I_IN;
        if (r < I_SQ) { const int kb = r / 32, nb = r % 32; p0_transpose_item(AR.in[10], 1024, 64 * kb, 32 * nb, (bf16*)(F.ws + WS_WUO_T), (size_t)(32 * nb), scr, F.lane); continue; } r -= I_SQ;
        if (r < I_SQ) { const int kb = r / 32, nb = r % 32; p0_transpose_item(AR.in[12], 1024, 64 * kb, 32 * nb, (bf16*)(F.ws + WS_WUO_T), (size_t)(1024 + 32 * nb), scr, F.lane); continue; } r -= I_SQ;
        if (r < I_SQ) { const int kb = r / 32, nb = r % 32; p0_transpose_item(AR.in[13], 1024, 64 * kb, 32 * nb, (bf16*)(F.ws + WS_WO_T), (size_t)(32 * nb), scr, F.lane); continue; } r -= I_SQ;
        if (r < I_W1) { const int e = r / 1024, q = r % 1024, kb = q / 64, nb = q % 64, n0 = 32 * nb, half = n0 >> 10, j = n0 & 1023;
            p0_transpose_item(AR.in[17] + (size_t)e * 1024 * 2048, 2048, 64 * kb, n0, (bf16*)(F.ws + WS_W1T), (size_t)e * 2048 + (size_t)((j >> 7) * 256 + half * 128 + (j & 127)), scr, F.lane); continue; } r -= I_W1;
        { const int e = r / 512, q = r % 512, kb = q / 32, nb = q % 32;
            p0_transpose_item(AR.in[19] + (size_t)e * 1024 * 1024, 1024, 64 * kb, 32 * nb, (bf16*)(F.ws + WS_W2T), (size_t)e * 1024 + (size_t)(32 * nb), scr, F.lane); }
    }
}

__device__ __forceinline__ void stage_wt(LAS float* WtL, const float* WT, int tid) {
    for (int idx = tid; idx < 32 * 256; idx += NTHR) { const int n = idx >> 8, k4 = idx & 255; const f4 v = *(const f4*)(WT + n * 1024 + 4 * k4); *(LAS f4*)(WtL + n * 1028 + 4 * k4) = v; }
}
__device__ __forceinline__ float dot32(const f4 (&v)[4], const LAS float* WtL, int lane) {
    float p[32];
#pragma unroll
    for (int n = 0; n < 32; ++n) { float s = 0.f;
#pragma unroll
        for (int j = 0; j < 4; ++j) { const f4 w = *(const LAS f4*)(WtL + n * 1028 + 256 * j + 4 * lane); s += v[j].x * w.x + v[j].y * w.y + v[j].z * w.z + v[j].w * w.w; }
        p[n] = s; if ((n & 3) == 3) asm volatile("" : "+v"(p[n - 3]), "+v"(p[n - 2]), "+v"(p[n - 1]), "+v"(p[n]) :: "memory"); }
#pragma unroll
    for (int i = 0; i < 16; ++i) { const bool hi = (lane & 32) != 0; const float send = hi ? p[i] : p[i + 16], keep = hi ? p[i + 16] : p[i]; p[i] = keep + __shfl_xor(send, 32); }
#pragma unroll
    for (int i = 0; i < 8; ++i) { const bool hi = (lane & 16) != 0; const float send = hi ? p[i] : p[i + 8], keep = hi ? p[i + 8] : p[i]; p[i] = keep + __shfl_xor(send, 16); }
#pragma unroll
    for (int i = 0; i < 4; ++i) { const bool hi = (lane & 8) != 0; const float send = hi ? p[i] : p[i + 4], keep = hi ? p[i + 4] : p[i]; p[i] = keep + __shfl_xor(send, 8); }
#pragma unroll
    for (int i = 0; i < 2; ++i) { const bool hi = (lane & 4) != 0; const float send = hi ? p[i] : p[i + 2], keep = hi ? p[i + 2] : p[i]; p[i] = keep + __shfl_xor(send, 4); }
    { const bool hi = (lane & 2) != 0; const float send = hi ? p[0] : p[1], keep = hi ? p[1] : p[0]; p[0] = keep + __shfl_xor(send, 2); }
    p[0] += __shfl_xor(p[0], 1);
    return p[0];
}

__device__ __forceinline__ void phase_p1(Frame& F, const Args& AR) {
    const float* x = AR.in[0]; const float* norm1_w = AR.in[4]; const float* mod = (const float*)(F.ws + WS_MOD);
    LAS float* WtL = (LAS float*)F.lds;
    LAS float* A1 = (LAS float*)(F.lds + 131584);
    LAS float* B1 = A1 + 2048;
    stage_wt(WtL, (const float*)(F.ws + WS_WSM_T), F.tid);
    for (int idx = F.tid; idx < 2048; idx += NTHR) { const int b = idx >> 10, k = idx & 1023; A1[idx] = norm1_w[k] * (1.0f + mod[b * 6144 + 1024 + k]); B1[idx] = mod[b * 6144 + k]; }
    __syncthreads();
    bf16* h = (bf16*)(F.ws + WS_H); float* psm = (float*)(F.ws + WS_PSM);
    const int gw = blockIdx.x * NWAVES + F.wave, NGW = F.G * NWAVES;
    for (int m = gw; m < NTOK; m += NGW) {
        const f4* xr = (const f4*)(x + (size_t)m * D) + F.lane; f4 v[4]; float ss = 0.f;
#pragma unroll
        for (int j = 0; j < 4; ++j) { v[j] = xr[64 * j]; ss += (v[j].x * v[j].x + v[j].y * v[j].y) + (v[j].z * v[j].z + v[j].w * v[j].w); }
        const float rstd = 1.0f / sqrtf(wave_sum(ss) * (1.0f / D) + EPS);
        const int b = m >> 13;
#pragma unroll
        for (int j = 0; j < 4; ++j) { const f4 a = *(const LAS f4*)(A1 + b * 1024 + 256 * j + 4 * F.lane), bb = *(const LAS f4*)(B1 + b * 1024 + 256 * j + 4 * F.lane);
            v[j] = v[j] * rstd * a + bb;
            u2 o; o.x = pk2(v[j].x, v[j].y); o.y = pk2(v[j].z, v[j].w); ((u2*)(h + (size_t)m * D))[F.lane + 64 * j] = o; }
        const float tot = dot32(v, WtL, F.lane);
        if (!(F.lane & 1)) psm[(size_t)m * 32 + (F.lane >> 1)] = tot;
    }
}

struct EpiStoreBf16 {
    static constexpr bool PERM = true, AFTER_DRAIN = false;
    bf16* O; int ldc;
    __device__ __forceinline__ void operator()(const pg8::f32x4 (&acc)[2][2][4][2], const pg8::Unit& u, int wr, int wc, int fr, int fq) const {
        const int row0 = u.pm * 256 + wr * 64 + fr, col0 = u.pn * 256 + wc * 32 + 8 * fq;
#pragma unroll
        for (int ai = 0; ai < 2; ++ai)
#pragma unroll
            for (int m = 0; m < 4; ++m) { bf16* rowp = O + (size_t)(row0 + ai * 128 + m * 16) * ldc + col0;
#pragma unroll
                for (int bj = 0; bj < 2; ++bj) { const pg8::f32x4 v0 = acc[ai][bj][m][0], v1 = acc[ai][bj][m][1];
                    u4 w; w.x = cvtpk(v0[0], v0[1]); w.y = cvtpk(v0[2], v0[3]); w.z = cvtpk(v1[0], v1[1]); w.w = cvtpk(v1[2], v1[3]);
                    *(u4*)(rowp + bj * 128) = w; } }
    }
};
struct EpiG23 {
    static constexpr bool PERM = true, AFTER_DRAIN = false;
    const bf16* P; float* M1; bf16* Mo;
    __device__ __forceinline__ void operator()(const pg8::f32x4 (&acc)[2][2][4][2], const pg8::Unit& u, int wr, int wc, int fr, int fq) const {
        const int s = u.pm >= 64 ? 1 : 0, pm = u.pm - 64 * s, pn = u.pn - 4 * s;
        const int row0 = pm * 256 + wr * 64 + fr, col0 = pn * 256 + wc * 32 + 8 * fq, gcol = (s ? PC_GB : PC_GA) + col0;
#pragma unroll
        for (int ai = 0; ai < 2; ++ai)
#pragma unroll
            for (int m = 0; m < 4; ++m) { const int row = row0 + ai * 128 + m * 16;
#pragma unroll
                for (int bj = 0; bj < 2; ++bj) { const int col = col0 + bj * 128;
                    float g[8]; unpack8(*(const u4*)(P + (size_t)row * PW + gcol + bj * 128), g);
                    const pg8::f32x4 v0 = acc[ai][bj][m][0], v1 = acc[ai][bj][m][1];
                    float o[8];
#pragma unroll
                    for (int e = 0; e < 4; ++e) { o[e] = sigm(g[e]) * v0[e]; o[4 + e] = sigm(g[4 + e]) * v1[e]; }
                    float* mp = M1 + (size_t)row * D + col;
                    if (s == 0) { *(f4*)mp = (f4){o[0], o[1], o[2], o[3]}; *(f4*)(mp + 4) = (f4){o[4], o[5], o[6], o[7]}; }
                    else { const f4 p0 = *(const f4*)mp, p1 = *(const f4*)(mp + 4);
                        u4 w; w.x = cvtpk(p0.x + o[0], p0.y + o[1]); w.y = cvtpk(p0.z + o[2], p0.w + o[3]); w.z = cvtpk(p1.x + o[4], p1.y + o[5]); w.w = cvtpk(p1.z + o[6], p1.w + o[7]);
                        *(u4*)(Mo + (size_t)row * D + col) = w; } } }
    }
};
struct OrderG23 {
    pg8::StaticOrder S;
    __device__ __forceinline__ bool next(int i, pg8::Unit& u) const { if (i >= 2) return false; pg8::Unit t; if (!S.next(0, t)) return false; u.pm = t.pm + 64 * i; u.pn = t.pn + 4 * i; return true; }
    __device__ __forceinline__ void a_ready(const pg8::Unit&) const {}
    __device__ __forceinline__ void done(const pg8::Unit&) const {}
};
struct EpiG4 {
    static constexpr bool PERM = false, AFTER_DRAIN = false;
    const float* X; const float* mod; float* X1;
    __device__ __forceinline__ void operator()(const pg8::f32x4 (&acc)[2][2][4][2], const pg8::Unit& u, int wr, int wc, int fr, int fq) const {
        const int row0 = u.pm * 256 + wr * 64 + fr, col0 = u.pn * 256 + wc * 32 + 4 * fq; const int b = u.pm >> 5;
        f4 gt[2][2];
#pragma unroll
        for (int bj = 0; bj < 2; ++bj)
#pragma unroll
            for (int n = 0; n < 2; ++n) gt[bj][n] = *(const f4*)(mod + b * 6144 + 2048 + col0 + bj * 128 + n * 16);
#pragma unroll
        for (int ai = 0; ai < 2; ++ai)
#pragma unroll
            for (int m = 0; m < 4; ++m) { const size_t off = (size_t)(row0 + ai * 128 + m * 16) * D + col0;
#pragma unroll
                for (int bj = 0; bj < 2; ++bj)
#pragma unroll
                    for (int n = 0; n < 2; ++n) { const f4 xv = *(const f4*)(X + off + bj * 128 + n * 16); const pg8::f32x4 a = acc[ai][bj][m][n];
                        *(f4*)(X1 + off + bj * 128 + n * 16) = (f4){xv.x + gt[bj][n].x * a[0], xv.y + gt[bj][n].y * a[1], xv.z + gt[bj][n].z * a[2], xv.w + gt[bj][n].w * a[3]}; } }
    }
};
struct MoeOrder {
    int nM, nN, nwg, G, c; const LAS int* blk_exp;
    __device__ __forceinline__ void init(int nblk, int nN_, int G_, int c_, const LAS int* be) { nM = nblk; nN = nN_; nwg = nM * nN; G = G_; c = c_; blk_exp = be; }
    __device__ __forceinline__ bool next(int i, pg8::Unit& u) const {
        const long L = (long)i * G + c; if (L >= nwg) return false;
        int wgid = (int)L; { const int q = nwg / 8, r = nwg % 8, xcd = wgid % 8, off = wgid / 8; wgid = (xcd < r ? xcd * (q + 1) : r * (q + 1) + (xcd - r) * q) + off; }
        const int nig = 8 * nN, gid = wgid / nig, fm = gid * 8, gsz = (nM - fm) < 8 ? (nM - fm) : 8;
        const int pm = fm + ((wgid % nig) % gsz), pnl = (wgid % nig) / gsz;
        u.pm = pm; u.pn = blk_exp[pm] * nN + pnl; return true;
    }
    __device__ __forceinline__ void a_ready(const pg8::Unit&) const {}
    __device__ __forceinline__ void done(const pg8::Unit&) const {}
};
struct EpiMoe1 {
    static constexpr bool PERM = true, AFTER_DRAIN = false;
    const float* b1; bf16* ACT;
    __device__ __forceinline__ void operator()(const pg8::f32x4 (&acc)[2][2][4][2], const pg8::Unit& u, int wr, int wc, int fr, int fq) const {
        const int e = u.pn >> 3, pnl = u.pn & 7; const int row0 = u.pm * 256 + wr * 64 + fr, j0 = pnl * 128 + wc * 32 + 8 * fq;
        const float* bg = b1 + (size_t)e * 2048 + j0; const float* bu = bg + 1024;
        const f4 bg0 = *(const f4*)bg, bg1 = *(const f4*)(bg + 4), bu0 = *(const f4*)bu, bu1 = *(const f4*)(bu + 4);
        const float bgv[8] = {bg0.x, bg0.y, bg0.z, bg0.w, bg1.x, bg1.y, bg1.z, bg1.w}, buv[8] = {bu0.x, bu0.y, bu0.z, bu0.w, bu1.x, bu1.y, bu1.z, bu1.w};
#pragma unroll
        for (int ai = 0; ai < 2; ++ai)
#pragma unroll
            for (int m = 0; m < 4; ++m) { float o[8];
#pragma unroll
                for (int e8 = 0; e8 < 8; ++e8) { const int n = e8 >> 2, q = e8 & 3;
                    float g = acc[ai][0][m][n][q] + bgv[e8], up = acc[ai][1][m][n][q] + buv[e8];
                    g = fminf(g, 7.0f); up = fminf(fmaxf(up, -7.0f), 7.0f);
                    o[e8] = g * sigm(1.702f * g) * (up + 1.0f); }
                u4 w; w.x = cvtpk(o[0], o[1]); w.y = cvtpk(o[2], o[3]); w.z = cvtpk(o[4], o[5]); w.w = cvtpk(o[6], o[7]);
                *(u4*)(ACT + (size_t)(row0 + ai * 128 + m * 16) * D + j0) = w; }
    }
};
struct EpiMoe2 {
    static constexpr bool PERM = true, AFTER_DRAIN = false;
    const float* b2; bf16* YS;
    __device__ __forceinline__ void operator()(const pg8::f32x4 (&acc)[2][2][4][2], const pg8::Unit& u, int wr, int wc, int fr, int fq) const {
        const int e = u.pn >> 2, pnl = u.pn & 3; const int row0 = u.pm * 256 + wr * 64 + fr, col0 = pnl * 256 + wc * 32 + 8 * fq;
        f4 bv[2][2];
#pragma unroll
        for (int bj = 0; bj < 2; ++bj)
#pragma unroll
            for (int n = 0; n < 2; ++n) bv[bj][n] = *(const f4*)(b2 + (size_t)e * D + col0 + bj * 128 + 4 * n);
#pragma unroll
        for (int ai = 0; ai < 2; ++ai)
#pragma unroll
            for (int m = 0; m < 4; ++m) { bf16* rowp = YS + (size_t)(row0 + ai * 128 + m * 16) * D + col0;
#pragma unroll
                for (int bj = 0; bj < 2; ++bj) { const pg8::f32x4 v0 = acc[ai][bj][m][0], v1 = acc[ai][bj][m][1];
                    u4 w; w.x = cvtpk(v0[0] + bv[bj][0].x, v0[1] + bv[bj][0].y); w.y = cvtpk(v0[2] + bv[bj][0].z, v0[3] + bv[bj][0].w);
                    w.z = cvtpk(v1[0] + bv[bj][1].x, v1[1] + bv[bj][1].y); w.w = cvtpk(v1[2] + bv[bj][1].z, v1[3] + bv[bj][1].w);
                    *(u4*)(rowp + bj * 128) = w; } }
    }
};

constexpr int QS = 129;
constexpr int QB = 136;
typedef short bf16x8 __attribute__((ext_vector_type(8)));
__device__ __forceinline__ bf16x8 pack_frag(const pg8::f32x4 a, const pg8::f32x4 b) {
    u4 w; w.x = cvtpk(a[0], a[1]); w.y = cvtpk(a[2], a[3]); w.z = cvtpk(b[0], b[1]); w.w = cvtpk(b[2], b[3]); return __builtin_bit_cast(bf16x8, w);
}
__device__ __forceinline__ void phase_p3(Frame& F, const Args& AR) {
    const bf16* P = (const bf16*)(F.ws + WS_P); const float* psm = (const float*)(F.ws + WS_PSM);
    const float* convw = AR.in[6]; const float* a_log = AR.in[7]; const float* dt_bias = AR.in[8];
    LAS bf16* qb = (LAS bf16*)F.lds;
    LAS bf16* kb = qb + 64 * QB;
    LAS float* vs = (LAS float*)(kb + 64 * QB);
    LAS float* Lm = vs + 64 * QS;
    LAS float* betaL = Lm + 2 * 4096;
    LAS float* GL = betaL + 128;
    for (int unit = blockIdx.x; unit < 2 * NH * NCHUNK; unit += F.G) {
        const int b = unit >> 10, h = (unit >> 7) & 7, c = unit & 127, t0 = c * 64; const size_t tokbase = (size_t)b * SEQ;
        int tid = F.tid; asm volatile("" : "+v"(tid));
        const int lane = tid & 63;
        if (tid < 384) {
            const int cv = tid % 48, rg = tid / 48, part = cv >> 4, ch = (cv & 15) * 8, pcol = part * 1024 + h * 128 + ch;
            float wj[5][8];
#pragma unroll
            for (int j = 0; j < 5; ++j) { const f4 w0 = *(const f4*)(convw + j * 3072 + pcol), w1 = *(const f4*)(convw + j * 3072 + pcol + 4);
                wj[j][0] = w0.x; wj[j][1] = w0.y; wj[j][2] = w0.z; wj[j][3] = w0.w; wj[j][4] = w1.x; wj[j][5] = w1.y; wj[j][6] = w1.z; wj[j][7] = w1.w; }
            u4 raw[12];
#pragma unroll
            for (int r = 0; r < 12; ++r) { const int t = t0 + 8 * rg - 2 + r; raw[r] = (t >= 0 && t < SEQ) ? *(const u4*)(P + (tokbase + t) * PW + pcol) : (u4){0u, 0u, 0u, 0u}; }
#pragma unroll
            for (int i = 0; i < 8; ++i) { float acc[8];
#pragma unroll
                for (int e = 0; e < 8; ++e) acc[e] = 0.f;
#pragma unroll
                for (int j = 0; j < 5; ++j) { float xin[8]; unpack8(raw[i + j], xin);
#pragma unroll
                    for (int e = 0; e < 8; ++e) acc[e] += wj[j][e] * xin[e]; }
                float ssq = 0.f;
#pragma unroll
                for (int e = 0; e < 8; ++e) { acc[e] = silu(acc[e]); ssq += acc[e] * acc[e]; }
                ssq += __shfl_xor(ssq, 1); ssq += __shfl_xor(ssq, 2); ssq += __shfl_xor(ssq, 4); ssq += __shfl_xor(ssq, 8);
                if (part == 2) {
#pragma unroll
                    for (int e = 0; e < 8; ++e) vs[(8 * rg + i) * QS + ch + e] = acc[e];
                } else {
                    float sc = 1.0f / sqrtf(ssq + EPS); if (part == 0) sc *= 0.08838834764831845f;
#pragma unroll
                    for (int e = 0; e < 8; ++e) acc[e] *= sc;
                    *(LAS u4*)((part ? kb : qb) + (8 * rg + i) * QB + ch) = pack8(acc); }
            }
        }
        if (tid < 128) {
            const int dir = tid >> 6, ii = lane, io = dir ? 63 - ii : ii; const size_t tok = tokbase + t0 + io;
            const float braw = psm[tok * 32 + dir * 8 + h], araw = psm[tok * 32 + 16 + dir * 8 + h];
            float g = -expf(a_log[dir * 8 + h]) * softplus(araw + dt_bias[dir * 8 + h]);
#pragma unroll
            for (int o = 1; o < 64; o <<= 1) { const float t = __shfl_up(g, o); if (lane >= o) g += t; }
            betaL[dir * 64 + ii] = sigm(braw); GL[dir * 64 + ii] = g;
        }
        __syncthreads();
        asm volatile("" : "+v"(tid));
        {
            const int w = tid >> 6, dir = w >> 2, mi = w & 3, r = lane & 15, q = lane >> 4;
            const int ipos = 16 * mi + r, io = dir ? 63 - ipos : ipos;
            const float Gi = GL[dir * 64 + ipos], bi = betaL[dir * 64 + ipos];
            bf16x8 ki[4], qi[4];
#pragma unroll
            for (int s = 0; s < 4; ++s) { ki[s] = *(const LAS bf16x8*)(kb + io * QB + 32 * s + 8 * q); qi[s] = *(const LAS bf16x8*)(qb + io * QB + 32 * s + 8 * q); }
            unsigned char* dbase = F.ws + WS_DD + ((size_t)((b * 8 + h) * 2 + dir) * 128 + (dir ? 127 - c : c)) * DD_UNIT;
#pragma unroll
            for (int s2 = 0; s2 < 2; ++s2) { float av[8];
#pragma unroll
                for (int t = 0; t < 2; ++t) { const int mj = 2 * s2 + t;
                    if (mj <= mi) {
                        const int jp = 16 * mj + r, jo = dir ? 63 - jp : jp;
                        pg8::f32x4 kk = {0.f, 0.f, 0.f, 0.f}, qk = {0.f, 0.f, 0.f, 0.f};
#pragma unroll
                        for (int s = 0; s < 4; ++s) { const bf16x8 kj = *(const LAS bf16x8*)(kb + jo * QB + 32 * s + 8 * q);
                            kk = __builtin_amdgcn_mfma_f32_16x16x32_bf16(kj, ki[s], kk, 0, 0, 0); qk = __builtin_amdgcn_mfma_f32_16x16x32_bf16(kj, qi[s], qk, 0, 0, 0); }
                        f4 lv;
#pragma unroll
                        for (int jj = 0; jj < 4; ++jj) { const int jpos = 16 * mj + 4 * q + jj; const float dec = expf(Gi - GL[dir * 64 + jpos]);
                            const float l = (ipos > jpos) ? bi * kk[jj] * dec : 0.f; av[4 * t + jj] = (ipos >= jpos) ? qk[jj] * dec : 0.f;
                            if (jj == 0) lv.x = l; else if (jj == 1) lv.y = l; else if (jj == 2) lv.z = l; else lv.w = l; }
                        *(LAS f4*)(Lm + dir * 4096 + ipos * 64 + 16 * mj + 4 * q) = lv;
                    } else {
#pragma unroll
                        for (int jj = 0; jj < 4; ++jj) av[4 * t + jj] = 0.f;
                    } }
                *(u4*)(dbase + DD_A + (size_t)((mi * 2 + s2) * 64 + lane) * 16) = pack8(av); }
        }
        __syncthreads();
        asm volatile("" : "+v"(tid));
        {
            const int dir = tid >> 8, col = tid & 255; const bool isw = col >= 128; const int cc = col & 127;
            const LAS float* Lr = Lm + dir * 4096;
            unsigned char* dbase = F.ws + WS_DD + ((size_t)((b * 8 + h) * 2 + dir) * 128 + (dir ? 127 - c : c)) * DD_UNIT;
            const int wi = cc & 31, wq = (wi < 16) ? (wi >> 2) : ((wi - 16) >> 2), wjs = (wi < 16) ? (wi & 3) : (4 + (wi & 3));
            bf16* outp = isw ? ((bf16*)(dbase + DD_W) + (cc >> 5) * 512 + wq * 128 + wjs) : ((bf16*)(dbase + DD_U) + (cc >> 4) * 1024 + (cc & 15) * 4);
            float X[64];
#pragma unroll
            for (int i = 0; i < 64; ++i) { const int io = dir ? 63 - i : i;
                float xv;
                if (isw) xv = betaL[dir * 64 + i] * expf(GL[dir * 64 + i]) * bf1(kb[io * QB + cc]); else xv = betaL[dir * 64 + i] * vs[io * QS + cc];
#pragma unroll
                for (int j = 0; j < i; ++j) xv -= Lr[i * 64 + j] * X[j];
                asm volatile("" : "+v"(xv) :: "memory"); X[i] = xv;
                const int offw = (i >> 4) * 2048 + (i & 15) * 8, offu = (i >> 4) * 256 + ((i >> 2) & 3) * 64 + (i & 3);
                outp[isw ? offw : offu] = (bf16)f2bf(xv); }
        }
        asm volatile("" : "+v"(tid));
#pragma unroll
        for (int it = 0; it < 8; ++it) { const int item = it * NTHR + tid, dir = item >> 11, arr = (item >> 10) & 1, fidx = (item >> 6) & 15, fl = item & 63, r = fl & 15, q = fl >> 4;
            unsigned char* dbase = F.ws + WS_DD + ((size_t)((b * 8 + h) * 2 + dir) * 128 + (dir ? 127 - c : c)) * DD_UNIT;
            float o[8];
            if (arr == 0) { const int mt = fidx >> 2, s = fidx & 3, pos = 16 * mt + r, io = dir ? 63 - pos : pos; const float f = expf(GL[dir * 64 + pos]);
                const u2 lo = *(const LAS u2*)(qb + io * QB + 32 * s + 4 * q), hi = *(const LAS u2*)(qb + io * QB + 32 * s + 16 + 4 * q);
                o[0] = bflo(lo.x) * f; o[1] = bfhi(lo.x) * f; o[2] = bflo(lo.y) * f; o[3] = bfhi(lo.y) * f; o[4] = bflo(hi.x) * f; o[5] = bfhi(hi.x) * f; o[6] = bflo(hi.y) * f; o[7] = bfhi(hi.y) * f;
                *(u4*)(dbase + DD_Q + (size_t)(fidx * 64 + fl) * 16) = pack8(o);
            } else { const int m = fidx >> 1, s2 = fidx & 1, dk = 16 * m + r; const float gl = GL[dir * 64 + 63];
#pragma unroll
                for (int j = 0; j < 8; ++j) { const int pos = 32 * s2 + (j < 4 ? 4 * q + j : 16 + 4 * q + j - 4), io = dir ? 63 - pos : pos; o[j] = bf1(kb[io * QB + dk]) * expf(gl - GL[dir * 64 + pos]); }
                *(u4*)(dbase + DD_K + (size_t)(fidx * 64 + fl) * 16) = pack8(o); } }
        if (tid < 2) ((float*)(F.ws + WS_GL))[((b * 8 + h) * 2 + tid) * 128 + (tid ? 127 - c : c)] = expf(GL[tid * 64 + 63]);
        __syncthreads();
    }
}

constexpr int P4_BUF = 61440;
__device__ __forceinline__ void phase_p4(Frame& F, const Args& AR) {
    for (int unit = blockIdx.x; unit < 128; unit += F.G) {
        const int xcd = unit & 7, kq = unit >> 3, chain = xcd * 4 + (kq >> 2), pair = kq & 3, dir = chain & 1, bh = chain >> 1, b = bh >> 3, h = bh & 7;
        const unsigned char* cbase = F.ws + WS_DD + (size_t)chain * 128 * DD_UNIT;
        __syncthreads();
        if (F.wave >= 2) {
            const int l = F.tid - 128; u4 rg[10];
#define P4_SRC(step, i) ((const u4*)(cbase + (size_t)(step) * DD_UNIT + (((i) * 384 + l) < 3584 ? (size_t)((i) * 384 + l) * 16 : (size_t)DD_U + (size_t)pair * 4096 + (size_t)((i) * 384 + l - 3584) * 16)))
#pragma unroll
            for (int i = 0; i < 10; ++i) rg[i] = *P4_SRC(0, i);
#pragma unroll
            for (int i = 0; i < 10; ++i) *(LAS u4*)(F.lds + (size_t)(i * 384 + l) * 16) = rg[i];
#pragma unroll
            for (int i = 0; i < 10; ++i) rg[i] = *P4_SRC(1, i);
            asm volatile("s_waitcnt lgkmcnt(0)" ::: "memory"); __builtin_amdgcn_s_barrier(); asm volatile("" ::: "memory");
            for (int k = 0; k < NCHUNK; ++k) {
                if (k + 1 < NCHUNK) {
#pragma unroll
                    for (int i = 0; i < 10; ++i) *(LAS u4*)(F.lds + ((k + 1) & 1) * P4_BUF + (size_t)(i * 384 + l) * 16) = rg[i];
                }
                if (k + 2 < NCHUNK) {
#pragma unroll
                    for (int i = 0; i < 10; ++i) rg[i] = *P4_SRC(k + 2, i);
                }
                asm volatile("s_waitcnt lgkmcnt(0)" ::: "memory"); __builtin_amdgcn_s_barrier(); asm volatile("" ::: "memory");
            }
#undef P4_SRC
        } else {
            const int lane = F.lane, r = lane & 15, q = lane >> 4, sl = 2 * pair + F.wave;
            const float* glp = (const float*)(F.ws + WS_GL) + chain * 128;
            bf16* od = (bf16*)(F.ws + WS_OD) + (size_t)dir * NTOK * D + (size_t)b * SEQ * D + h * 128 + 16 * sl + 4 * q;
            pg8::f32x4 S[8]; bf16x8 SB[4];
#pragma unroll
            for (int m = 0; m < 8; ++m) S[m] = (pg8::f32x4){0.f, 0.f, 0.f, 0.f};
#pragma unroll
            for (int s = 0; s < 4; ++s) SB[s] = (bf16x8){0, 0, 0, 0, 0, 0, 0, 0};
            float egl = glp[0];
            asm volatile("s_waitcnt lgkmcnt(0)" ::: "memory"); __builtin_amdgcn_s_barrier(); asm volatile("" ::: "memory");
            for (int k = 0; k < NCHUNK; ++k) {
                const LAS unsigned char* bp = F.lds + (k & 1) * P4_BUF + lane * 16;
                const float egl_next = glp[k + 1 < NCHUNK ? k + 1 : k];
                pg8::f32x4 WS[4], OT[4];
#pragma unroll
                for (int mt = 0; mt < 4; ++mt) { WS[mt] = (pg8::f32x4){0.f, 0.f, 0.f, 0.f}; OT[mt] = (pg8::f32x4){0.f, 0.f, 0.f, 0.f}; }
#pragma unroll
                for (int mt = 0; mt < 4; ++mt)
#pragma unroll
                    for (int s = 0; s < 4; ++s) WS[mt] = __builtin_amdgcn_mfma_f32_16x16x32_bf16(*(const LAS bf16x8*)(bp + (mt * 4 + s) * 1024), SB[s], WS[mt], 0, 0, 0);
#pragma unroll
                for (int mt = 0; mt < 4; ++mt)
#pragma unroll
                    for (int s = 0; s < 4; ++s) OT[mt] = __builtin_amdgcn_mfma_f32_16x16x32_bf16(SB[s], *(const LAS bf16x8*)(bp + 16384 + (mt * 4 + s) * 1024), OT[mt], 0, 0, 0);
                pg8::f32x4 vn[4];
#pragma unroll
                for (int mt = 0; mt < 4; ++mt) { const u2 uu = *(const LAS u2*)(F.lds + (k & 1) * P4_BUF + 57344 + (F.wave * 4 + mt) * 512 + lane * 8);
                    vn[mt] = (pg8::f32x4){bflo(uu.x) - WS[mt][0], bfhi(uu.x) - WS[mt][1], bflo(uu.y) - WS[mt][2], bfhi(uu.y) - WS[mt][3]}; }
                bf16x8 VB[2]; VB[0] = pack_frag(vn[0], vn[1]); VB[1] = pack_frag(vn[2], vn[3]);
#pragma unroll
                for (int mt = 0; mt < 4; ++mt)
#pragma unroll
                    for (int s2 = 0; s2 < 2; ++s2) OT[mt] = __builtin_amdgcn_mfma_f32_16x16x32_bf16(VB[s2], *(const LAS bf16x8*)(bp + 49152 + (mt * 2 + s2) * 1024), OT[mt], 0, 0, 0);
#pragma unroll
                for (int m = 0; m < 8; ++m) { S[m] = S[m] * egl;
#pragma unroll
                    for (int s2 = 0; s2 < 2; ++s2) S[m] = __builtin_amdgcn_mfma_f32_16x16x32_bf16(*(const LAS bf16x8*)(bp + 32768 + (m * 2 + s2) * 1024), VB[s2], S[m], 0, 0, 0); }
#pragma unroll
                for (int s = 0; s < 4; ++s) SB[s] = pack_frag(S[2 * s], S[2 * s + 1]);
                const int co = dir ? 127 - k : k;
#pragma unroll
                for (int mt = 0; mt < 4; ++mt) { const int pos = 16 * mt + r, ro = dir ? 63 - pos : pos;
                    u2 ov; ov.x = cvtpk(OT[mt][0], OT[mt][1]); ov.y = cvtpk(OT[mt][2], OT[mt][3]);
                    *(u2*)(od + (size_t)(co * 64 + ro) * D) = ov; }
                egl = egl_next;
                asm volatile("s_waitcnt lgkmcnt(0)" ::: "memory"); __builtin_amdgcn_s_barrier(); asm volatile("" ::: "memory");
            }
        }
        __syncthreads();
    }
}

__device__ __forceinline__ void phase_p5(Frame& F, const Args& AR) {
    const bf16* P = (const bf16*)(F.ws + WS_P); const bf16* od = (const bf16*)(F.ws + WS_OD); bf16* oasb = (bf16*)(F.ws + WS_OASB);
    const float* onorm_w = AR.in[9]; const float* convs = AR.in[11];
    const int lane = F.lane, ch = 16 * lane;
    float onw[16], cw[3][16];
#pragma unroll
    for (int e = 0; e < 16; ++e) { onw[e] = onorm_w[(ch + e) & 127];
#pragma unroll
        for (int j = 0; j < 3; ++j) cw[j][e] = convs[j * 1024 + ch + e]; }
    const int gw = blockIdx.x * NWAVES + F.wave, NGW = F.G * NWAVES;
    for (int m = gw; m < NTOK; m += NGW) {
        const int t = m & (SEQ - 1);
        float o[16], z[16], t8[8];
        unpack8(*(const u4*)(od + (size_t)m * D + ch), t8);
#pragma unroll
        for (int e = 0; e < 8; ++e) o[e] = t8[e];
        unpack8(*(const u4*)(od + (size_t)m * D + ch + 8), t8);
#pragma unroll
        for (int e = 0; e < 8; ++e) o[8 + e] = t8[e];
        unpack8(*(const u4*)(od + (size_t)(NTOK + m) * D + ch), t8);
#pragma unroll
        for (int e = 0; e < 8; ++e) o[e] += t8[e];
        unpack8(*(const u4*)(od + (size_t)(NTOK + m) * D + ch + 8), t8);
#pragma unroll
        for (int e = 0; e < 8; ++e) o[8 + e] += t8[e];
        unpack8(*(const u4*)(P + (size_t)m * PW + PC_Z + ch), t8);
#pragma unroll
        for (int e = 0; e < 8; ++e) z[e] = t8[e];
        unpack8(*(const u4*)(P + (size_t)m * PW + PC_Z + ch + 8), t8);
#pragma unroll
        for (int e = 0; e < 8; ++e) z[8 + e] = t8[e];
        float ss = 0.f;
#pragma unroll
        for (int e = 0; e < 16; ++e) ss += o[e] * o[e];
        ss += __shfl_xor(ss, 1); ss += __shfl_xor(ss, 2); ss += __shfl_xor(ss, 4);
        const float rstd = 1.0f / sqrtf(ss * (1.0f / 128.0f) + EPS);
        float r[8];
#pragma unroll
        for (int e = 0; e < 8; ++e) r[e] = o[e] * rstd * onw[e] * silu(z[e]);
        *(u4*)(oasb + (size_t)m * D + ch) = pack8(r);
#pragma unroll
        for (int e = 0; e < 8; ++e) r[e] = o[8 + e] * rstd * onw[8 + e] * silu(z[8 + e]);
        *(u4*)(oasb + (size_t)m * D + ch + 8) = pack8(r);
        float acc[16];
#pragma unroll
        for (int e = 0; e < 16; ++e) acc[e] = 0.f;
#pragma unroll
        for (int j = 0; j < 3; ++j) { const int tt = t + j - 1;
            if (tt >= 0 && tt < SEQ) { const bf16* rowp = P + (size_t)(m + j - 1) * PW; float cg[8], ui[8];
                unpack8(*(const u4*)(rowp + PC_CG + ch), cg); unpack8(*(const u4*)(rowp + PC_UI + ch), ui);
#pragma unroll
                for (int e = 0; e < 8; ++e) acc[e] += cw[j][e] * (cg[e] * ui[e]);
                unpack8(*(const u4*)(rowp + PC_CG + ch + 8), cg); unpack8(*(const u4*)(rowp + PC_UI + ch + 8), ui);
#pragma unroll
                for (int e = 0; e < 8; ++e) acc[8 + e] += cw[j][8 + e] * (cg[e] * ui[e]); } }
        float bg[8];
        unpack8(*(const u4*)(P + (size_t)m * PW + PC_BG + ch), bg);
#pragma unroll
        for (int e = 0; e < 8; ++e) r[e] = bg[e] * acc[e];
        *(u4*)(oasb + (size_t)(NTOK + m) * D + ch) = pack8(r);
        unpack8(*(const u4*)(P + (size_t)m * PW + PC_BG + ch + 8), bg);
#pragma unroll
        for (int e = 0; e < 8; ++e) r[e] = bg[e] * acc[8 + e];
        *(u4*)(oasb + (size_t)(NTOK + m) * D + ch + 8) = pack8(r);
    }
}

__device__ __forceinline__ void phase_p7(Frame& F, const Args& AR) {
    const float* x1 = (const float*)(F.ws + WS_OD); const float* norm2_w = AR.in[14]; const float* router_b = AR.in[16]; const float* mod = (const float*)(F.ws + WS_MOD);
    LAS float* WtL = (LAS float*)F.lds;
    LAS float* A1 = (LAS float*)(F.lds + 131584);
    LAS float* B1 = A1 + 2048;
    stage_wt(WtL, (const float*)(F.ws + WS_WR_T), F.tid);
    for (int idx = F.tid; idx < 2048; idx += NTHR) { const int b = idx >> 10, k = idx & 1023; A1[idx] = norm2_w[k] * (1.0f + mod[b * 6144 + 4096 + k]); B1[idx] = mod[b * 6144 + 3072 + k]; }
    __syncthreads();
    bf16* h2 = (bf16*)(F.ws + WS_H); int* topi = (int*)(F.ws + WS_TOPI); float* topg = (float*)(F.ws + WS_TOPG); int* topp = (int*)(F.ws + WS_TOPP);
    unsigned* cnt = (unsigned*)(F.ws + WS_CTL) + CW_CNT;
    const int lane = F.lane; const float rb = router_b[lane >> 1];
    const int gw = blockIdx.x * NWAVES + F.wave, NGW = F.G * NWAVES;
    for (int m = gw; m < NTOK; m += NGW) {
        const f4* xr = (const f4*)(x1 + (size_t)m * D) + lane; f4 v[4]; float ss = 0.f;
#pragma unroll
        for (int j = 0; j < 4; ++j) { v[j] = xr[64 * j]; ss += (v[j].x * v[j].x + v[j].y * v[j].y) + (v[j].z * v[j].z + v[j].w * v[j].w); }
        const float rstd = 1.0f / sqrtf(wave_sum(ss) * (1.0f / D) + EPS);
        const int b = m >> 13;
#pragma unroll
        for (int j = 0; j < 4; ++j) { const f4 a = *(const LAS f4*)(A1 + b * 1024 + 256 * j + 4 * lane), bb = *(const LAS f4*)(B1 + b * 1024 + 256 * j + 4 * lane);
            v[j] = v[j] * rstd * a + bb;
            u2 o; o.x = pk2(v[j].x, v[j].y); o.y = pk2(v[j].z, v[j].w); ((u2*)(h2 + (size_t)m * D))[lane + 64 * j] = o; }
        float val = dot32(v, WtL, lane) + rb; const int myn = lane >> 1;
        float tv[4]; int ti[4];
#pragma unroll
        for (int r = 0; r < 4; ++r) { float bv = val; int bi = myn;
#pragma unroll
            for (int o = 1; o < 64; o <<= 1) { const float ov = __shfl_xor(bv, o); const int oi = __shfl_xor(bi, o); if (ov > bv || (ov == bv && oi < bi)) { bv = ov; bi = oi; } }
            tv[r] = bv; ti[r] = bi; if (myn == bi) val = -__builtin_inff(); }
        const float e1 = __expf(tv[1] - tv[0]), e2 = __expf(tv[2] - tv[0]), e3 = __expf(tv[3] - tv[0]), inv = 1.0f / (1.0f + e1 + e2 + e3);
        if (lane < 4) { const int e = lane == 0 ? ti[0] : (lane == 1 ? ti[1] : (lane == 2 ? ti[2] : ti[3]));
            const float g = (lane == 0 ? 1.0f : (lane == 1 ? e1 : (lane == 2 ? e2 : e3))) * inv;
            const unsigned pos = __hip_atomic_fetch_add(cnt + 64 * e, 1u, __ATOMIC_RELAXED, __HIP_MEMORY_SCOPE_AGENT);
            topi[(size_t)m * 4 + lane] = e; topg[(size_t)m * 4 + lane] = g; topp[(size_t)m * 4 + lane] = (int)pos; }
    }
}

__device__ __forceinline__ int build_moe_tables(Frame& F, LAS int* tab  ) {
    const unsigned* cnt = (const unsigned*)(F.ws + WS_CTL) + CW_CNT;
    if (F.tid == 0) { int start = 0;
        for (int e = 0; e < NEXP; ++e) { const int n = (int)__hip_atomic_load(cnt + 64 * e, __ATOMIC_RELAXED, __HIP_MEMORY_SCOPE_AGENT); const int nb = (n + 255) >> 8; tab[e] = start * 256;
            for (int k = 0; k < nb; ++k) tab[64 + start + k] = e; start += nb; }
        tab[32] = start; }
    __syncthreads();
    return tab[32];
}

__device__ __forceinline__ void phase_p8(Frame& F, const Args& AR) {
    LAS int* tab = (LAS int*)(F.lds + LDS_TAB);
    build_moe_tables(F, tab);
    const bf16* h2 = (const bf16*)(F.ws + WS_H); bf16* xs = (bf16*)(F.ws + WS_XS);
    const int* topi = (const int*)(F.ws + WS_TOPI); int* topp = (int*)(F.ws + WS_TOPP);
    const int gw = blockIdx.x * NWAVES + F.wave, NGW = F.G * NWAVES;
    for (int q = gw; q < NTOK * TOPK; q += NGW) {
        const int e = topi[q], row = tab[e] + topp[q];
        const u4* src = (const u4*)(h2 + (size_t)(q >> 2) * D) + F.lane; u4* dst = (u4*)(xs + (size_t)row * D) + F.lane;
        const u4 a = src[0], b2 = src[64]; dst[0] = a; dst[64] = b2;
        if (F.lane == 0) topp[q] = row;
    }
}

__device__ __forceinline__ void phase_p9(Frame& F, const Args& AR, float* out) {
    const float* x1 = (const float*)(F.ws + WS_OD); const bf16* ys = (const bf16*)(F.ws + WS_YS); const float* mod = (const float*)(F.ws + WS_MOD); const float* fnw = AR.in[21];
    const float* topg = (const float*)(F.ws + WS_TOPG); const int* topp = (const int*)(F.ws + WS_TOPP);
    const int lane = F.lane;
    const int gw = blockIdx.x * NWAVES + F.wave, NGW = F.G * NWAVES;
    for (int m = gw; m < NTOK; m += NGW) {
        const int b = m >> 13;
        const f4 gk = *(const f4*)(topg + (size_t)m * 4); const int r0 = topp[(size_t)m * 4], r1 = topp[(size_t)m * 4 + 1], r2 = topp[(size_t)m * 4 + 2], r3 = topp[(size_t)m * 4 + 3];
        f4 v[4]; float ss = 0.f;
#pragma unroll
        for (int j = 0; j < 4; ++j) {
            const u2 y0 = ((const u2*)(ys + (size_t)r0 * D))[lane + 64 * j], y1 = ((const u2*)(ys + (size_t)r1 * D))[lane + 64 * j], y2 = ((const u2*)(ys + (size_t)r2 * D))[lane + 64 * j], y3 = ((const u2*)(ys + (size_t)r3 * D))[lane + 64 * j];
            f4 mo;
            mo.x = gk.x * bflo(y0.x) + gk.y * bflo(y1.x) + gk.z * bflo(y2.x) + gk.w * bflo(y3.x);
            mo.y = gk.x * bfhi(y0.x) + gk.y * bfhi(y1.x) + gk.z * bfhi(y2.x) + gk.w * bfhi(y3.x);
            mo.z = gk.x * bflo(y0.y) + gk.y * bflo(y1.y) + gk.z * bflo(y2.y) + gk.w * bflo(y3.y);
            mo.w = gk.x * bfhi(y0.y) + gk.y * bfhi(y1.y) + gk.z * bfhi(y2.y) + gk.w * bfhi(y3.y);
            const f4 xv = ((const f4*)(x1 + (size_t)m * D))[lane + 64 * j], gt = ((const f4*)(mod + b * 6144 + 5120))[lane + 64 * j];
            v[j] = xv + gt * mo; ss += (v[j].x * v[j].x + v[j].y * v[j].y) + (v[j].z * v[j].z + v[j].w * v[j].w); }
        const float rstd = 1.0f / sqrtf(wave_sum(ss) * (1.0f / D) + EPS);
#pragma unroll
        for (int j = 0; j < 4; ++j) { const f4 w = ((const f4*)fnw)[lane + 64 * j]; ((f4*)(out + (size_t)m * D))[lane + 64 * j] = v[j] * rstd * w; }
    }
}

__global__ void __launch_bounds__(NTHR, 2) fwd_kernel(Args args) {
    const Args& AR = args;
    extern __shared__ __attribute__((aligned(16))) unsigned char lds_raw[];
    Frame F;
    F.lds = (LAS unsigned char*)lds_raw;
    F.tid = threadIdx.x; F.lane = F.tid & 63; F.wave = __builtin_amdgcn_readfirstlane(F.tid >> 6); F.G = gridDim.x;
    F.ws = args.ws;
    volatile LAS unsigned* misc = (volatile LAS unsigned*)(F.lds + LDS_MISC);
    if (F.tid < 4) misc[F.tid] = 0u;
    __syncthreads();
    XcdBarrier bar; bar.bar = (unsigned*)(F.ws + WS_CTL) + CW_BAR; bar.x = 0; bar.st = nullptr;
    if (MK_N_LAUNCHES == 1) bar = xcd_barrier_post((unsigned*)(F.ws + WS_CTL) + CW_BAR, misc);
    const int lo = args.ph_lo, hi = args.ph_hi;
#ifndef PH_MASK
#define PH_MASK 0x1fff
#endif
#define IN(k) (((PH_MASK >> (k)) & 1) && lo <= (k) && (k) < hi)
#define SEAM(k) do { if (IN(k) && IN((k) + 1)) xcd_barrier(bar); } while (0)
    PG8_LAS unsigned char* glds = (PG8_LAS unsigned char*)lds_raw;

    if (IN(0)) { phase_p0(F, AR); } SEAM(0);
    if (IN(1)) { phase_p1(F, AR); } SEAM(1);
    if (IN(2)) {
        pg8::Gemm g{(const bf16*)(F.ws + WS_H), (const bf16*)(F.ws + WS_WIN_T), NTOK, PW, D}; pg8::StaticOrder S; S.init(NTOK, PW, F.G, (int)blockIdx.x);
        EpiStoreBf16 E{(bf16*)(F.ws + WS_P), PW};
        pg8::gemm_phase<EpiStoreBf16, pg8::StaticOrder, true, true>(glds, g, S, E);
    } SEAM(2);
    if (IN(3)) { phase_p3(F, AR); } SEAM(3);
    if (IN(4)) { phase_p4(F, AR); } SEAM(4);
    if (IN(5)) { phase_p5(F, AR); } SEAM(5);
    if (IN(6)) {
        pg8::Gemm g{(const bf16*)(F.ws + WS_OASB), (const bf16*)(F.ws + WS_WUO_T), 2 * NTOK, 2048, D}; OrderG23 S; S.S.init(NTOK, D, F.G, (int)blockIdx.x);
        EpiG23 E{(const bf16*)(F.ws + WS_P), (float*)(F.ws + WS_M1), (bf16*)(F.ws + WS_M)};
        pg8::gemm_phase<EpiG23, OrderG23, true, true>(glds, g, S, E);
    } SEAM(6);
    if (IN(7)) {
        pg8::Gemm g{(const bf16*)(F.ws + WS_M), (const bf16*)(F.ws + WS_WO_T), NTOK, D, D}; pg8::StaticOrder S; S.init(NTOK, D, F.G, (int)blockIdx.x);
        EpiG4 E{AR.in[0], (const float*)(F.ws + WS_MOD), (float*)(F.ws + WS_OD)};
        pg8::gemm_phase<EpiG4, pg8::StaticOrder, true, true>(glds, g, S, E);
    } SEAM(7);
    if (IN(8)) { phase_p7(F, AR); } SEAM(8);
    if (IN(9)) { phase_p8(F, AR); } SEAM(9);
    if (IN(10)) {
        __syncthreads();
        LAS int* tab = (LAS int*)(F.lds + LDS_TAB); const int nblk = build_moe_tables(F, tab);
        pg8::Gemm g{(const bf16*)(F.ws + WS_XS), (const bf16*)(F.ws + WS_W1T), MROWS, NEXP * 2048, D}; MoeOrder S; S.init(nblk, 8, F.G, (int)blockIdx.x, tab + 64);
        EpiMoe1 E{AR.in[18], (bf16*)(F.ws + WS_ACT)};
        pg8::gemm_phase<EpiMoe1, MoeOrder, true, true>(glds, g, S, E);
    } SEAM(10);
    if (IN(11)) {
        __syncthreads();
        LAS int* tab = (LAS int*)(F.lds + LDS_TAB); const int nblk = build_moe_tables(F, tab);
        pg8::Gemm g{(const bf16*)(F.ws + WS_ACT), (const bf16*)(F.ws + WS_W2T), MROWS, NEXP * 1024, D}; MoeOrder S; S.init(nblk, 4, F.G, (int)blockIdx.x, tab + 64);
        EpiMoe2 E{AR.in[20], (bf16*)(F.ws + WS_YS)};
        pg8::gemm_phase<EpiMoe2, MoeOrder, true, true>(glds, g, S, E);
    } SEAM(11);
    if (IN(12)) { phase_p9(F, AR, args.out); }
#undef IN
#undef SEAM
}

extern "C" void kernel_launch(void* const* d_in, const int* in_sizes, int n_in, void* d_out, int out_size, void* d_ws, size_t ws_size, hipStream_t stream) {
    static int grid = 0;
    if (grid == 0) {
        if (n_in != 22 || out_size != NTOK * D || ws_size < WS_END) { fprintf(stderr, "kernel_launch: unexpected shapes (n_in %d out %d ws %zu)\n", n_in, out_size, ws_size); grid = -1; return; }
        int dev = 0, cus = 0, per_cu = 0;
        if (hipGetDevice(&dev) != hipSuccess || hipDeviceGetAttribute(&cus, hipDeviceAttributeMultiprocessorCount, dev) != hipSuccess) { grid = -1; return; }
        if (hipFuncSetAttribute((const void*)fwd_kernel, hipFuncAttributeMaxDynamicSharedMemorySize, LDS_BYTES) != hipSuccess) { fprintf(stderr, "kernel_launch: hipFuncSetAttribute failed\n"); grid = -1; return; }
        if (hipOccupancyMaxActiveBlocksPerMultiprocessor(&per_cu, (const void*)fwd_kernel, NTHR, LDS_BYTES) != hipSuccess || per_cu < 1) { fprintf(stderr, "kernel_launch: occupancy query says %d\n", per_cu); }
        (void)hipGetLastError();
        grid = cus;
        if (grid > 256) grid = 256;
    }
    if (grid < 0) return;
    if (hipMemsetAsync((char*)d_ws + WS_CTL, 0, CTL_ZERO_BYTES, stream) != hipSuccess) return;
    Args a{};
    for (int i = 0; i < 22; ++i) a.in[i] = (const float*)d_in[i];
    a.out = (float*)d_out; a.ws = (unsigned char*)d_ws;
#if MK_N_LAUNCHES == 1
    a.ph_lo = 0; a.ph_hi = NPHASE;
    hipLaunchKernelGGL(fwd_kernel, dim3(grid), dim3(NTHR), LDS_BYTES, stream, a);
#else
    for (int ph = 0; ph < NPHASE; ++ph) { a.ph_lo = ph; a.ph_hi = ph + 1; hipLaunchKernelGGL(fwd_kernel, dim3(grid), dim3(NTHR), LDS_BYTES, stream, a); }
#endif
}
```

```cpp
#include <hip/hip_runtime.h>
#include <cstdio>
#include <cstdint>
namespace pg8 {
#define PG8_LAS __attribute__((address_space(3)))
typedef unsigned short bf16_t;
typedef short bf16x8 __attribute__((ext_vector_type(8)));
typedef float f32x4 __attribute__((ext_vector_type(4)));
typedef unsigned u32x4 __attribute__((ext_vector_type(4)));
constexpr int BM = 256, BK = 64, HALF = 128, HTB = HALF * BK * 2  , STAGE_BYTES = 8 * HTB, NXCD = 8, WGM = 8;

__host__ __device__ __forceinline__ int lds_byte(int r, int c) { const int st = (r >> 4) * 2 + (c >> 5), rr = r & 15, cc = c & 31, ob = rr * 64 + cc * 2; return st * 1024 + (ob ^ (((ob >> 9) & 1) << 5)); }
__host__ __device__ __forceinline__ void stage_rc(int b, int& R, int& C) { const int st = b / 1024, sb = b % 1024, swz = sb ^ (((sb >> 9) & 1) << 5); R = (st >> 1) * 16 + swz / 64; C = (st & 1) * 32 + (swz % 64) / 2; }
__host__ __device__ __forceinline__ int perm32(int rho) { const int n = rho >> 4, i = rho & 15; return 8 * (i >> 2) + 4 * n + (i & 3); }

struct Unit { int pm, pn; };
struct Gemm { const bf16_t* A; const bf16_t* Bt; int M, N, K; };

struct StaticOrder {
    int nM, nN, nwg, G, c;
    __host__ __device__ void init(int M, int N, int G_, int c_) { nM = M / BM; nN = N / BM; nwg = nM * nN; G = G_; c = c_; }
    __host__ __device__ bool next(int i, Unit& u) const {
        const long L = (long)i * G + c; if (L >= nwg) return false;
        int wgid = (int)L; { const int q = nwg / NXCD, r = nwg % NXCD, xcd = wgid % NXCD, off = wgid / NXCD; wgid = (xcd < r ? xcd * (q + 1) : r * (q + 1) + (xcd - r) * q) + off; }
        const int nig = WGM * nN, gid = wgid / nig, fm = gid * WGM, gsz = (nM - fm) < WGM ? (nM - fm) : WGM;
        u.pm = fm + ((wgid % nig) % gsz); u.pn = (wgid % nig) / gsz; return true;
    }
    __device__ __forceinline__ void a_ready(const Unit&) const {}
    __device__ __forceinline__ void done(const Unit&) const {}
};

__device__ __forceinline__ unsigned cvt_pk_bf16(float lo, float hi) { unsigned r; asm volatile("v_cvt_pk_bf16_f32 %0, %1, %2" : "=v"(r) : "v"(lo), "v"(hi)); return r; }
template <class Epi, class Sched, bool ALIGN_EPI = false, bool SP2 = false>
__device__ __forceinline__ void gemm_phase(PG8_LAS unsigned char* lds, const Gemm g, const Sched& S, const Epi& E) {
    const int tid = threadIdx.x, wid = __builtin_amdgcn_readfirstlane(tid >> 6), lane = tid & 63, wr = wid >> 2, wc = wid & 3, fr = lane & 15, fq = lane >> 4;
    const int K = g.K, nt = K / BK;
    unsigned voffA[2], voffB[2];
#pragma unroll
    for (int i = 0; i < 2; ++i) { int R, C; stage_rc(tid * 16 + i * 8192, R, C); const int Rb = Epi::PERM ? ((R & ~31) + perm32(R & 31)) : R;
        voffA[i] = (unsigned)(R * K + C) * 2u; voffB[i] = (unsigned)(Rb * K + C) * 2u; }
    const size_t kstep = (size_t)(BK * 2);
    const size_t hstep = (size_t)HALF * K * 2;
    const size_t tstep = 2 * hstep;
    const unsigned ldsw = (unsigned)wid * 1024u;
    const int aoff = lds_byte(wr * 64 + fr, fq * 8), boff = lds_byte(wc * 32 + fr, fq * 8);
#define PG8_SA(b, h) (((b) * 2 + (h)) * HTB)
#define PG8_SB(b, h) ((4 + (b) * 2 + (h)) * HTB)
#define PG8_STAGE(bufoff, gbase, voff) do { _Pragma("unroll") for (int _i = 0; _i < 2; ++_i) \
        __builtin_amdgcn_global_load_lds((const unsigned*)((const char*)(gbase) + (voff)[_i]), (PG8_LAS unsigned*)(lds + (bufoff) + ldsw + _i * 8192), 16, 0, 0); } while (0)
#define PG8_LDA(dst, b, h) do { _Pragma("unroll") for (int m = 0; m < 4; ++m) _Pragma("unroll") for (int k = 0; k < 2; ++k) dst[m][k] = *(const PG8_LAS bf16x8*)(lds + PG8_SA(b, h) + aoff + m * 2048 + k * 1024); } while (0)
#define PG8_LDB(dst, b, h) do { _Pragma("unroll") for (int n = 0; n < 2; ++n) _Pragma("unroll") for (int k = 0; k < 2; ++k) dst[n][k] = *(const PG8_LAS bf16x8*)(lds + PG8_SB(b, h) + boff + n * 2048 + k * 1024); } while (0)
#define PG8_MMA(ai, bj, At, Bt) do { __builtin_amdgcn_s_setprio(1); _Pragma("unroll") for (int m = 0; m < 4; ++m) _Pragma("unroll") for (int n = 0; n < 2; ++n) _Pragma("unroll") for (int k = 0; k < 2; ++k) \
        acc[ai][bj][m][n] = __builtin_amdgcn_mfma_f32_16x16x32_bf16(Bt[n][k], At[m][k], acc[ai][bj][m][n], 0, 0, 0); __builtin_amdgcn_s_setprio(0); } while (0)
#define PG8_WAIT_V(n) asm volatile("s_waitcnt vmcnt(" #n ")" ::: "memory")
#define PG8_WAIT_L(n) asm volatile("s_waitcnt lgkmcnt(" #n ")" ::: "memory")
#define PG8_BAR __builtin_amdgcn_s_barrier()
#define PG8_SCHED __builtin_amdgcn_sched_barrier(0)
    Unit cur, nxt; int ui = 0;
    if (!S.next(0, cur)) return;
    f32x4 acc[2][2][4][2];
#pragma unroll
    for (int a = 0; a < 2; ++a)
#pragma unroll
        for (int b = 0; b < 2; ++b)
#pragma unroll
            for (int m = 0; m < 4; ++m)
#pragma unroll
                for (int n = 0; n < 2; ++n) acc[a][b][m][n] = (f32x4){0.f, 0.f, 0.f, 0.f};
    bf16x8 At[4][2], B0[2][2], B1[2][2];
    const char* cA = (const char*)g.A + (size_t)cur.pm * tstep; const char* cB = (const char*)g.Bt + (size_t)cur.pn * tstep;
    S.a_ready(cur);
    if constexpr (SP2) {
        PG8_STAGE(PG8_SB(0, 0), cB, voffB); PG8_STAGE(PG8_SB(0, 1), cB + hstep, voffB); PG8_STAGE(PG8_SA(0, 0), cA, voffA); PG8_STAGE(PG8_SA(0, 1), cA + hstep, voffA);
        if (wr == 1) PG8_BAR;
        PG8_WAIT_V(2); PG8_BAR;
        PG8_STAGE(PG8_SB(1, 0), cB + kstep, voffB); PG8_STAGE(PG8_SA(1, 0), cA + kstep, voffA); PG8_STAGE(PG8_SB(1, 1), cB + hstep + kstep, voffB);
        PG8_WAIT_V(6); PG8_BAR;
    } else {
        PG8_STAGE(PG8_SB(0, 0), cB, voffB); PG8_STAGE(PG8_SA(0, 0), cA, voffA); PG8_STAGE(PG8_SB(0, 1), cB + hstep, voffB); PG8_STAGE(PG8_SA(0, 1), cA + hstep, voffA);
        if (wr == 1) PG8_BAR;
        PG8_WAIT_V(4); PG8_BAR;
        PG8_STAGE(PG8_SB(1, 0), cB + kstep, voffB); PG8_STAGE(PG8_SA(1, 0), cA + kstep, voffA); PG8_STAGE(PG8_SB(1, 1), cB + hstep + kstep, voffB);
        PG8_WAIT_V(6); PG8_BAR;
    }
    for (;;) {
        const bool has_next = S.next(ui + 1, nxt);
        const char* nA = has_next ? (const char*)g.A + (size_t)nxt.pm * tstep : cA; const char* nB = has_next ? (const char*)g.Bt + (size_t)nxt.pn * tstep : cB;
        for (int t = 0; t < nt; t += 2) {
            const bool last = (t == nt - 2);
            const char* a1 = cA + (size_t)(t + 1) * kstep;
            const char* a2 = last ? nA : cA + (size_t)(t + 2) * kstep; const char* b2 = last ? nB : cB + (size_t)(t + 2) * kstep;
            const char* a3 = a2 + kstep; const char* b3 = b2 + kstep;
            if (last && has_next) S.a_ready(nxt);
            if constexpr (SP2) {
            PG8_LDB(B0, 0, 0); PG8_LDB(B1, 0, 1); PG8_SCHED; PG8_LDA(At, 0, 0); PG8_STAGE(PG8_SA(1, 1), a1 + hstep, voffA);
            PG8_WAIT_V(8); PG8_WAIT_L(0); PG8_BAR; PG8_MMA(0, 0, At, B0); PG8_MMA(0, 1, At, B1); PG8_BAR; PG8_SCHED;
            PG8_LDA(At, 0, 1); PG8_STAGE(PG8_SB(0, 0), b2, voffB); PG8_STAGE(PG8_SB(0, 1), b2 + hstep, voffB); PG8_STAGE(PG8_SA(0, 0), a2, voffA);
            PG8_WAIT_V(8); PG8_WAIT_L(0); PG8_BAR; PG8_MMA(1, 0, At, B0); PG8_MMA(1, 1, At, B1); PG8_BAR; PG8_SCHED;
            PG8_LDB(B0, 1, 0); PG8_LDB(B1, 1, 1); PG8_SCHED; PG8_LDA(At, 1, 0); PG8_STAGE(PG8_SA(0, 1), a2 + hstep, voffA);
            PG8_WAIT_V(8); PG8_WAIT_L(0); PG8_BAR; PG8_MMA(0, 0, At, B0); PG8_MMA(0, 1, At, B1); PG8_BAR; PG8_SCHED;
            PG8_LDA(At, 1, 1); PG8_STAGE(PG8_SB(1, 0), b3, voffB); PG8_STAGE(PG8_SB(1, 1), b3 + hstep, voffB); PG8_STAGE(PG8_SA(1, 0), a3, voffA);
            PG8_WAIT_V(8); PG8_WAIT_L(0); PG8_BAR; PG8_MMA(1, 0, At, B0); PG8_MMA(1, 1, At, B1); PG8_BAR; PG8_SCHED;
            } else {
            PG8_LDB(B0, 0, 0); PG8_SCHED; PG8_LDA(At, 0, 0); PG8_STAGE(PG8_SA(1, 1), a1 + hstep, voffA);
            PG8_WAIT_L(8); PG8_BAR; PG8_WAIT_L(0); PG8_MMA(0, 0, At, B0); PG8_BAR; PG8_SCHED;
            PG8_LDB(B1, 0, 1); PG8_STAGE(PG8_SB(0, 0), b2, voffB);
            PG8_BAR; PG8_WAIT_L(0); PG8_MMA(0, 1, At, B1); PG8_BAR;
            PG8_LDA(At, 0, 1); PG8_STAGE(PG8_SA(0, 0), a2, voffA);
            PG8_BAR; PG8_WAIT_L(0); PG8_MMA(1, 0, At, B0); PG8_BAR; PG8_SCHED;
            PG8_STAGE(PG8_SB(0, 1), b2 + hstep, voffB);
            PG8_WAIT_V(6); PG8_BAR; PG8_MMA(1, 1, At, B1); PG8_BAR;
            PG8_LDB(B0, 1, 0); PG8_SCHED; PG8_LDA(At, 1, 0); PG8_STAGE(PG8_SA(0, 1), a2 + hstep, voffA);
            PG8_WAIT_L(8); PG8_BAR; PG8_WAIT_L(0); PG8_MMA(0, 0, At, B0); PG8_BAR; PG8_SCHED;
            PG8_LDB(B1, 1, 1); PG8_STAGE(PG8_SB(1, 0), b3, voffB);
            PG8_BAR; PG8_WAIT_L(0); PG8_MMA(0, 1, At, B1); PG8_BAR;
            PG8_LDA(At, 1, 1); PG8_STAGE(PG8_SA(1, 0), a3, voffA);
            PG8_BAR; PG8_WAIT_L(0); PG8_MMA(1, 0, At, B0); PG8_BAR; PG8_SCHED;
            PG8_STAGE(PG8_SB(1, 1), b3 + hstep, voffB);
            PG8_WAIT_V(6); PG8_BAR; PG8_MMA(1, 1, At, B1); PG8_BAR;
            }
        }
        if constexpr (ALIGN_EPI) { if (wr == 0) PG8_BAR; }
        if constexpr (!Epi::AFTER_DRAIN) { E(acc, cur, wr, wc, fr, fq); S.done(cur); }
        if (!has_next) break;
#pragma unroll
        for (int a = 0; a < 2; ++a)
#pragma unroll
            for (int b = 0; b < 2; ++b)
#pragma unroll
                for (int m = 0; m < 4; ++m)
#pragma unroll
                    for (int n = 0; n < 2; ++n) acc[a][b][m][n] = (f32x4){0.f, 0.f, 0.f, 0.f};
        cur = nxt; cA = nA; cB = nB; ++ui;
        if constexpr (ALIGN_EPI) { if (wr == 1) PG8_BAR; }
    }
    PG8_WAIT_V(0);
    if constexpr (!ALIGN_EPI) { if (wr == 0) PG8_BAR; }
    PG8_BAR;
    if constexpr (Epi::AFTER_DRAIN) { E.fused(acc, cur, wr, wc, fr, fq, lds, wid, lane); S.done(cur); }
#undef PG8_SA
#undef PG8_SB
#undef PG8_STAGE
#undef PG8_LDA
#undef PG8_LDB
#undef PG8_MMA
#undef PG8_WAIT_V
#undef PG8_WAIT_L
#undef PG8_BAR
#undef PG8_SCHED
}
}

#define XB_TMO      128
#define XB_XCNT(j)  (256  + 64 * (j))
#define XB_XSUB(j)  (1280 + 64 * (j))
#define XB_XGEN(j)  (2304 + 64 * (j))
#define XB_TOP      3328
#define XB_TOPGEN   3392
#define XCD_BAR_WORDS 3456
#define XB_SPIN_CAP (1u << 18)
#define LAS __attribute__((address_space(3)))

__device__ __forceinline__ unsigned xb_ld(unsigned* p)              { return __hip_atomic_load(p, __ATOMIC_RELAXED, __HIP_MEMORY_SCOPE_AGENT); }
__device__ __forceinline__ unsigned xb_add(unsigned* p, unsigned v) { return __hip_atomic_fetch_add(p, v, __ATOMIC_RELAXED, __HIP_MEMORY_SCOPE_AGENT); }
__device__ __forceinline__ unsigned xb_xcc_id() { return (unsigned)__builtin_amdgcn_s_getreg((3 << 11) | 20) & 0xFu; }
#define XB_SPIN(cond, bar) do { unsigned _sp = 0; while (cond) { __builtin_amdgcn_s_sleep(1); \
    if ((++_sp & 255u) == 0u) { if (xb_ld(&(bar)[XB_TMO])) break; if (_sp > XB_SPIN_CAP) { atomicAdd(&(bar)[XB_TMO], 1u); break; } } } } while (0)

struct XcdBarrier {
    unsigned* bar; unsigned x;
    volatile LAS unsigned* st;
};

__device__ __forceinline__ XcdBarrier xcd_barrier_post(unsigned* bar, volatile LAS unsigned* st) {
    XcdBarrier b; b.bar = bar; b.x = xb_xcc_id(); b.st = st;
    if (threadIdx.x == 0) (void)xb_add(&bar[XB_XCNT(b.x)], 1u);
    return b;
}
__device__ __forceinline__ void xcd_barrier_complete(unsigned* bar, unsigned x, unsigned& nloc, unsigned& nx) {
    const unsigned G = gridDim.x * gridDim.y * gridDim.z;
    unsigned sum, cnt, mine, sp = 0u;
    for (;;) {
        sum = 0u; cnt = 0u; mine = 0u;
#pragma unroll
        for (unsigned j = 0; j < 16; ++j) { const unsigned c = xb_ld(&bar[XB_XCNT(j)]); sum += c; cnt += (c > 0u) ? 1u : 0u; mine = (j == x) ? c : mine; }
        if (sum == G) break;
        __builtin_amdgcn_s_sleep(1);
        if ((++sp & 255u) == 0u) { if (xb_ld(&bar[XB_TMO])) break; if (sp > XB_SPIN_CAP) { atomicAdd(&bar[XB_TMO], 1u); break; } }
    }
    nloc = mine > 0u ? mine : 1u; nx = cnt > 0u ? cnt : 1u;
}

__device__ __forceinline__ void xcd_barrier(const XcdBarrier& b) {
    asm volatile("s_waitcnt vmcnt(0)" ::: "memory");
    __syncthreads();
    if (threadIdx.x == 0) {
        unsigned* bar = b.bar;
        __builtin_amdgcn_s_waitcnt(0);
        unsigned nloc = b.st[0], nx = b.st[1];
        if (nloc == 0u) { xcd_barrier_complete(bar, b.x, nloc, nx); b.st[0] = nloc; b.st[1] = nx; }
        const unsigned old = xb_add(&bar[XB_XSUB(b.x)], 1u);
        const unsigned gen = old / nloc;
        if (old + 1u == (gen + 1u) * nloc) {
            __builtin_amdgcn_fence(__ATOMIC_RELEASE, "agent");
            asm volatile("s_waitcnt vmcnt(0)" ::: "memory");
            const unsigned og = xb_add(&bar[XB_TOP], 1u);
            const unsigned tg = og / nx;
            if (og + 1u == (tg + 1u) * nx) xb_add(&bar[XB_TOPGEN], 1u);
            else XB_SPIN(xb_ld(&bar[XB_TOPGEN]) == tg, bar);
            __builtin_amdgcn_fence(__ATOMIC_ACQUIRE, "agent");
            xb_add(&bar[XB_XGEN(b.x)], 1u);
            asm volatile("s_waitcnt vmcnt(0)" ::: "memory");
        } else {
            XB_SPIN(xb_ld(&bar[XB_XGEN(b.x)]) == gen, bar);
            __builtin_amdgcn_fence(__ATOMIC_ACQUIRE, "agent");
            asm volatile("s_waitcnt vmcnt(0)" ::: "memory");
        }
    }
    __syncthreads();
}

#ifndef MK_N_LAUNCHES
#define MK_N_LAUNCHES 1
#endif
constexpr int NPHASE = 13;
constexpr int NWAVES = 8, NTHR = 512;
constexpr int D = 1024, SEQ = 8192, NTOK = 16384, NH = 8, HD = 128, CH = 64, NCHUNK = 128;
constexpr int PW = 9216;
constexpr int PC_Q = 0, PC_K = 1024, PC_V = 2048, PC_Z = 3072, PC_BG = 4096, PC_CG = 5120, PC_UI = 6144, PC_GA = 7168, PC_GB = 8192;
constexpr int INW = 9248;
constexpr int NEXP = 32, TOPK = 4, MROWS = 73728;
constexpr float EPS = 1e-6f;

constexpr size_t MiB = 1u << 20;
constexpr size_t WS_CTL = 0, CTL_ZERO_BYTES = 1 * MiB;
constexpr size_t WS_MOD = 1 * MiB;
constexpr size_t WS_WSM_T = 1 * MiB + 64 * 1024;
constexpr size_t WS_WR_T = 1 * MiB + 192 * 1024;
constexpr size_t WS_TOPI = 2 * MiB;
constexpr size_t WS_TOPG = 2 * MiB + 256 * 1024;
constexpr size_t WS_TOPP = 2 * MiB + 512 * 1024;
constexpr size_t WS_PSM = 3 * MiB;
constexpr size_t WS_GL = 5 * MiB;
constexpr size_t WS_WIN_T = 8 * MiB;
constexpr size_t WS_WUO_T = 26 * MiB;
constexpr size_t WS_WO_T = 30 * MiB;
constexpr size_t WS_W1T = 32 * MiB;
constexpr size_t WS_W2T = 160 * MiB;
constexpr size_t WS_H = 224 * MiB;
constexpr size_t WS_OD = 256 * MiB;
constexpr size_t WS_P = 320 * MiB;
constexpr size_t WS_DD = 608 * MiB;
constexpr size_t WS_END = 896 * MiB;
constexpr size_t DD_UNIT = 73728;
constexpr size_t DD_W = 0, DD_Q = 16384, DD_K = 32768, DD_A = 49152, DD_U = 57344;
constexpr size_t WS_OASB = WS_DD, WS_M1 = WS_DD + 64 * MiB, WS_M = WS_DD + 128 * MiB;
constexpr size_t WS_XS = WS_P, WS_ACT = WS_P + 144 * MiB, WS_YS = WS_DD;
constexpr int CW_BAR = 4096;
constexpr int CW_CVT = 28672;
constexpr int CW_Q = 24576;
constexpr int CW_CNT = 16384;

constexpr int LDS_BYTES = 155648;
constexpr int LDS_MISC = 152 * 1024 - 256;
constexpr int LDS_TAB = 131072;

#define GAS __attribute__((address_space(1)))
#define LAS __attribute__((address_space(3)))
typedef unsigned short bf16;
typedef float f4 __attribute__((ext_vector_type(4)));
typedef unsigned u4 __attribute__((ext_vector_type(4)));
typedef unsigned u2 __attribute__((ext_vector_type(2)));

typedef __bf16 hwbf2 __attribute__((ext_vector_type(2)));
typedef float hwf2 __attribute__((ext_vector_type(2)));
__device__ __forceinline__ unsigned cvtpk(float lo, float hi) { const hwf2 v = {lo, hi}; return __builtin_bit_cast(unsigned, __builtin_convertvector(v, hwbf2)); }
__device__ __forceinline__ unsigned f2bf(float f) { unsigned u = __float_as_uint(f); return (u + 0x7fffu + ((u >> 16) & 1u)) >> 16; }
__device__ __forceinline__ unsigned pk2(float lo, float hi) { return cvtpk(lo, hi); }
__device__ __forceinline__ float bflo(unsigned w) { return __uint_as_float(w << 16); }
__device__ __forceinline__ float bfhi(unsigned w) { return __uint_as_float(w & 0xffff0000u); }
__device__ __forceinline__ float bf1(bf16 b) { return __uint_as_float(((unsigned)b) << 16); }
__device__ __forceinline__ void unpack8(const u4 w, float (&o)[8]) { o[0] = bflo(w.x); o[1] = bfhi(w.x); o[2] = bflo(w.y); o[3] = bfhi(w.y); o[4] = bflo(w.z); o[5] = bfhi(w.z); o[6] = bflo(w.w); o[7] = bfhi(w.w); }
__device__ __forceinline__ u4 pack8(const float (&o)[8]) { u4 w; w.x = pk2(o[0], o[1]); w.y = pk2(o[2], o[3]); w.z = pk2(o[4], o[5]); w.w = pk2(o[6], o[7]); return w; }
__device__ __forceinline__ float wave_sum(float v) {
#pragma unroll
    for (int o = 1; o < 64; o <<= 1) v += __shfl_xor(v, o);
    return v;
}
#define LDS_BARRIER() do { asm volatile("s_waitcnt lgkmcnt(0)" ::: "memory"); __builtin_amdgcn_s_barrier(); asm volatile("" ::: "memory"); } while (0)
__device__ __forceinline__ float sigm(float x) { return 1.0f / (1.0f + __expf(-x)); }
__device__ __forceinline__ float silu(float x) { return x / (1.0f + __expf(-x)); }
__device__ __forceinline__ float softplus(float x) { return x > 20.f ? x : log1pf(expf(x)); }

struct Args { const float* in[22]; float* out; unsigned char* ws; int ph_lo, ph_hi; };

struct Frame {
    LAS unsigned char* lds;
    int tid, lane, wave, G;
    unsigned char* ws;
};

__device__ __forceinline__ void p0_transpose_item(const float* W, int ldw, int k0, int n0s, bf16* WT, size_t drow0, LAS float* scr, int lane) {
    { const int kq = lane >> 3, n4 = (lane & 7) * 4; f4 v[8];
#pragma unroll
        for (int i = 0; i < 8; ++i) v[i] = *(const f4*)(W + (size_t)(k0 + 8 * i + kq) * ldw + n0s + n4);
#pragma unroll
        for (int i = 0; i < 8; ++i) { LAS float* d = scr + (8 * i + kq) * 33 + n4; d[0] = v[i].x; d[1] = v[i].y; d[2] = v[i].z; d[3] = v[i].w; } }
    asm volatile("s_waitcnt lgkmcnt(0)" ::: "memory");
    const int c = lane & 7;
#pragma unroll
    for (int j = 0; j < 4; ++j) { const int n = (lane >> 3) + 8 * j; const LAS float* s = scr + (8 * c) * 33 + n;
        u4 o; o.x = pk2(s[0 * 33], s[1 * 33]); o.y = pk2(s[2 * 33], s[3 * 33]); o.z = pk2(s[4 * 33], s[5 * 33]); o.w = pk2(s[6 * 33], s[7 * 33]);
        *(u4*)(WT + (drow0 + n) * 1024 + k0 + 8 * c) = o; }
    asm volatile("s_waitcnt lgkmcnt(0)" ::: "memory");
}

__device__ __forceinline__ void phase_p0(Frame& F, const Args& AR) {
    const float* c_in = AR.in[1]; const float* ada_w = AR.in[2]; const float* ada_b = AR.in[3];
    const float* w_in = AR.in[5];
    for (int task = blockIdx.x; task < 192; task += F.G) {
        LAS float* red = (LAS float*)(F.lds + 131072);
        const int j0 = 32 * task, col = j0 + (F.lane & 31), kh = F.lane >> 5;
        float a0 = 0.f, a1 = 0.f;
#pragma unroll 8
        for (int i = 0; i < 64; ++i) { const int k = 128 * F.wave + 2 * i + kh; const float wv = ada_w[(size_t)k * 6144 + col];
            a0 += silu(c_in[k]) * wv; a1 += silu(c_in[1024 + k]) * wv; }
        a0 += __shfl_xor(a0, 32); a1 += __shfl_xor(a1, 32);
        if (F.lane < 32) { red[(F.wave * 2 + 0) * 32 + F.lane] = a0; red[(F.wave * 2 + 1) * 32 + F.lane] = a1; }
        __syncthreads();
        if (F.tid < 64) { const int b = F.tid >> 5, cc = F.tid & 31; float s = 0.f;
#pragma unroll
            for (int w = 0; w < 8; ++w) s += red[(w * 2 + b) * 32 + cc];
            ((float*)(F.ws + WS_MOD))[b * 6144 + j0 + cc] = s + ada_b[j0 + cc]; }
        __syncthreads();
    }
    {
        const float* router_w = AR.in[15]; float* wsm = (float*)(F.ws + WS_WSM_T); float* wr = (float*)(F.ws + WS_WR_T);
        for (int idx = blockIdx.x * NTHR + F.tid; idx < 65536; idx += F.G * NTHR) { const int which = idx >> 15, r = idx & 32767, k = r >> 5, n = r & 31;
            if (which == 0) wsm[n * 1024 + k] = w_in[(size_t)k * INW + 4096 + n]; else wr[n * 1024 + k] = router_w[k * 32 + n]; }
    }
    LAS float* scr = (LAS float*)(F.lds + F.wave * 16384);
    const int gw = blockIdx.x * NWAVES + F.wave, NGW = F.G * NWAVES;
    constexpr int I_IN = 16 * 288, I_SQ = 16 * 32;
    constexpr int NITEMS = I_IN + 3 * I_SQ;
    for (int it = gw; it < NITEMS; it += NGW) {
        int r = it;
        if (r < I_IN) { const int kb = r / 288, nb = r % 288, n0 = 32 * nb; p0_transpose_item(w_in, INW, 64 * kb, n0 + (n0 >= 4096 ? 32 : 0), (bf16*)(F.ws + WS_WIN_T), (size_t)n0, scr, F.lane); continue; } r -= I_IN;
        if (r < I_SQ) { const int kb = r / 32, nb = r % 32; p0_transpose_item(AR.in[10], 1024, 64 * kb, 32 * nb, (bf16*)(F.ws + WS_WUO_T), (size_t)(32 * nb), scr, F.lane); continue; } r -= I_SQ;
        if (r < I_SQ) { const int kb = r / 32, nb = r % 32; p0_transpose_item(AR.in[12], 1024, 64 * kb, 32 * nb, (bf16*)(F.ws + WS_WUO_T), (size_t)(1024 + 32 * nb), scr, F.lane); continue; } r -= I_SQ;
        { const int kb = r / 32, nb = r % 32; p0_transpose_item(AR.in[13], 1024, 64 * kb, 32 * nb, (bf16*)(F.ws + WS_WO_T), (size_t)(32 * nb), scr, F.lane); }
    }
}
struct CvtItem { const float* W; bf16* WT; size_t drow0; int ldw, k0, n0s; };
__device__ __forceinline__ CvtItem moe_item(const Args& AR, unsigned char* ws, int r) {
    constexpr int I_W1 = 32 * 16 * 64; CvtItem c;
    if (r < I_W1) { const int e = r / 1024, q = r % 1024, kb = q / 64, nb = q % 64, n0 = 32 * nb, half = n0 >> 10, j = n0 & 1023;
        c.W = AR.in[17] + (size_t)e * 1024 * 2048; c.ldw = 2048; c.k0 = 64 * kb; c.n0s = n0; c.WT = (bf16*)(ws + WS_W1T); c.drow0 = (size_t)e * 2048 + (size_t)((j >> 7) * 256 + half * 128 + (j & 127)); }
    else { r -= I_W1; const int e = r / 512, q = r % 512, kb = q / 32, nb = q % 32;
        c.W = AR.in[19] + (size_t)e * 1024 * 1024; c.ldw = 1024; c.k0 = 64 * kb; c.n0s = 32 * nb; c.WT = (bf16*)(ws + WS_W2T); c.drow0 = (size_t)e * 1024 + (size_t)(32 * nb); }
    return c;
}
__device__ __forceinline__ void cvt_load(const CvtItem& c, int lane, f4 (&v)[8]) {
    const int kq = lane >> 3, n4 = (lane & 7) * 4;
#pragma unroll
    for (int i = 0; i < 8; ++i) v[i] = *(const f4*)(c.W + (size_t)(c.k0 + 8 * i + kq) * c.ldw + c.n0s + n4);
}
__device__ __forceinline__ void cvt_store(const CvtItem& c, int lane, const f4 (&v)[8], LAS float* scr) {
    const int kq = lane >> 3, n4 = (lane & 7) * 4;
#pragma unroll
    for (int i = 0; i < 8; ++i) { LAS float* d = scr + (8 * i + kq) * 33 + n4; d[0] = v[i].x; d[1] = v[i].y; d[2] = v[i].z; d[3] = v[i].w; }
    asm volatile("s_waitcnt lgkmcnt(0)" ::: "memory");
    const int cc = lane & 7;
#pragma unroll
    for (int j = 0; j < 4; ++j) { const int n = (lane >> 3) + 8 * j; const LAS float* sp = scr + (8 * cc) * 33 + n;
        u4 o; o.x = pk2(sp[0 * 33], sp[1 * 33]); o.y = pk2(sp[2 * 33], sp[3 * 33]); o.z = pk2(sp[4 * 33], sp[5 * 33]); o.w = pk2(sp[6 * 33], sp[7 * 33]);
        *(u4*)(c.WT + (c.drow0 + n) * 1024 + c.k0 + 8 * cc) = o; }
    asm volatile("s_waitcnt lgkmcnt(0)" ::: "memory");
}
__device__ __forceinline__ void moe_convert(Frame& F, const Args& AR) {
    constexpr int NIT = 32 * 16 * 64 + 32 * 16 * 32;
    LAS float* scr = (LAS float*)(F.lds + F.wave * 16384);
    unsigned* ctr = (unsigned*)(F.ws + WS_CTL) + CW_CVT;
    for (;;) {
        unsigned base = 0u;
        if (F.lane == 0) base = __hip_atomic_fetch_add(ctr, 8u, __ATOMIC_RELAXED, __HIP_MEMORY_SCOPE_AGENT);
        base = (unsigned)__builtin_amdgcn_readfirstlane((int)base);
        if (base >= (unsigned)NIT) break;
        f4 va[8], vb[8];
        CvtItem ca = moe_item(AR, F.ws, (int)base), cb = ca;
        cvt_load(ca, F.lane, va);
#pragma unroll 1
        for (int t = 0; t < 8; t += 2) {
            cb = moe_item(AR, F.ws, (int)base + t + 1); cvt_load(cb, F.lane, vb);
            cvt_store(ca, F.lane, va, scr);
            if (t + 2 < 8) { ca = moe_item(AR, F.ws, (int)base + t + 2); cvt_load(ca, F.lane, va); }
            cvt_store(cb, F.lane, vb, scr);
        }
    }
}
__device__ __forceinline__ void stage_wt(LAS float* WtL, const float* WT, int tid) {
    for (int idx = tid; idx < 32 * 256; idx += NTHR) { const int n = idx >> 8, k4 = idx & 255; const f4 v = *(const f4*)(WT + n * 1024 + 4 * k4); *(LAS f4*)(WtL + n * 1028 + 4 * k4) = v; }
}
__device__ __forceinline__ float dot32(const f4 (&v)[4], const LAS float* WtL, int lane) {
    float p[32];
#pragma unroll
    for (int n = 0; n < 32; ++n) { float s = 0.f;
#pragma unroll
        for (int j = 0; j < 4; ++j) { const f4 w = *(const LAS f4*)(WtL + n * 1028 + 256 * j + 4 * lane); s += v[j].x * w.x + v[j].y * w.y + v[j].z * w.z + v[j].w * w.w; }
        p[n] = s; if ((n & 3) == 3) asm volatile("" : "+v"(p[n - 3]), "+v"(p[n - 2]), "+v"(p[n - 1]), "+v"(p[n]) :: "memory"); }
#pragma unroll
    for (int i = 0; i < 16; ++i) { const bool hi = (lane & 32) != 0; const float send = hi ? p[i] : p[i + 16], keep = hi ? p[i + 16] : p[i]; p[i] = keep + __shfl_xor(send, 32); }
#pragma unroll
    for (int i = 0; i < 8; ++i) { const bool hi = (lane & 16) != 0; const float send = hi ? p[i] : p[i + 8], keep = hi ? p[i + 8] : p[i]; p[i] = keep + __shfl_xor(send, 16); }
#pragma unroll
    for (int i = 0; i < 4; ++i) { const bool hi = (lane & 8) != 0; const float send = hi ? p[i] : p[i + 4], keep = hi ? p[i + 4] : p[i]; p[i] = keep + __shfl_xor(send, 8); }
#pragma unroll
    for (int i = 0; i < 2; ++i) { const bool hi = (lane & 4) != 0; const float send = hi ? p[i] : p[i + 2], keep = hi ? p[i + 2] : p[i]; p[i] = keep + __shfl_xor(send, 4); }
    { const bool hi = (lane & 2) != 0; const float send = hi ? p[0] : p[1], keep = hi ? p[1] : p[0]; p[0] = keep + __shfl_xor(send, 2); }
    p[0] += __shfl_xor(p[0], 1);
    return p[0];
}

__device__ __forceinline__ void phase_p1(Frame& F, const Args& AR) {
    const float* x = AR.in[0]; const float* norm1_w = AR.in[4]; const float* mod = (const float*)(F.ws + WS_MOD);
    LAS float* WtL = (LAS float*)F.lds;
    LAS float* A1 = (LAS float*)(F.lds + 131584);
    LAS float* B1 = A1 + 2048;
    stage_wt(WtL, (const float*)(F.ws + WS_WSM_T), F.tid);
    for (int idx = F.tid; idx < 2048; idx += NTHR) { const int b = idx >> 10, k = idx & 1023; A1[idx] = norm1_w[k] * (1.0f + mod[b * 6144 + 1024 + k]); B1[idx] = mod[b * 6144 + k]; }
    __syncthreads();
    bf16* h = (bf16*)(F.ws + WS_H); float* psm = (float*)(F.ws + WS_PSM);
    const int gw = blockIdx.x * NWAVES + F.wave, NGW = F.G * NWAVES;
    for (int m = gw; m < NTOK; m += NGW) {
        const f4* xr = (const f4*)(x + (size_t)m * D) + F.lane; f4 v[4]; float ss = 0.f;
#pragma unroll
        for (int j = 0; j < 4; ++j) { v[j] = xr[64 * j]; ss += (v[j].x * v[j].x + v[j].y * v[j].y) + (v[j].z * v[j].z + v[j].w * v[j].w); }
        const float rstd = 1.0f / sqrtf(wave_sum(ss) * (1.0f / D) + EPS);
        const int b = m >> 13;
#pragma unroll
        for (int j = 0; j < 4; ++j) { const f4 a = *(const LAS f4*)(A1 + b * 1024 + 256 * j + 4 * F.lane), bb = *(const LAS f4*)(B1 + b * 1024 + 256 * j + 4 * F.lane);
            v[j] = v[j] * rstd * a + bb;
            u2 o; o.x = pk2(v[j].x, v[j].y); o.y = pk2(v[j].z, v[j].w); ((u2*)(h + (size_t)m * D))[F.lane + 64 * j] = o; }
        const float tot = dot32(v, WtL, F.lane);
        if (!(F.lane & 1)) psm[(size_t)m * 32 + (F.lane >> 1)] = tot;
    }
}

struct EpiStoreBf16 {
    static constexpr bool PERM = true, AFTER_DRAIN = false;
    bf16* O; int ldc;
    __device__ __forceinline__ void operator()(const pg8::f32x4 (&acc)[2][2][4][2], const pg8::Unit& u, int wr, int wc, int fr, int fq) const {
        const int row0 = u.pm * 256 + wr * 64 + fr, col0 = u.pn * 256 + wc * 32 + 8 * fq;
#pragma unroll
        for (int ai = 0; ai < 2; ++ai)
#pragma unroll
            for (int m = 0; m < 4; ++m) { bf16* rowp = O + (size_t)(row0 + ai * 128 + m * 16) * ldc + col0;
#pragma unroll
                for (int bj = 0; bj < 2; ++bj) { const pg8::f32x4 v0 = acc[ai][bj][m][0], v1 = acc[ai][bj][m][1];
                    u4 w; w.x = cvtpk(v0[0], v0[1]); w.y = cvtpk(v0[2], v0[3]); w.z = cvtpk(v1[0], v1[1]); w.w = cvtpk(v1[2], v1[3]);
                    *(u4*)(rowp + bj * 128) = w; } }
    }
};
struct EpiG23 {
    static constexpr bool PERM = true, AFTER_DRAIN = false;
    const bf16* P; float* M1; bf16* Mo;
    __device__ __forceinline__ void operator()(const pg8::f32x4 (&acc)[2][2][4][2], const pg8::Unit& u, int wr, int wc, int fr, int fq) const {
        const int s = u.pm >= 64 ? 1 : 0, pm = u.pm - 64 * s, pn = u.pn - 4 * s;
        const int row0 = pm * 256 + wr * 64 + fr, col0 = pn * 256 + wc * 32 + 8 * fq, gcol = (s ? PC_GB : PC_GA) + col0;
#pragma unroll
        for (int ai = 0; ai < 2; ++ai)
#pragma unroll
            for (int m = 0; m < 4; ++m) { const int row = row0 + ai * 128 + m * 16;
#pragma unroll
                for (int bj = 0; bj < 2; ++bj) { const int col = col0 + bj * 128;
                    float g[8]; unpack8(*(const u4*)(P + (size_t)row * PW + gcol + bj * 128), g);
                    const pg8::f32x4 v0 = acc[ai][bj][m][0], v1 = acc[ai][bj][m][1];
                    float o[8];
#pragma unroll
                    for (int e = 0; e < 4; ++e) { o[e] = sigm(g[e]) * v0[e]; o[4 + e] = sigm(g[4 + e]) * v1[e]; }
                    float* mp = M1 + (size_t)row * D + col;
                    if (s == 0) { *(f4*)mp = (f4){o[0], o[1], o[2], o[3]}; *(f4*)(mp + 4) = (f4){o[4], o[5], o[6], o[7]}; }
                    else { const f4 p0 = *(const f4*)mp, p1 = *(const f4*)(mp + 4);
                        u4 w; w.x = cvtpk(p0.x + o[0], p0.y + o[1]); w.y = cvtpk(p0.z + o[2], p0.w + o[3]); w.z = cvtpk(p1.x + o[4], p1.y + o[5]); w.w = cvtpk(p1.z + o[6], p1.w + o[7]);
                        *(u4*)(Mo + (size_t)row * D + col) = w; } } }
    }
};
struct OrderG23 {
    pg8::StaticOrder S;
    __device__ __forceinline__ bool next(int i, pg8::Unit& u) const { if (i >= 2) return false; pg8::Unit t; if (!S.next(0, t)) return false; u.pm = t.pm + 64 * i; u.pn = t.pn + 4 * i; return true; }
    __device__ __forceinline__ void a_ready(const pg8::Unit&) const {}
    __device__ __forceinline__ void done(const pg8::Unit&) const {}
};
struct EpiG4 {
    static constexpr bool PERM = false, AFTER_DRAIN = false;
    const float* X; const float* mod; float* X1;
    __device__ __forceinline__ void operator()(const pg8::f32x4 (&acc)[2][2][4][2], const pg8::Unit& u, int wr, int wc, int fr, int fq) const {
        const int row0 = u.pm * 256 + wr * 64 + fr, col0 = u.pn * 256 + wc * 32 + 4 * fq; const int b = u.pm >> 5;
        f4 gt[2][2];
#pragma unroll
        for (int bj = 0; bj < 2; ++bj)
#pragma unroll
            for (int n = 0; n < 2; ++n) gt[bj][n] = *(const f4*)(mod + b * 6144 + 2048 + col0 + bj * 128 + n * 16);
#pragma unroll
        for (int ai = 0; ai < 2; ++ai)
#pragma unroll
            for (int m = 0; m < 4; ++m) { const size_t off = (size_t)(row0 + ai * 128 + m * 16) * D + col0;
#pragma unroll
                for (int bj = 0; bj < 2; ++bj)
#pragma unroll
                    for (int n = 0; n < 2; ++n) { const f4 xv = *(const f4*)(X + off + bj * 128 + n * 16); const pg8::f32x4 a = acc[ai][bj][m][n];
                        *(f4*)(X1 + off + bj * 128 + n * 16) = (f4){xv.x + gt[bj][n].x * a[0], xv.y + gt[bj][n].y * a[1], xv.z + gt[bj][n].z * a[2], xv.w + gt[bj][n].w * a[3]}; } }
    }
};
struct MoeOrder {
    int nM, nN, nwg, G, c; const LAS int* blk_exp;
    __device__ __forceinline__ void init(int nblk, int nN_, int G_, int c_, const LAS int* be) { nM = nblk; nN = nN_; nwg = nM * nN; G = G_; c = c_; blk_exp = be; }
    __device__ __forceinline__ bool next(int i, pg8::Unit& u) const {
        const long L = (long)i * G + c; if (L >= nwg) return false;
        int wgid = (int)L; { const int q = nwg / 8, r = nwg % 8, xcd = wgid % 8, off = wgid / 8; wgid = (xcd < r ? xcd * (q + 1) : r * (q + 1) + (xcd - r) * q) + off; }
        const int nig = 8 * nN, gid = wgid / nig, fm = gid * 8, gsz = (nM - fm) < 8 ? (nM - fm) : 8;
        const int pm = fm + ((wgid % nig) % gsz), pnl = (wgid % nig) / gsz;
        u.pm = pm; u.pn = blk_exp[pm] * nN + pnl; return true;
    }
    __device__ __forceinline__ void a_ready(const pg8::Unit&) const {}
    __device__ __forceinline__ void done(const pg8::Unit&) const {}
};
struct EpiMoe1 {
    static constexpr bool PERM = true, AFTER_DRAIN = false;
    const float* b1; bf16* ACT;
    __device__ __forceinline__ void operator()(const pg8::f32x4 (&acc)[2][2][4][2], const pg8::Unit& u, int wr, int wc, int fr, int fq) const {
        const int e = u.pn >> 3, pnl = u.pn & 7; const int row0 = u.pm * 256 + wr * 64 + fr, j0 = pnl * 128 + wc * 32 + 8 * fq;
        const float* bg = b1 + (size_t)e * 2048 + j0; const float* bu = bg + 1024;
        const f4 bg0 = *(const f4*)bg, bg1 = *(const f4*)(bg + 4), bu0 = *(const f4*)bu, bu1 = *(const f4*)(bu + 4);
        const float bgv[8] = {bg0.x, bg0.y, bg0.z, bg0.w, bg1.x, bg1.y, bg1.z, bg1.w}, buv[8] = {bu0.x, bu0.y, bu0.z, bu0.w, bu1.x, bu1.y, bu1.z, bu1.w};
#pragma unroll
        for (int ai = 0; ai < 2; ++ai)
#pragma unroll
            for (int m = 0; m < 4; ++m) { float o[8];
#pragma unroll
                for (int e8 = 0; e8 < 8; ++e8) { const int n = e8 >> 2, q = e8 & 3;
                    float g = acc[ai][0][m][n][q] + bgv[e8], up = acc[ai][1][m][n][q] + buv[e8];
                    g = fminf(g, 7.0f); up = fminf(fmaxf(up, -7.0f), 7.0f);
                    o[e8] = g * sigm(1.702f * g) * (up + 1.0f); }
                u4 w; w.x = cvtpk(o[0], o[1]); w.y = cvtpk(o[2], o[3]); w.z = cvtpk(o[4], o[5]); w.w = cvtpk(o[6], o[7]);
                *(u4*)(ACT + (size_t)(row0 + ai * 128 + m * 16) * D + j0) = w; }
    }
};
struct EpiMoe2 {
    static constexpr bool PERM = true, AFTER_DRAIN = false;
    const float* b2; bf16* YS;
    __device__ __forceinline__ void operator()(const pg8::f32x4 (&acc)[2][2][4][2], const pg8::Unit& u, int wr, int wc, int fr, int fq) const {
        const int e = u.pn >> 2, pnl = u.pn & 3; const int row0 = u.pm * 256 + wr * 64 + fr, col0 = pnl * 256 + wc * 32 + 8 * fq;
        f4 bv[2][2];
#pragma unroll
        for (int bj = 0; bj < 2; ++bj)
#pragma unroll
            for (int n = 0; n < 2; ++n) bv[bj][n] = *(const f4*)(b2 + (size_t)e * D + col0 + bj * 128 + 4 * n);
#pragma unroll
        for (int ai = 0; ai < 2; ++ai)
#pragma unroll
            for (int m = 0; m < 4; ++m) { bf16* rowp = YS + (size_t)(row0 + ai * 128 + m * 16) * D + col0;
#pragma unroll
                for (int bj = 0; bj < 2; ++bj) { const pg8::f32x4 v0 = acc[ai][bj][m][0], v1 = acc[ai][bj][m][1];
                    u4 w; w.x = cvtpk(v0[0] + bv[bj][0].x, v0[1] + bv[bj][0].y); w.y = cvtpk(v0[2] + bv[bj][0].z, v0[3] + bv[bj][0].w);
                    w.z = cvtpk(v1[0] + bv[bj][1].x, v1[1] + bv[bj][1].y); w.w = cvtpk(v1[2] + bv[bj][1].z, v1[3] + bv[bj][1].w);
                    *(u4*)(rowp + bj * 128) = w; } }
    }
};

constexpr int QS = 129;
constexpr int QB = 136;
typedef short bf16x8 __attribute__((ext_vector_type(8)));
__device__ __forceinline__ bf16x8 pack_frag(const pg8::f32x4 a, const pg8::f32x4 b) {
    u4 w; w.x = cvtpk(a[0], a[1]); w.y = cvtpk(a[2], a[3]); w.z = cvtpk(b[0], b[1]); w.w = cvtpk(b[2], b[3]); return __builtin_bit_cast(bf16x8, w);
}
__device__ __forceinline__ void phase_p3(Frame& F, const Args& AR) {
    const bf16* P = (const bf16*)(F.ws + WS_P); const float* psm = (const float*)(F.ws + WS_PSM);
    const float* convw = AR.in[6]; const float* a_log = AR.in[7]; const float* dt_bias = AR.in[8];
    LAS bf16* qb = (LAS bf16*)F.lds;
    LAS bf16* kb = qb + 64 * QB;
    LAS float* vs = (LAS float*)(kb + 64 * QB);
    LAS float* Lm = vs + 64 * QS;
    LAS float* betaL = Lm + 2 * 4096;
    LAS float* GL = betaL + 128;
    LAS float* Tm = GL + 128;
    LAS bf16* wb = (LAS bf16*)(Tm + 2048);
    u4 raw[12]; f4 wjv[10]; float braw = 0.f, araw = 0.f, alog_p = 0.f, dtb_p = 0.f;
#define P3_LOAD(unit_) do { const int b_ = (unit_) >> 10, h_ = ((unit_) >> 7) & 7, c_ = (unit_) & 127, t0_ = c_ * 64; const size_t tb_ = (size_t)b_ * SEQ; const int tid_ = F.tid; \
        if (tid_ < 384) { const int cv_ = tid_ % 48, rg_ = tid_ / 48, pcol_ = (cv_ >> 4) * 1024 + h_ * 128 + (cv_ & 15) * 8; \
            _Pragma("unroll") for (int j_ = 0; j_ < 5; ++j_) { wjv[2 * j_] = *(const f4*)(convw + j_ * 3072 + pcol_); wjv[2 * j_ + 1] = *(const f4*)(convw + j_ * 3072 + pcol_ + 4); } \
            _Pragma("unroll") for (int r_ = 0; r_ < 12; ++r_) { const int t_ = t0_ + 8 * rg_ - 2 + r_; raw[r_] = (t_ >= 0 && t_ < SEQ) ? *(const u4*)(P + (tb_ + t_) * PW + pcol_) : (u4){0u, 0u, 0u, 0u}; } } \
        if (tid_ < 128) { const int dir_ = tid_ >> 6, ii_ = tid_ & 63, io_ = dir_ ? 63 - ii_ : ii_; const size_t tok_ = tb_ + t0_ + io_; braw = psm[tok_ * 32 + dir_ * 8 + h_]; araw = psm[tok_ * 32 + 16 + dir_ * 8 + h_]; alog_p = a_log[dir_ * 8 + h_]; dtb_p = dt_bias[dir_ * 8 + h_]; } } while (0)
    if ((int)blockIdx.x < 2 * NH * NCHUNK) P3_LOAD((int)blockIdx.x);
    for (int unit = blockIdx.x; unit < 2 * NH * NCHUNK; unit += F.G) {
        const int b = unit >> 10, h = (unit >> 7) & 7, c = unit & 127;
        int tid = F.tid; asm volatile("" : "+v"(tid));
        const int lane = tid & 63;
        unsigned char* const ubase = F.ws + WS_DD + ((size_t)((b * 8 + h) * 2) * 128) * DD_UNIT;
        if (tid < 384) {
            const int cv = tid % 48, rg = tid / 48, part = cv >> 4, ch = (cv & 15) * 8;
#pragma unroll
            for (int i = 0; i < 8; ++i) { float acc[8];
#pragma unroll
                for (int e = 0; e < 8; ++e) acc[e] = 0.f;
#pragma unroll
                for (int j = 0; j < 5; ++j) { float xin[8]; unpack8(raw[i + j], xin); const f4 w0 = wjv[2 * j], w1 = wjv[2 * j + 1];
                    acc[0] += w0.x * xin[0]; acc[1] += w0.y * xin[1]; acc[2] += w0.z * xin[2]; acc[3] += w0.w * xin[3]; acc[4] += w1.x * xin[4]; acc[5] += w1.y * xin[5]; acc[6] += w1.z * xin[6]; acc[7] += w1.w * xin[7]; }
                float ssq = 0.f;
#pragma unroll
                for (int e = 0; e < 8; ++e) { acc[e] = silu(acc[e]); ssq += acc[e] * acc[e]; }
                ssq += __shfl_xor(ssq, 1); ssq += __shfl_xor(ssq, 2); ssq += __shfl_xor(ssq, 4); ssq += __shfl_xor(ssq, 8);
                if (part == 2) {
#pragma unroll
                    for (int e = 0; e < 8; ++e) vs[(8 * rg + i) * QS + ch + e] = acc[e];
                } else {
                    float sc = 1.0f / sqrtf(ssq + EPS); if (part == 0) sc *= 0.08838834764831845f;
#pragma unroll
                    for (int e = 0; e < 8; ++e) acc[e] *= sc;
                    *(LAS u4*)((part ? kb : qb) + (8 * rg + i) * QB + ch) = pack8(acc); }
            }
        }
        if (tid < 128) {
            const int dir = tid >> 6, ii = lane;
            float g = -expf(alog_p) * softplus(araw + dtb_p);
#pragma unroll
            for (int o = 1; o < 64; o <<= 1) { const float t = __shfl_up(g, o); if (lane >= o) g += t; }
            betaL[dir * 64 + ii] = sigm(braw); GL[dir * 64 + ii] = g;
        }
        if (unit + F.G < 2 * NH * NCHUNK) P3_LOAD(unit + F.G);
        LDS_BARRIER();
        asm volatile("" : "+v"(tid));
        {
            const int w = tid >> 6, dir = w >> 2, mi = w & 3, r = lane & 15, q = lane >> 4;
            const int ipos = 16 * mi + r, io = dir ? 63 - ipos : ipos;
            const float Gi = GL[dir * 64 + ipos], bi = betaL[dir * 64 + ipos];
            bf16x8 ki[4], qi[4];
#pragma unroll
            for (int s = 0; s < 4; ++s) { ki[s] = *(const LAS bf16x8*)(kb + io * QB + 32 * s + 8 * q); qi[s] = *(const LAS bf16x8*)(qb + io * QB + 32 * s + 8 * q); }
            unsigned char* dbase = ubase + ((size_t)dir * 128 + (dir ? 127 - c : c)) * DD_UNIT;
#pragma unroll
            for (int s2 = 0; s2 < 2; ++s2) { float av[8];
#pragma unroll
                for (int t = 0; t < 2; ++t) { const int mj = 2 * s2 + t;
                    if (mj <= mi) {
                        const int jp = 16 * mj + r, jo = dir ? 63 - jp : jp;
                        pg8::f32x4 kk = {0.f, 0.f, 0.f, 0.f}, qk = {0.f, 0.f, 0.f, 0.f};
#pragma unroll
                        for (int s = 0; s < 4; ++s) { const bf16x8 kj = *(const LAS bf16x8*)(kb + jo * QB + 32 * s + 8 * q);
                            kk = __builtin_amdgcn_mfma_f32_16x16x32_bf16(kj, ki[s], kk, 0, 0, 0); qk = __builtin_amdgcn_mfma_f32_16x16x32_bf16(kj, qi[s], qk, 0, 0, 0); }
                        f4 lv;
#pragma unroll
                        for (int jj = 0; jj < 4; ++jj) { const int jpos = 16 * mj + 4 * q + jj; const float dec = __expf(Gi - GL[dir * 64 + jpos]);
                            const float l = (ipos > jpos) ? bi * kk[jj] * dec : 0.f; av[4 * t + jj] = (ipos >= jpos) ? qk[jj] * dec : 0.f;
                            if (jj == 0) lv.x = l; else if (jj == 1) lv.y = l; else if (jj == 2) lv.z = l; else lv.w = l; }
                        *(LAS f4*)(Lm + dir * 4096 + ipos * 64 + 16 * mj + 4 * q) = lv;
                    } else {
#pragma unroll
                        for (int jj = 0; jj < 4; ++jj) av[4 * t + jj] = 0.f;
                    } }
                *(u4*)(dbase + DD_A + (size_t)((mi * 2 + s2) * 64 + lane) * 16) = pack8(av); }
        }
        LDS_BARRIER();
        asm volatile("" : "+v"(tid));
        if (tid < 128) {
            const int dir = tid >> 6, blk = (tid >> 4) & 3, cc = tid & 15;
            const LAS float* Lb = Lm + dir * 4096 + (16 * blk) * 64 + 16 * blk;
            float t[16];
#pragma unroll
            for (int i = 0; i < 16; ++i) { float sv = (i == cc) ? 1.0f : 0.0f;
#pragma unroll
                for (int j = 0; j < i; ++j) sv -= Lb[i * 64 + j] * t[j];
                t[i] = sv; Tm[(dir * 4 + blk) * 256 + i * 16 + cc] = sv; }
        }
        LDS_BARRIER();
        asm volatile("" : "+v"(tid));
        {
            const int w = tid >> 6, dir = w >> 2, g4 = w & 3, n = lane & 15, q = lane >> 4; const bool isw = g4 >= 2;
            const LAS float* Lr = Lm + dir * 4096; const LAS float* Tr = Tm + dir * 1024;
            const f4 z4 = {0.f, 0.f, 0.f, 0.f};
            bf16x8 fT[4], fL10, fL2, fL3a, fL3b;
#pragma unroll
            for (int i = 0; i < 4; ++i) fT[i] = pack_frag(*(const LAS f4*)(Tr + i * 256 + n * 16 + 4 * q), z4);
            fL10 = pack_frag(-*(const LAS f4*)(Lr + (16 + n) * 64 + 4 * q), z4);
            fL2 = pack_frag(-*(const LAS f4*)(Lr + (32 + n) * 64 + 4 * q), -*(const LAS f4*)(Lr + (32 + n) * 64 + 16 + 4 * q));
            fL3a = pack_frag(-*(const LAS f4*)(Lr + (48 + n) * 64 + 4 * q), -*(const LAS f4*)(Lr + (48 + n) * 64 + 16 + 4 * q));
            fL3b = pack_frag(-*(const LAS f4*)(Lr + (48 + n) * 64 + 32 + 4 * q), z4);
            float bE[4][4];
#pragma unroll
            for (int i = 0; i < 4; ++i)
#pragma unroll
                for (int jj = 0; jj < 4; ++jj) { const int row = 16 * i + 4 * q + jj; bE[i][jj] = betaL[dir * 64 + row] * (isw ? __expf(GL[dir * 64 + row]) : 1.0f); }
            unsigned char* dbase = ubase + ((size_t)dir * 128 + (dir ? 127 - c : c)) * DD_UNIT;
#pragma unroll
            for (int e = 0; e < 4; ++e) { const int nt = 4 * g4 + e;
                pg8::f32x4 R[4];
#pragma unroll
                for (int i = 0; i < 4; ++i)
#pragma unroll
                    for (int jj = 0; jj < 4; ++jj) { const int row = 16 * i + 4 * q + jj, io = dir ? 63 - row : row;
                        R[i][jj] = bE[i][jj] * (isw ? bf1(kb[io * QB + 16 * (nt - 8) + n]) : vs[io * QS + 16 * nt + n]); }
                const pg8::f32x4 x0 = __builtin_amdgcn_mfma_f32_16x16x32_bf16(fT[0], pack_frag(R[0], z4), z4, 0, 0, 0);
                const pg8::f32x4 y1 = __builtin_amdgcn_mfma_f32_16x16x32_bf16(fL10, pack_frag(x0, z4), R[1], 0, 0, 0);
                const pg8::f32x4 x1 = __builtin_amdgcn_mfma_f32_16x16x32_bf16(fT[1], pack_frag(y1, z4), z4, 0, 0, 0);
                const bf16x8 x01 = pack_frag(x0, x1);
                const pg8::f32x4 y2 = __builtin_amdgcn_mfma_f32_16x16x32_bf16(fL2, x01, R[2], 0, 0, 0);
                const pg8::f32x4 x2 = __builtin_amdgcn_mfma_f32_16x16x32_bf16(fT[2], pack_frag(y2, z4), z4, 0, 0, 0);
                pg8::f32x4 y3 = __builtin_amdgcn_mfma_f32_16x16x32_bf16(fL3a, x01, R[3], 0, 0, 0);
                y3 = __builtin_amdgcn_mfma_f32_16x16x32_bf16(fL3b, pack_frag(x2, z4), y3, 0, 0, 0);
                const pg8::f32x4 x3 = __builtin_amdgcn_mfma_f32_16x16x32_bf16(fT[3], pack_frag(y3, z4), z4, 0, 0, 0);
                const pg8::f32x4 X[4] = {x0, x1, x2, x3};
                if (!isw) {
#pragma unroll
                    for (int i = 0; i < 4; ++i) { u2 o; o.x = cvtpk(X[i][0], X[i][1]); o.y = cvtpk(X[i][2], X[i][3]); *(u2*)(dbase + DD_U + (size_t)((nt * 4 + i) * 64 + lane) * 8) = o; }
                } else { LAS bf16* wp = wb + dir * 64 * QB + 16 * (nt - 8) + n;
#pragma unroll
                    for (int i = 0; i < 4; ++i)
#pragma unroll
                        for (int jj = 0; jj < 4; ++jj) wp[(16 * i + 4 * q + jj) * QB] = (bf16)f2bf(X[i][jj]); }
            }
        }
        LDS_BARRIER();
        asm volatile("" : "+v"(tid));
#pragma unroll
        for (int it = 0; it < 4; ++it) { const int item = it * NTHR + tid, dir = item >> 10, fidx = (item >> 6) & 15, fl = item & 63, r = fl & 15, q = fl >> 4;
            const int mt = fidx >> 2, s = fidx & 3, pos = 16 * mt + r; const LAS bf16* wr = wb + (dir * 64 + pos) * QB + 32 * s + 4 * q;
            const u2 lo = *(const LAS u2*)wr, hi = *(const LAS u2*)(wr + 16);
            *(u4*)(ubase + ((size_t)dir * 128 + (dir ? 127 - c : c)) * DD_UNIT + DD_W + (size_t)(fidx * 64 + fl) * 16) = (u4){lo.x, lo.y, hi.x, hi.y}; }
#pragma unroll
        for (int it = 0; it < 8; ++it) { const int item = it * NTHR + tid, dir = item >> 11, arr = (item >> 10) & 1, fidx = (item >> 6) & 15, fl = item & 63, r = fl & 15, q = fl >> 4;
            unsigned char* dbase = ubase + ((size_t)dir * 128 + (dir ? 127 - c : c)) * DD_UNIT;
            float o[8];
            if (arr == 0) { const int mt = fidx >> 2, s = fidx & 3, pos = 16 * mt + r, io = dir ? 63 - pos : pos; const float f = __expf(GL[dir * 64 + pos]);
                const u2 lo = *(const LAS u2*)(qb + io * QB + 32 * s + 4 * q), hi = *(const LAS u2*)(qb + io * QB + 32 * s + 16 + 4 * q);
                o[0] = bflo(lo.x) * f; o[1] = bfhi(lo.x) * f; o[2] = bflo(lo.y) * f; o[3] = bfhi(lo.y) * f; o[4] = bflo(hi.x) * f; o[5] = bfhi(hi.x) * f; o[6] = bflo(hi.y) * f; o[7] = bfhi(hi.y) * f;
                *(u4*)(dbase + DD_Q + (size_t)(fidx * 64 + fl) * 16) = pack8(o);
            } else { const int m = fidx >> 1, s2 = fidx & 1, dk = 16 * m + r; const float gl = GL[dir * 64 + 63];
#pragma unroll
                for (int j = 0; j < 8; ++j) { const int pos = 32 * s2 + (j < 4 ? 4 * q + j : 16 + 4 * q + j - 4), io = dir ? 63 - pos : pos; o[j] = bf1(kb[io * QB + dk]) * __expf(gl - GL[dir * 64 + pos]); }
                *(u4*)(dbase + DD_K + (size_t)(fidx * 64 + fl) * 16) = pack8(o); } }
        if (tid < 2) ((float*)(F.ws + WS_GL))[((b * 8 + h) * 2 + tid) * 128 + (tid ? 127 - c : c)] = __expf(GL[tid * 64 + 63]);
        LDS_BARRIER();
    }
#undef P3_LOAD
}

constexpr int P4_BUF = 61440;
__device__ __forceinline__ void phase_p4(Frame& F, const Args& AR) {
    volatile LAS int* uq = (volatile LAS int*)(F.lds + LDS_TAB + 4096);
    unsigned* qctr = (unsigned*)(F.ws + WS_CTL) + CW_Q;
    const unsigned myx = xb_xcc_id() & 7u;
    for (;;) {
        __syncthreads();
        if (F.tid == 0) { int got = -1;
            for (unsigned t = 0; t < 8 && got < 0; ++t) { const unsigned x = (myx + t) & 7u; const unsigned sl = __hip_atomic_fetch_add(qctr + 64 * x, 1u, __ATOMIC_RELAXED, __HIP_MEMORY_SCOPE_AGENT); if (sl < 16u) got = (int)(x * 16u + sl); }
            uq[0] = got; }
        __syncthreads();
        const int unit = uq[0];
        if (unit < 0) break;
        const int chain = unit >> 2, pair = unit & 3, dir = chain & 1, bh = chain >> 1, b = bh >> 3, h = bh & 7;
        const unsigned char* cbase = F.ws + WS_DD + (size_t)chain * 128 * DD_UNIT;
        __syncthreads();
        if (F.wave >= 2) {
            const int l = F.tid - 128; u4 ra[10], rb[10], rc[10];
#define P4_SRC(step, i) ((const u4*)(cbase + (size_t)(step) * DD_UNIT + (((i) * 384 + l) < 3584 ? (size_t)((i) * 384 + l) * 16 : (size_t)DD_U + (size_t)pair * 4096 + (size_t)((i) * 384 + l - 3584) * 16)))
#define P4_LD(R, step) do { const int st_ = (step) < NCHUNK ? (step) : NCHUNK - 1; _Pragma("unroll") for (int i = 0; i < 10; ++i) R[i] = *P4_SRC(st_, i); } while (0)
#define P4_ST(R, step) do { _Pragma("unroll") for (int i = 0; i < 10; ++i) *(LAS u4*)(F.lds + ((step) & 1) * P4_BUF + (size_t)(i * 384 + l) * 16) = R[i]; } while (0)
            P4_LD(ra, 0); P4_ST(ra, 0);
            P4_LD(ra, 1); P4_LD(rb, 2); P4_LD(rc, 3);
            asm volatile("s_waitcnt lgkmcnt(0)" ::: "memory"); __builtin_amdgcn_s_barrier(); asm volatile("" ::: "memory");
            for (int k = 0; k < 129; k += 3) {
                P4_ST(ra, k + 1); P4_LD(ra, k + 4);
                asm volatile("s_waitcnt lgkmcnt(0)" ::: "memory"); __builtin_amdgcn_s_barrier(); asm volatile("" ::: "memory");
                P4_ST(rb, k + 2); P4_LD(rb, k + 5);
                asm volatile("s_waitcnt lgkmcnt(0)" ::: "memory"); __builtin_amdgcn_s_barrier(); asm volatile("" ::: "memory");
                P4_ST(rc, k + 3); P4_LD(rc, k + 6);
                asm volatile("s_waitcnt lgkmcnt(0)" ::: "memory"); __builtin_amdgcn_s_barrier(); asm volatile("" ::: "memory");
            }
#undef P4_SRC
#undef P4_LD
#undef P4_ST
        } else {
            const int lane = F.lane, r = lane & 15, q = lane >> 4, sl = 2 * pair + F.wave;
            const float* glp = (const float*)(F.ws + WS_GL) + chain * 128;
            bf16* od = (bf16*)(F.ws + WS_OD) + (size_t)dir * NTOK * D + (size_t)b * SEQ * D + h * 128 + 16 * sl + 4 * q;
            pg8::f32x4 S[8]; bf16x8 SB[4];
#pragma unroll
            for (int m = 0; m < 8; ++m) S[m] = (pg8::f32x4){0.f, 0.f, 0.f, 0.f};
#pragma unroll
            for (int s = 0; s < 4; ++s) SB[s] = (bf16x8){0, 0, 0, 0, 0, 0, 0, 0};
            const float glv0 = glp[lane], glv1 = glp[64 + lane];
            asm volatile("s_waitcnt lgkmcnt(0)" ::: "memory"); __builtin_amdgcn_s_barrier(); asm volatile("" ::: "memory");
            for (int k = 0; k < NCHUNK; ++k) {
                const LAS unsigned char* bp = F.lds + (k & 1) * P4_BUF + lane * 16;
                const float egl = __builtin_bit_cast(float, __builtin_amdgcn_readlane(__builtin_bit_cast(int, k < 64 ? glv0 : glv1), k & 63));
                pg8::f32x4 WS[4], OT[4];
#pragma unroll
                for (int mt = 0; mt < 4; ++mt) { WS[mt] = (pg8::f32x4){0.f, 0.f, 0.f, 0.f}; OT[mt] = (pg8::f32x4){0.f, 0.f, 0.f, 0.f}; }
#pragma unroll
                for (int mt = 0; mt < 4; ++mt)
#pragma unroll
                    for (int s = 0; s < 4; ++s) WS[mt] = __builtin_amdgcn_mfma_f32_16x16x32_bf16(*(const LAS bf16x8*)(bp + (mt * 4 + s) * 1024), SB[s], WS[mt], 0, 0, 0);
#pragma unroll
                for (int mt = 0; mt < 4; ++mt)
#pragma unroll
                    for (int s = 0; s < 4; ++s) OT[mt] = __builtin_amdgcn_mfma_f32_16x16x32_bf16(SB[s], *(const LAS bf16x8*)(bp + 16384 + (mt * 4 + s) * 1024), OT[mt], 0, 0, 0);
                pg8::f32x4 vn[4];
#pragma unroll
                for (int mt = 0; mt < 4; ++mt) { const u2 uu = *(const LAS u2*)(F.lds + (k & 1) * P4_BUF + 57344 + (F.wave * 4 + mt) * 512 + lane * 8);
                    vn[mt] = (pg8::f32x4){bflo(uu.x) - WS[mt][0], bfhi(uu.x) - WS[mt][1], bflo(uu.y) - WS[mt][2], bfhi(uu.y) - WS[mt][3]}; }
                bf16x8 VB[2]; VB[0] = pack_frag(vn[0], vn[1]); VB[1] = pack_frag(vn[2], vn[3]);
#pragma unroll
                for (int mt = 0; mt < 4; ++mt)
#pragma unroll
                    for (int s2 = 0; s2 < 2; ++s2) OT[mt] = __builtin_amdgcn_mfma_f32_16x16x32_bf16(VB[s2], *(const LAS bf16x8*)(bp + 49152 + (mt * 2 + s2) * 1024), OT[mt], 0, 0, 0);
#pragma unroll
                for (int m = 0; m < 8; ++m) { S[m] = S[m] * egl;
#pragma unroll
                    for (int s2 = 0; s2 < 2; ++s2) S[m] = __builtin_amdgcn_mfma_f32_16x16x32_bf16(*(const LAS bf16x8*)(bp + 32768 + (m * 2 + s2) * 1024), VB[s2], S[m], 0, 0, 0); }
#pragma unroll
                for (int s = 0; s < 4; ++s) SB[s] = pack_frag(S[2 * s], S[2 * s + 1]);
                const int co = dir ? 127 - k : k;
#pragma unroll
                for (int mt = 0; mt < 4; ++mt) { const int pos = 16 * mt + r, ro = dir ? 63 - pos : pos;
                    u2 ov; ov.x = cvtpk(OT[mt][0], OT[mt][1]); ov.y = cvtpk(OT[mt][2], OT[mt][3]);
                    *(u2*)(od + (size_t)(co * 64 + ro) * D) = ov; }
                asm volatile("s_waitcnt lgkmcnt(0)" ::: "memory"); __builtin_amdgcn_s_barrier(); asm volatile("" ::: "memory");
            }
            __builtin_amdgcn_s_barrier();
        }
        __syncthreads();
    }
    moe_convert(F, AR);
}

__device__ __forceinline__ void phase_p5(Frame& F, const Args& AR) {
    const bf16* P = (const bf16*)(F.ws + WS_P); const bf16* od = (const bf16*)(F.ws + WS_OD); bf16* oasb = (bf16*)(F.ws + WS_OASB);
    const float* onorm_w = AR.in[9]; const float* convs = AR.in[11];
    const int lane = F.lane, ch = 16 * lane;
    float onw[16], cw[3][16];
#pragma unroll
    for (int e = 0; e < 16; ++e) { onw[e] = onorm_w[(ch + e) & 127];
#pragma unroll
        for (int j = 0; j < 3; ++j) cw[j][e] = convs[j * 1024 + ch + e]; }
    const int gw = blockIdx.x * NWAVES + F.wave, NGW = F.G * NWAVES;
    for (int m = gw; m < NTOK; m += NGW) {
        const int t = m & (SEQ - 1);
        float o[16], z[16], t8[8];
        unpack8(*(const u4*)(od + (size_t)m * D + ch), t8);
#pragma unroll
        for (int e = 0; e < 8; ++e) o[e] = t8[e];
        unpack8(*(const u4*)(od + (size_t)m * D + ch + 8), t8);
#pragma unroll
        for (int e = 0; e < 8; ++e) o[8 + e] = t8[e];
        unpack8(*(const u4*)(od + (size_t)(NTOK + m) * D + ch), t8);
#pragma unroll
        for (int e = 0; e < 8; ++e) o[e] += t8[e];
        unpack8(*(const u4*)(od + (size_t)(NTOK + m) * D + ch + 8), t8);
#pragma unroll
        for (int e = 0; e < 8; ++e) o[8 + e] += t8[e];
        unpack8(*(const u4*)(P + (size_t)m * PW + PC_Z + ch), t8);
#pragma unroll
        for (int e = 0; e < 8; ++e) z[e] = t8[e];
        unpack8(*(const u4*)(P + (size_t)m * PW + PC_Z + ch + 8), t8);
#pragma unroll
        for (int e = 0; e < 8; ++e) z[8 + e] = t8[e];
        float ss = 0.f;
#pragma unroll
        for (int e = 0; e < 16; ++e) ss += o[e] * o[e];
        ss += __shfl_xor(ss, 1); ss += __shfl_xor(ss, 2); ss += __shfl_xor(ss, 4);
        const float rstd = 1.0f / sqrtf(ss * (1.0f / 128.0f) + EPS);
        float r[8];
#pragma unroll
        for (int e = 0; e < 8; ++e) r[e] = o[e] * rstd * onw[e] * silu(z[e]);
        *(u4*)(oasb + (size_t)m * D + ch) = pack8(r);
#pragma unroll
        for (int e = 0; e < 8; ++e) r[e] = o[8 + e] * rstd * onw[8 + e] * silu(z[8 + e]);
        *(u4*)(oasb + (size_t)m * D + ch + 8) = pack8(r);
        float acc[16];
#pragma unroll
        for (int e = 0; e < 16; ++e) acc[e] = 0.f;
#pragma unroll
        for (int j = 0; j < 3; ++j) { const int tt = t + j - 1;
            if (tt >= 0 && tt < SEQ) { const bf16* rowp = P + (size_t)(m + j - 1) * PW; float cg[8], ui[8];
                unpack8(*(const u4*)(rowp + PC_CG + ch), cg); unpack8(*(const u4*)(rowp + PC_UI + ch), ui);
#pragma unroll
                for (int e = 0; e < 8; ++e) acc[e] += cw[j][e] * (cg[e] * ui[e]);
                unpack8(*(const u4*)(rowp + PC_CG + ch + 8), cg); unpack8(*(const u4*)(rowp + PC_UI + ch + 8), ui);
#pragma unroll
                for (int e = 0; e < 8; ++e) acc[8 + e] += cw[j][8 + e] * (cg[e] * ui[e]); } }
        float bg[8];
        unpack8(*(const u4*)(P + (size_t)m * PW + PC_BG + ch), bg);
#pragma unroll
        for (int e = 0; e < 8; ++e) r[e] = bg[e] * acc[e];
        *(u4*)(oasb + (size_t)(NTOK + m) * D + ch) = pack8(r);
        unpack8(*(const u4*)(P + (size_t)m * PW + PC_BG + ch + 8), bg);
#pragma unroll
        for (int e = 0; e < 8; ++e) r[e] = bg[e] * acc[8 + e];
        *(u4*)(oasb + (size_t)(NTOK + m) * D + ch + 8) = pack8(r);
    }
}

constexpr int P7_MAXIT = 16;
__device__ __forceinline__ void phase_p7(Frame& F, const Args& AR) {
    const float* x1 = (const float*)(F.ws + WS_OD); const float* norm2_w = AR.in[14]; const float* router_b = AR.in[16]; const float* mod = (const float*)(F.ws + WS_MOD);
    LAS float* WtL = (LAS float*)F.lds;
    LAS float* A1 = (LAS float*)(F.lds + 131584);
    LAS float* B1 = A1 + 2048;
    stage_wt(WtL, (const float*)(F.ws + WS_WR_T), F.tid);
    for (int idx = F.tid; idx < 2048; idx += NTHR) { const int b = idx >> 10, k = idx & 1023; A1[idx] = norm2_w[k] * (1.0f + mod[b * 6144 + 4096 + k]); B1[idx] = mod[b * 6144 + 3072 + k]; }
    LAS unsigned* lcnt = (LAS unsigned*)(B1 + 2048);
    LAS unsigned* rec = lcnt + 64;
    if (F.tid < 64) lcnt[F.tid] = 0u;
    __syncthreads();
    bf16* h2 = (bf16*)(F.ws + WS_H); int* topi = (int*)(F.ws + WS_TOPI); float* topg = (float*)(F.ws + WS_TOPG); int* topp = (int*)(F.ws + WS_TOPP);
    unsigned* cnt = (unsigned*)(F.ws + WS_CTL) + CW_CNT;
    const int lane = F.lane; const float rb = router_b[lane >> 1];
    const int gw = blockIdx.x * NWAVES + F.wave, NGW = F.G * NWAVES;
    int it = 0;
    for (int m = gw; m < NTOK; m += NGW, ++it) {
        const f4* xr = (const f4*)(x1 + (size_t)m * D) + lane; f4 v[4]; float ss = 0.f;
#pragma unroll
        for (int j = 0; j < 4; ++j) { v[j] = xr[64 * j]; ss += (v[j].x * v[j].x + v[j].y * v[j].y) + (v[j].z * v[j].z + v[j].w * v[j].w); }
        const float rstd = 1.0f / sqrtf(wave_sum(ss) * (1.0f / D) + EPS);
        const int b = m >> 13;
#pragma unroll
        for (int j = 0; j < 4; ++j) { const f4 a = *(const LAS f4*)(A1 + b * 1024 + 256 * j + 4 * lane), bb = *(const LAS f4*)(B1 + b * 1024 + 256 * j + 4 * lane);
            v[j] = v[j] * rstd * a + bb;
            u2 o; o.x = pk2(v[j].x, v[j].y); o.y = pk2(v[j].z, v[j].w); ((u2*)(h2 + (size_t)m * D))[lane + 64 * j] = o; }
        float val = dot32(v, WtL, lane) + rb; const int myn = lane >> 1;
        float tv[4]; int ti[4];
#pragma unroll
        for (int r = 0; r < 4; ++r) { float bv = val; int bi = myn;
#pragma unroll
            for (int o = 1; o < 64; o <<= 1) { const float ov = __shfl_xor(bv, o); const int oi = __shfl_xor(bi, o); if (ov > bv || (ov == bv && oi < bi)) { bv = ov; bi = oi; } }
            tv[r] = bv; ti[r] = bi; if (myn == bi) val = -__builtin_inff(); }
        const float e1 = __expf(tv[1] - tv[0]), e2 = __expf(tv[2] - tv[0]), e3 = __expf(tv[3] - tv[0]), inv = 1.0f / (1.0f + e1 + e2 + e3);
        if (lane < 4) { const int e = lane == 0 ? ti[0] : (lane == 1 ? ti[1] : (lane == 2 ? ti[2] : ti[3]));
            const float g = (lane == 0 ? 1.0f : (lane == 1 ? e1 : (lane == 2 ? e2 : e3))) * inv;
            topi[(size_t)m * 4 + lane] = e; topg[(size_t)m * 4 + lane] = g;
            if (it < P7_MAXIT) { const unsigned lp = __hip_atomic_fetch_add(lcnt + e, 1u, __ATOMIC_RELAXED, __HIP_MEMORY_SCOPE_WORKGROUP); rec[(F.wave * P7_MAXIT + it) * 4 + lane] = (unsigned)e | (lp << 8); }
            else topp[(size_t)m * 4 + lane] = (int)__hip_atomic_fetch_add(cnt + 64 * e, 1u, __ATOMIC_RELAXED, __HIP_MEMORY_SCOPE_AGENT); }
    }
    __syncthreads();
    if (F.tid < 32) lcnt[32 + F.tid] = __hip_atomic_fetch_add(cnt + 64 * F.tid, lcnt[F.tid], __ATOMIC_RELAXED, __HIP_MEMORY_SCOPE_AGENT);
    __syncthreads();
    { int it = 0;
        for (int m = gw; m < NTOK && it < P7_MAXIT; m += NGW, ++it)
            if (lane < 4) { const unsigned rc = rec[(F.wave * P7_MAXIT + it) * 4 + lane]; topp[(size_t)m * 4 + lane] = (int)(lcnt[32 + (rc & 255u)] + (rc >> 8)); } }
}

__device__ __forceinline__ int build_moe_tables(Frame& F, LAS int* tab  ) {
    const unsigned* cnt = (const unsigned*)(F.ws + WS_CTL) + CW_CNT;
    if (F.tid == 0) { int start = 0;
        for (int e = 0; e < NEXP; ++e) { const int n = (int)__hip_atomic_load(cnt + 64 * e, __ATOMIC_RELAXED, __HIP_MEMORY_SCOPE_AGENT); const int nb = (n + 255) >> 8; tab[e] = start * 256;
            for (int k = 0; k < nb; ++k) tab[64 + start + k] = e; start += nb; }
        tab[32] = start; }
    __syncthreads();
    return tab[32];
}

__device__ __forceinline__ void phase_p8(Frame& F, const Args& AR) {
    LAS int* tab = (LAS int*)(F.lds + LDS_TAB);
    build_moe_tables(F, tab);
    const bf16* h2 = (const bf16*)(F.ws + WS_H); bf16* xs = (bf16*)(F.ws + WS_XS);
    const int* topi = (const int*)(F.ws + WS_TOPI); int* topp = (int*)(F.ws + WS_TOPP);
    const int gw = blockIdx.x * NWAVES + F.wave, NGW = F.G * NWAVES;
    for (int q0 = gw * 8; q0 < NTOK * TOPK; q0 += NGW * 8) {
        int rows[8]; u4 a[8], b2[8];
#pragma unroll
        for (int j = 0; j < 8; ++j) { const int q = q0 + j; rows[j] = tab[topi[q]] + topp[q]; }
#pragma unroll
        for (int j = 0; j < 8; ++j) { const u4* src = (const u4*)(h2 + (size_t)((q0 + j) >> 2) * D) + F.lane; a[j] = src[0]; b2[j] = src[64]; }
#pragma unroll
        for (int j = 0; j < 8; ++j) { u4* dst = (u4*)(xs + (size_t)rows[j] * D) + F.lane; dst[0] = a[j]; dst[64] = b2[j]; }
        if (F.lane < 8) { int r = rows[0];
#pragma unroll
            for (int j = 1; j < 8; ++j) r = (F.lane == j) ? rows[j] : r;
            topp[q0 + F.lane] = r; }
    }
}

__device__ __forceinline__ void phase_p9(Frame& F, const Args& AR, float* out) {
    const float* x1 = (const float*)(F.ws + WS_OD); const bf16* ys = (const bf16*)(F.ws + WS_YS); const float* mod = (const float*)(F.ws + WS_MOD); const float* fnw = AR.in[21];
    const float* topg = (const float*)(F.ws + WS_TOPG); const int* topp = (const int*)(F.ws + WS_TOPP);
    const int lane = F.lane;
    const int gw = blockIdx.x * NWAVES + F.wave, NGW = F.G * NWAVES;
    for (int m = gw; m < NTOK; m += NGW) {
        const int b = m >> 13;
        const f4 gk = *(const f4*)(topg + (size_t)m * 4); const int r0 = topp[(size_t)m * 4], r1 = topp[(size_t)m * 4 + 1], r2 = topp[(size_t)m * 4 + 2], r3 = topp[(size_t)m * 4 + 3];
        f4 v[4]; float ss = 0.f;
#pragma unroll
        for (int j = 0; j < 4; ++j) {
            const u2 y0 = ((const u2*)(ys + (size_t)r0 * D))[lane + 64 * j], y1 = ((const u2*)(ys + (size_t)r1 * D))[lane + 64 * j], y2 = ((const u2*)(ys + (size_t)r2 * D))[lane + 64 * j], y3 = ((const u2*)(ys + (size_t)r3 * D))[lane + 64 * j];
            f4 mo;
            mo.x = gk.x * bflo(y0.x) + gk.y * bflo(y1.x) + gk.z * bflo(y2.x) + gk.w * bflo(y3.x);
            mo.y = gk.x * bfhi(y0.x) + gk.y * bfhi(y1.x) + gk.z * bfhi(y2.x) + gk.w * bfhi(y3.x);
            mo.z = gk.x * bflo(y0.y) + gk.y * bflo(y1.y) + gk.z * bflo(y2.y) + gk.w * bflo(y3.y);
            mo.w = gk.x * bfhi(y0.y) + gk.y * bfhi(y1.y) + gk.z * bfhi(y2.y) + gk.w * bfhi(y3.y);
            const f4 xv = ((const f4*)(x1 + (size_t)m * D))[lane + 64 * j], gt = ((const f4*)(mod + b * 6144 + 5120))[lane + 64 * j];
            v[j] = xv + gt * mo; ss += (v[j].x * v[j].x + v[j].y * v[j].y) + (v[j].z * v[j].z + v[j].w * v[j].w); }
        const float rstd = 1.0f / sqrtf(wave_sum(ss) * (1.0f / D) + EPS);
#pragma unroll
        for (int j = 0; j < 4; ++j) { const f4 w = ((const f4*)fnw)[lane + 64 * j]; ((f4*)(out + (size_t)m * D))[lane + 64 * j] = v[j] * rstd * w; }
    }
}

__global__ void __launch_bounds__(NTHR, 2) fwd_kernel(Args args) {
    const Args& AR = args;
    extern __shared__ __attribute__((aligned(16))) unsigned char lds_raw[];
    Frame F;
    F.lds = (LAS unsigned char*)lds_raw;
    F.tid = threadIdx.x; F.lane = F.tid & 63; F.wave = __builtin_amdgcn_readfirstlane(F.tid >> 6); F.G = gridDim.x;
    F.ws = args.ws;
    volatile LAS unsigned* misc = (volatile LAS unsigned*)(F.lds + LDS_MISC);
    if (F.tid < 4) misc[F.tid] = 0u;
    __syncthreads();
    XcdBarrier bar; bar.bar = (unsigned*)(F.ws + WS_CTL) + CW_BAR; bar.x = 0; bar.st = nullptr;
    if (MK_N_LAUNCHES == 1) bar = xcd_barrier_post((unsigned*)(F.ws + WS_CTL) + CW_BAR, misc);
    const int lo = args.ph_lo, hi = args.ph_hi;
#ifndef PH_MASK
#define PH_MASK 0x1fff
#endif
#define IN(k) (((PH_MASK >> (k)) & 1) && lo <= (k) && (k) < hi)
#ifndef PROBE_PH
#define PROBE_PH -1
#define PROBE_REP 1
#endif
#define REPS(k) for (int rep_ = 0; rep_ < ((k) == PROBE_PH ? PROBE_REP : 1); ++rep_)
#define SEAM(k) do { if (IN(k) && IN((k) + 1)) xcd_barrier(bar); } while (0)
    PG8_LAS unsigned char* glds = (PG8_LAS unsigned char*)lds_raw;

    if (IN(0)) REPS(0) { phase_p0(F, AR); } SEAM(0);
    if (IN(1)) REPS(1) { phase_p1(F, AR); } SEAM(1);
    if (IN(2)) REPS(2) {
        pg8::Gemm g{(const bf16*)(F.ws + WS_H), (const bf16*)(F.ws + WS_WIN_T), NTOK, PW, D}; pg8::StaticOrder S; S.init(NTOK, PW, F.G, (int)blockIdx.x);
        EpiStoreBf16 E{(bf16*)(F.ws + WS_P), PW};
        pg8::gemm_phase<EpiStoreBf16, pg8::StaticOrder, true, true>(glds, g, S, E);
    } SEAM(2);
    if (IN(3)) REPS(3) { phase_p3(F, AR); } SEAM(3);
    if (IN(4)) REPS(4) { phase_p4(F, AR); } SEAM(4);
    if (IN(5)) REPS(5) { phase_p5(F, AR); } SEAM(5);
    if (IN(6)) REPS(6) {
        pg8::Gemm g{(const bf16*)(F.ws + WS_OASB), (const bf16*)(F.ws + WS_WUO_T), 2 * NTOK, 2048, D}; OrderG23 S; S.S.init(NTOK, D, F.G, (int)blockIdx.x);
        EpiG23 E{(const bf16*)(F.ws + WS_P), (float*)(F.ws + WS_M1), (bf16*)(F.ws + WS_M)};
        pg8::gemm_phase<EpiG23, OrderG23, true, true>(glds, g, S, E);
    } SEAM(6);
    if (IN(7)) REPS(7) {
        pg8::Gemm g{(const bf16*)(F.ws + WS_M), (const bf16*)(F.ws + WS_WO_T), NTOK, D, D}; pg8::StaticOrder S; S.init(NTOK, D, F.G, (int)blockIdx.x);
        EpiG4 E{AR.in[0], (const float*)(F.ws + WS_MOD), (float*)(F.ws + WS_OD)};
        pg8::gemm_phase<EpiG4, pg8::StaticOrder, true, true>(glds, g, S, E);
    } SEAM(7);
    if (IN(8)) REPS(8) { phase_p7(F, AR); } SEAM(8);
    if (IN(9)) REPS(9) { phase_p8(F, AR); } SEAM(9);
    if (IN(10)) REPS(10) {
        __syncthreads();
        LAS int* tab = (LAS int*)(F.lds + LDS_TAB); const int nblk = build_moe_tables(F, tab);
        pg8::Gemm g{(const bf16*)(F.ws + WS_XS), (const bf16*)(F.ws + WS_W1T), MROWS, NEXP * 2048, D}; MoeOrder S; S.init(nblk, 8, F.G, (int)blockIdx.x, tab + 64);
        EpiMoe1 E{AR.in[18], (bf16*)(F.ws + WS_ACT)};
        pg8::gemm_phase<EpiMoe1, MoeOrder, true, true>(glds, g, S, E);
    } SEAM(10);
    if (IN(11)) REPS(11) {
        __syncthreads();
        LAS int* tab = (LAS int*)(F.lds + LDS_TAB); const int nblk = build_moe_tables(F, tab);
        pg8::Gemm g{(const bf16*)(F.ws + WS_ACT), (const bf16*)(F.ws + WS_W2T), MROWS, NEXP * 1024, D}; MoeOrder S; S.init(nblk, 4, F.G, (int)blockIdx.x, tab + 64);
        EpiMoe2 E{AR.in[20], (bf16*)(F.ws + WS_YS)};
        pg8::gemm_phase<EpiMoe2, MoeOrder, true, true>(glds, g, S, E);
    } SEAM(11);
    if (IN(12)) REPS(12) { phase_p9(F, AR, args.out); }
#undef IN
#undef SEAM
}

extern "C" void kernel_launch(void* const* d_in, const int* in_sizes, int n_in, void* d_out, int out_size, void* d_ws, size_t ws_size, hipStream_t stream) {
    static int grid = 0;
    if (grid == 0) {
        if (n_in != 22 || out_size != NTOK * D || ws_size < WS_END) { fprintf(stderr, "kernel_launch: unexpected shapes (n_in %d out %d ws %zu)\n", n_in, out_size, ws_size); grid = -1; return; }
        int dev = 0, cus = 0, per_cu = 0;
        if (hipGetDevice(&dev) != hipSuccess || hipDeviceGetAttribute(&cus, hipDeviceAttributeMultiprocessorCount, dev) != hipSuccess) { grid = -1; return; }
        if (hipFuncSetAttribute((const void*)fwd_kernel, hipFuncAttributeMaxDynamicSharedMemorySize, LDS_BYTES) != hipSuccess) { fprintf(stderr, "kernel_launch: hipFuncSetAttribute failed\n"); grid = -1; return; }
        if (hipOccupancyMaxActiveBlocksPerMultiprocessor(&per_cu, (const void*)fwd_kernel, NTHR, LDS_BYTES) != hipSuccess || per_cu < 1) { fprintf(stderr, "kernel_launch: occupancy query says %d\n", per_cu); }
        (void)hipGetLastError();
        grid = cus;
        if (grid > 256) grid = 256;
    }
    if (grid < 0) return;
    if (hipMemsetAsync((char*)d_ws + WS_CTL, 0, CTL_ZERO_BYTES, stream) != hipSuccess) return;
    Args a{};
    for (int i = 0; i < 22; ++i) a.in[i] = (const float*)d_in[i];
    a.out = (float*)d_out; a.ws = (unsigned char*)d_ws;
#if MK_N_LAUNCHES == 1
    a.ph_lo = 0; a.ph_hi = NPHASE;
    hipLaunchKernelGGL(fwd_kernel, dim3(grid), dim3(NTHR), LDS_BYTES, stream, a);
#else
    for (int ph = 0; ph < NPHASE; ++ph) { a.ph_lo = ph; a.ph_hi = ph + 1; hipLaunchKernelGGL(fwd_kernel, dim3(grid), dim3(NTHR), LDS_BYTES, stream, a); }
#endif
}
```

```cpp
#include <hip/hip_runtime.h>
#include <cstdio>
#include <cstdint>
namespace pg8 {
#define PG8_LAS __attribute__((address_space(3)))
typedef unsigned short bf16_t;
typedef short bf16x8 __attribute__((ext_vector_type(8)));
typedef float f32x4 __attribute__((ext_vector_type(4)));
typedef unsigned u32x4 __attribute__((ext_vector_type(4)));
constexpr int BM = 256, BK = 64, HALF = 128, HTB = HALF * BK * 2  , STAGE_BYTES = 8 * HTB, NXCD = 8, WGM = 8;

__host__ __device__ __forceinline__ int lds_byte(int r, int c) { const int st = (r >> 4) * 2 + (c >> 5), rr = r & 15, cc = c & 31, ob = rr * 64 + cc * 2; return st * 1024 + (ob ^ (((ob >> 9) & 1) << 5)); }
__host__ __device__ __forceinline__ void stage_rc(int b, int& R, int& C) { const int st = b / 1024, sb = b % 1024, swz = sb ^ (((sb >> 9) & 1) << 5); R = (st >> 1) * 16 + swz / 64; C = (st & 1) * 32 + (swz % 64) / 2; }
__host__ __device__ __forceinline__ int perm32(int rho) { const int n = rho >> 4, i = rho & 15; return 8 * (i >> 2) + 4 * n + (i & 3); }

struct Unit { int pm, pn; };
struct Gemm { const bf16_t* A; const bf16_t* Bt; int M, N, K; };

struct StaticOrder {
    int nM, nN, nwg, G, c;
    __host__ __device__ void init(int M, int N, int G_, int c_) { nM = M / BM; nN = N / BM; nwg = nM * nN; G = G_; c = c_; }
    __host__ __device__ bool next(int i, Unit& u) const {
        const long L = (long)i * G + c; if (L >= nwg) return false;
        int wgid = (int)L; { const int q = nwg / NXCD, r = nwg % NXCD, xcd = wgid % NXCD, off = wgid / NXCD; wgid = (xcd < r ? xcd * (q + 1) : r * (q + 1) + (xcd - r) * q) + off; }
        const int nig = WGM * nN, gid = wgid / nig, fm = gid * WGM, gsz = (nM - fm) < WGM ? (nM - fm) : WGM;
        u.pm = fm + ((wgid % nig) % gsz); u.pn = (wgid % nig) / gsz; return true;
    }
    __device__ __forceinline__ void a_ready(const Unit&) const {}
    __device__ __forceinline__ void done(const Unit&) const {}
};

__device__ __forceinline__ unsigned cvt_pk_bf16(float lo, float hi) { unsigned r; asm volatile("v_cvt_pk_bf16_f32 %0, %1, %2" : "=v"(r) : "v"(lo), "v"(hi)); return r; }
template <class Epi, class Sched, bool ALIGN_EPI = false, bool SP2 = false, bool GATHER = false>
__device__ __forceinline__ void gemm_phase(PG8_LAS unsigned char* lds, const Gemm g, const Sched& S, const Epi& E) {
    const int tid = threadIdx.x, wid = __builtin_amdgcn_readfirstlane(tid >> 6), lane = tid & 63, wr = wid >> 2, wc = wid & 3, fr = lane & 15, fq = lane >> 4;
    const int K = g.K, nt = K / BK;
    unsigned voffA[2], voffB[2];
#pragma unroll
    for (int i = 0; i < 2; ++i) { int R, C; stage_rc(tid * 16 + i * 8192, R, C); const int Rb = Epi::PERM ? ((R & ~31) + perm32(R & 31)) : R;
        voffA[i] = (unsigned)(R * K + C) * 2u; voffB[i] = (unsigned)(Rb * K + C) * 2u; }
    unsigned vA[2][2], vN[2][2];
#pragma unroll
    for (int h = 0; h < 2; ++h)
#pragma unroll
        for (int i = 0; i < 2; ++i) { vA[h][i] = voffA[i] + (unsigned)(h * HALF * K * 2); vN[h][i] = vA[h][i]; }
#define PG8_TOKS(u, tq) do { _Pragma("unroll") for (int _h = 0; _h < 2; ++_h) _Pragma("unroll") for (int _i = 0; _i < 2; ++_i) { int _R, _C; stage_rc(tid * 16 + _i * 8192, _R, _C); tq[_h][_i] = S.row_token(u, _h * HALF + _R); } } while (0)
#define PG8_OFFS(tq, v) do { _Pragma("unroll") for (int _h = 0; _h < 2; ++_h) _Pragma("unroll") for (int _i = 0; _i < 2; ++_i) { int _R, _C; stage_rc(tid * 16 + _i * 8192, _R, _C); v[_h][_i] = (unsigned)(tq[_h][_i] * K + _C) * 2u; } } while (0)
    const size_t kstep = (size_t)(BK * 2);
    const size_t hstep = (size_t)HALF * K * 2;
    const size_t tstep = 2 * hstep;
    const unsigned ldsw = (unsigned)wid * 1024u;
    const int aoff = lds_byte(wr * 64 + fr, fq * 8), boff = lds_byte(wc * 32 + fr, fq * 8);
#define PG8_SA(b, h) (((b) * 2 + (h)) * HTB)
#define PG8_SB(b, h) ((4 + (b) * 2 + (h)) * HTB)
#define PG8_STAGE(bufoff, gbase, voff) do { _Pragma("unroll") for (int _i = 0; _i < 2; ++_i) \
        __builtin_amdgcn_global_load_lds((const unsigned*)((const char*)(gbase) + (voff)[_i]), (PG8_LAS unsigned*)(lds + (bufoff) + ldsw + _i * 8192), 16, 0, 0); } while (0)
#define PG8_LDA(dst, b, h) do { _Pragma("unroll") for (int m = 0; m < 4; ++m) _Pragma("unroll") for (int k = 0; k < 2; ++k) dst[m][k] = *(const PG8_LAS bf16x8*)(lds + PG8_SA(b, h) + aoff + m * 2048 + k * 1024); } while (0)
#define PG8_LDB(dst, b, h) do { _Pragma("unroll") for (int n = 0; n < 2; ++n) _Pragma("unroll") for (int k = 0; k < 2; ++k) dst[n][k] = *(const PG8_LAS bf16x8*)(lds + PG8_SB(b, h) + boff + n * 2048 + k * 1024); } while (0)
#define PG8_MMA(ai, bj, At, Bt) do { __builtin_amdgcn_s_setprio(1); _Pragma("unroll") for (int m = 0; m < 4; ++m) _Pragma("unroll") for (int n = 0; n < 2; ++n) _Pragma("unroll") for (int k = 0; k < 2; ++k) \
        acc[ai][bj][m][n] = __builtin_amdgcn_mfma_f32_16x16x32_bf16(Bt[n][k], At[m][k], acc[ai][bj][m][n], 0, 0, 0); __builtin_amdgcn_s_setprio(0); } while (0)
#define PG8_WAIT_V(n) asm volatile("s_waitcnt vmcnt(" #n ")" ::: "memory")
#define PG8_WAIT_L(n) asm volatile("s_waitcnt lgkmcnt(" #n ")" ::: "memory")
#define PG8_BAR __builtin_amdgcn_s_barrier()
#define PG8_SCHED __builtin_amdgcn_sched_barrier(0)
    Unit cur, nxt; int ui = 0;
    if (!S.next(0, cur)) return;
    f32x4 acc[2][2][4][2];
#pragma unroll
    for (int a = 0; a < 2; ++a)
#pragma unroll
        for (int b = 0; b < 2; ++b)
#pragma unroll
            for (int m = 0; m < 4; ++m)
#pragma unroll
                for (int n = 0; n < 2; ++n) acc[a][b][m][n] = (f32x4){0.f, 0.f, 0.f, 0.f};
    bf16x8 At[4][2], B0[2][2], B1[2][2];
    const char* cA = (const char*)g.A + (GATHER ? (size_t)0 : (size_t)cur.pm * tstep); const char* cB = (const char*)g.Bt + (size_t)cur.pn * tstep;
    if constexpr (GATHER) { int tq0[2][2]; PG8_TOKS(cur, tq0); PG8_OFFS(tq0, vA); Unit n1; if (S.next(1, n1)) { PG8_TOKS(n1, tq0); PG8_OFFS(tq0, vN); } else { vN[0][0] = vA[0][0]; vN[0][1] = vA[0][1]; vN[1][0] = vA[1][0]; vN[1][1] = vA[1][1]; } }
    S.a_ready(cur);
    if constexpr (SP2) {
        PG8_STAGE(PG8_SB(0, 0), cB, voffB); PG8_STAGE(PG8_SB(0, 1), cB + hstep, voffB); PG8_STAGE(PG8_SA(0, 0), cA, vA[0]); PG8_STAGE(PG8_SA(0, 1), cA, vA[1]);
        if (wr == 1) PG8_BAR;
        PG8_WAIT_V(2); PG8_BAR;
        PG8_STAGE(PG8_SB(1, 0), cB + kstep, voffB); PG8_STAGE(PG8_SA(1, 0), cA + kstep, vA[0]); PG8_STAGE(PG8_SB(1, 1), cB + hstep + kstep, voffB);
        PG8_WAIT_V(6); PG8_BAR;
    } else {
        PG8_STAGE(PG8_SB(0, 0), cB, voffB); PG8_STAGE(PG8_SA(0, 0), cA, voffA); PG8_STAGE(PG8_SB(0, 1), cB + hstep, voffB); PG8_STAGE(PG8_SA(0, 1), cA + hstep, voffA);
        if (wr == 1) PG8_BAR;
        PG8_WAIT_V(4); PG8_BAR;
        PG8_STAGE(PG8_SB(1, 0), cB + kstep, voffB); PG8_STAGE(PG8_SA(1, 0), cA + kstep, voffA); PG8_STAGE(PG8_SB(1, 1), cB + hstep + kstep, voffB);
        PG8_WAIT_V(6); PG8_BAR;
    }
    for (;;) {
        const bool has_next = S.next(ui + 1, nxt);
        const char* nA = (has_next && !GATHER) ? (const char*)g.A + (size_t)nxt.pm * tstep : cA; const char* nB = has_next ? (const char*)g.Bt + (size_t)nxt.pn * tstep : cB;
        for (int t = 0; t < nt; t += 2) {
            const bool last = (t == nt - 2);
            const char* a1 = cA + (size_t)(t + 1) * kstep;
            const char* a2 = last ? nA : cA + (size_t)(t + 2) * kstep; const char* b2 = last ? nB : cB + (size_t)(t + 2) * kstep;
            const char* a3 = a2 + kstep; const char* b3 = b2 + kstep;
            if (last && has_next) S.a_ready(nxt);
            unsigned o0[2] = {vA[0][0], vA[0][1]}, o1[2] = {vA[1][0], vA[1][1]};
            if (last) { o0[0] = vN[0][0]; o0[1] = vN[0][1]; o1[0] = vN[1][0]; o1[1] = vN[1][1]; }
            if constexpr (SP2) {
            PG8_LDB(B0, 0, 0); PG8_LDB(B1, 0, 1); PG8_SCHED; PG8_LDA(At, 0, 0); PG8_STAGE(PG8_SA(1, 1), a1, vA[1]);
            PG8_WAIT_V(8); PG8_WAIT_L(0); PG8_BAR; PG8_MMA(0, 0, At, B0); PG8_MMA(0, 1, At, B1); PG8_BAR; PG8_SCHED;
            PG8_LDA(At, 0, 1); PG8_STAGE(PG8_SB(0, 0), b2, voffB); PG8_STAGE(PG8_SB(0, 1), b2 + hstep, voffB); PG8_STAGE(PG8_SA(0, 0), a2, o0);
            PG8_WAIT_V(8); PG8_WAIT_L(0); PG8_BAR; PG8_MMA(1, 0, At, B0); PG8_MMA(1, 1, At, B1); PG8_BAR; PG8_SCHED;
            PG8_LDB(B0, 1, 0); PG8_LDB(B1, 1, 1); PG8_SCHED; PG8_LDA(At, 1, 0); PG8_STAGE(PG8_SA(0, 1), a2, o1);
            PG8_WAIT_V(8); PG8_WAIT_L(0); PG8_BAR; PG8_MMA(0, 0, At, B0); PG8_MMA(0, 1, At, B1); PG8_BAR; PG8_SCHED;
            PG8_LDA(At, 1, 1); PG8_STAGE(PG8_SB(1, 0), b3, voffB); PG8_STAGE(PG8_SB(1, 1), b3 + hstep, voffB); PG8_STAGE(PG8_SA(1, 0), a3, o0);
            PG8_WAIT_V(8); PG8_WAIT_L(0); PG8_BAR; PG8_MMA(1, 0, At, B0); PG8_MMA(1, 1, At, B1); PG8_BAR; PG8_SCHED;
            } else {
            PG8_LDB(B0, 0, 0); PG8_SCHED; PG8_LDA(At, 0, 0); PG8_STAGE(PG8_SA(1, 1), a1 + hstep, voffA);
            PG8_WAIT_L(8); PG8_BAR; PG8_WAIT_L(0); PG8_MMA(0, 0, At, B0); PG8_BAR; PG8_SCHED;
            PG8_LDB(B1, 0, 1); PG8_STAGE(PG8_SB(0, 0), b2, voffB);
            PG8_BAR; PG8_WAIT_L(0); PG8_MMA(0, 1, At, B1); PG8_BAR;
            PG8_LDA(At, 0, 1); PG8_STAGE(PG8_SA(0, 0), a2, voffA);
            PG8_BAR; PG8_WAIT_L(0); PG8_MMA(1, 0, At, B0); PG8_BAR; PG8_SCHED;
            PG8_STAGE(PG8_SB(0, 1), b2 + hstep, voffB);
            PG8_WAIT_V(6); PG8_BAR; PG8_MMA(1, 1, At, B1); PG8_BAR;
            PG8_LDB(B0, 1, 0); PG8_SCHED; PG8_LDA(At, 1, 0); PG8_STAGE(PG8_SA(0, 1), a2 + hstep, voffA);
            PG8_WAIT_L(8); PG8_BAR; PG8_WAIT_L(0); PG8_MMA(0, 0, At, B0); PG8_BAR; PG8_SCHED;
            PG8_LDB(B1, 1, 1); PG8_STAGE(PG8_SB(1, 0), b3, voffB);
            PG8_BAR; PG8_WAIT_L(0); PG8_MMA(0, 1, At, B1); PG8_BAR;
            PG8_LDA(At, 1, 1); PG8_STAGE(PG8_SA(1, 0), a3, voffA);
            PG8_BAR; PG8_WAIT_L(0); PG8_MMA(1, 0, At, B0); PG8_BAR; PG8_SCHED;
            PG8_STAGE(PG8_SB(1, 1), b3 + hstep, voffB);
            PG8_WAIT_V(6); PG8_BAR; PG8_MMA(1, 1, At, B1); PG8_BAR;
            }
        }
        if constexpr (ALIGN_EPI) { if (wr == 0) PG8_BAR; }
        int tq[2][2] = {{0, 0}, {0, 0}}; bool has2 = false;
        if constexpr (GATHER) { Unit nx2; has2 = S.next(ui + 2, nx2); if (has2) PG8_TOKS(nx2, tq); }
        if constexpr (!Epi::AFTER_DRAIN) { E(acc, cur, wr, wc, fr, fq); S.done(cur); }
        if constexpr (GATHER) { asm volatile("" : "+v"(tq[0][0]), "+v"(tq[0][1]), "+v"(tq[1][0]), "+v"(tq[1][1])); }
        if (!has_next) break;
#pragma unroll
        for (int a = 0; a < 2; ++a)
#pragma unroll
            for (int b = 0; b < 2; ++b)
#pragma unroll
                for (int m = 0; m < 4; ++m)
#pragma unroll
                    for (int n = 0; n < 2; ++n) acc[a][b][m][n] = (f32x4){0.f, 0.f, 0.f, 0.f};
        cur = nxt; cA = nA; cB = nB; ++ui; vA[0][0] = vN[0][0]; vA[0][1] = vN[0][1]; vA[1][0] = vN[1][0]; vA[1][1] = vN[1][1];
        if constexpr (GATHER) { if (has2) PG8_OFFS(tq, vN); }
        if constexpr (ALIGN_EPI) { if (wr == 1) PG8_BAR; }
    }
    PG8_WAIT_V(0);
    if constexpr (!ALIGN_EPI) { if (wr == 0) PG8_BAR; }
    PG8_BAR;
    if constexpr (Epi::AFTER_DRAIN) { E.fused(acc, cur, wr, wc, fr, fq, lds, wid, lane); S.done(cur); }
#undef PG8_TOKS
#undef PG8_OFFS
#undef PG8_SA
#undef PG8_SB
#undef PG8_STAGE
#undef PG8_LDA
#undef PG8_LDB
#undef PG8_MMA
#undef PG8_WAIT_V
#undef PG8_WAIT_L
#undef PG8_BAR
#undef PG8_SCHED
}
}

#define XB_TMO      128
#define XB_XCNT(j)  (256  + 64 * (j))
#define XB_XSUB(j)  (1280 + 64 * (j))
#define XB_XGEN(j)  (2304 + 64 * (j))
#define XB_TOP      3328
#define XB_TOPGEN   3392
#define XCD_BAR_WORDS 3456
#define XB_SPIN_CAP (1u << 18)
#define LAS __attribute__((address_space(3)))

__device__ __forceinline__ unsigned xb_ld(unsigned* p)              { return __hip_atomic_load(p, __ATOMIC_RELAXED, __HIP_MEMORY_SCOPE_AGENT); }
__device__ __forceinline__ unsigned xb_add(unsigned* p, unsigned v) { return __hip_atomic_fetch_add(p, v, __ATOMIC_RELAXED, __HIP_MEMORY_SCOPE_AGENT); }
__device__ __forceinline__ unsigned xb_xcc_id() { return (unsigned)__builtin_amdgcn_s_getreg((3 << 11) | 20) & 0xFu; }
#define XB_SPIN(cond, bar) do { unsigned _sp = 0; while (cond) { __builtin_amdgcn_s_sleep(1); \
    if ((++_sp & 255u) == 0u) { if (xb_ld(&(bar)[XB_TMO])) break; if (_sp > XB_SPIN_CAP) { atomicAdd(&(bar)[XB_TMO], 1u); break; } } } } while (0)

struct XcdBarrier {
    unsigned* bar; unsigned x;
    volatile LAS unsigned* st;
};

__device__ __forceinline__ XcdBarrier xcd_barrier_post(unsigned* bar, volatile LAS unsigned* st) {
    XcdBarrier b; b.bar = bar; b.x = xb_xcc_id(); b.st = st;
    if (threadIdx.x == 0) (void)xb_add(&bar[XB_XCNT(b.x)], 1u);
    return b;
}
__device__ __forceinline__ void xcd_barrier_complete(unsigned* bar, unsigned x, unsigned& nloc, unsigned& nx) {
    const unsigned G = gridDim.x * gridDim.y * gridDim.z;
    unsigned sum, cnt, mine, sp = 0u;
    for (;;) {
        sum = 0u; cnt = 0u; mine = 0u;
#pragma unroll
        for (unsigned j = 0; j < 16; ++j) { const unsigned c = xb_ld(&bar[XB_XCNT(j)]); sum += c; cnt += (c > 0u) ? 1u : 0u; mine = (j == x) ? c : mine; }
        if (sum == G) break;
        __builtin_amdgcn_s_sleep(1);
        if ((++sp & 255u) == 0u) { if (xb_ld(&bar[XB_TMO])) break; if (sp > XB_SPIN_CAP) { atomicAdd(&bar[XB_TMO], 1u); break; } }
    }
    nloc = mine > 0u ? mine : 1u; nx = cnt > 0u ? cnt : 1u;
}

__device__ __forceinline__ void xcd_barrier(const XcdBarrier& b) {
    asm volatile("s_waitcnt vmcnt(0)" ::: "memory");
    __syncthreads();
    if (threadIdx.x == 0) {
        unsigned* bar = b.bar;
        __builtin_amdgcn_s_waitcnt(0);
        unsigned nloc = b.st[0], nx = b.st[1];
        if (nloc == 0u) { xcd_barrier_complete(bar, b.x, nloc, nx); b.st[0] = nloc; b.st[1] = nx; }
        const unsigned old = xb_add(&bar[XB_XSUB(b.x)], 1u);
        const unsigned gen = old / nloc;
        if (old + 1u == (gen + 1u) * nloc) {
            __builtin_amdgcn_fence(__ATOMIC_RELEASE, "agent");
            asm volatile("s_waitcnt vmcnt(0)" ::: "memory");
            const unsigned og = xb_add(&bar[XB_TOP], 1u);
            const unsigned tg = og / nx;
            if (og + 1u == (tg + 1u) * nx) xb_add(&bar[XB_TOPGEN], 1u);
            else XB_SPIN(xb_ld(&bar[XB_TOPGEN]) == tg, bar);
            __builtin_amdgcn_fence(__ATOMIC_ACQUIRE, "agent");
            xb_add(&bar[XB_XGEN(b.x)], 1u);
            asm volatile("s_waitcnt vmcnt(0)" ::: "memory");
        } else {
            XB_SPIN(xb_ld(&bar[XB_XGEN(b.x)]) == gen, bar);
            __builtin_amdgcn_fence(__ATOMIC_ACQUIRE, "agent");
            asm volatile("s_waitcnt vmcnt(0)" ::: "memory");
        }
    }
    __syncthreads();
}

#ifndef MK_N_LAUNCHES
#define MK_N_LAUNCHES 1
#endif
constexpr int NPHASE = 12;
constexpr int NWAVES = 8, NTHR = 512;
constexpr int D = 1024, SEQ = 8192, NTOK = 16384, NH = 8, HD = 128, CH = 64, NCHUNK = 128;
constexpr int PW = 9216;
constexpr int PC_Q = 0, PC_K = 1024, PC_V = 2048, PC_Z = 3072, PC_BG = 4096, PC_CG = 5120, PC_UI = 6144, PC_GA = 7168, PC_GB = 8192;
constexpr int INW = 9248;
constexpr int NEXP = 32, TOPK = 4, MROWS = 73728;
constexpr float EPS = 1e-6f;

constexpr size_t MiB = 1u << 20;
constexpr size_t WS_CTL = 0, CTL_ZERO_BYTES = 1 * MiB;
constexpr size_t WS_MOD = 1 * MiB;
constexpr size_t WS_WSM_T = 1 * MiB + 64 * 1024;
constexpr size_t WS_WR_T = 1 * MiB + 192 * 1024;
constexpr size_t WS_TOPI = 2 * MiB;
constexpr size_t WS_TOPG = 2 * MiB + 256 * 1024;
constexpr size_t WS_TOPP = 2 * MiB + 512 * 1024;
constexpr size_t WS_PSM = 3 * MiB;
constexpr size_t WS_GL = 5 * MiB;
constexpr size_t WS_LIST = 6 * MiB;
constexpr size_t WS_WIN_T = 8 * MiB;
constexpr size_t WS_WUO_T = 26 * MiB;
constexpr size_t WS_WO_T = 30 * MiB;
constexpr size_t WS_W1T = 32 * MiB;
constexpr size_t WS_W2T = 160 * MiB;
constexpr size_t WS_H = 224 * MiB;
constexpr size_t WS_OD = 256 * MiB;
constexpr size_t WS_P = 320 * MiB;
constexpr size_t WS_DD = 608 * MiB;
constexpr size_t WS_END = 896 * MiB;
constexpr size_t DD_UNIT = 73728;
constexpr size_t DD_W = 0, DD_Q = 16384, DD_K = 32768, DD_A = 49152, DD_U = 57344;
constexpr size_t WS_OASB = WS_DD, WS_M1 = WS_DD + 64 * MiB, WS_M = WS_DD + 128 * MiB;
constexpr size_t WS_XS = WS_P, WS_ACT = WS_P + 144 * MiB, WS_YS = WS_DD;
constexpr int CW_BAR = 4096;
constexpr int CW_CVT = 28672;
constexpr int CW_Q = 24576;
constexpr int CW_CNT = 16384;

constexpr int LDS_BYTES = 155648;
constexpr int LDS_MISC = 152 * 1024 - 256;
constexpr int LDS_TAB = 131072;

#define GAS __attribute__((address_space(1)))
#define LAS __attribute__((address_space(3)))
typedef unsigned short bf16;
typedef float f4 __attribute__((ext_vector_type(4)));
typedef unsigned u4 __attribute__((ext_vector_type(4)));
typedef unsigned u2 __attribute__((ext_vector_type(2)));

typedef __bf16 hwbf2 __attribute__((ext_vector_type(2)));
typedef float hwf2 __attribute__((ext_vector_type(2)));
__device__ __forceinline__ unsigned cvtpk(float lo, float hi) { const hwf2 v = {lo, hi}; return __builtin_bit_cast(unsigned, __builtin_convertvector(v, hwbf2)); }
__device__ __forceinline__ unsigned f2bf(float f) { unsigned u = __float_as_uint(f); return (u + 0x7fffu + ((u >> 16) & 1u)) >> 16; }
__device__ __forceinline__ unsigned pk2(float lo, float hi) { return cvtpk(lo, hi); }
__device__ __forceinline__ float bflo(unsigned w) { return __uint_as_float(w << 16); }
__device__ __forceinline__ float bfhi(unsigned w) { return __uint_as_float(w & 0xffff0000u); }
__device__ __forceinline__ float bf1(bf16 b) { return __uint_as_float(((unsigned)b) << 16); }
__device__ __forceinline__ void unpack8(const u4 w, float (&o)[8]) { o[0] = bflo(w.x); o[1] = bfhi(w.x); o[2] = bflo(w.y); o[3] = bfhi(w.y); o[4] = bflo(w.z); o[5] = bfhi(w.z); o[6] = bflo(w.w); o[7] = bfhi(w.w); }
__device__ __forceinline__ u4 pack8(const float (&o)[8]) { u4 w; w.x = pk2(o[0], o[1]); w.y = pk2(o[2], o[3]); w.z = pk2(o[4], o[5]); w.w = pk2(o[6], o[7]); return w; }
__device__ __forceinline__ float wave_sum(float v) {
#pragma unroll
    for (int o = 1; o < 64; o <<= 1) v += __shfl_xor(v, o);
    return v;
}
#define LDS_BARRIER() do { asm volatile("s_waitcnt lgkmcnt(0)" ::: "memory"); __builtin_amdgcn_s_barrier(); asm volatile("" ::: "memory"); } while (0)
__device__ __forceinline__ float sigm(float x) { return 1.0f / (1.0f + __expf(-x)); }
__device__ __forceinline__ float silu(float x) { return x / (1.0f + __expf(-x)); }
__device__ __forceinline__ float softplus(float x) { return x > 20.f ? x : log1pf(expf(x)); }

struct Args { const float* in[22]; float* out; unsigned char* ws; int ph_lo, ph_hi; };

struct Frame {
    LAS unsigned char* lds;
    int tid, lane, wave, G;
    unsigned char* ws;
};

__device__ __forceinline__ void p0_transpose_item(const float* W, int ldw, int k0, int n0s, bf16* WT, size_t drow0, LAS float* scr, int lane) {
    { const int kq = lane >> 3, n4 = (lane & 7) * 4; f4 v[8];
#pragma unroll
        for (int i = 0; i < 8; ++i) v[i] = *(const f4*)(W + (size_t)(k0 + 8 * i + kq) * ldw + n0s + n4);
#pragma unroll
        for (int i = 0; i < 8; ++i) { LAS float* d = scr + (8 * i + kq) * 33 + n4; d[0] = v[i].x; d[1] = v[i].y; d[2] = v[i].z; d[3] = v[i].w; } }
    asm volatile("s_waitcnt lgkmcnt(0)" ::: "memory");
    const int c = lane & 7;
#pragma unroll
    for (int j = 0; j < 4; ++j) { const int n = (lane >> 3) + 8 * j; const LAS float* s = scr + (8 * c) * 33 + n;
        u4 o; o.x = pk2(s[0 * 33], s[1 * 33]); o.y = pk2(s[2 * 33], s[3 * 33]); o.z = pk2(s[4 * 33], s[5 * 33]); o.w = pk2(s[6 * 33], s[7 * 33]);
        *(u4*)(WT + (drow0 + n) * 1024 + k0 + 8 * c) = o; }
    asm volatile("s_waitcnt lgkmcnt(0)" ::: "memory");
}

__device__ __forceinline__ void phase_p0(Frame& F, const Args& AR) {
    const float* c_in = AR.in[1]; const float* ada_w = AR.in[2]; const float* ada_b = AR.in[3];
    const float* w_in = AR.in[5];
    for (int task = blockIdx.x; task < 192; task += F.G) {
        LAS float* red = (LAS float*)(F.lds + 131072);
        const int j0 = 32 * task, col = j0 + (F.lane & 31), kh = F.lane >> 5;
        float a0 = 0.f, a1 = 0.f;
#pragma unroll 8
        for (int i = 0; i < 64; ++i) { const int k = 128 * F.wave + 2 * i + kh; const float wv = ada_w[(size_t)k * 6144 + col];
            a0 += silu(c_in[k]) * wv; a1 += silu(c_in[1024 + k]) * wv; }
        a0 += __shfl_xor(a0, 32); a1 += __shfl_xor(a1, 32);
        if (F.lane < 32) { red[(F.wave * 2 + 0) * 32 + F.lane] = a0; red[(F.wave * 2 + 1) * 32 + F.lane] = a1; }
        __syncthreads();
        if (F.tid < 64) { const int b = F.tid >> 5, cc = F.tid & 31; float s = 0.f;
#pragma unroll
            for (int w = 0; w < 8; ++w) s += red[(w * 2 + b) * 32 + cc];
            ((float*)(F.ws + WS_MOD))[b * 6144 + j0 + cc] = s + ada_b[j0 + cc]; }
        __syncthreads();
    }
    {
        const float* router_w = AR.in[15]; float* wsm = (float*)(F.ws + WS_WSM_T); float* wr = (float*)(F.ws + WS_WR_T);
        for (int idx = blockIdx.x * NTHR + F.tid; idx < 65536; idx += F.G * NTHR) { const int which = idx >> 15, r = idx & 32767, k = r >> 5, n = r & 31;
            if (which == 0) wsm[n * 1024 + k] = w_in[(size_t)k * INW + 4096 + n]; else wr[n * 1024 + k] = router_w[k * 32 + n]; }
    }
    LAS float* scr = (LAS float*)(F.lds + F.wave * 16384);
    const int gw = blockIdx.x * NWAVES + F.wave, NGW = F.G * NWAVES;
    constexpr int I_IN = 16 * 288, I_SQ = 16 * 32;
    constexpr int NITEMS = I_IN + 3 * I_SQ;
    for (int it = gw; it < NITEMS; it += NGW) {
        int r = it;
        if (r < I_IN) { const int kb = r / 288, nb = r % 288, n0 = 32 * nb; p0_transpose_item(w_in, INW, 64 * kb, n0 + (n0 >= 4096 ? 32 : 0), (bf16*)(F.ws + WS_WIN_T), (size_t)n0, scr, F.lane); continue; } r -= I_IN;
        if (r < I_SQ) { const int kb = r / 32, nb = r % 32; p0_transpose_item(AR.in[10], 1024, 64 * kb, 32 * nb, (bf16*)(F.ws + WS_WUO_T), (size_t)(32 * nb), scr, F.lane); continue; } r -= I_SQ;
        if (r < I_SQ) { const int kb = r / 32, nb = r % 32; p0_transpose_item(AR.in[12], 1024, 64 * kb, 32 * nb, (bf16*)(F.ws + WS_WUO_T), (size_t)(1024 + 32 * nb), scr, F.lane); continue; } r -= I_SQ;
        { const int kb = r / 32, nb = r % 32; p0_transpose_item(AR.in[13], 1024, 64 * kb, 32 * nb, (bf16*)(F.ws + WS_WO_T), (size_t)(32 * nb), scr, F.lane); }
    }
}
struct CvtItem { const float* W; bf16* WT; size_t drow0; int ldw, k0, n0s; };
__device__ __forceinline__ CvtItem moe_item(const Args& AR, unsigned char* ws, int r) {
    constexpr int I_W1 = 32 * 16 * 64; CvtItem c;
    if (r < I_W1) { const int e = r / 1024, q = r % 1024, kb = q / 64, nb = q % 64, n0 = 32 * nb, half = n0 >> 10, j = n0 & 1023;
        c.W = AR.in[17] + (size_t)e * 1024 * 2048; c.ldw = 2048; c.k0 = 64 * kb; c.n0s = n0; c.WT = (bf16*)(ws + WS_W1T); c.drow0 = (size_t)e * 2048 + (size_t)((j >> 7) * 256 + half * 128 + (j & 127)); }
    else { r -= I_W1; const int e = r / 512, q = r % 512, kb = q / 32, nb = q % 32;
        c.W = AR.in[19] + (size_t)e * 1024 * 1024; c.ldw = 1024; c.k0 = 64 * kb; c.n0s = 32 * nb; c.WT = (bf16*)(ws + WS_W2T); c.drow0 = (size_t)e * 1024 + (size_t)(32 * nb); }
    return c;
}
__device__ __forceinline__ void cvt_load(const CvtItem& c, int lane, f4 (&v)[8]) {
    const int kq = lane >> 3, n4 = (lane & 7) * 4;
#pragma unroll
    for (int i = 0; i < 8; ++i) v[i] = *(const f4*)(c.W + (size_t)(c.k0 + 8 * i + kq) * c.ldw + c.n0s + n4);
}
__device__ __forceinline__ void cvt_store(const CvtItem& c, int lane, const f4 (&v)[8], LAS float* scr) {
    const int kq = lane >> 3, n4 = (lane & 7) * 4;
#pragma unroll
    for (int i = 0; i < 8; ++i) { LAS float* d = scr + (8 * i + kq) * 33 + n4; d[0] = v[i].x; d[1] = v[i].y; d[2] = v[i].z; d[3] = v[i].w; }
    asm volatile("s_waitcnt lgkmcnt(0)" ::: "memory");
    const int cc = lane & 7;
#pragma unroll
    for (int j = 0; j < 4; ++j) { const int n = (lane >> 3) + 8 * j; const LAS float* sp = scr + (8 * cc) * 33 + n;
        u4 o; o.x = pk2(sp[0 * 33], sp[1 * 33]); o.y = pk2(sp[2 * 33], sp[3 * 33]); o.z = pk2(sp[4 * 33], sp[5 * 33]); o.w = pk2(sp[6 * 33], sp[7 * 33]);
        *(u4*)(c.WT + (c.drow0 + n) * 1024 + c.k0 + 8 * cc) = o; }
    asm volatile("s_waitcnt lgkmcnt(0)" ::: "memory");
}
__device__ __forceinline__ void moe_convert(Frame& F, const Args& AR) {
    constexpr int NIT = 32 * 16 * 64 + 32 * 16 * 32;
    LAS float* scr = (LAS float*)(F.lds + F.wave * 16384);
    unsigned* ctr = (unsigned*)(F.ws + WS_CTL) + CW_CVT;
    for (;;) {
        unsigned base = 0u;
        if (F.lane == 0) base = __hip_atomic_fetch_add(ctr, 8u, __ATOMIC_RELAXED, __HIP_MEMORY_SCOPE_AGENT);
        base = (unsigned)__builtin_amdgcn_readfirstlane((int)base);
        if (base >= (unsigned)NIT) break;
        f4 va[8], vb[8];
        CvtItem ca = moe_item(AR, F.ws, (int)base), cb = ca;
        cvt_load(ca, F.lane, va);
#pragma unroll 1
        for (int t = 0; t < 8; t += 2) {
            cb = moe_item(AR, F.ws, (int)base + t + 1); cvt_load(cb, F.lane, vb);
            cvt_store(ca, F.lane, va, scr);
            if (t + 2 < 8) { ca = moe_item(AR, F.ws, (int)base + t + 2); cvt_load(ca, F.lane, va); }
            cvt_store(cb, F.lane, vb, scr);
        }
    }
}
__device__ __forceinline__ void stage_wt(LAS float* WtL, const float* WT, int tid) {
    for (int idx = tid; idx < 32 * 256; idx += NTHR) { const int n = idx >> 8, k4 = idx & 255; const f4 v = *(const f4*)(WT + n * 1024 + 4 * k4); *(LAS f4*)(WtL + n * 1028 + 4 * k4) = v; }
}
__device__ __forceinline__ float dot32(const f4 (&v)[4], const LAS float* WtL, int lane) {
    float p[32];
#pragma unroll
    for (int n = 0; n < 32; ++n) { float s = 0.f;
#pragma unroll
        for (int j = 0; j < 4; ++j) { const f4 w = *(const LAS f4*)(WtL + n * 1028 + 256 * j + 4 * lane); s += v[j].x * w.x + v[j].y * w.y + v[j].z * w.z + v[j].w * w.w; }
        p[n] = s; if ((n & 3) == 3) asm volatile("" : "+v"(p[n - 3]), "+v"(p[n - 2]), "+v"(p[n - 1]), "+v"(p[n]) :: "memory"); }
#pragma unroll
    for (int i = 0; i < 16; ++i) { const bool hi = (lane & 32) != 0; const float send = hi ? p[i] : p[i + 16], keep = hi ? p[i + 16] : p[i]; p[i] = keep + __shfl_xor(send, 32); }
#pragma unroll
    for (int i = 0; i < 8; ++i) { const bool hi = (lane & 16) != 0; const float send = hi ? p[i] : p[i + 8], keep = hi ? p[i + 8] : p[i]; p[i] = keep + __shfl_xor(send, 16); }
#pragma unroll
    for (int i = 0; i < 4; ++i) { const bool hi = (lane & 8) != 0; const float send = hi ? p[i] : p[i + 4], keep = hi ? p[i + 4] : p[i]; p[i] = keep + __shfl_xor(send, 8); }
#pragma unroll
    for (int i = 0; i < 2; ++i) { const bool hi = (lane & 4) != 0; const float send = hi ? p[i] : p[i + 2], keep = hi ? p[i + 2] : p[i]; p[i] = keep + __shfl_xor(send, 4); }
    { const bool hi = (lane & 2) != 0; const float send = hi ? p[0] : p[1], keep = hi ? p[1] : p[0]; p[0] = keep + __shfl_xor(send, 2); }
    p[0] += __shfl_xor(p[0], 1);
    return p[0];
}

__device__ __forceinline__ void phase_p1(Frame& F, const Args& AR) {
    const float* x = AR.in[0]; const float* norm1_w = AR.in[4]; const float* mod = (const float*)(F.ws + WS_MOD);
    LAS float* WtL = (LAS float*)F.lds;
    LAS float* A1 = (LAS float*)(F.lds + 131584);
    LAS float* B1 = A1 + 2048;
    stage_wt(WtL, (const float*)(F.ws + WS_WSM_T), F.tid);
    for (int idx = F.tid; idx < 2048; idx += NTHR) { const int b = idx >> 10, k = idx & 1023; A1[idx] = norm1_w[k] * (1.0f + mod[b * 6144 + 1024 + k]); B1[idx] = mod[b * 6144 + k]; }
    __syncthreads();
    bf16* h = (bf16*)(F.ws + WS_H); float* psm = (float*)(F.ws + WS_PSM);
    const int gw = blockIdx.x * NWAVES + F.wave, NGW = F.G * NWAVES;
    for (int m = gw; m < NTOK; m += NGW) {
        const f4* xr = (const f4*)(x + (size_t)m * D) + F.lane; f4 v[4]; float ss = 0.f;
#pragma unroll
        for (int j = 0; j < 4; ++j) { v[j] = xr[64 * j]; ss += (v[j].x * v[j].x + v[j].y * v[j].y) + (v[j].z * v[j].z + v[j].w * v[j].w); }
        const float rstd = 1.0f / sqrtf(wave_sum(ss) * (1.0f / D) + EPS);
        const int b = m >> 13;
#pragma unroll
        for (int j = 0; j < 4; ++j) { const f4 a = *(const LAS f4*)(A1 + b * 1024 + 256 * j + 4 * F.lane), bb = *(const LAS f4*)(B1 + b * 1024 + 256 * j + 4 * F.lane);
            v[j] = v[j] * rstd * a + bb;
            u2 o; o.x = pk2(v[j].x, v[j].y); o.y = pk2(v[j].z, v[j].w); ((u2*)(h + (size_t)m * D))[F.lane + 64 * j] = o; }
        const float tot = dot32(v, WtL, F.lane);
        if (!(F.lane & 1)) psm[(size_t)m * 32 + (F.lane >> 1)] = tot;
    }
}

struct EpiStoreBf16 {
    static constexpr bool PERM = true, AFTER_DRAIN = false;
    bf16* O; int ldc;
    __device__ __forceinline__ void operator()(const pg8::f32x4 (&acc)[2][2][4][2], const pg8::Unit& u, int wr, int wc, int fr, int fq) const {
        const int row0 = u.pm * 256 + wr * 64 + fr, col0 = u.pn * 256 + wc * 32 + 8 * fq;
#pragma unroll
        for (int ai = 0; ai < 2; ++ai)
#pragma unroll
            for (int m = 0; m < 4; ++m) { bf16* rowp = O + (size_t)(row0 + ai * 128 + m * 16) * ldc + col0;
#pragma unroll
                for (int bj = 0; bj < 2; ++bj) { const pg8::f32x4 v0 = acc[ai][bj][m][0], v1 = acc[ai][bj][m][1];
                    u4 w; w.x = cvtpk(v0[0], v0[1]); w.y = cvtpk(v0[2], v0[3]); w.z = cvtpk(v1[0], v1[1]); w.w = cvtpk(v1[2], v1[3]);
                    *(u4*)(rowp + bj * 128) = w; } }
    }
};
struct EpiG23 {
    static constexpr bool PERM = true, AFTER_DRAIN = false;
    const bf16* P; float* M1; bf16* Mo;
    __device__ __forceinline__ void operator()(const pg8::f32x4 (&acc)[2][2][4][2], const pg8::Unit& u, int wr, int wc, int fr, int fq) const {
        const int s = u.pm >= 64 ? 1 : 0, pm = u.pm - 64 * s, pn = u.pn - 4 * s;
        const int row0 = pm * 256 + wr * 64 + fr, col0 = pn * 256 + wc * 32 + 8 * fq, gcol = (s ? PC_GB : PC_GA) + col0;
#pragma unroll
        for (int ai = 0; ai < 2; ++ai)
#pragma unroll
            for (int m = 0; m < 4; ++m) { const int row = row0 + ai * 128 + m * 16;
#pragma unroll
                for (int bj = 0; bj < 2; ++bj) { const int col = col0 + bj * 128;
                    float g[8]; unpack8(*(const u4*)(P + (size_t)row * PW + gcol + bj * 128), g);
                    const pg8::f32x4 v0 = acc[ai][bj][m][0], v1 = acc[ai][bj][m][1];
                    float o[8];
#pragma unroll
                    for (int e = 0; e < 4; ++e) { o[e] = sigm(g[e]) * v0[e]; o[4 + e] = sigm(g[4 + e]) * v1[e]; }
                    float* mp = M1 + (size_t)row * D + col;
                    if (s == 0) { *(f4*)mp = (f4){o[0], o[1], o[2], o[3]}; *(f4*)(mp + 4) = (f4){o[4], o[5], o[6], o[7]}; }
                    else { const f4 p0 = *(const f4*)mp, p1 = *(const f4*)(mp + 4);
                        u4 w; w.x = cvtpk(p0.x + o[0], p0.y + o[1]); w.y = cvtpk(p0.z + o[2], p0.w + o[3]); w.z = cvtpk(p1.x + o[4], p1.y + o[5]); w.w = cvtpk(p1.z + o[6], p1.w + o[7]);
                        *(u4*)(Mo + (size_t)row * D + col) = w; } } }
    }
};
struct OrderG23 {
    pg8::StaticOrder S;
    __device__ __forceinline__ bool next(int i, pg8::Unit& u) const { if (i >= 2) return false; pg8::Unit t; if (!S.next(0, t)) return false; u.pm = t.pm + 64 * i; u.pn = t.pn + 4 * i; return true; }
    __device__ __forceinline__ void a_ready(const pg8::Unit&) const {}
    __device__ __forceinline__ void done(const pg8::Unit&) const {}
};
struct EpiG4 {
    static constexpr bool PERM = false, AFTER_DRAIN = false;
    const float* X; const float* mod; float* X1;
    __device__ __forceinline__ void operator()(const pg8::f32x4 (&acc)[2][2][4][2], const pg8::Unit& u, int wr, int wc, int fr, int fq) const {
        const int row0 = u.pm * 256 + wr * 64 + fr, col0 = u.pn * 256 + wc * 32 + 4 * fq; const int b = u.pm >> 5;
        f4 gt[2][2];
#pragma unroll
        for (int bj = 0; bj < 2; ++bj)
#pragma unroll
            for (int n = 0; n < 2; ++n) gt[bj][n] = *(const f4*)(mod + b * 6144 + 2048 + col0 + bj * 128 + n * 16);
#pragma unroll
        for (int ai = 0; ai < 2; ++ai)
#pragma unroll
            for (int m = 0; m < 4; ++m) { const size_t off = (size_t)(row0 + ai * 128 + m * 16) * D + col0;
#pragma unroll
                for (int bj = 0; bj < 2; ++bj)
#pragma unroll
                    for (int n = 0; n < 2; ++n) { const f4 xv = *(const f4*)(X + off + bj * 128 + n * 16); const pg8::f32x4 a = acc[ai][bj][m][n];
                        *(f4*)(X1 + off + bj * 128 + n * 16) = (f4){xv.x + gt[bj][n].x * a[0], xv.y + gt[bj][n].y * a[1], xv.z + gt[bj][n].z * a[2], xv.w + gt[bj][n].w * a[3]}; } }
    }
};
struct MoeOrder {
    int nM, nN, nwg, G, c; const LAS int* blk_exp; const LAS int* tab; const int* list;
    __device__ __forceinline__ void init(int nblk, int nN_, int G_, int c_, const LAS int* tab_, const int* list_) { nM = nblk; nN = nN_; nwg = nM * nN; G = G_; c = c_; tab = tab_; blk_exp = tab_ + 64; list = list_; }
    __device__ __forceinline__ int row_token(const pg8::Unit& u, int r) const { const int e = u.pn / nN, cn = tab[512 + e]; int idx = 256 * (u.pm - (tab[e] >> 8)) + r; idx = idx < cn ? idx : cn - 1; return list[e * 16384 + idx]; }
    __device__ __forceinline__ bool next(int i, pg8::Unit& u) const {
        const long L = (long)i * G + c; if (L >= nwg) return false;
        int wgid = (int)L; { const int q = nwg / 8, r = nwg % 8, xcd = wgid % 8, off = wgid / 8; wgid = (xcd < r ? xcd * (q + 1) : r * (q + 1) + (xcd - r) * q) + off; }
        const int nig = 8 * nN, gid = wgid / nig, fm = gid * 8, gsz = (nM - fm) < 8 ? (nM - fm) : 8;
        const int pm = fm + ((wgid % nig) % gsz), pnl = (wgid % nig) / gsz;
        u.pm = pm; u.pn = blk_exp[pm] * nN + pnl; return true;
    }
    __device__ __forceinline__ void a_ready(const pg8::Unit&) const {}
    __device__ __forceinline__ void done(const pg8::Unit&) const {}
};
struct EpiMoe1 {
    static constexpr bool PERM = true, AFTER_DRAIN = false;
    const float* b1; bf16* ACT;
    __device__ __forceinline__ void operator()(const pg8::f32x4 (&acc)[2][2][4][2], const pg8::Unit& u, int wr, int wc, int fr, int fq) const {
        const int e = u.pn >> 3, pnl = u.pn & 7; const int row0 = u.pm * 256 + wr * 64 + fr, j0 = pnl * 128 + wc * 32 + 8 * fq;
        const float* bg = b1 + (size_t)e * 2048 + j0; const float* bu = bg + 1024;
        const f4 bg0 = *(const f4*)bg, bg1 = *(const f4*)(bg + 4), bu0 = *(const f4*)bu, bu1 = *(const f4*)(bu + 4);
        const float bgv[8] = {bg0.x, bg0.y, bg0.z, bg0.w, bg1.x, bg1.y, bg1.z, bg1.w}, buv[8] = {bu0.x, bu0.y, bu0.z, bu0.w, bu1.x, bu1.y, bu1.z, bu1.w};
#pragma unroll
        for (int ai = 0; ai < 2; ++ai)
#pragma unroll
            for (int m = 0; m < 4; ++m) { float o[8];
#pragma unroll
                for (int e8 = 0; e8 < 8; ++e8) { const int n = e8 >> 2, q = e8 & 3;
                    float g = acc[ai][0][m][n][q] + bgv[e8], up = acc[ai][1][m][n][q] + buv[e8];
                    g = fminf(g, 7.0f); up = fminf(fmaxf(up, -7.0f), 7.0f);
                    o[e8] = g * sigm(1.702f * g) * (up + 1.0f); }
                u4 w; w.x = cvtpk(o[0], o[1]); w.y = cvtpk(o[2], o[3]); w.z = cvtpk(o[4], o[5]); w.w = cvtpk(o[6], o[7]);
                *(u4*)(ACT + (size_t)(row0 + ai * 128 + m * 16) * D + j0) = w; }
    }
};
struct EpiMoe2 {
    static constexpr bool PERM = true, AFTER_DRAIN = false;
    const float* b2; bf16* YS;
    __device__ __forceinline__ void operator()(const pg8::f32x4 (&acc)[2][2][4][2], const pg8::Unit& u, int wr, int wc, int fr, int fq) const {
        const int e = u.pn >> 2, pnl = u.pn & 3; const int row0 = u.pm * 256 + wr * 64 + fr, col0 = pnl * 256 + wc * 32 + 8 * fq;
        f4 bv[2][2];
#pragma unroll
        for (int bj = 0; bj < 2; ++bj)
#pragma unroll
            for (int n = 0; n < 2; ++n) bv[bj][n] = *(const f4*)(b2 + (size_t)e * D + col0 + bj * 128 + 4 * n);
#pragma unroll
        for (int ai = 0; ai < 2; ++ai)
#pragma unroll
            for (int m = 0; m < 4; ++m) { bf16* rowp = YS + (size_t)(row0 + ai * 128 + m * 16) * D + col0;
#pragma unroll
                for (int bj = 0; bj < 2; ++bj) { const pg8::f32x4 v0 = acc[ai][bj][m][0], v1 = acc[ai][bj][m][1];
                    u4 w; w.x = cvtpk(v0[0] + bv[bj][0].x, v0[1] + bv[bj][0].y); w.y = cvtpk(v0[2] + bv[bj][0].z, v0[3] + bv[bj][0].w);
                    w.z = cvtpk(v1[0] + bv[bj][1].x, v1[1] + bv[bj][1].y); w.w = cvtpk(v1[2] + bv[bj][1].z, v1[3] + bv[bj][1].w);
                    *(u4*)(rowp + bj * 128) = w; } }
    }
};

constexpr int QS = 129;
constexpr int QB = 136;
typedef short bf16x8 __attribute__((ext_vector_type(8)));
__device__ __forceinline__ bf16x8 pack_frag(const pg8::f32x4 a, const pg8::f32x4 b) {
    u4 w; w.x = cvtpk(a[0], a[1]); w.y = cvtpk(a[2], a[3]); w.z = cvtpk(b[0], b[1]); w.w = cvtpk(b[2], b[3]); return __builtin_bit_cast(bf16x8, w);
}
__device__ __forceinline__ void phase_p3(Frame& F, const Args& AR) {
    const bf16* P = (const bf16*)(F.ws + WS_P); const float* psm = (const float*)(F.ws + WS_PSM);
    const float* convw = AR.in[6]; const float* a_log = AR.in[7]; const float* dt_bias = AR.in[8];
    LAS bf16* qb = (LAS bf16*)F.lds;
    LAS bf16* kb = qb + 64 * QB;
    LAS float* vs = (LAS float*)(kb + 64 * QB);
    LAS float* Lm = vs + 64 * QS;
    LAS float* betaL = Lm + 2 * 4096;
    LAS float* GL = betaL + 128;
    LAS float* Tm = GL + 128;
    LAS bf16* wb = (LAS bf16*)(Tm + 2048);
    u4 raw[12]; f4 wjv[10]; float braw = 0.f, araw = 0.f, alog_p = 0.f, dtb_p = 0.f;
#define P3_LOAD(unit_) do { const int b_ = (unit_) >> 10, h_ = ((unit_) >> 7) & 7, c_ = (unit_) & 127, t0_ = c_ * 64; const size_t tb_ = (size_t)b_ * SEQ; const int tid_ = F.tid; \
        if (tid_ < 384) { const int cv_ = tid_ % 48, rg_ = tid_ / 48, pcol_ = (cv_ >> 4) * 1024 + h_ * 128 + (cv_ & 15) * 8; \
            _Pragma("unroll") for (int j_ = 0; j_ < 5; ++j_) { wjv[2 * j_] = *(const f4*)(convw + j_ * 3072 + pcol_); wjv[2 * j_ + 1] = *(const f4*)(convw + j_ * 3072 + pcol_ + 4); } \
            _Pragma("unroll") for (int r_ = 0; r_ < 12; ++r_) { const int t_ = t0_ + 8 * rg_ - 2 + r_; raw[r_] = (t_ >= 0 && t_ < SEQ) ? *(const u4*)(P + (tb_ + t_) * PW + pcol_) : (u4){0u, 0u, 0u, 0u}; } } \
        if (tid_ < 128) { const int dir_ = tid_ >> 6, ii_ = tid_ & 63, io_ = dir_ ? 63 - ii_ : ii_; const size_t tok_ = tb_ + t0_ + io_; braw = psm[tok_ * 32 + dir_ * 8 + h_]; araw = psm[tok_ * 32 + 16 + dir_ * 8 + h_]; alog_p = a_log[dir_ * 8 + h_]; dtb_p = dt_bias[dir_ * 8 + h_]; } } while (0)
    if ((int)blockIdx.x < 2 * NH * NCHUNK) P3_LOAD((int)blockIdx.x);
    for (int unit = blockIdx.x; unit < 2 * NH * NCHUNK; unit += F.G) {
        const int b = unit >> 10, h = (unit >> 7) & 7, c = unit & 127;
        int tid = F.tid; asm volatile("" : "+v"(tid));
        const int lane = tid & 63;
        unsigned char* const ubase = F.ws + WS_DD + ((size_t)((b * 8 + h) * 2) * 128) * DD_UNIT;
        if (tid < 384) {
            const int cv = tid % 48, rg = tid / 48, part = cv >> 4, ch = (cv & 15) * 8;
#pragma unroll
            for (int i = 0; i < 8; ++i) { float acc[8];
#pragma unroll
                for (int e = 0; e < 8; ++e) acc[e] = 0.f;
#pragma unroll
                for (int j = 0; j < 5; ++j) { float xin[8]; unpack8(raw[i + j], xin); const f4 w0 = wjv[2 * j], w1 = wjv[2 * j + 1];
                    acc[0] += w0.x * xin[0]; acc[1] += w0.y * xin[1]; acc[2] += w0.z * xin[2]; acc[3] += w0.w * xin[3]; acc[4] += w1.x * xin[4]; acc[5] += w1.y * xin[5]; acc[6] += w1.z * xin[6]; acc[7] += w1.w * xin[7]; }
                float ssq = 0.f;
#pragma unroll
                for (int e = 0; e < 8; ++e) { acc[e] = silu(acc[e]); ssq += acc[e] * acc[e]; }
                ssq += __shfl_xor(ssq, 1); ssq += __shfl_xor(ssq, 2); ssq += __shfl_xor(ssq, 4); ssq += __shfl_xor(ssq, 8);
                if (part == 2) {
#pragma unroll
                    for (int e = 0; e < 8; ++e) vs[(8 * rg + i) * QS + ch + e] = acc[e];
                } else {
                    float sc = 1.0f / sqrtf(ssq + EPS); if (part == 0) sc *= 0.08838834764831845f;
#pragma unroll
                    for (int e = 0; e < 8; ++e) acc[e] *= sc;
                    *(LAS u4*)((part ? kb : qb) + (8 * rg + i) * QB + ch) = pack8(acc); }
            }
        }
        if (tid < 128) {
            const int dir = tid >> 6, ii = lane;
            float g = -expf(alog_p) * softplus(araw + dtb_p);
#pragma unroll
            for (int o = 1; o < 64; o <<= 1) { const float t = __shfl_up(g, o); if (lane >= o) g += t; }
            betaL[dir * 64 + ii] = sigm(braw); GL[dir * 64 + ii] = g;
        }
        if (unit + F.G < 2 * NH * NCHUNK) P3_LOAD(unit + F.G);
        LDS_BARRIER();
        asm volatile("" : "+v"(tid));
        {
            const int w = tid >> 6, dir = w >> 2, mi = w & 3, r = lane & 15, q = lane >> 4;
            const int ipos = 16 * mi + r, io = dir ? 63 - ipos : ipos;
            const float Gi = GL[dir * 64 + ipos], bi = betaL[dir * 64 + ipos];
            bf16x8 ki[4], qi[4];
#pragma unroll
            for (int s = 0; s < 4; ++s) { ki[s] = *(const LAS bf16x8*)(kb + io * QB + 32 * s + 8 * q); qi[s] = *(const LAS bf16x8*)(qb + io * QB + 32 * s + 8 * q); }
            unsigned char* dbase = ubase + ((size_t)dir * 128 + (dir ? 127 - c : c)) * DD_UNIT;
#pragma unroll
            for (int s2 = 0; s2 < 2; ++s2) { float av[8];
#pragma unroll
                for (int t = 0; t < 2; ++t) { const int mj = 2 * s2 + t;
                    if (mj <= mi) {
                        const int jp = 16 * mj + r, jo = dir ? 63 - jp : jp;
                        pg8::f32x4 kk = {0.f, 0.f, 0.f, 0.f}, qk = {0.f, 0.f, 0.f, 0.f};
#pragma unroll
                        for (int s = 0; s < 4; ++s) { const bf16x8 kj = *(const LAS bf16x8*)(kb + jo * QB + 32 * s + 8 * q);
                            kk = __builtin_amdgcn_mfma_f32_16x16x32_bf16(kj, ki[s], kk, 0, 0, 0); qk = __builtin_amdgcn_mfma_f32_16x16x32_bf16(kj, qi[s], qk, 0, 0, 0); }
                        f4 lv;
#pragma unroll
                        for (int jj = 0; jj < 4; ++jj) { const int jpos = 16 * mj + 4 * q + jj; const float dec = __expf(Gi - GL[dir * 64 + jpos]);
                            const float l = (ipos > jpos) ? bi * kk[jj] * dec : 0.f; av[4 * t + jj] = (ipos >= jpos) ? qk[jj] * dec : 0.f;
                            if (jj == 0) lv.x = l; else if (jj == 1) lv.y = l; else if (jj == 2) lv.z = l; else lv.w = l; }
                        *(LAS f4*)(Lm + dir * 4096 + ipos * 64 + 16 * mj + 4 * q) = lv;
                    } else {
#pragma unroll
                        for (int jj = 0; jj < 4; ++jj) av[4 * t + jj] = 0.f;
                    } }
                *(u4*)(dbase + DD_A + (size_t)((mi * 2 + s2) * 64 + lane) * 16) = pack8(av); }
        }
        LDS_BARRIER();
        asm volatile("" : "+v"(tid));
        if (tid < 128) {
            const int dir = tid >> 6, blk = (tid >> 4) & 3, cc = tid & 15;
            const LAS float* Lb = Lm + dir * 4096 + (16 * blk) * 64 + 16 * blk;
            float t[16];
#pragma unroll
            for (int i = 0; i < 16; ++i) { float sv = (i == cc) ? 1.0f : 0.0f;
#pragma unroll
                for (int j = 0; j < i; ++j) sv -= Lb[i * 64 + j] * t[j];
                t[i] = sv; Tm[(dir * 4 + blk) * 256 + i * 16 + cc] = sv; }
        }
        LDS_BARRIER();
        asm volatile("" : "+v"(tid));
        {
            const int w = tid >> 6, dir = w >> 2, g4 = w & 3, n = lane & 15, q = lane >> 4; const bool isw = g4 >= 2;
            const LAS float* Lr = Lm + dir * 4096; const LAS float* Tr = Tm + dir * 1024;
            const f4 z4 = {0.f, 0.f, 0.f, 0.f};
            bf16x8 fT[4], fL10, fL2, fL3a, fL3b;
#pragma unroll
            for (int i = 0; i < 4; ++i) fT[i] = pack_frag(*(const LAS f4*)(Tr + i * 256 + n * 16 + 4 * q), z4);
            fL10 = pack_frag(-*(const LAS f4*)(Lr + (16 + n) * 64 + 4 * q), z4);
            fL2 = pack_frag(-*(const LAS f4*)(Lr + (32 + n) * 64 + 4 * q), -*(const LAS f4*)(Lr + (32 + n) * 64 + 16 + 4 * q));
            fL3a = pack_frag(-*(const LAS f4*)(Lr + (48 + n) * 64 + 4 * q), -*(const LAS f4*)(Lr + (48 + n) * 64 + 16 + 4 * q));
            fL3b = pack_frag(-*(const LAS f4*)(Lr + (48 + n) * 64 + 32 + 4 * q), z4);
            float bE[4][4];
#pragma unroll
            for (int i = 0; i < 4; ++i)
#pragma unroll
                for (int jj = 0; jj < 4; ++jj) { const int row = 16 * i + 4 * q + jj; bE[i][jj] = betaL[dir * 64 + row] * (isw ? __expf(GL[dir * 64 + row]) : 1.0f); }
            unsigned char* dbase = ubase + ((size_t)dir * 128 + (dir ? 127 - c : c)) * DD_UNIT;
#pragma unroll
            for (int e = 0; e < 4; ++e) { const int nt = 4 * g4 + e;
                pg8::f32x4 R[4];
#pragma unroll
                for (int i = 0; i < 4; ++i)
#pragma unroll
                    for (int jj = 0; jj < 4; ++jj) { const int row = 16 * i + 4 * q + jj, io = dir ? 63 - row : row;
                        R[i][jj] = bE[i][jj] * (isw ? bf1(kb[io * QB + 16 * (nt - 8) + n]) : vs[io * QS + 16 * nt + n]); }
                const pg8::f32x4 x0 = __builtin_amdgcn_mfma_f32_16x16x32_bf16(fT[0], pack_frag(R[0], z4), z4, 0, 0, 0);
                const pg8::f32x4 y1 = __builtin_amdgcn_mfma_f32_16x16x32_bf16(fL10, pack_frag(x0, z4), R[1], 0, 0, 0);
                const pg8::f32x4 x1 = __builtin_amdgcn_mfma_f32_16x16x32_bf16(fT[1], pack_frag(y1, z4), z4, 0, 0, 0);
                const bf16x8 x01 = pack_frag(x0, x1);
                const pg8::f32x4 y2 = __builtin_amdgcn_mfma_f32_16x16x32_bf16(fL2, x01, R[2], 0, 0, 0);
                const pg8::f32x4 x2 = __builtin_amdgcn_mfma_f32_16x16x32_bf16(fT[2], pack_frag(y2, z4), z4, 0, 0, 0);
                pg8::f32x4 y3 = __builtin_amdgcn_mfma_f32_16x16x32_bf16(fL3a, x01, R[3], 0, 0, 0);
                y3 = __builtin_amdgcn_mfma_f32_16x16x32_bf16(fL3b, pack_frag(x2, z4), y3, 0, 0, 0);
                const pg8::f32x4 x3 = __builtin_amdgcn_mfma_f32_16x16x32_bf16(fT[3], pack_frag(y3, z4), z4, 0, 0, 0);
                const pg8::f32x4 X[4] = {x0, x1, x2, x3};
                if (!isw) {
#pragma unroll
                    for (int i = 0; i < 4; ++i) { u2 o; o.x = cvtpk(X[i][0], X[i][1]); o.y = cvtpk(X[i][2], X[i][3]); *(u2*)(dbase + DD_U + (size_t)((nt * 4 + i) * 64 + lane) * 8) = o; }
                } else { LAS bf16* wp = wb + dir * 64 * QB + 16 * (nt - 8) + n;
#pragma unroll
                    for (int i = 0; i < 4; ++i)
#pragma unroll
                        for (int jj = 0; jj < 4; ++jj) wp[(16 * i + 4 * q + jj) * QB] = (bf16)f2bf(X[i][jj]); }
            }
        }
        LDS_BARRIER();
        asm volatile("" : "+v"(tid));
#pragma unroll
        for (int it = 0; it < 4; ++it) { const int item = it * NTHR + tid, dir = item >> 10, fidx = (item >> 6) & 15, fl = item & 63, r = fl & 15, q = fl >> 4;
            const int mt = fidx >> 2, s = fidx & 3, pos = 16 * mt + r; const LAS bf16* wr = wb + (dir * 64 + pos) * QB + 32 * s + 4 * q;
            const u2 lo = *(const LAS u2*)wr, hi = *(const LAS u2*)(wr + 16);
            *(u4*)(ubase + ((size_t)dir * 128 + (dir ? 127 - c : c)) * DD_UNIT + DD_W + (size_t)(fidx * 64 + fl) * 16) = (u4){lo.x, lo.y, hi.x, hi.y}; }
#pragma unroll
        for (int it = 0; it < 8; ++it) { const int item = it * NTHR + tid, dir = item >> 11, arr = (item >> 10) & 1, fidx = (item >> 6) & 15, fl = item & 63, r = fl & 15, q = fl >> 4;
            unsigned char* dbase = ubase + ((size_t)dir * 128 + (dir ? 127 - c : c)) * DD_UNIT;
            float o[8];
            if (arr == 0) { const int mt = fidx >> 2, s = fidx & 3, pos = 16 * mt + r, io = dir ? 63 - pos : pos; const float f = __expf(GL[dir * 64 + pos]);
                const u2 lo = *(const LAS u2*)(qb + io * QB + 32 * s + 4 * q), hi = *(const LAS u2*)(qb + io * QB + 32 * s + 16 + 4 * q);
                o[0] = bflo(lo.x) * f; o[1] = bfhi(lo.x) * f; o[2] = bflo(lo.y) * f; o[3] = bfhi(lo.y) * f; o[4] = bflo(hi.x) * f; o[5] = bfhi(hi.x) * f; o[6] = bflo(hi.y) * f; o[7] = bfhi(hi.y) * f;
                *(u4*)(dbase + DD_Q + (size_t)(fidx * 64 + fl) * 16) = pack8(o);
            } else { const int m = fidx >> 1, s2 = fidx & 1, dk = 16 * m + r; const float gl = GL[dir * 64 + 63];
#pragma unroll
                for (int j = 0; j < 8; ++j) { const int pos = 32 * s2 + (j < 4 ? 4 * q + j : 16 + 4 * q + j - 4), io = dir ? 63 - pos : pos; o[j] = bf1(kb[io * QB + dk]) * __expf(gl - GL[dir * 64 + pos]); }
                *(u4*)(dbase + DD_K + (size_t)(fidx * 64 + fl) * 16) = pack8(o); } }
        if (tid < 2) ((float*)(F.ws + WS_GL))[((b * 8 + h) * 2 + tid) * 128 + (tid ? 127 - c : c)] = __expf(GL[tid * 64 + 63]);
        LDS_BARRIER();
    }
#undef P3_LOAD
}

constexpr int P4_BUF = 61440;
__device__ __forceinline__ void phase_p4(Frame& F, const Args& AR) {
    volatile LAS int* uq = (volatile LAS int*)(F.lds + LDS_TAB + 4096);
    unsigned* qctr = (unsigned*)(F.ws + WS_CTL) + CW_Q;
    const unsigned myx = xb_xcc_id() & 7u;
    for (;;) {
        __syncthreads();
        if (F.tid == 0) { int got = -1;
            for (unsigned t = 0; t < 8 && got < 0; ++t) { const unsigned x = (myx + t) & 7u; const unsigned sl = __hip_atomic_fetch_add(qctr + 64 * x, 1u, __ATOMIC_RELAXED, __HIP_MEMORY_SCOPE_AGENT); if (sl < 16u) got = (int)(x * 16u + sl); }
            uq[0] = got; }
        __syncthreads();
        const int unit = uq[0];
        if (unit < 0) break;
        const int chain = unit >> 2, pair = unit & 3, dir = chain & 1, bh = chain >> 1, b = bh >> 3, h = bh & 7;
        const unsigned char* cbase = F.ws + WS_DD + (size_t)chain * 128 * DD_UNIT;
        __syncthreads();
        if (F.wave >= 2) {
            const int l = F.tid - 128; u4 ra[10], rb[10], rc[10];
#define P4_SRC(step, i) ((const u4*)(cbase + (size_t)(step) * DD_UNIT + (((i) * 384 + l) < 3584 ? (size_t)((i) * 384 + l) * 16 : (size_t)DD_U + (size_t)pair * 4096 + (size_t)((i) * 384 + l - 3584) * 16)))
#define P4_LD(R, step) do { const int st_ = (step) < NCHUNK ? (step) : NCHUNK - 1; _Pragma("unroll") for (int i = 0; i < 10; ++i) R[i] = *P4_SRC(st_, i); } while (0)
#define P4_ST(R, step) do { _Pragma("unroll") for (int i = 0; i < 10; ++i) *(LAS u4*)(F.lds + ((step) & 1) * P4_BUF + (size_t)(i * 384 + l) * 16) = R[i]; } while (0)
            P4_LD(ra, 0); P4_ST(ra, 0);
            P4_LD(ra, 1); P4_LD(rb, 2); P4_LD(rc, 3);
            asm volatile("s_waitcnt lgkmcnt(0)" ::: "memory"); __builtin_amdgcn_s_barrier(); asm volatile("" ::: "memory");
            for (int k = 0; k < 129; k += 3) {
                P4_ST(ra, k + 1); P4_LD(ra, k + 4);
                asm volatile("s_waitcnt lgkmcnt(0)" ::: "memory"); __builtin_amdgcn_s_barrier(); asm volatile("" ::: "memory");
                P4_ST(rb, k + 2); P4_LD(rb, k + 5);
                asm volatile("s_waitcnt lgkmcnt(0)" ::: "memory"); __builtin_amdgcn_s_barrier(); asm volatile("" ::: "memory");
                P4_ST(rc, k + 3); P4_LD(rc, k + 6);
                asm volatile("s_waitcnt lgkmcnt(0)" ::: "memory"); __builtin_amdgcn_s_barrier(); asm volatile("" ::: "memory");
            }
#undef P4_SRC
#undef P4_LD
#undef P4_ST
        } else {
            const int lane = F.lane, r = lane & 15, q = lane >> 4, sl = 2 * pair + F.wave;
            const float* glp = (const float*)(F.ws + WS_GL) + chain * 128;
            bf16* od = (bf16*)(F.ws + WS_OD) + (size_t)dir * NTOK * D + (size_t)b * SEQ * D + h * 128 + 16 * sl + 4 * q;
            pg8::f32x4 S[8]; bf16x8 SB[4];
#pragma unroll
            for (int m = 0; m < 8; ++m) S[m] = (pg8::f32x4){0.f, 0.f, 0.f, 0.f};
#pragma unroll
            for (int s = 0; s < 4; ++s) SB[s] = (bf16x8){0, 0, 0, 0, 0, 0, 0, 0};
            const float glv0 = glp[lane], glv1 = glp[64 + lane];
            asm volatile("s_waitcnt lgkmcnt(0)" ::: "memory"); __builtin_amdgcn_s_barrier(); asm volatile("" ::: "memory");
            for (int k = 0; k < NCHUNK; ++k) {
                const LAS unsigned char* bp = F.lds + (k & 1) * P4_BUF + lane * 16;
                const float egl = __builtin_bit_cast(float, __builtin_amdgcn_readlane(__builtin_bit_cast(int, k < 64 ? glv0 : glv1), k & 63));
                pg8::f32x4 WS[4], OT[4];
#pragma unroll
                for (int mt = 0; mt < 4; ++mt) { WS[mt] = (pg8::f32x4){0.f, 0.f, 0.f, 0.f}; OT[mt] = (pg8::f32x4){0.f, 0.f, 0.f, 0.f}; }
#pragma unroll
                for (int mt = 0; mt < 4; ++mt)
#pragma unroll
                    for (int s = 0; s < 4; ++s) WS[mt] = __builtin_amdgcn_mfma_f32_16x16x32_bf16(*(const LAS bf16x8*)(bp + (mt * 4 + s) * 1024), SB[s], WS[mt], 0, 0, 0);
#pragma unroll
                for (int mt = 0; mt < 4; ++mt)
#pragma unroll
                    for (int s = 0; s < 4; ++s) OT[mt] = __builtin_amdgcn_mfma_f32_16x16x32_bf16(SB[s], *(const LAS bf16x8*)(bp + 16384 + (mt * 4 + s) * 1024), OT[mt], 0, 0, 0);
                pg8::f32x4 vn[4];
#pragma unroll
                for (int mt = 0; mt < 4; ++mt) { const u2 uu = *(const LAS u2*)(F.lds + (k & 1) * P4_BUF + 57344 + (F.wave * 4 + mt) * 512 + lane * 8);
                    vn[mt] = (pg8::f32x4){bflo(uu.x) - WS[mt][0], bfhi(uu.x) - WS[mt][1], bflo(uu.y) - WS[mt][2], bfhi(uu.y) - WS[mt][3]}; }
                bf16x8 VB[2]; VB[0] = pack_frag(vn[0], vn[1]); VB[1] = pack_frag(vn[2], vn[3]);
#pragma unroll
                for (int mt = 0; mt < 4; ++mt)
#pragma unroll
                    for (int s2 = 0; s2 < 2; ++s2) OT[mt] = __builtin_amdgcn_mfma_f32_16x16x32_bf16(VB[s2], *(const LAS bf16x8*)(bp + 49152 + (mt * 2 + s2) * 1024), OT[mt], 0, 0, 0);
#pragma unroll
                for (int m = 0; m < 8; ++m) { S[m] = S[m] * egl;
#pragma unroll
                    for (int s2 = 0; s2 < 2; ++s2) S[m] = __builtin_amdgcn_mfma_f32_16x16x32_bf16(*(const LAS bf16x8*)(bp + 32768 + (m * 2 + s2) * 1024), VB[s2], S[m], 0, 0, 0); }
#pragma unroll
                for (int s = 0; s < 4; ++s) SB[s] = pack_frag(S[2 * s], S[2 * s + 1]);
                const int co = dir ? 127 - k : k;
#pragma unroll
                for (int mt = 0; mt < 4; ++mt) { const int pos = 16 * mt + r, ro = dir ? 63 - pos : pos;
                    u2 ov; ov.x = cvtpk(OT[mt][0], OT[mt][1]); ov.y = cvtpk(OT[mt][2], OT[mt][3]);
                    *(u2*)(od + (size_t)(co * 64 + ro) * D) = ov; }
                asm volatile("s_waitcnt lgkmcnt(0)" ::: "memory"); __builtin_amdgcn_s_barrier(); asm volatile("" ::: "memory");
            }
            __builtin_amdgcn_s_barrier();
        }
        __syncthreads();
    }
    moe_convert(F, AR);
}

__device__ __forceinline__ void phase_p5(Frame& F, const Args& AR) {
    const bf16* P = (const bf16*)(F.ws + WS_P); const bf16* od = (const bf16*)(F.ws + WS_OD); bf16* oasb = (bf16*)(F.ws + WS_OASB);
    const float* onorm_w = AR.in[9]; const float* convs = AR.in[11];
    const int lane = F.lane, ch = 16 * lane;
    float onw[16], cw[3][16];
#pragma unroll
    for (int e = 0; e < 16; ++e) { onw[e] = onorm_w[(ch + e) & 127];
#pragma unroll
        for (int j = 0; j < 3; ++j) cw[j][e] = convs[j * 1024 + ch + e]; }
    const int gw = blockIdx.x * NWAVES + F.wave, NGW = F.G * NWAVES;
    for (int m = gw; m < NTOK; m += NGW) {
        const int t = m & (SEQ - 1);
        float o[16], z[16], t8[8];
        unpack8(*(const u4*)(od + (size_t)m * D + ch), t8);
#pragma unroll
        for (int e = 0; e < 8; ++e) o[e] = t8[e];
        unpack8(*(const u4*)(od + (size_t)m * D + ch + 8), t8);
#pragma unroll
        for (int e = 0; e < 8; ++e) o[8 + e] = t8[e];
        unpack8(*(const u4*)(od + (size_t)(NTOK + m) * D + ch), t8);
#pragma unroll
        for (int e = 0; e < 8; ++e) o[e] += t8[e];
        unpack8(*(const u4*)(od + (size_t)(NTOK + m) * D + ch + 8), t8);
#pragma unroll
        for (int e = 0; e < 8; ++e) o[8 + e] += t8[e];
        unpack8(*(const u4*)(P + (size_t)m * PW + PC_Z + ch), t8);
#pragma unroll
        for (int e = 0; e < 8; ++e) z[e] = t8[e];
        unpack8(*(const u4*)(P + (size_t)m * PW + PC_Z + ch + 8), t8);
#pragma unroll
        for (int e = 0; e < 8; ++e) z[8 + e] = t8[e];
        float ss = 0.f;
#pragma unroll
        for (int e = 0; e < 16; ++e) ss += o[e] * o[e];
        ss += __shfl_xor(ss, 1); ss += __shfl_xor(ss, 2); ss += __shfl_xor(ss, 4);
        const float rstd = 1.0f / sqrtf(ss * (1.0f / 128.0f) + EPS);
        float r[8];
#pragma unroll
        for (int e = 0; e < 8; ++e) r[e] = o[e] * rstd * onw[e] * silu(z[e]);
        *(u4*)(oasb + (size_t)m * D + ch) = pack8(r);
#pragma unroll
        for (int e = 0; e < 8; ++e) r[e] = o[8 + e] * rstd * onw[8 + e] * silu(z[8 + e]);
        *(u4*)(oasb + (size_t)m * D + ch + 8) = pack8(r);
        float acc[16];
#pragma unroll
        for (int e = 0; e < 16; ++e) acc[e] = 0.f;
#pragma unroll
        for (int j = 0; j < 3; ++j) { const int tt = t + j - 1;
            if (tt >= 0 && tt < SEQ) { const bf16* rowp = P + (size_t)(m + j - 1) * PW; float cg[8], ui[8];
                unpack8(*(const u4*)(rowp + PC_CG + ch), cg); unpack8(*(const u4*)(rowp + PC_UI + ch), ui);
#pragma unroll
                for (int e = 0; e < 8; ++e) acc[e] += cw[j][e] * (cg[e] * ui[e]);
                unpack8(*(const u4*)(rowp + PC_CG + ch + 8), cg); unpack8(*(const u4*)(rowp + PC_UI + ch + 8), ui);
#pragma unroll
                for (int e = 0; e < 8; ++e) acc[8 + e] += cw[j][8 + e] * (cg[e] * ui[e]); } }
        float bg[8];
        unpack8(*(const u4*)(P + (size_t)m * PW + PC_BG + ch), bg);
#pragma unroll
        for (int e = 0; e < 8; ++e) r[e] = bg[e] * acc[e];
        *(u4*)(oasb + (size_t)(NTOK + m) * D + ch) = pack8(r);
        unpack8(*(const u4*)(P + (size_t)m * PW + PC_BG + ch + 8), bg);
#pragma unroll
        for (int e = 0; e < 8; ++e) r[e] = bg[e] * acc[8 + e];
        *(u4*)(oasb + (size_t)(NTOK + m) * D + ch + 8) = pack8(r);
    }
}

constexpr int P7_MAXIT = 16;
__device__ __forceinline__ void phase_p7(Frame& F, const Args& AR) {
    const float* x1 = (const float*)(F.ws + WS_OD); const float* norm2_w = AR.in[14]; const float* router_b = AR.in[16]; const float* mod = (const float*)(F.ws + WS_MOD);
    LAS float* WtL = (LAS float*)F.lds;
    LAS float* A1 = (LAS float*)(F.lds + 131584);
    LAS float* B1 = A1 + 2048;
    stage_wt(WtL, (const float*)(F.ws + WS_WR_T), F.tid);
    for (int idx = F.tid; idx < 2048; idx += NTHR) { const int b = idx >> 10, k = idx & 1023; A1[idx] = norm2_w[k] * (1.0f + mod[b * 6144 + 4096 + k]); B1[idx] = mod[b * 6144 + 3072 + k]; }
    LAS unsigned* lcnt = (LAS unsigned*)(B1 + 2048);
    LAS unsigned* rec = lcnt + 64;
    if (F.tid < 64) lcnt[F.tid] = 0u;
    __syncthreads();
    bf16* h2 = (bf16*)(F.ws + WS_H); int* topi = (int*)(F.ws + WS_TOPI); float* topg = (float*)(F.ws + WS_TOPG); int* topp = (int*)(F.ws + WS_TOPP);
    unsigned* cnt = (unsigned*)(F.ws + WS_CTL) + CW_CNT; int* elist = (int*)(F.ws + WS_LIST);
    const int lane = F.lane; const float rb = router_b[lane >> 1];
    const int gw = blockIdx.x * NWAVES + F.wave, NGW = F.G * NWAVES;
    int it = 0;
    for (int m = gw; m < NTOK; m += NGW, ++it) {
        const f4* xr = (const f4*)(x1 + (size_t)m * D) + lane; f4 v[4]; float ss = 0.f;
#pragma unroll
        for (int j = 0; j < 4; ++j) { v[j] = xr[64 * j]; ss += (v[j].x * v[j].x + v[j].y * v[j].y) + (v[j].z * v[j].z + v[j].w * v[j].w); }
        const float rstd = 1.0f / sqrtf(wave_sum(ss) * (1.0f / D) + EPS);
        const int b = m >> 13;
#pragma unroll
        for (int j = 0; j < 4; ++j) { const f4 a = *(const LAS f4*)(A1 + b * 1024 + 256 * j + 4 * lane), bb = *(const LAS f4*)(B1 + b * 1024 + 256 * j + 4 * lane);
            v[j] = v[j] * rstd * a + bb;
            u2 o; o.x = pk2(v[j].x, v[j].y); o.y = pk2(v[j].z, v[j].w); ((u2*)(h2 + (size_t)m * D))[lane + 64 * j] = o; }
        float val = dot32(v, WtL, lane) + rb; const int myn = lane >> 1;
        float tv[4]; int ti[4];
#pragma unroll
        for (int r = 0; r < 4; ++r) { float bv = val; int bi = myn;
#pragma unroll
            for (int o = 1; o < 64; o <<= 1) { const float ov = __shfl_xor(bv, o); const int oi = __shfl_xor(bi, o); if (ov > bv || (ov == bv && oi < bi)) { bv = ov; bi = oi; } }
            tv[r] = bv; ti[r] = bi; if (myn == bi) val = -__builtin_inff(); }
        const float e1 = __expf(tv[1] - tv[0]), e2 = __expf(tv[2] - tv[0]), e3 = __expf(tv[3] - tv[0]), inv = 1.0f / (1.0f + e1 + e2 + e3);
        if (lane < 4) { const int e = lane == 0 ? ti[0] : (lane == 1 ? ti[1] : (lane == 2 ? ti[2] : ti[3]));
            const float g = (lane == 0 ? 1.0f : (lane == 1 ? e1 : (lane == 2 ? e2 : e3))) * inv;
            topi[(size_t)m * 4 + lane] = e; topg[(size_t)m * 4 + lane] = g;
            if (it < P7_MAXIT) { const unsigned lp = __hip_atomic_fetch_add(lcnt + e, 1u, __ATOMIC_RELAXED, __HIP_MEMORY_SCOPE_WORKGROUP); rec[(F.wave * P7_MAXIT + it) * 4 + lane] = (unsigned)e | (lp << 8); }
            else { const unsigned pos = __hip_atomic_fetch_add(cnt + 64 * e, 1u, __ATOMIC_RELAXED, __HIP_MEMORY_SCOPE_AGENT); topp[(size_t)m * 4 + lane] = (int)pos; elist[e * 16384 + pos] = m; } }
    }
    __syncthreads();
    if (F.tid < 32) lcnt[32 + F.tid] = __hip_atomic_fetch_add(cnt + 64 * F.tid, lcnt[F.tid], __ATOMIC_RELAXED, __HIP_MEMORY_SCOPE_AGENT);
    __syncthreads();
    { int it = 0;
        for (int m = gw; m < NTOK && it < P7_MAXIT; m += NGW, ++it)
            if (lane < 4) { const unsigned rc = rec[(F.wave * P7_MAXIT + it) * 4 + lane]; const unsigned e = rc & 255u, pos = lcnt[32 + e] + (rc >> 8); topp[(size_t)m * 4 + lane] = (int)pos; elist[e * 16384 + pos] = m; } }
}

__device__ __forceinline__ int build_moe_tables(Frame& F, LAS int* tab  ) {
    const unsigned* cnt = (const unsigned*)(F.ws + WS_CTL) + CW_CNT;
    if (F.tid == 0) { int start = 0;
        for (int e = 0; e < NEXP; ++e) { const int n = (int)__hip_atomic_load(cnt + 64 * e, __ATOMIC_RELAXED, __HIP_MEMORY_SCOPE_AGENT); const int nb = (n + 255) >> 8; tab[e] = start * 256; tab[512 + e] = n;
            for (int k = 0; k < nb; ++k) tab[64 + start + k] = e; start += nb; }
        tab[32] = start; }
    __syncthreads();
    return tab[32];
}

__device__ __forceinline__ void phase_p9(Frame& F, const Args& AR, float* out) {
    const float* x1 = (const float*)(F.ws + WS_OD); const bf16* ys = (const bf16*)(F.ws + WS_YS); const float* mod = (const float*)(F.ws + WS_MOD); const float* fnw = AR.in[21];
    const float* topg = (const float*)(F.ws + WS_TOPG); const int* topp = (const int*)(F.ws + WS_TOPP); const int* topi = (const int*)(F.ws + WS_TOPI);
    LAS int* tab = (LAS int*)(F.lds + LDS_TAB); build_moe_tables(F, tab);
    const int lane = F.lane;
    const int gw = blockIdx.x * NWAVES + F.wave, NGW = F.G * NWAVES;
    for (int m = gw; m < NTOK; m += NGW) {
        const int b = m >> 13;
        const f4 gk = *(const f4*)(topg + (size_t)m * 4); const int r0 = tab[topi[(size_t)m * 4]] + topp[(size_t)m * 4], r1 = tab[topi[(size_t)m * 4 + 1]] + topp[(size_t)m * 4 + 1], r2 = tab[topi[(size_t)m * 4 + 2]] + topp[(size_t)m * 4 + 2], r3 = tab[topi[(size_t)m * 4 + 3]] + topp[(size_t)m * 4 + 3];
        f4 v[4]; float ss = 0.f;
#pragma unroll
        for (int j = 0; j < 4; ++j) {
            const u2 y0 = ((const u2*)(ys + (size_t)r0 * D))[lane + 64 * j], y1 = ((const u2*)(ys + (size_t)r1 * D))[lane + 64 * j], y2 = ((const u2*)(ys + (size_t)r2 * D))[lane + 64 * j], y3 = ((const u2*)(ys + (size_t)r3 * D))[lane + 64 * j];
            f4 mo;
            mo.x = gk.x * bflo(y0.x) + gk.y * bflo(y1.x) + gk.z * bflo(y2.x) + gk.w * bflo(y3.x);
            mo.y = gk.x * bfhi(y0.x) + gk.y * bfhi(y1.x) + gk.z * bfhi(y2.x) + gk.w * bfhi(y3.x);
            mo.z = gk.x * bflo(y0.y) + gk.y * bflo(y1.y) + gk.z * bflo(y2.y) + gk.w * bflo(y3.y);
            mo.w = gk.x * bfhi(y0.y) + gk.y * bfhi(y1.y) + gk.z * bfhi(y2.y) + gk.w * bfhi(y3.y);
            const f4 xv = ((const f4*)(x1 + (size_t)m * D))[lane + 64 * j], gt = ((const f4*)(mod + b * 6144 + 5120))[lane + 64 * j];
            v[j] = xv + gt * mo; ss += (v[j].x * v[j].x + v[j].y * v[j].y) + (v[j].z * v[j].z + v[j].w * v[j].w); }
        const float rstd = 1.0f / sqrtf(wave_sum(ss) * (1.0f / D) + EPS);
#pragma unroll
        for (int j = 0; j < 4; ++j) { const f4 w = ((const f4*)fnw)[lane + 64 * j]; ((f4*)(out + (size_t)m * D))[lane + 64 * j] = v[j] * rstd * w; }
    }
}

__global__ void __launch_bounds__(NTHR, 2) fwd_kernel(Args args) {
    const Args& AR = args;
    extern __shared__ __attribute__((aligned(16))) unsigned char lds_raw[];
    Frame F;
    F.lds = (LAS unsigned char*)lds_raw;
    F.tid = threadIdx.x; F.lane = F.tid & 63; F.wave = __builtin_amdgcn_readfirstlane(F.tid >> 6); F.G = gridDim.x;
    F.ws = args.ws;
    volatile LAS unsigned* misc = (volatile LAS unsigned*)(F.lds + LDS_MISC);
    if (F.tid < 4) misc[F.tid] = 0u;
    __syncthreads();
    XcdBarrier bar; bar.bar = (unsigned*)(F.ws + WS_CTL) + CW_BAR; bar.x = 0; bar.st = nullptr;
    if (MK_N_LAUNCHES == 1) bar = xcd_barrier_post((unsigned*)(F.ws + WS_CTL) + CW_BAR, misc);
    const int lo = args.ph_lo, hi = args.ph_hi;
#ifndef PH_MASK
#define PH_MASK 0x1fff
#endif
#define IN(k) (((PH_MASK >> (k)) & 1) && lo <= (k) && (k) < hi)
#ifndef PROBE_PH
#define PROBE_PH -1
#define PROBE_REP 1
#endif
#define REPS(k) for (int rep_ = 0; rep_ < ((k) == PROBE_PH ? PROBE_REP : 1); ++rep_)
#define SEAM(k) do { if (IN(k) && IN((k) + 1)) xcd_barrier(bar); } while (0)
    PG8_LAS unsigned char* glds = (PG8_LAS unsigned char*)lds_raw;

    if (IN(0)) REPS(0) { phase_p0(F, AR); } SEAM(0);
    if (IN(1)) REPS(1) { phase_p1(F, AR); } SEAM(1);
    if (IN(2)) REPS(2) {
        pg8::Gemm g{(const bf16*)(F.ws + WS_H), (const bf16*)(F.ws + WS_WIN_T), NTOK, PW, D}; pg8::StaticOrder S; S.init(NTOK, PW, F.G, (int)blockIdx.x);
        EpiStoreBf16 E{(bf16*)(F.ws + WS_P), PW};
        pg8::gemm_phase<EpiStoreBf16, pg8::StaticOrder, true, true>(glds, g, S, E);
    } SEAM(2);
    if (IN(3)) REPS(3) { phase_p3(F, AR); } SEAM(3);
    if (IN(4)) REPS(4) { phase_p4(F, AR); } SEAM(4);
    if (IN(5)) REPS(5) { phase_p5(F, AR); } SEAM(5);
    if (IN(6)) REPS(6) {
        pg8::Gemm g{(const bf16*)(F.ws + WS_OASB), (const bf16*)(F.ws + WS_WUO_T), 2 * NTOK, 2048, D}; OrderG23 S; S.S.init(NTOK, D, F.G, (int)blockIdx.x);
        EpiG23 E{(const bf16*)(F.ws + WS_P), (float*)(F.ws + WS_M1), (bf16*)(F.ws + WS_M)};
        pg8::gemm_phase<EpiG23, OrderG23, true, true>(glds, g, S, E);
    } SEAM(6);
    if (IN(7)) REPS(7) {
        pg8::Gemm g{(const bf16*)(F.ws + WS_M), (const bf16*)(F.ws + WS_WO_T), NTOK, D, D}; pg8::StaticOrder S; S.init(NTOK, D, F.G, (int)blockIdx.x);
        EpiG4 E{AR.in[0], (const float*)(F.ws + WS_MOD), (float*)(F.ws + WS_OD)};
        pg8::gemm_phase<EpiG4, pg8::StaticOrder, true, true>(glds, g, S, E);
    } SEAM(7);
    if (IN(8)) REPS(8) { phase_p7(F, AR); } SEAM(8);
    if (IN(9)) REPS(9) {
        __syncthreads();
        LAS int* tab = (LAS int*)(F.lds + LDS_TAB); const int nblk = build_moe_tables(F, tab);
        pg8::Gemm g{(const bf16*)(F.ws + WS_H), (const bf16*)(F.ws + WS_W1T), NTOK, NEXP * 2048, D}; MoeOrder S; S.init(nblk, 8, F.G, (int)blockIdx.x, tab, (const int*)(F.ws + WS_LIST));
        EpiMoe1 E{AR.in[18], (bf16*)(F.ws + WS_ACT)};
        pg8::gemm_phase<EpiMoe1, MoeOrder, true, true, true>(glds, g, S, E);
    } SEAM(9);
    if (IN(10)) REPS(10) {
        __syncthreads();
        LAS int* tab = (LAS int*)(F.lds + LDS_TAB); const int nblk = build_moe_tables(F, tab);
        pg8::Gemm g{(const bf16*)(F.ws + WS_ACT), (const bf16*)(F.ws + WS_W2T), MROWS, NEXP * 1024, D}; MoeOrder S; S.init(nblk, 4, F.G, (int)blockIdx.x, tab, (const int*)(F.ws + WS_LIST));
        EpiMoe2 E{AR.in[20], (bf16*)(F.ws + WS_YS)};
        pg8::gemm_phase<EpiMoe2, MoeOrder, true, true>(glds, g, S, E);
    } SEAM(10);
    if (IN(11)) REPS(11) { phase_p9(F, AR, args.out); }
#undef IN
#undef SEAM
}

extern "C" void kernel_launch(void* const* d_in, const int* in_sizes, int n_in, void* d_out, int out_size, void* d_ws, size_t ws_size, hipStream_t stream) {
    static int grid = 0;
    if (grid == 0) {
        if (n_in != 22 || out_size != NTOK * D || ws_size < WS_END) { fprintf(stderr, "kernel_launch: unexpected shapes (n_in %d out %d ws %zu)\n", n_in, out_size, ws_size); grid = -1; return; }
        int dev = 0, cus = 0, per_cu = 0;
        if (hipGetDevice(&dev) != hipSuccess || hipDeviceGetAttribute(&cus, hipDeviceAttributeMultiprocessorCount, dev) != hipSuccess) { grid = -1; return; }
        if (hipFuncSetAttribute((const void*)fwd_kernel, hipFuncAttributeMaxDynamicSharedMemorySize, LDS_BYTES) != hipSuccess) { fprintf(stderr, "kernel_launch: hipFuncSetAttribute failed\n"); grid = -1; return; }
        if (hipOccupancyMaxActiveBlocksPerMultiprocessor(&per_cu, (const void*)fwd_kernel, NTHR, LDS_BYTES) != hipSuccess || per_cu < 1) { fprintf(stderr, "kernel_launch: occupancy query says %d\n", per_cu); }
        (void)hipGetLastError();
        grid = cus;
        if (grid > 256) grid = 256;
    }
    if (grid < 0) return;
    if (hipMemsetAsync((char*)d_ws + WS_CTL, 0, CTL_ZERO_BYTES, stream) != hipSuccess) return;
    Args a{};
    for (int i = 0; i < 22; ++i) a.in[i] = (const float*)d_in[i];
    a.out = (float*)d_out; a.ws = (unsigned char*)d_ws;
#if MK_N_LAUNCHES == 1
    a.ph_lo = 0; a.ph_hi = NPHASE;
    hipLaunchKernelGGL(fwd_kernel, dim3(grid), dim3(NTHR), LDS_BYTES, stream, a);
#else
    for (int ph = 0; ph < NPHASE; ++ph) { a.ph_lo = ph; a.ph_hi = ph + 1; hipLaunchKernelGGL(fwd_kernel, dim3(grid), dim3(NTHR), LDS_BYTES, stream, a); }
#endif
}
```

```cpp
#include <hip/hip_runtime.h>
#include <cstdio>
#include <cstdint>
namespace pg8 {
#define PG8_LAS __attribute__((address_space(3)))
typedef unsigned short bf16_t;
typedef short bf16x8 __attribute__((ext_vector_type(8)));
typedef float f32x4 __attribute__((ext_vector_type(4)));
typedef unsigned u32x4 __attribute__((ext_vector_type(4)));
constexpr int BM = 256, BK = 64, HALF = 128, HTB = HALF * BK * 2  , STAGE_BYTES = 8 * HTB, NXCD = 8, WGM = 8;

__host__ __device__ __forceinline__ int lds_byte(int r, int c) { const int st = (r >> 4) * 2 + (c >> 5), rr = r & 15, cc = c & 31, ob = rr * 64 + cc * 2; return st * 1024 + (ob ^ (((ob >> 9) & 1) << 5)); }
__host__ __device__ __forceinline__ void stage_rc(int b, int& R, int& C) { const int st = b / 1024, sb = b % 1024, swz = sb ^ (((sb >> 9) & 1) << 5); R = (st >> 1) * 16 + swz / 64; C = (st & 1) * 32 + (swz % 64) / 2; }
__host__ __device__ __forceinline__ int perm32(int rho) { const int n = rho >> 4, i = rho & 15; return 8 * (i >> 2) + 4 * n + (i & 3); }

struct Unit { int pm, pn; };
struct Gemm { const bf16_t* A; const bf16_t* Bt; int M, N, K; };

struct StaticOrder {
    int nM, nN, nwg, G, c;
    __host__ __device__ void init(int M, int N, int G_, int c_) { nM = M / BM; nN = N / BM; nwg = nM * nN; G = G_; c = c_; }
    __host__ __device__ bool next(int i, Unit& u) const {
        const long L = (long)i * G + c; if (L >= nwg) return false;
        int wgid = (int)L; { const int q = nwg / NXCD, r = nwg % NXCD, xcd = wgid % NXCD, off = wgid / NXCD; wgid = (xcd < r ? xcd * (q + 1) : r * (q + 1) + (xcd - r) * q) + off; }
        const int nig = WGM * nN, gid = wgid / nig, fm = gid * WGM, gsz = (nM - fm) < WGM ? (nM - fm) : WGM;
        u.pm = fm + ((wgid % nig) % gsz); u.pn = (wgid % nig) / gsz; return true;
    }
    __device__ __forceinline__ void a_ready(const Unit&) const {}
    __device__ __forceinline__ void done(const Unit&) const {}
};

__device__ __forceinline__ unsigned cvt_pk_bf16(float lo, float hi) { unsigned r; asm volatile("v_cvt_pk_bf16_f32 %0, %1, %2" : "=v"(r) : "v"(lo), "v"(hi)); return r; }
template <class Epi, class Sched, bool ALIGN_EPI = false, bool SP2 = false, bool GATHER = false>
__device__ __forceinline__ void gemm_phase(PG8_LAS unsigned char* lds, const Gemm g, const Sched& S, const Epi& E) {
    const int tid = threadIdx.x, wid = __builtin_amdgcn_readfirstlane(tid >> 6), lane = tid & 63, wr = wid >> 2, wc = wid & 3, fr = lane & 15, fq = lane >> 4;
    const int K = g.K, nt = K / BK;
    unsigned voffA[2], voffB[2];
#pragma unroll
    for (int i = 0; i < 2; ++i) { int R, C; stage_rc(tid * 16 + i * 8192, R, C); const int Rb = Epi::PERM ? ((R & ~31) + perm32(R & 31)) : R;
        voffA[i] = (unsigned)(R * K + C) * 2u; voffB[i] = (unsigned)(Rb * K + C) * 2u; }
    unsigned vA[2][2], vN[2][2];
#pragma unroll
    for (int h = 0; h < 2; ++h)
#pragma unroll
        for (int i = 0; i < 2; ++i) { vA[h][i] = voffA[i] + (unsigned)(h * HALF * K * 2); vN[h][i] = vA[h][i]; }
#define PG8_TOKS(u, tq) do { _Pragma("unroll") for (int _h = 0; _h < 2; ++_h) _Pragma("unroll") for (int _i = 0; _i < 2; ++_i) { int _R, _C; stage_rc(tid * 16 + _i * 8192, _R, _C); tq[_h][_i] = S.row_token(u, _h * HALF + _R); } } while (0)
#define PG8_OFFS(tq, v) do { _Pragma("unroll") for (int _h = 0; _h < 2; ++_h) _Pragma("unroll") for (int _i = 0; _i < 2; ++_i) { int _R, _C; stage_rc(tid * 16 + _i * 8192, _R, _C); v[_h][_i] = (unsigned)(tq[_h][_i] * K + _C) * 2u; } } while (0)
    const size_t kstep = (size_t)(BK * 2);
    const size_t hstep = (size_t)HALF * K * 2;
    const size_t tstep = 2 * hstep;
    const unsigned ldsw = (unsigned)wid * 1024u;
    const int aoff = lds_byte(wr * 64 + fr, fq * 8), boff = lds_byte(wc * 32 + fr, fq * 8);
#define PG8_SA(b, h) (((b) * 2 + (h)) * HTB)
#define PG8_SB(b, h) ((4 + (b) * 2 + (h)) * HTB)
#define PG8_STAGE(bufoff, gbase, voff) do { _Pragma("unroll") for (int _i = 0; _i < 2; ++_i) \
        __builtin_amdgcn_global_load_lds((const unsigned*)((const char*)(gbase) + (voff)[_i]), (PG8_LAS unsigned*)(lds + (bufoff) + ldsw + _i * 8192), 16, 0, 0); } while (0)
#define PG8_LDA(dst, b, h) do { _Pragma("unroll") for (int m = 0; m < 4; ++m) _Pragma("unroll") for (int k = 0; k < 2; ++k) dst[m][k] = *(const PG8_LAS bf16x8*)(lds + PG8_SA(b, h) + aoff + m * 2048 + k * 1024); } while (0)
#define PG8_LDB(dst, b, h) do { _Pragma("unroll") for (int n = 0; n < 2; ++n) _Pragma("unroll") for (int k = 0; k < 2; ++k) dst[n][k] = *(const PG8_LAS bf16x8*)(lds + PG8_SB(b, h) + boff + n * 2048 + k * 1024); } while (0)
#define PG8_MMA(ai, bj, At, Bt) do { __builtin_amdgcn_s_setprio(1); _Pragma("unroll") for (int m = 0; m < 4; ++m) _Pragma("unroll") for (int n = 0; n < 2; ++n) _Pragma("unroll") for (int k = 0; k < 2; ++k) \
        acc[ai][bj][m][n] = __builtin_amdgcn_mfma_f32_16x16x32_bf16(Bt[n][k], At[m][k], acc[ai][bj][m][n], 0, 0, 0); __builtin_amdgcn_s_setprio(0); } while (0)
#define PG8_WAIT_V(n) asm volatile("s_waitcnt vmcnt(" #n ")" ::: "memory")
#define PG8_WAIT_L(n) asm volatile("s_waitcnt lgkmcnt(" #n ")" ::: "memory")
#define PG8_BAR __builtin_amdgcn_s_barrier()
#define PG8_SCHED __builtin_amdgcn_sched_barrier(0)
    Unit cur, nxt; int ui = 0;
    if (!S.next(0, cur)) return;
    f32x4 acc[2][2][4][2];
#pragma unroll
    for (int a = 0; a < 2; ++a)
#pragma unroll
        for (int b = 0; b < 2; ++b)
#pragma unroll
            for (int m = 0; m < 4; ++m)
#pragma unroll
                for (int n = 0; n < 2; ++n) acc[a][b][m][n] = (f32x4){0.f, 0.f, 0.f, 0.f};
    bf16x8 At[4][2], B0[2][2], B1[2][2];
    const char* cA = (const char*)g.A + (GATHER ? (size_t)0 : (size_t)cur.pm * tstep); const char* cB = (const char*)g.Bt + (size_t)cur.pn * tstep;
    if constexpr (GATHER) { int tq0[2][2]; PG8_TOKS(cur, tq0); PG8_OFFS(tq0, vA); Unit n1; if (S.next(1, n1)) { PG8_TOKS(n1, tq0); PG8_OFFS(tq0, vN); } else { vN[0][0] = vA[0][0]; vN[0][1] = vA[0][1]; vN[1][0] = vA[1][0]; vN[1][1] = vA[1][1]; } }
    S.a_ready(cur);
    if constexpr (SP2) {
        PG8_STAGE(PG8_SB(0, 0), cB, voffB); PG8_STAGE(PG8_SB(0, 1), cB + hstep, voffB); PG8_STAGE(PG8_SA(0, 0), cA, vA[0]); PG8_STAGE(PG8_SA(0, 1), cA, vA[1]);
        if (wr == 1) PG8_BAR;
        PG8_WAIT_V(2); PG8_BAR;
        PG8_STAGE(PG8_SB(1, 0), cB + kstep, voffB); PG8_STAGE(PG8_SA(1, 0), cA + kstep, vA[0]); PG8_STAGE(PG8_SB(1, 1), cB + hstep + kstep, voffB);
        PG8_WAIT_V(6); PG8_BAR;
    } else {
        PG8_STAGE(PG8_SB(0, 0), cB, voffB); PG8_STAGE(PG8_SA(0, 0), cA, voffA); PG8_STAGE(PG8_SB(0, 1), cB + hstep, voffB); PG8_STAGE(PG8_SA(0, 1), cA + hstep, voffA);
        if (wr == 1) PG8_BAR;
        PG8_WAIT_V(4); PG8_BAR;
        PG8_STAGE(PG8_SB(1, 0), cB + kstep, voffB); PG8_STAGE(PG8_SA(1, 0), cA + kstep, voffA); PG8_STAGE(PG8_SB(1, 1), cB + hstep + kstep, voffB);
        PG8_WAIT_V(6); PG8_BAR;
    }
    for (;;) {
        const bool has_next = S.next(ui + 1, nxt);
        const char* nA = (has_next && !GATHER) ? (const char*)g.A + (size_t)nxt.pm * tstep : cA; const char* nB = has_next ? (const char*)g.Bt + (size_t)nxt.pn * tstep : cB;
        for (int t = 0; t < nt; t += 2) {
            const bool last = (t == nt - 2);
            const char* a1 = cA + (size_t)(t + 1) * kstep;
            const char* a2 = last ? nA : cA + (size_t)(t + 2) * kstep; const char* b2 = last ? nB : cB + (size_t)(t + 2) * kstep;
            const char* a3 = a2 + kstep; const char* b3 = b2 + kstep;
            if (last && has_next) S.a_ready(nxt);
            unsigned o0[2] = {vA[0][0], vA[0][1]}, o1[2] = {vA[1][0], vA[1][1]};
            if (last) { o0[0] = vN[0][0]; o0[1] = vN[0][1]; o1[0] = vN[1][0]; o1[1] = vN[1][1]; }
            if constexpr (SP2) {
            PG8_LDB(B0, 0, 0); PG8_LDB(B1, 0, 1); PG8_SCHED; PG8_LDA(At, 0, 0); PG8_STAGE(PG8_SA(1, 1), a1, vA[1]);
            PG8_WAIT_V(8); PG8_WAIT_L(0); PG8_BAR; PG8_MMA(0, 0, At, B0); PG8_MMA(0, 1, At, B1); PG8_BAR; PG8_SCHED;
            PG8_LDA(At, 0, 1); PG8_STAGE(PG8_SB(0, 0), b2, voffB); PG8_STAGE(PG8_SB(0, 1), b2 + hstep, voffB); PG8_STAGE(PG8_SA(0, 0), a2, o0);
            PG8_WAIT_V(8); PG8_WAIT_L(0); PG8_BAR; PG8_MMA(1, 0, At, B0); PG8_MMA(1, 1, At, B1); PG8_BAR; PG8_SCHED;
            PG8_LDB(B0, 1, 0); PG8_LDB(B1, 1, 1); PG8_SCHED; PG8_LDA(At, 1, 0); PG8_STAGE(PG8_SA(0, 1), a2, o1);
            PG8_WAIT_V(8); PG8_WAIT_L(0); PG8_BAR; PG8_MMA(0, 0, At, B0); PG8_MMA(0, 1, At, B1); PG8_BAR; PG8_SCHED;
            PG8_LDA(At, 1, 1); PG8_STAGE(PG8_SB(1, 0), b3, voffB); PG8_STAGE(PG8_SB(1, 1), b3 + hstep, voffB); PG8_STAGE(PG8_SA(1, 0), a3, o0);
            PG8_WAIT_V(8); PG8_WAIT_L(0); PG8_BAR; PG8_MMA(1, 0, At, B0); PG8_MMA(1, 1, At, B1); PG8_BAR; PG8_SCHED;
            } else {
            PG8_LDB(B0, 0, 0); PG8_SCHED; PG8_LDA(At, 0, 0); PG8_STAGE(PG8_SA(1, 1), a1 + hstep, voffA);
            PG8_WAIT_L(8); PG8_BAR; PG8_WAIT_L(0); PG8_MMA(0, 0, At, B0); PG8_BAR; PG8_SCHED;
            PG8_LDB(B1, 0, 1); PG8_STAGE(PG8_SB(0, 0), b2, voffB);
            PG8_BAR; PG8_WAIT_L(0); PG8_MMA(0, 1, At, B1); PG8_BAR;
            PG8_LDA(At, 0, 1); PG8_STAGE(PG8_SA(0, 0), a2, voffA);
            PG8_BAR; PG8_WAIT_L(0); PG8_MMA(1, 0, At, B0); PG8_BAR; PG8_SCHED;
            PG8_STAGE(PG8_SB(0, 1), b2 + hstep, voffB);
            PG8_WAIT_V(6); PG8_BAR; PG8_MMA(1, 1, At, B1); PG8_BAR;
            PG8_LDB(B0, 1, 0); PG8_SCHED; PG8_LDA(At, 1, 0); PG8_STAGE(PG8_SA(0, 1), a2 + hstep, voffA);
            PG8_WAIT_L(8); PG8_BAR; PG8_WAIT_L(0); PG8_MMA(0, 0, At, B0); PG8_BAR; PG8_SCHED;
            PG8_LDB(B1, 1, 1); PG8_STAGE(PG8_SB(1, 0), b3, voffB);
            PG8_BAR; PG8_WAIT_L(0); PG8_MMA(0, 1, At, B1); PG8_BAR;
            PG8_LDA(At, 1, 1); PG8_STAGE(PG8_SA(1, 0), a3, voffA);
            PG8_BAR; PG8_WAIT_L(0); PG8_MMA(1, 0, At, B0); PG8_BAR; PG8_SCHED;
            PG8_STAGE(PG8_SB(1, 1), b3 + hstep, voffB);
            PG8_WAIT_V(6); PG8_BAR; PG8_MMA(1, 1, At, B1); PG8_BAR;
            }
        }
        if constexpr (ALIGN_EPI) { if (wr == 0) PG8_BAR; }
        int tq[2][2] = {{0, 0}, {0, 0}}; bool has2 = false;
        if constexpr (GATHER) { Unit nx2; has2 = S.next(ui + 2, nx2); if (has2) PG8_TOKS(nx2, tq); }
        if constexpr (!Epi::AFTER_DRAIN) { E(acc, cur, wr, wc, fr, fq); S.done(cur); }
        if constexpr (GATHER) { asm volatile("" : "+v"(tq[0][0]), "+v"(tq[0][1]), "+v"(tq[1][0]), "+v"(tq[1][1])); }
        if (!has_next) break;
#pragma unroll
        for (int a = 0; a < 2; ++a)
#pragma unroll
            for (int b = 0; b < 2; ++b)
#pragma unroll
                for (int m = 0; m < 4; ++m)
#pragma unroll
                    for (int n = 0; n < 2; ++n) acc[a][b][m][n] = (f32x4){0.f, 0.f, 0.f, 0.f};
        cur = nxt; cA = nA; cB = nB; ++ui; vA[0][0] = vN[0][0]; vA[0][1] = vN[0][1]; vA[1][0] = vN[1][0]; vA[1][1] = vN[1][1];
        if constexpr (GATHER) { if (has2) PG8_OFFS(tq, vN); }
        if constexpr (ALIGN_EPI) { if (wr == 1) PG8_BAR; }
    }
    PG8_WAIT_V(0);
    if constexpr (!ALIGN_EPI) { if (wr == 0) PG8_BAR; }
    PG8_BAR;
    if constexpr (Epi::AFTER_DRAIN) { E.fused(acc, cur, wr, wc, fr, fq, lds, wid, lane); S.done(cur); }
#undef PG8_TOKS
#undef PG8_OFFS
#undef PG8_SA
#undef PG8_SB
#undef PG8_STAGE
#undef PG8_LDA
#undef PG8_LDB
#undef PG8_MMA
#undef PG8_WAIT_V
#undef PG8_WAIT_L
#undef PG8_BAR
#undef PG8_SCHED
}
}

#define XB_TMO      128
#define XB_XCNT(j)  (256  + 64 * (j))
#define XB_XSUB(j)  (1280 + 64 * (j))
#define XB_XGEN(j)  (2304 + 64 * (j))
#define XB_TOP      3328
#define XB_TOPGEN   3392
#define XCD_BAR_WORDS 3456
#define XB_SPIN_CAP (1u << 18)
#define LAS __attribute__((address_space(3)))

__device__ __forceinline__ unsigned xb_ld(unsigned* p)              { return __hip_atomic_load(p, __ATOMIC_RELAXED, __HIP_MEMORY_SCOPE_AGENT); }
__device__ __forceinline__ unsigned xb_add(unsigned* p, unsigned v) { return __hip_atomic_fetch_add(p, v, __ATOMIC_RELAXED, __HIP_MEMORY_SCOPE_AGENT); }
__device__ __forceinline__ unsigned xb_xcc_id() { return (unsigned)__builtin_amdgcn_s_getreg((3 << 11) | 20) & 0xFu; }
#define XB_SPIN(cond, bar) do { unsigned _sp = 0; while (cond) { __builtin_amdgcn_s_sleep(1); \
    if ((++_sp & 255u) == 0u) { if (xb_ld(&(bar)[XB_TMO])) break; if (_sp > XB_SPIN_CAP) { atomicAdd(&(bar)[XB_TMO], 1u); break; } } } } while (0)

struct XcdBarrier {
    unsigned* bar; unsigned x;
    volatile LAS unsigned* st;
};

__device__ __forceinline__ XcdBarrier xcd_barrier_post(unsigned* bar, volatile LAS unsigned* st) {
    XcdBarrier b; b.bar = bar; b.x = xb_xcc_id(); b.st = st;
    if (threadIdx.x == 0) (void)xb_add(&bar[XB_XCNT(b.x)], 1u);
    return b;
}
__device__ __forceinline__ void xcd_barrier_complete(unsigned* bar, unsigned x, unsigned& nloc, unsigned& nx) {
    const unsigned G = gridDim.x * gridDim.y * gridDim.z;
    unsigned sum, cnt, mine, sp = 0u;
    for (;;) {
        sum = 0u; cnt = 0u; mine = 0u;
#pragma unroll
        for (unsigned j = 0; j < 16; ++j) { const unsigned c = xb_ld(&bar[XB_XCNT(j)]); sum += c; cnt += (c > 0u) ? 1u : 0u; mine = (j == x) ? c : mine; }
        if (sum == G) break;
        __builtin_amdgcn_s_sleep(1);
        if ((++sp & 255u) == 0u) { if (xb_ld(&bar[XB_TMO])) break; if (sp > XB_SPIN_CAP) { atomicAdd(&bar[XB_TMO], 1u); break; } }
    }
    nloc = mine > 0u ? mine : 1u; nx = cnt > 0u ? cnt : 1u;
}

__device__ __forceinline__ void xcd_barrier(const XcdBarrier& b) {
    asm volatile("s_waitcnt vmcnt(0)" ::: "memory");
    __syncthreads();
    if (threadIdx.x == 0) {
        unsigned* bar = b.bar;
        __builtin_amdgcn_s_waitcnt(0);
        unsigned nloc = b.st[0], nx = b.st[1];
        if (nloc == 0u) { xcd_barrier_complete(bar, b.x, nloc, nx); b.st[0] = nloc; b.st[1] = nx; }
        const unsigned old = xb_add(&bar[XB_XSUB(b.x)], 1u);
        const unsigned gen = old / nloc;
        if (old + 1u == (gen + 1u) * nloc) {
            __builtin_amdgcn_fence(__ATOMIC_RELEASE, "agent");
            asm volatile("s_waitcnt vmcnt(0)" ::: "memory");
            const unsigned og = xb_add(&bar[XB_TOP], 1u);
            const unsigned tg = og / nx;
            if (og + 1u == (tg + 1u) * nx) xb_add(&bar[XB_TOPGEN], 1u);
            else XB_SPIN(xb_ld(&bar[XB_TOPGEN]) == tg, bar);
            __builtin_amdgcn_fence(__ATOMIC_ACQUIRE, "agent");
            xb_add(&bar[XB_XGEN(b.x)], 1u);
            asm volatile("s_waitcnt vmcnt(0)" ::: "memory");
        } else {
            XB_SPIN(xb_ld(&bar[XB_XGEN(b.x)]) == gen, bar);
            __builtin_amdgcn_fence(__ATOMIC_ACQUIRE, "agent");
            asm volatile("s_waitcnt vmcnt(0)" ::: "memory");
        }
    }
    __syncthreads();
}

#ifndef MK_N_LAUNCHES
#define MK_N_LAUNCHES 1
#endif
constexpr int NPHASE = 12;
constexpr int NWAVES = 8, NTHR = 512;
constexpr int D = 1024, SEQ = 8192, NTOK = 16384, NH = 8, HD = 128, CH = 64, NCHUNK = 128;
constexpr int PW = 9216;
constexpr int PC_Q = 0, PC_K = 1024, PC_V = 2048, PC_Z = 3072, PC_BG = 4096, PC_CG = 5120, PC_UI = 6144, PC_GA = 7168, PC_GB = 8192;
constexpr int INW = 9248;
constexpr int NEXP = 32, TOPK = 4, MROWS = 73728;
constexpr float EPS = 1e-6f;

constexpr size_t MiB = 1u << 20;
constexpr size_t WS_CTL = 0, CTL_ZERO_BYTES = 1 * MiB;
constexpr size_t WS_MOD = 1 * MiB;
constexpr size_t WS_WSM_T = 1 * MiB + 64 * 1024;
constexpr size_t WS_WR_T = 1 * MiB + 192 * 1024;
constexpr size_t WS_TOPI = 2 * MiB;
constexpr size_t WS_TOPG = 2 * MiB + 256 * 1024;
constexpr size_t WS_TOPP = 2 * MiB + 512 * 1024;
constexpr size_t WS_PSM = 3 * MiB;
constexpr size_t WS_GL = 5 * MiB;
constexpr size_t WS_LIST = 6 * MiB;
constexpr size_t WS_WIN_T = 8 * MiB;
constexpr size_t WS_WUO_T = 26 * MiB;
constexpr size_t WS_WO_T = 30 * MiB;
constexpr size_t WS_W1T = 32 * MiB;
constexpr size_t WS_W2T = 160 * MiB;
constexpr size_t WS_H = 224 * MiB;
constexpr size_t WS_OD = 256 * MiB;
constexpr size_t WS_P = 320 * MiB;
constexpr size_t WS_DD = 608 * MiB;
constexpr size_t WS_SB = WS_H;
constexpr size_t WS_M1X = 896 * MiB;
constexpr size_t WS_END = 960 * MiB;
constexpr size_t DD_UNIT = 73728;
constexpr size_t DD_W = 0, DD_Q = 16384, DD_K = 32768, DD_A = 49152, DD_U = 57344;
constexpr size_t WS_OASB = WS_DD, WS_M1 = WS_DD + 64 * MiB, WS_M = WS_DD + 128 * MiB;
constexpr size_t WS_XS = WS_P, WS_ACT = WS_P + 144 * MiB, WS_YS = WS_DD;
constexpr int CW_BAR = 4096;
constexpr int CW_RANK = 30720;
constexpr int CW_CVT = 28672;
constexpr int CW_Q = 24576;
constexpr int CW_CNT = 16384;

constexpr int LDS_BYTES = 155648;
constexpr int LDS_MISC = 152 * 1024 - 256;
constexpr int LDS_TAB = 131072;

#define GAS __attribute__((address_space(1)))
#define LAS __attribute__((address_space(3)))
typedef unsigned short bf16;
typedef float f4 __attribute__((ext_vector_type(4)));
typedef unsigned u4 __attribute__((ext_vector_type(4)));
typedef unsigned u2 __attribute__((ext_vector_type(2)));

typedef __bf16 hwbf2 __attribute__((ext_vector_type(2)));
typedef float hwf2 __attribute__((ext_vector_type(2)));
__device__ __forceinline__ unsigned cvtpk(float lo, float hi) { const hwf2 v = {lo, hi}; return __builtin_bit_cast(unsigned, __builtin_convertvector(v, hwbf2)); }
__device__ __forceinline__ unsigned f2bf(float f) { unsigned u = __float_as_uint(f); return (u + 0x7fffu + ((u >> 16) & 1u)) >> 16; }
__device__ __forceinline__ unsigned pk2(float lo, float hi) { return cvtpk(lo, hi); }
__device__ __forceinline__ float bflo(unsigned w) { return __uint_as_float(w << 16); }
__device__ __forceinline__ float bfhi(unsigned w) { return __uint_as_float(w & 0xffff0000u); }
__device__ __forceinline__ float bf1(bf16 b) { return __uint_as_float(((unsigned)b) << 16); }
__device__ __forceinline__ void unpack8(const u4 w, float (&o)[8]) { o[0] = bflo(w.x); o[1] = bfhi(w.x); o[2] = bflo(w.y); o[3] = bfhi(w.y); o[4] = bflo(w.z); o[5] = bfhi(w.z); o[6] = bflo(w.w); o[7] = bfhi(w.w); }
__device__ __forceinline__ u4 pack8(const float (&o)[8]) { u4 w; w.x = pk2(o[0], o[1]); w.y = pk2(o[2], o[3]); w.z = pk2(o[4], o[5]); w.w = pk2(o[6], o[7]); return w; }
__device__ __forceinline__ float wave_sum(float v) {
#pragma unroll
    for (int o = 1; o < 64; o <<= 1) v += __shfl_xor(v, o);
    return v;
}
#define LDS_BARRIER() do { asm volatile("s_waitcnt lgkmcnt(0)" ::: "memory"); __builtin_amdgcn_s_barrier(); asm volatile("" ::: "memory"); } while (0)
__device__ __forceinline__ float sigm(float x) { return 1.0f / (1.0f + __expf(-x)); }
__device__ __forceinline__ float silu(float x) { return x / (1.0f + __expf(-x)); }
__device__ __forceinline__ float softplus(float x) { return x > 20.f ? x : log1pf(expf(x)); }

struct Args { const float* in[22]; float* out; unsigned char* ws; int ph_lo, ph_hi; };

struct Frame {
    LAS unsigned char* lds;
    int tid, lane, wave, G;
    unsigned char* ws;
};

__device__ __forceinline__ void p0_transpose_item(const float* W, int ldw, int k0, int n0s, bf16* WT, size_t drow0, LAS float* scr, int lane) {
    { const int kq = lane >> 3, n4 = (lane & 7) * 4; f4 v[8];
#pragma unroll
        for (int i = 0; i < 8; ++i) v[i] = __builtin_nontemporal_load((const f4*)(W + (size_t)(k0 + 8 * i + kq) * ldw + n0s + n4));
#pragma unroll
        for (int i = 0; i < 8; ++i) { LAS float* d = scr + (8 * i + kq) * 33 + n4; d[0] = v[i].x; d[1] = v[i].y; d[2] = v[i].z; d[3] = v[i].w; } }
    asm volatile("s_waitcnt lgkmcnt(0)" ::: "memory");
    const int c = lane & 7;
#pragma unroll
    for (int j = 0; j < 4; ++j) { const int n = (lane >> 3) + 8 * j; const LAS float* s = scr + (8 * c) * 33 + n;
        u4 o; o.x = pk2(s[0 * 33], s[1 * 33]); o.y = pk2(s[2 * 33], s[3 * 33]); o.z = pk2(s[4 * 33], s[5 * 33]); o.w = pk2(s[6 * 33], s[7 * 33]);
        *(u4*)(WT + (drow0 + n) * 1024 + k0 + 8 * c) = o; }
    asm volatile("s_waitcnt lgkmcnt(0)" ::: "memory");
}

__device__ __forceinline__ void phase_p0(Frame& F, const Args& AR) {
    const float* c_in = AR.in[1]; const float* ada_w = AR.in[2]; const float* ada_b = AR.in[3];
    const float* w_in = AR.in[5];
    for (int task = blockIdx.x; task < 192; task += F.G) {
        LAS float* red = (LAS float*)(F.lds + 131072);
        const int j0 = 32 * task, col = j0 + (F.lane & 31), kh = F.lane >> 5;
        float a0 = 0.f, a1 = 0.f;
#pragma unroll 8
        for (int i = 0; i < 64; ++i) { const int k = 128 * F.wave + 2 * i + kh; const float wv = ada_w[(size_t)k * 6144 + col];
            a0 += silu(c_in[k]) * wv; a1 += silu(c_in[1024 + k]) * wv; }
        a0 += __shfl_xor(a0, 32); a1 += __shfl_xor(a1, 32);
        if (F.lane < 32) { red[(F.wave * 2 + 0) * 32 + F.lane] = a0; red[(F.wave * 2 + 1) * 32 + F.lane] = a1; }
        __syncthreads();
        if (F.tid < 64) { const int b = F.tid >> 5, cc = F.tid & 31; float s = 0.f;
#pragma unroll
            for (int w = 0; w < 8; ++w) s += red[(w * 2 + b) * 32 + cc];
            ((float*)(F.ws + WS_MOD))[b * 6144 + j0 + cc] = s + ada_b[j0 + cc]; }
        __syncthreads();
    }
    {
        const float* router_w = AR.in[15]; float* wsm = (float*)(F.ws + WS_WSM_T); float* wr = (float*)(F.ws + WS_WR_T);
        for (int idx = blockIdx.x * NTHR + F.tid; idx < 65536; idx += F.G * NTHR) { const int which = idx >> 15, r = idx & 32767, k = r >> 5, n = r & 31;
            if (which == 0) wsm[n * 1024 + k] = w_in[(size_t)k * INW + 4096 + n]; else wr[n * 1024 + k] = router_w[k * 32 + n]; }
    }
    LAS float* scr = (LAS float*)(F.lds + F.wave * 16384);
    const int gw = blockIdx.x * NWAVES + F.wave, NGW = F.G * NWAVES;
    constexpr int I_IN = 16 * 288, I_SQ = 16 * 32;
    constexpr int NITEMS = I_IN + 3 * I_SQ;
    for (int it = gw; it < NITEMS; it += NGW) {
        int r = it;
        if (r < I_IN) { const int kb = r / 288, nb = r % 288, n0 = 32 * nb; p0_transpose_item(w_in, INW, 64 * kb, n0 + (n0 >= 4096 ? 32 : 0), (bf16*)(F.ws + WS_WIN_T), (size_t)n0, scr, F.lane); continue; } r -= I_IN;
        if (r < I_SQ) { const int kb = r / 32, nb = r % 32; p0_transpose_item(AR.in[10], 1024, 64 * kb, 32 * nb, (bf16*)(F.ws + WS_WUO_T), (size_t)(32 * nb), scr, F.lane); continue; } r -= I_SQ;
        if (r < I_SQ) { const int kb = r / 32, nb = r % 32; p0_transpose_item(AR.in[12], 1024, 64 * kb, 32 * nb, (bf16*)(F.ws + WS_WUO_T), (size_t)(1024 + 32 * nb), scr, F.lane); continue; } r -= I_SQ;
        { const int kb = r / 32, nb = r % 32; p0_transpose_item(AR.in[13], 1024, 64 * kb, 32 * nb, (bf16*)(F.ws + WS_WO_T), (size_t)(32 * nb), scr, F.lane); }
    }
}
struct CvtItem { const float* W; bf16* WT; size_t drow0; int ldw, k0, n0s; };
__device__ __forceinline__ CvtItem moe_item(const Args& AR, unsigned char* ws, int r) {
    constexpr int I_W1 = 32 * 16 * 64; CvtItem c;
    if (r < I_W1) { const int e = r / 1024, q = r % 1024, kb = q / 64, nb = q % 64, n0 = 32 * nb, half = n0 >> 10, j = n0 & 1023;
        c.W = AR.in[17] + (size_t)e * 1024 * 2048; c.ldw = 2048; c.k0 = 64 * kb; c.n0s = n0; c.WT = (bf16*)(ws + WS_W1T); c.drow0 = (size_t)e * 2048 + (size_t)((j >> 7) * 256 + half * 128 + (j & 127)); }
    else { r -= I_W1; const int e = r / 512, q = r % 512, kb = q / 32, nb = q % 32;
        c.W = AR.in[19] + (size_t)e * 1024 * 1024; c.ldw = 1024; c.k0 = 64 * kb; c.n0s = 32 * nb; c.WT = (bf16*)(ws + WS_W2T); c.drow0 = (size_t)e * 1024 + (size_t)(32 * nb); }
    return c;
}
__device__ __forceinline__ void cvt_load(const CvtItem& c, int lane, f4 (&v)[8]) {
    const int kq = lane >> 3, n4 = (lane & 7) * 4;
#pragma unroll
    for (int i = 0; i < 8; ++i) v[i] = __builtin_nontemporal_load((const f4*)(c.W + (size_t)(c.k0 + 8 * i + kq) * c.ldw + c.n0s + n4));
}
__device__ __forceinline__ void cvt_store(const CvtItem& c, int lane, const f4 (&v)[8], LAS float* scr) {
    const int kq = lane >> 3, n4 = (lane & 7) * 4;
#pragma unroll
    for (int i = 0; i < 8; ++i) { LAS float* d = scr + (8 * i + kq) * 33 + n4; d[0] = v[i].x; d[1] = v[i].y; d[2] = v[i].z; d[3] = v[i].w; }
    asm volatile("s_waitcnt lgkmcnt(0)" ::: "memory");
    const int cc = lane & 7;
#pragma unroll
    for (int j = 0; j < 4; ++j) { const int n = (lane >> 3) + 8 * j; const LAS float* sp = scr + (8 * cc) * 33 + n;
        u4 o; o.x = pk2(sp[0 * 33], sp[1 * 33]); o.y = pk2(sp[2 * 33], sp[3 * 33]); o.z = pk2(sp[4 * 33], sp[5 * 33]); o.w = pk2(sp[6 * 33], sp[7 * 33]);
        __builtin_nontemporal_store(o, (u4*)(c.WT + (c.drow0 + n) * 1024 + c.k0 + 8 * cc)); }
    asm volatile("s_waitcnt lgkmcnt(0)" ::: "memory");
}
__device__ __forceinline__ void moe_convert(Frame& F, const Args& AR) {
    constexpr int NIT = 32 * 16 * 64 + 32 * 16 * 32;
    LAS float* scr = (LAS float*)(F.lds + F.wave * 16384);
    unsigned* ctr = (unsigned*)(F.ws + WS_CTL) + CW_CVT;
    for (;;) {
        unsigned base = 0u;
        if (F.lane == 0) base = __hip_atomic_fetch_add(ctr, 8u, __ATOMIC_RELAXED, __HIP_MEMORY_SCOPE_AGENT);
        base = (unsigned)__builtin_amdgcn_readfirstlane((int)base);
        if (base >= (unsigned)NIT) break;
        f4 va[8], vb[8];
        CvtItem ca = moe_item(AR, F.ws, (int)base), cb = ca;
        cvt_load(ca, F.lane, va);
#pragma unroll 1
        for (int t = 0; t < 8; t += 2) {
            cb = moe_item(AR, F.ws, (int)base + t + 1); cvt_load(cb, F.lane, vb);
            cvt_store(ca, F.lane, va, scr);
            if (t + 2 < 8) { ca = moe_item(AR, F.ws, (int)base + t + 2); cvt_load(ca, F.lane, va); }
            cvt_store(cb, F.lane, vb, scr);
        }
    }
}
__device__ __forceinline__ void stage_wt(LAS float* WtL, const float* WT, int tid) {
    for (int idx = tid; idx < 32 * 256; idx += NTHR) { const int n = idx >> 8, k4 = idx & 255; const f4 v = *(const f4*)(WT + n * 1024 + 4 * k4); *(LAS f4*)(WtL + n * 1028 + 4 * k4) = v; }
}
__device__ __forceinline__ float dot32(const f4 (&v)[4], const LAS float* WtL, int lane) {
    float p[32];
#pragma unroll
    for (int n = 0; n < 32; ++n) { float s = 0.f;
#pragma unroll
        for (int j = 0; j < 4; ++j) { const f4 w = *(const LAS f4*)(WtL + n * 1028 + 256 * j + 4 * lane); s += v[j].x * w.x + v[j].y * w.y + v[j].z * w.z + v[j].w * w.w; }
        p[n] = s; if ((n & 3) == 3) asm volatile("" : "+v"(p[n - 3]), "+v"(p[n - 2]), "+v"(p[n - 1]), "+v"(p[n]) :: "memory"); }
#pragma unroll
    for (int i = 0; i < 16; ++i) { const bool hi = (lane & 32) != 0; const float send = hi ? p[i] : p[i + 16], keep = hi ? p[i + 16] : p[i]; p[i] = keep + __shfl_xor(send, 32); }
#pragma unroll
    for (int i = 0; i < 8; ++i) { const bool hi = (lane & 16) != 0; const float send = hi ? p[i] : p[i + 8], keep = hi ? p[i + 8] : p[i]; p[i] = keep + __shfl_xor(send, 16); }
#pragma unroll
    for (int i = 0; i < 4; ++i) { const bool hi = (lane & 8) != 0; const float send = hi ? p[i] : p[i + 4], keep = hi ? p[i + 4] : p[i]; p[i] = keep + __shfl_xor(send, 8); }
#pragma unroll
    for (int i = 0; i < 2; ++i) { const bool hi = (lane & 4) != 0; const float send = hi ? p[i] : p[i + 2], keep = hi ? p[i + 2] : p[i]; p[i] = keep + __shfl_xor(send, 4); }
    { const bool hi = (lane & 2) != 0; const float send = hi ? p[0] : p[1], keep = hi ? p[1] : p[0]; p[0] = keep + __shfl_xor(send, 2); }
    p[0] += __shfl_xor(p[0], 1);
    return p[0];
}

__device__ __forceinline__ void phase_p1(Frame& F, const Args& AR) {
    const float* x = AR.in[0]; const float* norm1_w = AR.in[4]; const float* mod = (const float*)(F.ws + WS_MOD);
    LAS float* WtL = (LAS float*)F.lds;
    LAS float* A1 = (LAS float*)(F.lds + 131584);
    LAS float* B1 = A1 + 2048;
    stage_wt(WtL, (const float*)(F.ws + WS_WSM_T), F.tid);
    for (int idx = F.tid; idx < 2048; idx += NTHR) { const int b = idx >> 10, k = idx & 1023; A1[idx] = norm1_w[k] * (1.0f + mod[b * 6144 + 1024 + k]); B1[idx] = mod[b * 6144 + k]; }
    __syncthreads();
    bf16* h = (bf16*)(F.ws + WS_H); float* psm = (float*)(F.ws + WS_PSM);
    const int gw = blockIdx.x * NWAVES + F.wave, NGW = F.G * NWAVES;
    for (int m = gw; m < NTOK; m += NGW) {
        const f4* xr = (const f4*)(x + (size_t)m * D) + F.lane; f4 v[4]; float ss = 0.f;
#pragma unroll
        for (int j = 0; j < 4; ++j) { v[j] = xr[64 * j]; ss += (v[j].x * v[j].x + v[j].y * v[j].y) + (v[j].z * v[j].z + v[j].w * v[j].w); }
        const float rstd = 1.0f / sqrtf(wave_sum(ss) * (1.0f / D) + EPS);
        const int b = m >> 13;
#pragma unroll
        for (int j = 0; j < 4; ++j) { const f4 a = *(const LAS f4*)(A1 + b * 1024 + 256 * j + 4 * F.lane), bb = *(const LAS f4*)(B1 + b * 1024 + 256 * j + 4 * F.lane);
            v[j] = v[j] * rstd * a + bb;
            u2 o; o.x = pk2(v[j].x, v[j].y); o.y = pk2(v[j].z, v[j].w); ((u2*)(h + (size_t)m * D))[F.lane + 64 * j] = o; }
        const float tot = dot32(v, WtL, F.lane);
        if (!(F.lane & 1)) psm[(size_t)m * 32 + (F.lane >> 1)] = tot;
    }
}

struct EpiStoreBf16 {
    static constexpr bool PERM = true, AFTER_DRAIN = false;
    bf16* O; int ldc;
    __device__ __forceinline__ void operator()(const pg8::f32x4 (&acc)[2][2][4][2], const pg8::Unit& u, int wr, int wc, int fr, int fq) const {
        const int row0 = u.pm * 256 + wr * 64 + fr, col0 = u.pn * 256 + wc * 32 + 8 * fq;
#pragma unroll
        for (int ai = 0; ai < 2; ++ai)
#pragma unroll
            for (int m = 0; m < 4; ++m) { bf16* rowp = O + (size_t)(row0 + ai * 128 + m * 16) * ldc + col0;
#pragma unroll
                for (int bj = 0; bj < 2; ++bj) { const pg8::f32x4 v0 = acc[ai][bj][m][0], v1 = acc[ai][bj][m][1];
                    u4 w; w.x = cvtpk(v0[0], v0[1]); w.y = cvtpk(v0[2], v0[3]); w.z = cvtpk(v1[0], v1[1]); w.w = cvtpk(v1[2], v1[3]);
                    __builtin_nontemporal_store(w, (u4*)(rowp + bj * 128)); } }
    }
};
struct EpiGate {
    static constexpr bool PERM = true, AFTER_DRAIN = false;
    const bf16* P; float* M1; bf16* Mo; int gcolb, second;
    __device__ __forceinline__ void operator()(const pg8::f32x4 (&acc)[2][2][4][2], const pg8::Unit& u, int wr, int wc, int fr, int fq) const {
        const int s = second;
        const int row0 = u.pm * 256 + wr * 64 + fr, col0 = u.pn * 256 + wc * 32 + 8 * fq, gcol = gcolb + col0;
#pragma unroll
        for (int am = 0; am < 4; ++am) { const int ai = am >> 1, mb = (am & 1) * 2;
            u4 gw[2][2]; f4 p0[2][2], p1[2][2];
#pragma unroll
            for (int mm = 0; mm < 2; ++mm)
#pragma unroll
                for (int bj = 0; bj < 2; ++bj) { const int row = row0 + ai * 128 + (mb + mm) * 16;
                    gw[mm][bj] = *(const u4*)(P + (size_t)row * PW + gcol + bj * 128);
                    if (s) { const float* mp = M1 + (size_t)row * D + col0 + bj * 128; p0[mm][bj] = *(const f4*)mp; p1[mm][bj] = *(const f4*)(mp + 4); } }
#pragma unroll
            for (int mm = 0; mm < 2; ++mm)
#pragma unroll
                for (int bj = 0; bj < 2; ++bj) { const int m = mb + mm; const int row = row0 + ai * 128 + m * 16, col = col0 + bj * 128;
                    float g[8]; unpack8(gw[mm][bj], g);
                    const pg8::f32x4 v0 = acc[ai][bj][m][0], v1 = acc[ai][bj][m][1];
                    float o[8];
#pragma unroll
                    for (int e = 0; e < 4; ++e) { o[e] = sigm(g[e]) * v0[e]; o[4 + e] = sigm(g[4 + e]) * v1[e]; }
                    if (s == 0) { float* mp = M1 + (size_t)row * D + col; *(f4*)mp = (f4){o[0], o[1], o[2], o[3]}; *(f4*)(mp + 4) = (f4){o[4], o[5], o[6], o[7]}; }
                    else { const f4 q0 = p0[mm][bj], q1 = p1[mm][bj];
                        u4 w; w.x = cvtpk(q0.x + o[0], q0.y + o[1]); w.y = cvtpk(q0.z + o[2], q0.w + o[3]); w.z = cvtpk(q1.x + o[4], q1.y + o[5]); w.w = cvtpk(q1.z + o[6], q1.w + o[7]);
                        *(u4*)(Mo + (size_t)row * D + col) = w; } }
        }
    }
};
struct EpiG4 {
    static constexpr bool PERM = false, AFTER_DRAIN = false;
    const float* X; const float* mod; float* X1;
    __device__ __forceinline__ void operator()(const pg8::f32x4 (&acc)[2][2][4][2], const pg8::Unit& u, int wr, int wc, int fr, int fq) const {
        const int row0 = u.pm * 256 + wr * 64 + fr, col0 = u.pn * 256 + wc * 32 + 4 * fq; const int b = u.pm >> 5;
        f4 gt[2][2];
#pragma unroll
        for (int bj = 0; bj < 2; ++bj)
#pragma unroll
            for (int n = 0; n < 2; ++n) gt[bj][n] = *(const f4*)(mod + b * 6144 + 2048 + col0 + bj * 128 + n * 16);
#pragma unroll
        for (int ai = 0; ai < 2; ++ai) {
            f4 xv[4][2][2];
#pragma unroll
            for (int m = 0; m < 4; ++m)
#pragma unroll
                for (int bj = 0; bj < 2; ++bj)
#pragma unroll
                    for (int n = 0; n < 2; ++n) xv[m][bj][n] = *(const f4*)(X + (size_t)(row0 + ai * 128 + m * 16) * D + col0 + bj * 128 + n * 16);
#pragma unroll
            for (int m = 0; m < 4; ++m) { const size_t off = (size_t)(row0 + ai * 128 + m * 16) * D + col0;
#pragma unroll
                for (int bj = 0; bj < 2; ++bj)
#pragma unroll
                    for (int n = 0; n < 2; ++n) { const f4 x = xv[m][bj][n]; const pg8::f32x4 a = acc[ai][bj][m][n];
                        *(f4*)(X1 + off + bj * 128 + n * 16) = (f4){x.x + gt[bj][n].x * a[0], x.y + gt[bj][n].y * a[1], x.z + gt[bj][n].z * a[2], x.w + gt[bj][n].w * a[3]}; } }
        }
    }
};
struct MoeOrder {
    int nM, nN, nwg, G, c; const LAS int* blk_exp; const LAS int* tab; const int* list;
    __device__ __forceinline__ void init(int nblk, int nN_, int G_, int c_, const LAS int* tab_, const int* list_) { nM = nblk; nN = nN_; nwg = nM * nN; G = G_; c = c_; tab = tab_; blk_exp = tab_ + 64; list = list_; }
    __device__ __forceinline__ int row_token(const pg8::Unit& u, int r) const { const int e = u.pn / nN, cn = tab[512 + e]; int idx = 256 * (u.pm - (tab[e] >> 8)) + r; idx = idx < cn ? idx : cn - 1; return list[e * 16384 + idx]; }
    __device__ __forceinline__ bool next(int i, pg8::Unit& u) const {
        const long L = (long)i * G + c; if (L >= nwg) return false;
        int wgid = (int)L; { const int q = nwg / 8, r = nwg % 8, xcd = wgid % 8, off = wgid / 8; wgid = (xcd < r ? xcd * (q + 1) : r * (q + 1) + (xcd - r) * q) + off; }
        const int nig = 8 * nN, gid = wgid / nig, fm = gid * 8, gsz = (nM - fm) < 8 ? (nM - fm) : 8;
        const int pm = fm + ((wgid % nig) % gsz), pnl = (wgid % nig) / gsz;
        u.pm = pm; u.pn = blk_exp[pm] * nN + pnl; return true;
    }
    __device__ __forceinline__ void a_ready(const pg8::Unit&) const {}
    __device__ __forceinline__ void done(const pg8::Unit&) const {}
};
struct EpiMoe1 {
    static constexpr bool PERM = true, AFTER_DRAIN = false;
    const float* b1; bf16* ACT;
    __device__ __forceinline__ void operator()(const pg8::f32x4 (&acc)[2][2][4][2], const pg8::Unit& u, int wr, int wc, int fr, int fq) const {
        const int e = u.pn >> 3, pnl = u.pn & 7; const int row0 = u.pm * 256 + wr * 64 + fr, j0 = pnl * 128 + wc * 32 + 8 * fq;
        const float* bg = b1 + (size_t)e * 2048 + j0; const float* bu = bg + 1024;
        const f4 bg0 = *(const f4*)bg, bg1 = *(const f4*)(bg + 4), bu0 = *(const f4*)bu, bu1 = *(const f4*)(bu + 4);
        const float bgv[8] = {bg0.x, bg0.y, bg0.z, bg0.w, bg1.x, bg1.y, bg1.z, bg1.w}, buv[8] = {bu0.x, bu0.y, bu0.z, bu0.w, bu1.x, bu1.y, bu1.z, bu1.w};
#pragma unroll
        for (int ai = 0; ai < 2; ++ai)
#pragma unroll
            for (int m = 0; m < 4; ++m) { float o[8];
#pragma unroll
                for (int e8 = 0; e8 < 8; ++e8) { const int n = e8 >> 2, q = e8 & 3;
                    float g = acc[ai][0][m][n][q] + bgv[e8], up = acc[ai][1][m][n][q] + buv[e8];
                    g = fminf(g, 7.0f); up = fminf(fmaxf(up, -7.0f), 7.0f);
                    o[e8] = g * sigm(1.702f * g) * (up + 1.0f); }
                u4 w; w.x = cvtpk(o[0], o[1]); w.y = cvtpk(o[2], o[3]); w.z = cvtpk(o[4], o[5]); w.w = cvtpk(o[6], o[7]);
                *(u4*)(ACT + (size_t)(row0 + ai * 128 + m * 16) * D + j0) = w; }
    }
};
struct EpiMoe2 {
    static constexpr bool PERM = true, AFTER_DRAIN = false;
    const float* b2; bf16* YS;
    __device__ __forceinline__ void operator()(const pg8::f32x4 (&acc)[2][2][4][2], const pg8::Unit& u, int wr, int wc, int fr, int fq) const {
        const int e = u.pn >> 2, pnl = u.pn & 3; const int row0 = u.pm * 256 + wr * 64 + fr, col0 = pnl * 256 + wc * 32 + 8 * fq;
        f4 bv[2][2];
#pragma unroll
        for (int bj = 0; bj < 2; ++bj)
#pragma unroll
            for (int n = 0; n < 2; ++n) bv[bj][n] = *(const f4*)(b2 + (size_t)e * D + col0 + bj * 128 + 4 * n);
#pragma unroll
        for (int ai = 0; ai < 2; ++ai)
#pragma unroll
            for (int m = 0; m < 4; ++m) { bf16* rowp = YS + (size_t)(row0 + ai * 128 + m * 16) * D + col0;
#pragma unroll
                for (int bj = 0; bj < 2; ++bj) { const pg8::f32x4 v0 = acc[ai][bj][m][0], v1 = acc[ai][bj][m][1];
                    u4 w; w.x = cvtpk(v0[0] + bv[bj][0].x, v0[1] + bv[bj][0].y); w.y = cvtpk(v0[2] + bv[bj][0].z, v0[3] + bv[bj][0].w);
                    w.z = cvtpk(v1[0] + bv[bj][1].x, v1[1] + bv[bj][1].y); w.w = cvtpk(v1[2] + bv[bj][1].z, v1[3] + bv[bj][1].w);
                    __builtin_nontemporal_store(w, (u4*)(rowp + bj * 128)); } }
    }
};

constexpr int QS = 129;
constexpr int QB = 136;
typedef short bf16x8 __attribute__((ext_vector_type(8)));
__device__ __forceinline__ bf16x8 pack_frag(const pg8::f32x4 a, const pg8::f32x4 b) {
    u4 w; w.x = cvtpk(a[0], a[1]); w.y = cvtpk(a[2], a[3]); w.z = cvtpk(b[0], b[1]); w.w = cvtpk(b[2], b[3]); return __builtin_bit_cast(bf16x8, w);
}
__device__ __forceinline__ void phase_p3(Frame& F, const Args& AR) {
    const bf16* P = (const bf16*)(F.ws + WS_P); const float* psm = (const float*)(F.ws + WS_PSM);
    const float* convw = AR.in[6]; const float* a_log = AR.in[7]; const float* dt_bias = AR.in[8];
    LAS bf16* qb = (LAS bf16*)F.lds;
    LAS bf16* kb = qb + 64 * QB;
    LAS float* vs = (LAS float*)(kb + 64 * QB);
    LAS float* Lm = vs + 64 * QS;
    LAS float* betaL = Lm + 2 * 4096;
    LAS float* GL = betaL + 128;
    LAS float* Tm = GL + 128;
    LAS bf16* wb = (LAS bf16*)(Tm + 2048);
    u4 raw[12]; f4 wjv[10]; float braw = 0.f, araw = 0.f, alog_p = 0.f, dtb_p = 0.f;
#define P3_LOAD(unit_) do { const int b_ = (unit_) >> 10, h_ = ((unit_) >> 7) & 7, c_ = (unit_) & 127, t0_ = c_ * 64; const size_t tb_ = (size_t)b_ * SEQ; const int tid_ = F.tid; \
        if (tid_ < 384) { const int cv_ = tid_ % 48, rg_ = tid_ / 48, pcol_ = (cv_ >> 4) * 1024 + h_ * 128 + (cv_ & 15) * 8; \
            _Pragma("unroll") for (int j_ = 0; j_ < 5; ++j_) { wjv[2 * j_] = *(const f4*)(convw + j_ * 3072 + pcol_); wjv[2 * j_ + 1] = *(const f4*)(convw + j_ * 3072 + pcol_ + 4); } \
            _Pragma("unroll") for (int r_ = 0; r_ < 12; ++r_) { const int t_ = t0_ + 8 * rg_ - 2 + r_; raw[r_] = (t_ >= 0 && t_ < SEQ) ? *(const u4*)(P + (tb_ + t_) * PW + pcol_) : (u4){0u, 0u, 0u, 0u}; } } \
        if (tid_ < 128) { const int dir_ = tid_ >> 6, ii_ = tid_ & 63, io_ = dir_ ? 63 - ii_ : ii_; const size_t tok_ = tb_ + t0_ + io_; braw = psm[tok_ * 32 + dir_ * 8 + h_]; araw = psm[tok_ * 32 + 16 + dir_ * 8 + h_]; alog_p = a_log[dir_ * 8 + h_]; dtb_p = dt_bias[dir_ * 8 + h_]; } } while (0)
    if ((int)blockIdx.x < 2 * NH * NCHUNK) P3_LOAD((int)blockIdx.x);
    for (int unit = blockIdx.x; unit < 2 * NH * NCHUNK; unit += F.G) {
        const int b = unit >> 10, h = (unit >> 7) & 7, c = unit & 127;
        int tid = F.tid; asm volatile("" : "+v"(tid));
        const int lane = tid & 63;
        unsigned char* const ubase = F.ws + WS_DD + ((size_t)((b * 8 + h) * 2) * 128) * DD_UNIT;
        if (tid < 384) {
            const int cv = tid % 48, rg = tid / 48, part = cv >> 4, ch = (cv & 15) * 8;
#pragma unroll
            for (int i = 0; i < 8; ++i) { float acc[8];
#pragma unroll
                for (int e = 0; e < 8; ++e) acc[e] = 0.f;
#pragma unroll
                for (int j = 0; j < 5; ++j) { float xin[8]; unpack8(raw[i + j], xin); const f4 w0 = wjv[2 * j], w1 = wjv[2 * j + 1];
                    acc[0] += w0.x * xin[0]; acc[1] += w0.y * xin[1]; acc[2] += w0.z * xin[2]; acc[3] += w0.w * xin[3]; acc[4] += w1.x * xin[4]; acc[5] += w1.y * xin[5]; acc[6] += w1.z * xin[6]; acc[7] += w1.w * xin[7]; }
                float ssq = 0.f;
#pragma unroll
                for (int e = 0; e < 8; ++e) { acc[e] = silu(acc[e]); ssq += acc[e] * acc[e]; }
                ssq += __shfl_xor(ssq, 1); ssq += __shfl_xor(ssq, 2); ssq += __shfl_xor(ssq, 4); ssq += __shfl_xor(ssq, 8);
                if (part == 2) {
#pragma unroll
                    for (int e = 0; e < 8; ++e) vs[(8 * rg + i) * QS + ch + e] = acc[e];
                } else {
                    float sc = 1.0f / sqrtf(ssq + EPS); if (part == 0) sc *= 0.08838834764831845f;
#pragma unroll
                    for (int e = 0; e < 8; ++e) acc[e] *= sc;
                    *(LAS u4*)((part ? kb : qb) + (8 * rg + i) * QB + ch) = pack8(acc); }
            }
        }
        if (tid < 128) {
            const int dir = tid >> 6, ii = lane;
            float g = -expf(alog_p) * softplus(araw + dtb_p);
#pragma unroll
            for (int o = 1; o < 64; o <<= 1) { const float t = __shfl_up(g, o); if (lane >= o) g += t; }
            betaL[dir * 64 + ii] = sigm(braw); GL[dir * 64 + ii] = g;
        }
        if (unit + F.G < 2 * NH * NCHUNK) P3_LOAD(unit + F.G);
        LDS_BARRIER();
        asm volatile("" : "+v"(tid));
        {
            const int w = tid >> 6, dir = w >> 2, mi = w & 3, r = lane & 15, q = lane >> 4;
            const int ipos = 16 * mi + r, io = dir ? 63 - ipos : ipos;
            const float Gi = GL[dir * 64 + ipos], bi = betaL[dir * 64 + ipos];
            bf16x8 ki[4], qi[4];
#pragma unroll
            for (int s = 0; s < 4; ++s) { ki[s] = *(const LAS bf16x8*)(kb + io * QB + 32 * s + 8 * q); qi[s] = *(const LAS bf16x8*)(qb + io * QB + 32 * s + 8 * q); }
            unsigned char* dbase = ubase + ((size_t)dir * 128 + (dir ? 127 - c : c)) * DD_UNIT;
#pragma unroll
            for (int s2 = 0; s2 < 2; ++s2) { float av[8];
#pragma unroll
                for (int t = 0; t < 2; ++t) { const int mj = 2 * s2 + t;
                    if (mj <= mi) {
                        const int jp = 16 * mj + r, jo = dir ? 63 - jp : jp;
                        pg8::f32x4 kk = {0.f, 0.f, 0.f, 0.f}, qk = {0.f, 0.f, 0.f, 0.f};
#pragma unroll
                        for (int s = 0; s < 4; ++s) { const bf16x8 kj = *(const LAS bf16x8*)(kb + jo * QB + 32 * s + 8 * q);
                            kk = __builtin_amdgcn_mfma_f32_16x16x32_bf16(kj, ki[s], kk, 0, 0, 0); qk = __builtin_amdgcn_mfma_f32_16x16x32_bf16(kj, qi[s], qk, 0, 0, 0); }
                        f4 lv;
#pragma unroll
                        for (int jj = 0; jj < 4; ++jj) { const int jpos = 16 * mj + 4 * q + jj; const float dec = __expf(Gi - GL[dir * 64 + jpos]);
                            const float l = (ipos > jpos) ? bi * kk[jj] * dec : 0.f; av[4 * t + jj] = (ipos >= jpos) ? qk[jj] * dec : 0.f;
                            if (jj == 0) lv.x = l; else if (jj == 1) lv.y = l; else if (jj == 2) lv.z = l; else lv.w = l; }
                        *(LAS f4*)(Lm + dir * 4096 + ipos * 64 + 16 * mj + 4 * q) = lv;
                    } else {
#pragma unroll
                        for (int jj = 0; jj < 4; ++jj) av[4 * t + jj] = 0.f;
                    } }
                __builtin_nontemporal_store(pack8(av), (u4*)(dbase + DD_A + (size_t)((mi * 2 + s2) * 64 + lane) * 16)); }
        }
        LDS_BARRIER();
        asm volatile("" : "+v"(tid));
        if (tid < 128) {
            const int dir = tid >> 6, blk = (tid >> 4) & 3, cc = tid & 15;
            const LAS float* Lb = Lm + dir * 4096 + (16 * blk) * 64 + 16 * blk;
            float t[16];
#pragma unroll
            for (int i = 0; i < 16; ++i) { float sv = (i == cc) ? 1.0f : 0.0f;
#pragma unroll
                for (int j = 0; j < i; ++j) sv -= Lb[i * 64 + j] * t[j];
                t[i] = sv; Tm[(dir * 4 + blk) * 256 + i * 16 + cc] = sv; }
        }
        LDS_BARRIER();
        asm volatile("" : "+v"(tid));
        {
            const int w = tid >> 6, dir = w >> 2, g4 = w & 3, n = lane & 15, q = lane >> 4; const bool isw = g4 >= 2;
            const LAS float* Lr = Lm + dir * 4096; const LAS float* Tr = Tm + dir * 1024;
            const f4 z4 = {0.f, 0.f, 0.f, 0.f};
            bf16x8 fT[4], fL10, fL2, fL3a, fL3b;
#pragma unroll
            for (int i = 0; i < 4; ++i) fT[i] = pack_frag(*(const LAS f4*)(Tr + i * 256 + n * 16 + 4 * q), z4);
            fL10 = pack_frag(-*(const LAS f4*)(Lr + (16 + n) * 64 + 4 * q), z4);
            fL2 = pack_frag(-*(const LAS f4*)(Lr + (32 + n) * 64 + 4 * q), -*(const LAS f4*)(Lr + (32 + n) * 64 + 16 + 4 * q));
            fL3a = pack_frag(-*(const LAS f4*)(Lr + (48 + n) * 64 + 4 * q), -*(const LAS f4*)(Lr + (48 + n) * 64 + 16 + 4 * q));
            fL3b = pack_frag(-*(const LAS f4*)(Lr + (48 + n) * 64 + 32 + 4 * q), z4);
            float bE[4][4];
#pragma unroll
            for (int i = 0; i < 4; ++i)
#pragma unroll
                for (int jj = 0; jj < 4; ++jj) { const int row = 16 * i + 4 * q + jj; bE[i][jj] = betaL[dir * 64 + row] * (isw ? __expf(GL[dir * 64 + row]) : 1.0f); }
            unsigned char* dbase = ubase + ((size_t)dir * 128 + (dir ? 127 - c : c)) * DD_UNIT;
#pragma unroll
            for (int e = 0; e < 4; ++e) { const int nt = 4 * g4 + e;
                pg8::f32x4 R[4];
#pragma unroll
                for (int i = 0; i < 4; ++i)
#pragma unroll
                    for (int jj = 0; jj < 4; ++jj) { const int row = 16 * i + 4 * q + jj, io = dir ? 63 - row : row;
                        R[i][jj] = bE[i][jj] * (isw ? bf1(kb[io * QB + 16 * (nt - 8) + n]) : vs[io * QS + 16 * nt + n]); }
                const pg8::f32x4 x0 = __builtin_amdgcn_mfma_f32_16x16x32_bf16(fT[0], pack_frag(R[0], z4), z4, 0, 0, 0);
                const pg8::f32x4 y1 = __builtin_amdgcn_mfma_f32_16x16x32_bf16(fL10, pack_frag(x0, z4), R[1], 0, 0, 0);
                const pg8::f32x4 x1 = __builtin_amdgcn_mfma_f32_16x16x32_bf16(fT[1], pack_frag(y1, z4), z4, 0, 0, 0);
                const bf16x8 x01 = pack_frag(x0, x1);
                const pg8::f32x4 y2 = __builtin_amdgcn_mfma_f32_16x16x32_bf16(fL2, x01, R[2], 0, 0, 0);
                const pg8::f32x4 x2 = __builtin_amdgcn_mfma_f32_16x16x32_bf16(fT[2], pack_frag(y2, z4), z4, 0, 0, 0);
                pg8::f32x4 y3 = __builtin_amdgcn_mfma_f32_16x16x32_bf16(fL3a, x01, R[3], 0, 0, 0);
                y3 = __builtin_amdgcn_mfma_f32_16x16x32_bf16(fL3b, pack_frag(x2, z4), y3, 0, 0, 0);
                const pg8::f32x4 x3 = __builtin_amdgcn_mfma_f32_16x16x32_bf16(fT[3], pack_frag(y3, z4), z4, 0, 0, 0);
                const pg8::f32x4 X[4] = {x0, x1, x2, x3};
                if (!isw) {
#pragma unroll
                    for (int i = 0; i < 4; ++i) { u2 o; o.x = cvtpk(X[i][0], X[i][1]); o.y = cvtpk(X[i][2], X[i][3]); __builtin_nontemporal_store(o, (u2*)(dbase + DD_U + (size_t)((nt * 4 + i) * 64 + lane) * 8)); }
                } else { LAS bf16* wp = wb + dir * 64 * QB + 16 * (nt - 8) + n;
#pragma unroll
                    for (int i = 0; i < 4; ++i)
#pragma unroll
                        for (int jj = 0; jj < 4; ++jj) wp[(16 * i + 4 * q + jj) * QB] = (bf16)f2bf(X[i][jj]); }
            }
        }
        LDS_BARRIER();
        asm volatile("" : "+v"(tid));
#pragma unroll
        for (int it = 0; it < 4; ++it) { const int item = it * NTHR + tid, dir = item >> 10, fidx = (item >> 6) & 15, fl = item & 63, r = fl & 15, q = fl >> 4;
            const int mt = fidx >> 2, s = fidx & 3, pos = 16 * mt + r; const LAS bf16* wr = wb + (dir * 64 + pos) * QB + 32 * s + 4 * q;
            const u2 lo = *(const LAS u2*)wr, hi = *(const LAS u2*)(wr + 16);
            __builtin_nontemporal_store((u4){lo.x, lo.y, hi.x, hi.y}, (u4*)(ubase + ((size_t)dir * 128 + (dir ? 127 - c : c)) * DD_UNIT + DD_W + (size_t)(fidx * 64 + fl) * 16)); }
#pragma unroll
        for (int it = 0; it < 8; ++it) { const int item = it * NTHR + tid, dir = item >> 11, arr = (item >> 10) & 1, fidx = (item >> 6) & 15, fl = item & 63, r = fl & 15, q = fl >> 4;
            unsigned char* dbase = ubase + ((size_t)dir * 128 + (dir ? 127 - c : c)) * DD_UNIT;
            float o[8];
            if (arr == 0) { const int mt = fidx >> 2, s = fidx & 3, pos = 16 * mt + r, io = dir ? 63 - pos : pos; const float f = __expf(GL[dir * 64 + pos]);
                const u2 lo = *(const LAS u2*)(qb + io * QB + 32 * s + 4 * q), hi = *(const LAS u2*)(qb + io * QB + 32 * s + 16 + 4 * q);
                o[0] = bflo(lo.x) * f; o[1] = bfhi(lo.x) * f; o[2] = bflo(lo.y) * f; o[3] = bfhi(lo.y) * f; o[4] = bflo(hi.x) * f; o[5] = bfhi(hi.x) * f; o[6] = bflo(hi.y) * f; o[7] = bfhi(hi.y) * f;
                __builtin_nontemporal_store(pack8(o), (u4*)(dbase + DD_Q + (size_t)(fidx * 64 + fl) * 16));
            } else { const int m = fidx >> 1, s2 = fidx & 1, dk = 16 * m + r; const float gl = GL[dir * 64 + 63];
#pragma unroll
                for (int j = 0; j < 8; ++j) { const int pos = 32 * s2 + (j < 4 ? 4 * q + j : 16 + 4 * q + j - 4), io = dir ? 63 - pos : pos; o[j] = bf1(kb[io * QB + dk]) * __expf(gl - GL[dir * 64 + pos]); }
                __builtin_nontemporal_store(pack8(o), (u4*)(dbase + DD_K + (size_t)(fidx * 64 + fl) * 16)); } }
        if (tid < 2) ((float*)(F.ws + WS_GL))[((b * 8 + h) * 2 + tid) * 128 + (tid ? 127 - c : c)] = __expf(GL[tid * 64 + 63]);
        LDS_BARRIER();
    }
#undef P3_LOAD
}

constexpr int P4_BUF = 61440;
__device__ __forceinline__ void phase_p4(Frame& F, const Args& AR) {
    volatile LAS int* uq = (volatile LAS int*)(F.lds + LDS_TAB + 4096);
    unsigned* qctr = (unsigned*)(F.ws + WS_CTL) + CW_Q;
    const unsigned myx = xb_xcc_id() & 7u;
    for (;;) {
        __syncthreads();
        if (F.tid == 0) { int got = -1;
            for (unsigned t = 0; t < 8 && got < 0; ++t) { const unsigned x = (myx + t) & 7u; const unsigned sl = __hip_atomic_fetch_add(qctr + 64 * x, 1u, __ATOMIC_RELAXED, __HIP_MEMORY_SCOPE_AGENT); if (sl < 16u) got = (int)(x * 16u + sl); }
            uq[0] = got; }
        __syncthreads();
        const int unit = uq[0];
        if (unit < 0) break;
        const int chain = unit >> 2, pair = unit & 3, dir = chain & 1, bh = chain >> 1, b = bh >> 3, h = bh & 7;
        const unsigned char* cbase = F.ws + WS_DD + (size_t)chain * 128 * DD_UNIT;
        __syncthreads();
        if (F.wave >= 2) {
            const int l = F.tid - 128; u4 ra[10], rb[10], rc[10];
#define P4_SRC(step, i) ((const u4*)(cbase + (size_t)(step) * DD_UNIT + (((i) * 384 + l) < 3584 ? (size_t)((i) * 384 + l) * 16 : (size_t)DD_U + (size_t)pair * 4096 + (size_t)((i) * 384 + l - 3584) * 16)))
#define P4_LD(R, step) do { const int st_ = (step) < NCHUNK ? (step) : NCHUNK - 1; _Pragma("unroll") for (int i = 0; i < 10; ++i) R[i] = *P4_SRC(st_, i); } while (0)
#define P4_ST(R, step) do { _Pragma("unroll") for (int i = 0; i < 10; ++i) *(LAS u4*)(F.lds + ((step) & 1) * P4_BUF + (size_t)(i * 384 + l) * 16) = R[i]; } while (0)
            P4_LD(ra, 0); P4_ST(ra, 0);
            P4_LD(ra, 1); P4_LD(rb, 2); P4_LD(rc, 3);
            asm volatile("s_waitcnt lgkmcnt(0)" ::: "memory"); __builtin_amdgcn_s_barrier(); asm volatile("" ::: "memory");
            for (int k = 0; k < 129; k += 3) {
                P4_ST(ra, k + 1); P4_LD(ra, k + 4);
                asm volatile("s_waitcnt lgkmcnt(0)" ::: "memory"); __builtin_amdgcn_s_barrier(); asm volatile("" ::: "memory");
                P4_ST(rb, k + 2); P4_LD(rb, k + 5);
                asm volatile("s_waitcnt lgkmcnt(0)" ::: "memory"); __builtin_amdgcn_s_barrier(); asm volatile("" ::: "memory");
                P4_ST(rc, k + 3); P4_LD(rc, k + 6);
                asm volatile("s_waitcnt lgkmcnt(0)" ::: "memory"); __builtin_amdgcn_s_barrier(); asm volatile("" ::: "memory");
            }
#undef P4_SRC
#undef P4_LD
#undef P4_ST
        } else {
            const int lane = F.lane, r = lane & 15, q = lane >> 4, sl = 2 * pair + F.wave;
            const float* glp = (const float*)(F.ws + WS_GL) + chain * 128;
            bf16* od = (bf16*)(F.ws + WS_OD) + (size_t)dir * NTOK * D + (size_t)b * SEQ * D + h * 128 + 16 * sl + 4 * q;
            pg8::f32x4 S[8]; bf16x8 SB[4];
#pragma unroll
            for (int m = 0; m < 8; ++m) S[m] = (pg8::f32x4){0.f, 0.f, 0.f, 0.f};
#pragma unroll
            for (int s = 0; s < 4; ++s) SB[s] = (bf16x8){0, 0, 0, 0, 0, 0, 0, 0};
            const float glv0 = glp[lane], glv1 = glp[64 + lane];
            asm volatile("s_waitcnt lgkmcnt(0)" ::: "memory"); __builtin_amdgcn_s_barrier(); asm volatile("" ::: "memory");
            for (int k = 0; k < NCHUNK; ++k) {
                const LAS unsigned char* bp = F.lds + (k & 1) * P4_BUF + lane * 16;
                const float egl = __builtin_bit_cast(float, __builtin_amdgcn_readlane(__builtin_bit_cast(int, k < 64 ? glv0 : glv1), k & 63));
                pg8::f32x4 WS[4], OT[4];
#pragma unroll
                for (int mt = 0; mt < 4; ++mt) { WS[mt] = (pg8::f32x4){0.f, 0.f, 0.f, 0.f}; OT[mt] = (pg8::f32x4){0.f, 0.f, 0.f, 0.f}; }
#pragma unroll
                for (int mt = 0; mt < 4; ++mt)
#pragma unroll
                    for (int s = 0; s < 4; ++s) WS[mt] = __builtin_amdgcn_mfma_f32_16x16x32_bf16(*(const LAS bf16x8*)(bp + (mt * 4 + s) * 1024), SB[s], WS[mt], 0, 0, 0);
#pragma unroll
                for (int mt = 0; mt < 4; ++mt)
#pragma unroll
                    for (int s = 0; s < 4; ++s) OT[mt] = __builtin_amdgcn_mfma_f32_16x16x32_bf16(SB[s], *(const LAS bf16x8*)(bp + 16384 + (mt * 4 + s) * 1024), OT[mt], 0, 0, 0);
                pg8::f32x4 vn[4];
#pragma unroll
                for (int mt = 0; mt < 4; ++mt) { const u2 uu = *(const LAS u2*)(F.lds + (k & 1) * P4_BUF + 57344 + (F.wave * 4 + mt) * 512 + lane * 8);
                    vn[mt] = (pg8::f32x4){bflo(uu.x) - WS[mt][0], bfhi(uu.x) - WS[mt][1], bflo(uu.y) - WS[mt][2], bfhi(uu.y) - WS[mt][3]}; }
                bf16x8 VB[2]; VB[0] = pack_frag(vn[0], vn[1]); VB[1] = pack_frag(vn[2], vn[3]);
#pragma unroll
                for (int mt = 0; mt < 4; ++mt)
#pragma unroll
                    for (int s2 = 0; s2 < 2; ++s2) OT[mt] = __builtin_amdgcn_mfma_f32_16x16x32_bf16(VB[s2], *(const LAS bf16x8*)(bp + 49152 + (mt * 2 + s2) * 1024), OT[mt], 0, 0, 0);
#pragma unroll
                for (int m = 0; m < 8; ++m) { S[m] = S[m] * egl;
#pragma unroll
                    for (int s2 = 0; s2 < 2; ++s2) S[m] = __builtin_amdgcn_mfma_f32_16x16x32_bf16(*(const LAS bf16x8*)(bp + 32768 + (m * 2 + s2) * 1024), VB[s2], S[m], 0, 0, 0); }
#pragma unroll
                for (int s = 0; s < 4; ++s) SB[s] = pack_frag(S[2 * s], S[2 * s + 1]);
                const int co = dir ? 127 - k : k;
#pragma unroll
                for (int mt = 0; mt < 4; ++mt) { const int pos = 16 * mt + r, ro = dir ? 63 - pos : pos;
                    u2 ov; ov.x = cvtpk(OT[mt][0], OT[mt][1]); ov.y = cvtpk(OT[mt][2], OT[mt][3]);
                    *(u2*)(od + (size_t)(co * 64 + ro) * D) = ov; }
                asm volatile("s_waitcnt lgkmcnt(0)" ::: "memory"); __builtin_amdgcn_s_barrier(); asm volatile("" ::: "memory");
            }
            __builtin_amdgcn_s_barrier();
        }
        __syncthreads();
    }
    {
        __syncthreads();
        if (F.tid == 0) uq[0] = (int)__hip_atomic_fetch_add((unsigned*)(F.ws + WS_CTL) + CW_RANK, 1u, __ATOMIC_RELAXED, __HIP_MEMORY_SCOPE_AGENT);
        __syncthreads();
        const int rank = uq[0];
        pg8::Gemm g{(const bf16*)(F.ws + WS_SB), (const bf16*)(F.ws + WS_WUO_T) + (size_t)1024 * 1024, NTOK, D, D}; pg8::StaticOrder S; S.init(NTOK, D, 128, rank); if (rank >= 128) S.nwg = 0;
        EpiGate E{(const bf16*)(F.ws + WS_P), (float*)(F.ws + WS_M1X), (bf16*)nullptr, PC_GB, 0};
        pg8::gemm_phase<EpiGate, pg8::StaticOrder, true, true>((PG8_LAS unsigned char*)F.lds, g, S, E);
        __syncthreads();
    }
    moe_convert(F, AR);
}

__device__ __forceinline__ void phase_p5_sb(Frame& F, const Args& AR) {
    const bf16* P = (const bf16*)(F.ws + WS_P); bf16* sbp = (bf16*)(F.ws + WS_SB);
    const float* convs = AR.in[11];
    const int lane = F.lane, ch = 16 * lane;
    float cw[3][16];
#pragma unroll
    for (int e = 0; e < 16; ++e)
#pragma unroll
        for (int j = 0; j < 3; ++j) cw[j][e] = convs[j * 1024 + ch + e];
    const int gw = blockIdx.x * NWAVES + F.wave, NGW = F.G * NWAVES;
    for (int m = gw; m < NTOK; m += NGW) {
        const int t = m & (SEQ - 1);
        float acc[16], r[8];
#pragma unroll
        for (int e = 0; e < 16; ++e) acc[e] = 0.f;
#pragma unroll
        for (int j = 0; j < 3; ++j) { const int tt = t + j - 1;
            if (tt >= 0 && tt < SEQ) { const bf16* rowp = P + (size_t)(m + j - 1) * PW; float cg[8], ui[8];
                unpack8(*(const u4*)(rowp + PC_CG + ch), cg); unpack8(*(const u4*)(rowp + PC_UI + ch), ui);
#pragma unroll
                for (int e = 0; e < 8; ++e) acc[e] += cw[j][e] * (cg[e] * ui[e]);
                unpack8(*(const u4*)(rowp + PC_CG + ch + 8), cg); unpack8(*(const u4*)(rowp + PC_UI + ch + 8), ui);
#pragma unroll
                for (int e = 0; e < 8; ++e) acc[8 + e] += cw[j][8 + e] * (cg[e] * ui[e]); } }
        float bg[8];
        unpack8(*(const u4*)(P + (size_t)m * PW + PC_BG + ch), bg);
#pragma unroll
        for (int e = 0; e < 8; ++e) r[e] = bg[e] * acc[e];
        *(u4*)(sbp + (size_t)m * D + ch) = pack8(r);
        unpack8(*(const u4*)(P + (size_t)m * PW + PC_BG + ch + 8), bg);
#pragma unroll
        for (int e = 0; e < 8; ++e) r[e] = bg[e] * acc[8 + e];
        *(u4*)(sbp + (size_t)m * D + ch + 8) = pack8(r);
    }
}
__device__ __forceinline__ void phase_p5(Frame& F, const Args& AR) {
    const bf16* P = (const bf16*)(F.ws + WS_P); const bf16* od = (const bf16*)(F.ws + WS_OD); bf16* oap = (bf16*)(F.ws + WS_OASB);
    const float* onorm_w = AR.in[9];
    const int lane = F.lane, ch = 16 * lane;
    float onw[16];
#pragma unroll
    for (int e = 0; e < 16; ++e) onw[e] = onorm_w[(ch + e) & 127];
    const int gw = blockIdx.x * NWAVES + F.wave, NGW = F.G * NWAVES;
    for (int m = gw; m < NTOK; m += NGW) {
        float o[16], z[16], t8[8];
        unpack8(*(const u4*)(od + (size_t)m * D + ch), t8);
#pragma unroll
        for (int e = 0; e < 8; ++e) o[e] = t8[e];
        unpack8(*(const u4*)(od + (size_t)m * D + ch + 8), t8);
#pragma unroll
        for (int e = 0; e < 8; ++e) o[8 + e] = t8[e];
        unpack8(*(const u4*)(od + (size_t)(NTOK + m) * D + ch), t8);
#pragma unroll
        for (int e = 0; e < 8; ++e) o[e] += t8[e];
        unpack8(*(const u4*)(od + (size_t)(NTOK + m) * D + ch + 8), t8);
#pragma unroll
        for (int e = 0; e < 8; ++e) o[8 + e] += t8[e];
        unpack8(*(const u4*)(P + (size_t)m * PW + PC_Z + ch), t8);
#pragma unroll
        for (int e = 0; e < 8; ++e) z[e] = t8[e];
        unpack8(*(const u4*)(P + (size_t)m * PW + PC_Z + ch + 8), t8);
#pragma unroll
        for (int e = 0; e < 8; ++e) z[8 + e] = t8[e];
        float ss = 0.f;
#pragma unroll
        for (int e = 0; e < 16; ++e) ss += o[e] * o[e];
        ss += __shfl_xor(ss, 1); ss += __shfl_xor(ss, 2); ss += __shfl_xor(ss, 4);
        const float rstd = 1.0f / sqrtf(ss * (1.0f / 128.0f) + EPS);
        float r[8];
#pragma unroll
        for (int e = 0; e < 8; ++e) r[e] = o[e] * rstd * onw[e] * silu(z[e]);
        *(u4*)(oap + (size_t)m * D + ch) = pack8(r);
#pragma unroll
        for (int e = 0; e < 8; ++e) r[e] = o[8 + e] * rstd * onw[8 + e] * silu(z[8 + e]);
        *(u4*)(oap + (size_t)m * D + ch + 8) = pack8(r);
    }
}

constexpr int P7_MAXIT = 16;
__device__ __forceinline__ void phase_p7(Frame& F, const Args& AR) {
    const float* x1 = (const float*)(F.ws + WS_OD); const float* norm2_w = AR.in[14]; const float* router_b = AR.in[16]; const float* mod = (const float*)(F.ws + WS_MOD);
    LAS float* WtL = (LAS float*)F.lds;
    LAS float* A1 = (LAS float*)(F.lds + 131584);
    LAS float* B1 = A1 + 2048;
    stage_wt(WtL, (const float*)(F.ws + WS_WR_T), F.tid);
    for (int idx = F.tid; idx < 2048; idx += NTHR) { const int b = idx >> 10, k = idx & 1023; A1[idx] = norm2_w[k] * (1.0f + mod[b * 6144 + 4096 + k]); B1[idx] = mod[b * 6144 + 3072 + k]; }
    LAS unsigned* lcnt = (LAS unsigned*)(B1 + 2048);
    LAS unsigned* rec = lcnt + 64;
    if (F.tid < 64) lcnt[F.tid] = 0u;
    __syncthreads();
    bf16* h2 = (bf16*)(F.ws + WS_H); int* topi = (int*)(F.ws + WS_TOPI); float* topg = (float*)(F.ws + WS_TOPG); int* topp = (int*)(F.ws + WS_TOPP);
    unsigned* cnt = (unsigned*)(F.ws + WS_CTL) + CW_CNT; int* elist = (int*)(F.ws + WS_LIST);
    const int lane = F.lane; const float rb = router_b[lane >> 1];
    const int gw = blockIdx.x * NWAVES + F.wave, NGW = F.G * NWAVES;
    int it = 0;
    for (int m = gw; m < NTOK; m += NGW, ++it) {
        const f4* xr = (const f4*)(x1 + (size_t)m * D) + lane; f4 v[4]; float ss = 0.f;
#pragma unroll
        for (int j = 0; j < 4; ++j) { v[j] = xr[64 * j]; ss += (v[j].x * v[j].x + v[j].y * v[j].y) + (v[j].z * v[j].z + v[j].w * v[j].w); }
        const float rstd = 1.0f / sqrtf(wave_sum(ss) * (1.0f / D) + EPS);
        const int b = m >> 13;
#pragma unroll
        for (int j = 0; j < 4; ++j) { const f4 a = *(const LAS f4*)(A1 + b * 1024 + 256 * j + 4 * lane), bb = *(const LAS f4*)(B1 + b * 1024 + 256 * j + 4 * lane);
            v[j] = v[j] * rstd * a + bb;
            u2 o; o.x = pk2(v[j].x, v[j].y); o.y = pk2(v[j].z, v[j].w); ((u2*)(h2 + (size_t)m * D))[lane + 64 * j] = o; }
        float val = dot32(v, WtL, lane) + rb; const int myn = lane >> 1;
        float tv[4]; int ti[4];
#pragma unroll
        for (int r = 0; r < 4; ++r) { float bv = val; int bi = myn;
#pragma unroll
            for (int o = 1; o < 64; o <<= 1) { const float ov = __shfl_xor(bv, o); const int oi = __shfl_xor(bi, o); if (ov > bv || (ov == bv && oi < bi)) { bv = ov; bi = oi; } }
            tv[r] = bv; ti[r] = bi; if (myn == bi) val = -__builtin_inff(); }
        const float e1 = __expf(tv[1] - tv[0]), e2 = __expf(tv[2] - tv[0]), e3 = __expf(tv[3] - tv[0]), inv = 1.0f / (1.0f + e1 + e2 + e3);
        if (lane < 4) { const int e = lane == 0 ? ti[0] : (lane == 1 ? ti[1] : (lane == 2 ? ti[2] : ti[3]));
            const float g = (lane == 0 ? 1.0f : (lane == 1 ? e1 : (lane == 2 ? e2 : e3))) * inv;
            topi[(size_t)m * 4 + lane] = e; topg[(size_t)m * 4 + lane] = g;
            if (it < P7_MAXIT) { const unsigned lp = __hip_atomic_fetch_add(lcnt + e, 1u, __ATOMIC_RELAXED, __HIP_MEMORY_SCOPE_WORKGROUP); rec[(F.wave * P7_MAXIT + it) * 4 + lane] = (unsigned)e | (lp << 8); }
            else { const unsigned pos = __hip_atomic_fetch_add(cnt + 64 * e, 1u, __ATOMIC_RELAXED, __HIP_MEMORY_SCOPE_AGENT); topp[(size_t)m * 4 + lane] = (int)pos; elist[e * 16384 + pos] = m; } }
    }
    __syncthreads();
    if (F.tid < 32) lcnt[32 + F.tid] = __hip_atomic_fetch_add(cnt + 64 * F.tid, lcnt[F.tid], __ATOMIC_RELAXED, __HIP_MEMORY_SCOPE_AGENT);
    __syncthreads();
    { int it = 0;
        for (int m = gw; m < NTOK && it < P7_MAXIT; m += NGW, ++it)
            if (lane < 4) { const unsigned rc = rec[(F.wave * P7_MAXIT + it) * 4 + lane]; const unsigned e = rc & 255u, pos = lcnt[32 + e] + (rc >> 8); topp[(size_t)m * 4 + lane] = (int)pos; elist[e * 16384 + pos] = m; } }
}

__device__ __forceinline__ int build_moe_tables(Frame& F, LAS int* tab  ) {
    const unsigned* cnt = (const unsigned*)(F.ws + WS_CTL) + CW_CNT;
    if (F.tid == 0) { int start = 0;
        for (int e = 0; e < NEXP; ++e) { const int n = (int)__hip_atomic_load(cnt + 64 * e, __ATOMIC_RELAXED, __HIP_MEMORY_SCOPE_AGENT); const int nb = (n + 255) >> 8; tab[e] = start * 256; tab[512 + e] = n;
            for (int k = 0; k < nb; ++k) tab[64 + start + k] = e; start += nb; }
        tab[32] = start; }
    __syncthreads();
    return tab[32];
}

__device__ __forceinline__ void phase_p9(Frame& F, const Args& AR, float* out) {
    const float* x1 = (const float*)(F.ws + WS_OD); const bf16* ys = (const bf16*)(F.ws + WS_YS); const float* mod = (const float*)(F.ws + WS_MOD); const float* fnw = AR.in[21];
    const float* topg = (const float*)(F.ws + WS_TOPG); const int* topp = (const int*)(F.ws + WS_TOPP); const int* topi = (const int*)(F.ws + WS_TOPI);
    LAS int* tab = (LAS int*)(F.lds + LDS_TAB); build_moe_tables(F, tab);
    const int lane = F.lane;
    const int gw = blockIdx.x * NWAVES + F.wave, NGW = F.G * NWAVES;
    for (int m = gw; m < NTOK; m += NGW) {
        const int b = m >> 13;
        const f4 gk = *(const f4*)(topg + (size_t)m * 4); const int r0 = tab[topi[(size_t)m * 4]] + topp[(size_t)m * 4], r1 = tab[topi[(size_t)m * 4 + 1]] + topp[(size_t)m * 4 + 1], r2 = tab[topi[(size_t)m * 4 + 2]] + topp[(size_t)m * 4 + 2], r3 = tab[topi[(size_t)m * 4 + 3]] + topp[(size_t)m * 4 + 3];
        f4 v[4]; float ss = 0.f;
#pragma unroll
        for (int j = 0; j < 4; ++j) {
            const u2 y0 = __builtin_nontemporal_load((const u2*)(ys + (size_t)r0 * D) + lane + 64 * j), y1 = __builtin_nontemporal_load((const u2*)(ys + (size_t)r1 * D) + lane + 64 * j), y2 = __builtin_nontemporal_load((const u2*)(ys + (size_t)r2 * D) + lane + 64 * j), y3 = __builtin_nontemporal_load((const u2*)(ys + (size_t)r3 * D) + lane + 64 * j);
            f4 mo;
            mo.x = gk.x * bflo(y0.x) + gk.y * bflo(y1.x) + gk.z * bflo(y2.x) + gk.w * bflo(y3.x);
            mo.y = gk.x * bfhi(y0.x) + gk.y * bfhi(y1.x) + gk.z * bfhi(y2.x) + gk.w * bfhi(y3.x);
            mo.z = gk.x * bflo(y0.y) + gk.y * bflo(y1.y) + gk.z * bflo(y2.y) + gk.w * bflo(y3.y);
            mo.w = gk.x * bfhi(y0.y) + gk.y * bfhi(y1.y) + gk.z * bfhi(y2.y) + gk.w * bfhi(y3.y);
            const f4 xv = ((const f4*)(x1 + (size_t)m * D))[lane + 64 * j], gt = ((const f4*)(mod + b * 6144 + 5120))[lane + 64 * j];
            v[j] = xv + gt * mo; ss += (v[j].x * v[j].x + v[j].y * v[j].y) + (v[j].z * v[j].z + v[j].w * v[j].w); }
        const float rstd = 1.0f / sqrtf(wave_sum(ss) * (1.0f / D) + EPS);
#pragma unroll
        for (int j = 0; j < 4; ++j) { const f4 w = ((const f4*)fnw)[lane + 64 * j]; __builtin_nontemporal_store(v[j] * rstd * w, (f4*)(out + (size_t)m * D) + lane + 64 * j); }
    }
}

__global__ void __launch_bounds__(NTHR, 2) fwd_kernel(Args args) {
    const Args& AR = args;
    extern __shared__ __attribute__((aligned(16))) unsigned char lds_raw[];
    Frame F;
    F.lds = (LAS unsigned char*)lds_raw;
    F.tid = threadIdx.x; F.lane = F.tid & 63; F.wave = __builtin_amdgcn_readfirstlane(F.tid >> 6); F.G = gridDim.x;
    F.ws = args.ws;
    volatile LAS unsigned* misc = (volatile LAS unsigned*)(F.lds + LDS_MISC);
    if (F.tid < 4) misc[F.tid] = 0u;
    __syncthreads();
    XcdBarrier bar; bar.bar = (unsigned*)(F.ws + WS_CTL) + CW_BAR; bar.x = 0; bar.st = nullptr;
    if (MK_N_LAUNCHES == 1) bar = xcd_barrier_post((unsigned*)(F.ws + WS_CTL) + CW_BAR, misc);
    const int lo = args.ph_lo, hi = args.ph_hi;
#ifndef PH_MASK
#define PH_MASK 0x1fff
#endif
#define IN(k) (((PH_MASK >> (k)) & 1) && lo <= (k) && (k) < hi)
#ifndef PROBE_PH
#define PROBE_PH -1
#define PROBE_REP 1
#endif
#define REPS(k) for (int rep_ = 0; rep_ < ((k) == PROBE_PH ? PROBE_REP : 1); ++rep_)
#define SEAM(k) do { if (IN(k) && IN((k) + 1)) xcd_barrier(bar); } while (0)
    PG8_LAS unsigned char* glds = (PG8_LAS unsigned char*)lds_raw;

    if (IN(0)) REPS(0) { phase_p0(F, AR); } SEAM(0);
    if (IN(1)) REPS(1) { phase_p1(F, AR); } SEAM(1);
    if (IN(2)) REPS(2) {
        pg8::Gemm g{(const bf16*)(F.ws + WS_H), (const bf16*)(F.ws + WS_WIN_T), NTOK, PW, D}; pg8::StaticOrder S; S.init(NTOK, PW, F.G, (int)blockIdx.x);
        EpiStoreBf16 E{(bf16*)(F.ws + WS_P), PW};
        pg8::gemm_phase<EpiStoreBf16, pg8::StaticOrder, true, true>(glds, g, S, E);
    } SEAM(2);
    if (IN(3)) REPS(3) { phase_p3(F, AR); __syncthreads(); phase_p5_sb(F, AR); } SEAM(3);
    if (IN(4)) REPS(4) { phase_p4(F, AR); } SEAM(4);
    if (IN(5)) REPS(5) { phase_p5(F, AR); } SEAM(5);
    if (IN(6)) REPS(6) {
        pg8::Gemm g{(const bf16*)(F.ws + WS_OASB), (const bf16*)(F.ws + WS_WUO_T), NTOK, D, D}; pg8::StaticOrder S; S.init(NTOK, D, F.G, (int)blockIdx.x);
        EpiGate E{(const bf16*)(F.ws + WS_P), (float*)(F.ws + WS_M1X), (bf16*)(F.ws + WS_M), PC_GA, 1};
        pg8::gemm_phase<EpiGate, pg8::StaticOrder, true, true>(glds, g, S, E);
    } SEAM(6);
    if (IN(7)) REPS(7) {
        pg8::Gemm g{(const bf16*)(F.ws + WS_M), (const bf16*)(F.ws + WS_WO_T), NTOK, D, D}; pg8::StaticOrder S; S.init(NTOK, D, F.G, (int)blockIdx.x);
        EpiG4 E{AR.in[0], (const float*)(F.ws + WS_MOD), (float*)(F.ws + WS_OD)};
        pg8::gemm_phase<EpiG4, pg8::StaticOrder, true, true>(glds, g, S, E);
    } SEAM(7);
    if (IN(8)) REPS(8) { phase_p7(F, AR); } SEAM(8);
    if (IN(9)) REPS(9) {
        __syncthreads();
        LAS int* tab = (LAS int*)(F.lds + LDS_TAB); const int nblk = build_moe_tables(F, tab);
        pg8::Gemm g{(const bf16*)(F.ws + WS_H), (const bf16*)(F.ws + WS_W1T), NTOK, NEXP * 2048, D}; MoeOrder S; S.init(nblk, 8, F.G, (int)blockIdx.x, tab, (const int*)(F.ws + WS_LIST));
        EpiMoe1 E{AR.in[18], (bf16*)(F.ws + WS_ACT)};
        pg8::gemm_phase<EpiMoe1, MoeOrder, true, true, true>(glds, g, S, E);
    } SEAM(9);
    if (IN(10)) REPS(10) {
        __syncthreads();
        LAS int* tab = (LAS int*)(F.lds + LDS_TAB); const int nblk = build_moe_tables(F, tab);
        pg8::Gemm g{(const bf16*)(F.ws + WS_ACT), (const bf16*)(F.ws + WS_W2T), MROWS, NEXP * 1024, D}; MoeOrder S; S.init(nblk, 4, F.G, (int)blockIdx.x, tab, (const int*)(F.ws + WS_LIST));
        EpiMoe2 E{AR.in[20], (bf16*)(F.ws + WS_YS)};
        pg8::gemm_phase<EpiMoe2, MoeOrder, true, true>(glds, g, S, E);
    } SEAM(10);
    if (IN(11)) REPS(11) { phase_p9(F, AR, args.out); }
#undef IN
#undef SEAM
}

extern "C" void kernel_launch(void* const* d_in, const int* in_sizes, int n_in, void* d_out, int out_size, void* d_ws, size_t ws_size, hipStream_t stream) {
    static int grid = 0;
    if (grid == 0) {
        if (n_in != 22 || out_size != NTOK * D || ws_size < WS_END) { fprintf(stderr, "kernel_launch: unexpected shapes (n_in %d out %d ws %zu)\n", n_in, out_size, ws_size); grid = -1; return; }
        int dev = 0, cus = 0, per_cu = 0;
        if (hipGetDevice(&dev) != hipSuccess || hipDeviceGetAttribute(&cus, hipDeviceAttributeMultiprocessorCount, dev) != hipSuccess) { grid = -1; return; }
        if (hipFuncSetAttribute((const void*)fwd_kernel, hipFuncAttributeMaxDynamicSharedMemorySize, LDS_BYTES) != hipSuccess) { fprintf(stderr, "kernel_launch: hipFuncSetAttribute failed\n"); grid = -1; return; }
        if (hipOccupancyMaxActiveBlocksPerMultiprocessor(&per_cu, (const void*)fwd_kernel, NTHR, LDS_BYTES) != hipSuccess || per_cu < 1) { fprintf(stderr, "kernel_launch: occupancy query says %d\n", per_cu); }
        (void)hipGetLastError();
        grid = cus;
        if (grid > 256) grid = 256;
    }
    if (grid < 0) return;
    if (hipMemsetAsync((char*)d_ws + WS_CTL, 0, CTL_ZERO_BYTES, stream) != hipSuccess) return;
    Args a{};
    for (int i = 0; i < 22; ++i) a.in[i] = (const float*)d_in[i];
    a.out = (float*)d_out; a.ws = (unsigned char*)d_ws;
#if MK_N_LAUNCHES == 1
    a.ph_lo = 0; a.ph_hi = NPHASE;
    hipLaunchKernelGGL(fwd_kernel, dim3(grid), dim3(NTHR), LDS_BYTES, stream, a);
#else
    for (int ph = 0; ph < NPHASE; ++ph) { a.ph_lo = ph; a.ph_hi = ph + 1; hipLaunchKernelGGL(fwd_kernel, dim3(grid), dim3(NTHR), LDS_BYTES, stream, a); }
#endif
}
```

```cpp
#include <hip/hip_runtime.h>
#include <cstdio>
#include <cstdint>
namespace pg8 {
#define PG8_LAS __attribute__((address_space(3)))
typedef unsigned short bf16_t;
typedef short bf16x8 __attribute__((ext_vector_type(8)));
typedef float f32x4 __attribute__((ext_vector_type(4)));
typedef unsigned u32x4 __attribute__((ext_vector_type(4)));
constexpr int BM = 256, BK = 64, HALF = 128, HTB = HALF * BK * 2  , STAGE_BYTES = 8 * HTB, NXCD = 8, WGM = 8;

__host__ __device__ __forceinline__ int lds_byte(int r, int c) { const int st = (r >> 4) * 2 + (c >> 5), rr = r & 15, cc = c & 31, ob = rr * 64 + cc * 2; return st * 1024 + (ob ^ (((ob >> 9) & 1) << 5)); }
__host__ __device__ __forceinline__ void stage_rc(int b, int& R, int& C) { const int st = b / 1024, sb = b % 1024, swz = sb ^ (((sb >> 9) & 1) << 5); R = (st >> 1) * 16 + swz / 64; C = (st & 1) * 32 + (swz % 64) / 2; }
__host__ __device__ __forceinline__ int perm32(int rho) { const int n = rho >> 4, i = rho & 15; return 8 * (i >> 2) + 4 * n + (i & 3); }

struct Unit { int pm, pn; };
struct Gemm { const bf16_t* A; const bf16_t* Bt; int M, N, K; };

struct StaticOrder {
    int nM, nN, nwg, G, c;
    __host__ __device__ void init(int M, int N, int G_, int c_) { nM = M / BM; nN = N / BM; nwg = nM * nN; G = G_; c = c_; }
    __host__ __device__ bool next(int i, Unit& u) const {
        const long L = (long)i * G + c; if (L >= nwg) return false;
        int wgid = (int)L; { const int q = nwg / NXCD, r = nwg % NXCD, xcd = wgid % NXCD, off = wgid / NXCD; wgid = (xcd < r ? xcd * (q + 1) : r * (q + 1) + (xcd - r) * q) + off; }
        const int nig = WGM * nN, gid = wgid / nig, fm = gid * WGM, gsz = (nM - fm) < WGM ? (nM - fm) : WGM;
        u.pm = fm + ((wgid % nig) % gsz); u.pn = (wgid % nig) / gsz; return true;
    }
    __device__ __forceinline__ void a_ready(const Unit&) const {}
    __device__ __forceinline__ void done(const Unit&) const {}
};

__device__ __forceinline__ unsigned cvt_pk_bf16(float lo, float hi) { unsigned r; asm volatile("v_cvt_pk_bf16_f32 %0, %1, %2" : "=v"(r) : "v"(lo), "v"(hi)); return r; }
template <class Epi, class Sched, bool ALIGN_EPI = false, bool SP2 = false, bool GATHER = false>
__device__ __forceinline__ void gemm_phase(PG8_LAS unsigned char* lds, const Gemm g, const Sched& S, const Epi& E) {
    const int tid = threadIdx.x, wid = __builtin_amdgcn_readfirstlane(tid >> 6), lane = tid & 63, wr = wid >> 2, wc = wid & 3, fr = lane & 15, fq = lane >> 4;
    const int K = g.K, nt = K / BK;
    unsigned voffA[2], voffB[2];
#pragma unroll
    for (int i = 0; i < 2; ++i) { int R, C; stage_rc(tid * 16 + i * 8192, R, C); const int Rb = Epi::PERM ? ((R & ~31) + perm32(R & 31)) : R;
        voffA[i] = (unsigned)(R * K + C) * 2u; voffB[i] = (unsigned)(Rb * K + C) * 2u; }
    unsigned vA[2][2], vN[2][2];
#pragma unroll
    for (int h = 0; h < 2; ++h)
#pragma unroll
        for (int i = 0; i < 2; ++i) { vA[h][i] = voffA[i] + (unsigned)(h * HALF * K * 2); vN[h][i] = vA[h][i]; }
#define PG8_TOKS(u, tq) do { _Pragma("unroll") for (int _h = 0; _h < 2; ++_h) _Pragma("unroll") for (int _i = 0; _i < 2; ++_i) { int _R, _C; stage_rc(tid * 16 + _i * 8192, _R, _C); tq[_h][_i] = S.row_token(u, _h * HALF + _R); } } while (0)
#define PG8_OFFS(tq, v) do { _Pragma("unroll") for (int _h = 0; _h < 2; ++_h) _Pragma("unroll") for (int _i = 0; _i < 2; ++_i) { int _R, _C; stage_rc(tid * 16 + _i * 8192, _R, _C); v[_h][_i] = (unsigned)(tq[_h][_i] * K + _C) * 2u; } } while (0)
    const size_t kstep = (size_t)(BK * 2);
    const size_t hstep = (size_t)HALF * K * 2;
    const size_t tstep = 2 * hstep;
    const unsigned ldsw = (unsigned)wid * 1024u;
    const int aoff = lds_byte(wr * 64 + fr, fq * 8), boff = lds_byte(wc * 32 + fr, fq * 8);
#define PG8_SA(b, h) (((b) * 2 + (h)) * HTB)
#define PG8_SB(b, h) ((4 + (b) * 2 + (h)) * HTB)
#define PG8_STAGE(bufoff, gbase, voff) do { _Pragma("unroll") for (int _i = 0; _i < 2; ++_i) \
        __builtin_amdgcn_global_load_lds((const unsigned*)((const char*)(gbase) + (voff)[_i]), (PG8_LAS unsigned*)(lds + (bufoff) + ldsw + _i * 8192), 16, 0, 0); } while (0)
#define PG8_LDA(dst, b, h) do { _Pragma("unroll") for (int m = 0; m < 4; ++m) _Pragma("unroll") for (int k = 0; k < 2; ++k) dst[m][k] = *(const PG8_LAS bf16x8*)(lds + PG8_SA(b, h) + aoff + m * 2048 + k * 1024); } while (0)
#define PG8_LDB(dst, b, h) do { _Pragma("unroll") for (int n = 0; n < 2; ++n) _Pragma("unroll") for (int k = 0; k < 2; ++k) dst[n][k] = *(const PG8_LAS bf16x8*)(lds + PG8_SB(b, h) + boff + n * 2048 + k * 1024); } while (0)
#define PG8_MMA(ai, bj, At, Bt) do { __builtin_amdgcn_s_setprio(1); _Pragma("unroll") for (int m = 0; m < 4; ++m) _Pragma("unroll") for (int n = 0; n < 2; ++n) _Pragma("unroll") for (int k = 0; k < 2; ++k) \
        acc[ai][bj][m][n] = __builtin_amdgcn_mfma_f32_16x16x32_bf16(Bt[n][k], At[m][k], acc[ai][bj][m][n], 0, 0, 0); __builtin_amdgcn_s_setprio(0); } while (0)
#define PG8_WAIT_V(n) asm volatile("s_waitcnt vmcnt(" #n ")" ::: "memory")
#define PG8_WAIT_L(n) asm volatile("s_waitcnt lgkmcnt(" #n ")" ::: "memory")
#define PG8_BAR __builtin_amdgcn_s_barrier()
#define PG8_SCHED __builtin_amdgcn_sched_barrier(0)
    Unit cur, nxt; int ui = 0;
    if (!S.next(0, cur)) return;
    f32x4 acc[2][2][4][2];
#pragma unroll
    for (int a = 0; a < 2; ++a)
#pragma unroll
        for (int b = 0; b < 2; ++b)
#pragma unroll
            for (int m = 0; m < 4; ++m)
#pragma unroll
                for (int n = 0; n < 2; ++n) acc[a][b][m][n] = (f32x4){0.f, 0.f, 0.f, 0.f};
    bf16x8 At[4][2], B0[2][2], B1[2][2];
    const char* cA = (const char*)g.A + (GATHER ? (size_t)0 : (size_t)cur.pm * tstep); const char* cB = (const char*)g.Bt + (size_t)cur.pn * tstep;
    if constexpr (GATHER) { int tq0[2][2]; PG8_TOKS(cur, tq0); PG8_OFFS(tq0, vA); Unit n1; if (S.next(1, n1)) { PG8_TOKS(n1, tq0); PG8_OFFS(tq0, vN); } else { vN[0][0] = vA[0][0]; vN[0][1] = vA[0][1]; vN[1][0] = vA[1][0]; vN[1][1] = vA[1][1]; } }
    S.a_ready(cur);
    if constexpr (SP2) {
        PG8_STAGE(PG8_SB(0, 0), cB, voffB); PG8_STAGE(PG8_SB(0, 1), cB + hstep, voffB); PG8_STAGE(PG8_SA(0, 0), cA, vA[0]); PG8_STAGE(PG8_SA(0, 1), cA, vA[1]);
        if (wr == 1) PG8_BAR;
        PG8_WAIT_V(2); PG8_BAR;
        PG8_STAGE(PG8_SB(1, 0), cB + kstep, voffB); PG8_STAGE(PG8_SA(1, 0), cA + kstep, vA[0]); PG8_STAGE(PG8_SB(1, 1), cB + hstep + kstep, voffB);
        PG8_WAIT_V(6); PG8_BAR;
    } else {
        PG8_STAGE(PG8_SB(0, 0), cB, voffB); PG8_STAGE(PG8_SA(0, 0), cA, voffA); PG8_STAGE(PG8_SB(0, 1), cB + hstep, voffB); PG8_STAGE(PG8_SA(0, 1), cA + hstep, voffA);
        if (wr == 1) PG8_BAR;
        PG8_WAIT_V(4); PG8_BAR;
        PG8_STAGE(PG8_SB(1, 0), cB + kstep, voffB); PG8_STAGE(PG8_SA(1, 0), cA + kstep, voffA); PG8_STAGE(PG8_SB(1, 1), cB + hstep + kstep, voffB);
        PG8_WAIT_V(6); PG8_BAR;
    }
    for (;;) {
        const bool has_next = S.next(ui + 1, nxt);
        const char* nA = (has_next && !GATHER) ? (const char*)g.A + (size_t)nxt.pm * tstep : cA; const char* nB = has_next ? (const char*)g.Bt + (size_t)nxt.pn * tstep : cB;
        for (int t = 0; t < nt; t += 2) {
            const bool last = (t == nt - 2);
            const char* a1 = cA + (size_t)(t + 1) * kstep;
            const char* a2 = last ? nA : cA + (size_t)(t + 2) * kstep; const char* b2 = last ? nB : cB + (size_t)(t + 2) * kstep;
            const char* a3 = a2 + kstep; const char* b3 = b2 + kstep;
            if (last && has_next) S.a_ready(nxt);
            unsigned o0[2] = {vA[0][0], vA[0][1]}, o1[2] = {vA[1][0], vA[1][1]};
            if (last) { o0[0] = vN[0][0]; o0[1] = vN[0][1]; o1[0] = vN[1][0]; o1[1] = vN[1][1]; }
            if constexpr (SP2) {
            PG8_LDB(B0, 0, 0); PG8_LDB(B1, 0, 1); PG8_SCHED; PG8_LDA(At, 0, 0); PG8_STAGE(PG8_SA(1, 1), a1, vA[1]);
            PG8_WAIT_V(8); PG8_WAIT_L(0); PG8_BAR; PG8_MMA(0, 0, At, B0); PG8_MMA(0, 1, At, B1); PG8_BAR; PG8_SCHED;
            PG8_LDA(At, 0, 1); PG8_STAGE(PG8_SB(0, 0), b2, voffB); PG8_STAGE(PG8_SB(0, 1), b2 + hstep, voffB); PG8_STAGE(PG8_SA(0, 0), a2, o0);
            PG8_WAIT_V(8); PG8_WAIT_L(0); PG8_BAR; PG8_MMA(1, 0, At, B0); PG8_MMA(1, 1, At, B1); PG8_BAR; PG8_SCHED;
            PG8_LDB(B0, 1, 0); PG8_LDB(B1, 1, 1); PG8_SCHED; PG8_LDA(At, 1, 0); PG8_STAGE(PG8_SA(0, 1), a2, o1);
            PG8_WAIT_V(8); PG8_WAIT_L(0); PG8_BAR; PG8_MMA(0, 0, At, B0); PG8_MMA(0, 1, At, B1); PG8_BAR; PG8_SCHED;
            PG8_LDA(At, 1, 1); PG8_STAGE(PG8_SB(1, 0), b3, voffB); PG8_STAGE(PG8_SB(1, 1), b3 + hstep, voffB); PG8_STAGE(PG8_SA(1, 0), a3, o0);
            PG8_WAIT_V(8); PG8_WAIT_L(0); PG8_BAR; PG8_MMA(1, 0, At, B0); PG8_MMA(1, 1, At, B1); PG8_BAR; PG8_SCHED;
            } else {
            PG8_LDB(B0, 0, 0); PG8_SCHED; PG8_LDA(At, 0, 0); PG8_STAGE(PG8_SA(1, 1), a1 + hstep, voffA);
            PG8_WAIT_L(8); PG8_BAR; PG8_WAIT_L(0); PG8_MMA(0, 0, At, B0); PG8_BAR; PG8_SCHED;
            PG8_LDB(B1, 0, 1); PG8_STAGE(PG8_SB(0, 0), b2, voffB);
            PG8_BAR; PG8_WAIT_L(0); PG8_MMA(0, 1, At, B1); PG8_BAR;
            PG8_LDA(At, 0, 1); PG8_STAGE(PG8_SA(0, 0), a2, voffA);
            PG8_BAR; PG8_WAIT_L(0); PG8_MMA(1, 0, At, B0); PG8_BAR; PG8_SCHED;
            PG8_STAGE(PG8_SB(0, 1), b2 + hstep, voffB);
            PG8_WAIT_V(6); PG8_BAR; PG8_MMA(1, 1, At, B1); PG8_BAR;
            PG8_LDB(B0, 1, 0); PG8_SCHED; PG8_LDA(At, 1, 0); PG8_STAGE(PG8_SA(0, 1), a2 + hstep, voffA);
            PG8_WAIT_L(8); PG8_BAR; PG8_WAIT_L(0); PG8_MMA(0, 0, At, B0); PG8_BAR; PG8_SCHED;
            PG8_LDB(B1, 1, 1); PG8_STAGE(PG8_SB(1, 0), b3, voffB);
            PG8_BAR; PG8_WAIT_L(0); PG8_MMA(0, 1, At, B1); PG8_BAR;
            PG8_LDA(At, 1, 1); PG8_STAGE(PG8_SA(1, 0), a3, voffA);
            PG8_BAR; PG8_WAIT_L(0); PG8_MMA(1, 0, At, B0); PG8_BAR; PG8_SCHED;
            PG8_STAGE(PG8_SB(1, 1), b3 + hstep, voffB);
            PG8_WAIT_V(6); PG8_BAR; PG8_MMA(1, 1, At, B1); PG8_BAR;
            }
        }
        if constexpr (ALIGN_EPI) { if (wr == 0) PG8_BAR; }
        int tq[2][2] = {{0, 0}, {0, 0}}; bool has2 = false;
        if constexpr (GATHER) { Unit nx2; has2 = S.next(ui + 2, nx2); if (has2) PG8_TOKS(nx2, tq); }
        if constexpr (!Epi::AFTER_DRAIN) { E(acc, cur, wr, wc, fr, fq); S.done(cur); }
        if constexpr (GATHER) { asm volatile("" : "+v"(tq[0][0]), "+v"(tq[0][1]), "+v"(tq[1][0]), "+v"(tq[1][1])); }
        if (!has_next) break;
#pragma unroll
        for (int a = 0; a < 2; ++a)
#pragma unroll
            for (int b = 0; b < 2; ++b)
#pragma unroll
                for (int m = 0; m < 4; ++m)
#pragma unroll
                    for (int n = 0; n < 2; ++n) acc[a][b][m][n] = (f32x4){0.f, 0.f, 0.f, 0.f};
        cur = nxt; cA = nA; cB = nB; ++ui; vA[0][0] = vN[0][0]; vA[0][1] = vN[0][1]; vA[1][0] = vN[1][0]; vA[1][1] = vN[1][1];
        if constexpr (GATHER) { if (has2) PG8_OFFS(tq, vN); }
        if constexpr (ALIGN_EPI) { if (wr == 1) PG8_BAR; }
    }
    PG8_WAIT_V(0);
    if constexpr (!ALIGN_EPI) { if (wr == 0) PG8_BAR; }
    PG8_BAR;
    if constexpr (Epi::AFTER_DRAIN) { E.fused(acc, cur, wr, wc, fr, fq, lds, wid, lane); S.done(cur); }
#undef PG8_TOKS
#undef PG8_OFFS
#undef PG8_SA
#undef PG8_SB
#undef PG8_STAGE
#undef PG8_LDA
#undef PG8_LDB
#undef PG8_MMA
#undef PG8_WAIT_V
#undef PG8_WAIT_L
#undef PG8_BAR
#undef PG8_SCHED
}
}

#define XB_TMO      128
#define XB_XCNT(j)  (256  + 64 * (j))
#define XB_XSUB(j)  (1280 + 64 * (j))
#define XB_XGEN(j)  (2304 + 64 * (j))
#define XB_TOP      3328
#define XB_TOPGEN   3392
#define XCD_BAR_WORDS 3456
#define XB_SPIN_CAP (1u << 18)
#define LAS __attribute__((address_space(3)))

__device__ __forceinline__ unsigned xb_ld(unsigned* p)              { return __hip_atomic_load(p, __ATOMIC_RELAXED, __HIP_MEMORY_SCOPE_AGENT); }
__device__ __forceinline__ unsigned xb_add(unsigned* p, unsigned v) { return __hip_atomic_fetch_add(p, v, __ATOMIC_RELAXED, __HIP_MEMORY_SCOPE_AGENT); }
__device__ __forceinline__ unsigned xb_xcc_id() { return (unsigned)__builtin_amdgcn_s_getreg((3 << 11) | 20) & 0xFu; }
#define XB_SPIN(cond, bar) do { unsigned _sp = 0; while (cond) { __builtin_amdgcn_s_sleep(1); \
    if ((++_sp & 255u) == 0u) { if (xb_ld(&(bar)[XB_TMO])) break; if (_sp > XB_SPIN_CAP) { atomicAdd(&(bar)[XB_TMO], 1u); break; } } } } while (0)

struct XcdBarrier {
    unsigned* bar; unsigned x;
    volatile LAS unsigned* st;
};

__device__ __forceinline__ XcdBarrier xcd_barrier_post(unsigned* bar, volatile LAS unsigned* st) {
    XcdBarrier b; b.bar = bar; b.x = xb_xcc_id(); b.st = st;
    if (threadIdx.x == 0) (void)xb_add(&bar[XB_XCNT(b.x)], 1u);
    return b;
}
__device__ __forceinline__ void xcd_barrier_complete(unsigned* bar, unsigned x, unsigned& nloc, unsigned& nx) {
    const unsigned G = gridDim.x * gridDim.y * gridDim.z;
    unsigned sum, cnt, mine, sp = 0u;
    for (;;) {
        sum = 0u; cnt = 0u; mine = 0u;
#pragma unroll
        for (unsigned j = 0; j < 16; ++j) { const unsigned c = xb_ld(&bar[XB_XCNT(j)]); sum += c; cnt += (c > 0u) ? 1u : 0u; mine = (j == x) ? c : mine; }
        if (sum == G) break;
        __builtin_amdgcn_s_sleep(1);
        if ((++sp & 255u) == 0u) { if (xb_ld(&bar[XB_TMO])) break; if (sp > XB_SPIN_CAP) { atomicAdd(&bar[XB_TMO], 1u); break; } }
    }
    nloc = mine > 0u ? mine : 1u; nx = cnt > 0u ? cnt : 1u;
}

__device__ __forceinline__ void xcd_barrier(const XcdBarrier& b) {
    asm volatile("s_waitcnt vmcnt(0)" ::: "memory");
    __syncthreads();
    if (threadIdx.x == 0) {
        unsigned* bar = b.bar;
        __builtin_amdgcn_s_waitcnt(0);
        unsigned nloc = b.st[0], nx = b.st[1];
        if (nloc == 0u) { xcd_barrier_complete(bar, b.x, nloc, nx); b.st[0] = nloc; b.st[1] = nx; }
        const unsigned old = xb_add(&bar[XB_XSUB(b.x)], 1u);
        const unsigned gen = old / nloc;
        if (old + 1u == (gen + 1u) * nloc) {
            __builtin_amdgcn_fence(__ATOMIC_RELEASE, "agent");
            asm volatile("s_waitcnt vmcnt(0)" ::: "memory");
            const unsigned og = xb_add(&bar[XB_TOP], 1u);
            const unsigned tg = og / nx;
            if (og + 1u == (tg + 1u) * nx) xb_add(&bar[XB_TOPGEN], 1u);
            else XB_SPIN(xb_ld(&bar[XB_TOPGEN]) == tg, bar);
            __builtin_amdgcn_fence(__ATOMIC_ACQUIRE, "agent");
            xb_add(&bar[XB_XGEN(b.x)], 1u);
            asm volatile("s_waitcnt vmcnt(0)" ::: "memory");
        } else {
            XB_SPIN(xb_ld(&bar[XB_XGEN(b.x)]) == gen, bar);
            __builtin_amdgcn_fence(__ATOMIC_ACQUIRE, "agent");
            asm volatile("s_waitcnt vmcnt(0)" ::: "memory");
        }
    }
    __syncthreads();
}

#ifndef MK_N_LAUNCHES
#define MK_N_LAUNCHES 1
#endif
constexpr int NPHASE = 12;
constexpr int NWAVES = 8, NTHR = 512;
constexpr int D = 1024, SEQ = 8192, NTOK = 16384, NH = 8, HD = 128, CH = 64, NCHUNK = 128;
constexpr int PW = 9216;
constexpr int PC_Q = 0, PC_K = 1024, PC_V = 2048, PC_Z = 3072, PC_BG = 4096, PC_CG = 5120, PC_UI = 6144, PC_GA = 7168, PC_GB = 8192;
constexpr int INW = 9248;
constexpr int NEXP = 32, TOPK = 4, MROWS = 73728;
constexpr float EPS = 1e-6f;

constexpr size_t MiB = 1u << 20;
constexpr size_t WS_CTL = 0, CTL_ZERO_BYTES = 1 * MiB;
constexpr size_t WS_MOD = 1 * MiB;
constexpr size_t WS_WSM_T = 1 * MiB + 64 * 1024;
constexpr size_t WS_WR_T = 1 * MiB + 192 * 1024;
constexpr size_t WS_TOPI = 2 * MiB;
constexpr size_t WS_TOPG = 2 * MiB + 256 * 1024;
constexpr size_t WS_TOPP = 2 * MiB + 512 * 1024;
constexpr size_t WS_PSM = 3 * MiB;
constexpr size_t WS_GL = 5 * MiB;
constexpr size_t WS_LIST = 6 * MiB;
constexpr size_t WS_WIN_T = 8 * MiB;
constexpr size_t WS_WUO_T = 26 * MiB;
constexpr size_t WS_WO_T = 30 * MiB;
constexpr size_t WS_W1T = 32 * MiB;
constexpr size_t WS_W2T = 160 * MiB;
constexpr size_t WS_H = 224 * MiB;
constexpr size_t WS_OD = 256 * MiB;
constexpr size_t WS_P = 320 * MiB;
constexpr size_t WS_DD = 608 * MiB;
constexpr size_t WS_SB = WS_H;
constexpr size_t WS_M1X = 896 * MiB;
constexpr size_t WS_END = 960 * MiB;
constexpr size_t DD_UNIT = 73728;
constexpr size_t DD_W = 0, DD_Q = 16384, DD_K = 32768, DD_A = 49152, DD_U = 57344;
constexpr size_t WS_OASB = WS_DD, WS_M1 = WS_DD + 64 * MiB, WS_M = WS_DD + 128 * MiB;
constexpr size_t WS_XS = WS_P, WS_ACT = WS_P + 144 * MiB, WS_YS = WS_DD;
constexpr int CW_BAR = 4096;
constexpr int CW_RANK = 30720;
constexpr int CW_CVT = 28672;
constexpr int CW_Q = 24576;
constexpr int CW_CNT = 16384;

constexpr int LDS_BYTES = 155648;
constexpr int LDS_MISC = 152 * 1024 - 256;
constexpr int LDS_TAB = 131072;

#define GAS __attribute__((address_space(1)))
#define LAS __attribute__((address_space(3)))
typedef unsigned short bf16;
typedef float f4 __attribute__((ext_vector_type(4)));
typedef unsigned u4 __attribute__((ext_vector_type(4)));
typedef unsigned u2 __attribute__((ext_vector_type(2)));

typedef __bf16 hwbf2 __attribute__((ext_vector_type(2)));
typedef float hwf2 __attribute__((ext_vector_type(2)));
__device__ __forceinline__ unsigned cvtpk(float lo, float hi) { const hwf2 v = {lo, hi}; return __builtin_bit_cast(unsigned, __builtin_convertvector(v, hwbf2)); }
__device__ __forceinline__ unsigned f2bf(float f) { unsigned u = __float_as_uint(f); return (u + 0x7fffu + ((u >> 16) & 1u)) >> 16; }
__device__ __forceinline__ unsigned pk2(float lo, float hi) { return cvtpk(lo, hi); }
__device__ __forceinline__ float bflo(unsigned w) { return __uint_as_float(w << 16); }
__device__ __forceinline__ float bfhi(unsigned w) { return __uint_as_float(w & 0xffff0000u); }
__device__ __forceinline__ float bf1(bf16 b) { return __uint_as_float(((unsigned)b) << 16); }
__device__ __forceinline__ void unpack8(const u4 w, float (&o)[8]) { o[0] = bflo(w.x); o[1] = bfhi(w.x); o[2] = bflo(w.y); o[3] = bfhi(w.y); o[4] = bflo(w.z); o[5] = bfhi(w.z); o[6] = bflo(w.w); o[7] = bfhi(w.w); }
__device__ __forceinline__ u4 pack8(const float (&o)[8]) { u4 w; w.x = pk2(o[0], o[1]); w.y = pk2(o[2], o[3]); w.z = pk2(o[4], o[5]); w.w = pk2(o[6], o[7]); return w; }
__device__ __forceinline__ float wave_sum(float v) {
#pragma unroll
    for (int o = 1; o < 64; o <<= 1) v += __shfl_xor(v, o);
    return v;
}
#define LDS_BARRIER() do { asm volatile("s_waitcnt lgkmcnt(0)" ::: "memory"); __builtin_amdgcn_s_barrier(); asm volatile("" ::: "memory"); } while (0)
__device__ __forceinline__ float sigm(float x) { return 1.0f / (1.0f + __expf(-x)); }
__device__ __forceinline__ float silu(float x) { return x / (1.0f + __expf(-x)); }
__device__ __forceinline__ float softplus(float x) { return x > 20.f ? x : log1pf(expf(x)); }

struct Args { const float* in[22]; float* out; unsigned char* ws; int ph_lo, ph_hi; };

struct Frame {
    LAS unsigned char* lds;
    int tid, lane, wave, G;
    unsigned char* ws;
};

__device__ __forceinline__ void p0_transpose_item(const float* W, int ldw, int k0, int n0s, bf16* WT, size_t drow0, LAS float* scr, int lane) {
    { const int kq = lane >> 3, n4 = (lane & 7) * 4; f4 v[8];
#pragma unroll
        for (int i = 0; i < 8; ++i) v[i] = __builtin_nontemporal_load((const f4*)(W + (size_t)(k0 + 8 * i + kq) * ldw + n0s + n4));
#pragma unroll
        for (int i = 0; i < 8; ++i) { LAS float* d = scr + (8 * i + kq) * 33 + n4; d[0] = v[i].x; d[1] = v[i].y; d[2] = v[i].z; d[3] = v[i].w; } }
    asm volatile("s_waitcnt lgkmcnt(0)" ::: "memory");
    const int c = lane & 7;
#pragma unroll
    for (int j = 0; j < 4; ++j) { const int n = (lane >> 3) + 8 * j; const LAS float* s = scr + (8 * c) * 33 + n;
        u4 o; o.x = pk2(s[0 * 33], s[1 * 33]); o.y = pk2(s[2 * 33], s[3 * 33]); o.z = pk2(s[4 * 33], s[5 * 33]); o.w = pk2(s[6 * 33], s[7 * 33]);
        *(u4*)(WT + (drow0 + n) * 1024 + k0 + 8 * c) = o; }
    asm volatile("s_waitcnt lgkmcnt(0)" ::: "memory");
}

__device__ __forceinline__ void phase_p0(Frame& F, const Args& AR) {
    const float* c_in = AR.in[1]; const float* ada_w = AR.in[2]; const float* ada_b = AR.in[3];
    const float* w_in = AR.in[5];
    for (int task = blockIdx.x; task < 192; task += F.G) {
        LAS float* red = (LAS float*)(F.lds + 131072);
        const int j0 = 32 * task, col = j0 + (F.lane & 31), kh = F.lane >> 5;
        float a0 = 0.f, a1 = 0.f;
        const float c0 = c_in[128 * F.wave + F.lane], c1 = c_in[128 * F.wave + 64 + F.lane], d0 = c_in[1024 + 128 * F.wave + F.lane], d1 = c_in[1024 + 128 * F.wave + 64 + F.lane];
        const float s0 = silu(c0), s1 = silu(c1), t0 = silu(d0), t1 = silu(d1);
#pragma unroll
        for (int hb = 0; hb < 2; ++hb) { float wv[32];
#pragma unroll
            for (int i = 0; i < 32; ++i) wv[i] = __builtin_nontemporal_load(ada_w + (size_t)(128 * F.wave + 2 * (32 * hb + i) + kh) * 6144 + col);
#pragma unroll
            for (int i = 0; i < 32; ++i) { const int kl = 2 * (32 * hb + i) + kh;
                const float ca = __shfl(hb == 0 ? s0 : s1, kl & 63), cb = __shfl(hb == 0 ? t0 : t1, kl & 63);
                a0 += ca * wv[i]; a1 += cb * wv[i]; } }
        a0 += __shfl_xor(a0, 32); a1 += __shfl_xor(a1, 32);
        if (F.lane < 32) { red[(F.wave * 2 + 0) * 32 + F.lane] = a0; red[(F.wave * 2 + 1) * 32 + F.lane] = a1; }
        __syncthreads();
        if (F.tid < 64) { const int b = F.tid >> 5, cc = F.tid & 31; float s = 0.f;
#pragma unroll
            for (int w = 0; w < 8; ++w) s += red[(w * 2 + b) * 32 + cc];
            ((float*)(F.ws + WS_MOD))[b * 6144 + j0 + cc] = s + ada_b[j0 + cc]; }
        __syncthreads();
    }
    {
        const float* router_w = AR.in[15]; float* wsm = (float*)(F.ws + WS_WSM_T); float* wr = (float*)(F.ws + WS_WR_T);
        for (int idx = blockIdx.x * NTHR + F.tid; idx < 65536; idx += F.G * NTHR) { const int which = idx >> 15, r = idx & 32767, k = r >> 5, n = r & 31;
            if (which == 0) wsm[n * 1024 + k] = w_in[(size_t)k * INW + 4096 + n]; else wr[n * 1024 + k] = router_w[k * 32 + n]; }
    }
    LAS float* scr = (LAS float*)(F.lds + F.wave * 16384);
    const int gw = blockIdx.x * NWAVES + F.wave, NGW = F.G * NWAVES;
    constexpr int I_IN = 16 * 288, I_SQ = 16 * 32;
    constexpr int NITEMS = I_IN + 3 * I_SQ;
    for (int it = gw; it < NITEMS; it += NGW) {
        int r = it;
        if (r < I_IN) { const int kb = r / 288, nb = r % 288, n0 = 32 * nb; p0_transpose_item(w_in, INW, 64 * kb, n0 + (n0 >= 4096 ? 32 : 0), (bf16*)(F.ws + WS_WIN_T), (size_t)n0, scr, F.lane); continue; } r -= I_IN;
        if (r < I_SQ) { const int kb = r / 32, nb = r % 32; p0_transpose_item(AR.in[10], 1024, 64 * kb, 32 * nb, (bf16*)(F.ws + WS_WUO_T), (size_t)(32 * nb), scr, F.lane); continue; } r -= I_SQ;
        if (r < I_SQ) { const int kb = r / 32, nb = r % 32; p0_transpose_item(AR.in[12], 1024, 64 * kb, 32 * nb, (bf16*)(F.ws + WS_WUO_T), (size_t)(1024 + 32 * nb), scr, F.lane); continue; } r -= I_SQ;
        { const int kb = r / 32, nb = r % 32; p0_transpose_item(AR.in[13], 1024, 64 * kb, 32 * nb, (bf16*)(F.ws + WS_WO_T), (size_t)(32 * nb), scr, F.lane); }
    }
}
struct CvtItem { const float* W; bf16* WT; size_t drow0; int ldw, k0, n0s; };
__device__ __forceinline__ CvtItem moe_item(const Args& AR, unsigned char* ws, int r) {
    constexpr int I_W1 = 32 * 16 * 64; CvtItem c;
    if (r < I_W1) { const int e = r / 1024, q = r % 1024, kb = q / 64, nb = q % 64, n0 = 32 * nb, half = n0 >> 10, j = n0 & 1023;
        c.W = AR.in[17] + (size_t)e * 1024 * 2048; c.ldw = 2048; c.k0 = 64 * kb; c.n0s = n0; c.WT = (bf16*)(ws + WS_W1T); c.drow0 = (size_t)e * 2048 + (size_t)((j >> 7) * 256 + half * 128 + (j & 127)); }
    else { r -= I_W1; const int e = r / 512, q = r % 512, kb = q / 32, nb = q % 32;
        c.W = AR.in[19] + (size_t)e * 1024 * 1024; c.ldw = 1024; c.k0 = 64 * kb; c.n0s = 32 * nb; c.WT = (bf16*)(ws + WS_W2T); c.drow0 = (size_t)e * 1024 + (size_t)(32 * nb); }
    return c;
}
__device__ __forceinline__ void cvt_load(const CvtItem& c, int lane, f4 (&v)[8]) {
    const int kq = lane >> 3, n4 = (lane & 7) * 4;
#pragma unroll
    for (int i = 0; i < 8; ++i) v[i] = __builtin_nontemporal_load((const f4*)(c.W + (size_t)(c.k0 + 8 * i + kq) * c.ldw + c.n0s + n4));
}
__device__ __forceinline__ void cvt_store(const CvtItem& c, int lane, const f4 (&v)[8], LAS float* scr) {
    const int kq = lane >> 3, n4 = (lane & 7) * 4;
#pragma unroll
    for (int i = 0; i < 8; ++i) { LAS float* d = scr + (8 * i + kq) * 33 + n4; d[0] = v[i].x; d[1] = v[i].y; d[2] = v[i].z; d[3] = v[i].w; }
    asm volatile("s_waitcnt lgkmcnt(0)" ::: "memory");
    const int cc = lane & 7;
#pragma unroll
    for (int j = 0; j < 4; ++j) { const int n = (lane >> 3) + 8 * j; const LAS float* sp = scr + (8 * cc) * 33 + n;
        u4 o; o.x = pk2(sp[0 * 33], sp[1 * 33]); o.y = pk2(sp[2 * 33], sp[3 * 33]); o.z = pk2(sp[4 * 33], sp[5 * 33]); o.w = pk2(sp[6 * 33], sp[7 * 33]);
        __builtin_nontemporal_store(o, (u4*)(c.WT + (c.drow0 + n) * 1024 + c.k0 + 8 * cc)); }
    asm volatile("s_waitcnt lgkmcnt(0)" ::: "memory");
}
__device__ __forceinline__ void moe_convert(Frame& F, const Args& AR) {
    constexpr int NIT = 32 * 16 * 64 + 32 * 16 * 32;
    LAS float* scr = (LAS float*)(F.lds + F.wave * 16384);
    unsigned* ctr = (unsigned*)(F.ws + WS_CTL) + CW_CVT;
    for (;;) {
        unsigned base = 0u;
        if (F.lane == 0) base = __hip_atomic_fetch_add(ctr, 8u, __ATOMIC_RELAXED, __HIP_MEMORY_SCOPE_AGENT);
        base = (unsigned)__builtin_amdgcn_readfirstlane((int)base);
        if (base >= (unsigned)NIT) break;
        f4 va[8], vb[8];
        CvtItem ca = moe_item(AR, F.ws, (int)base), cb = ca;
        cvt_load(ca, F.lane, va);
#pragma unroll 1
        for (int t = 0; t < 8; t += 2) {
            cb = moe_item(AR, F.ws, (int)base + t + 1); cvt_load(cb, F.lane, vb);
            cvt_store(ca, F.lane, va, scr);
            if (t + 2 < 8) { ca = moe_item(AR, F.ws, (int)base + t + 2); cvt_load(ca, F.lane, va); }
            cvt_store(cb, F.lane, vb, scr);
        }
    }
}
__device__ __forceinline__ void stage_wt(LAS float* WtL, const float* WT, int tid) {
    for (int idx = tid; idx < 32 * 256; idx += NTHR) { const int n = idx >> 8, k4 = idx & 255; const f4 v = *(const f4*)(WT + n * 1024 + 4 * k4); *(LAS f4*)(WtL + n * 1028 + 4 * k4) = v; }
}
__device__ __forceinline__ float dot32(const f4 (&v)[4], const LAS float* WtL, int lane) {
    float p[32];
#pragma unroll
    for (int n = 0; n < 32; ++n) { float s = 0.f;
#pragma unroll
        for (int j = 0; j < 4; ++j) { const f4 w = *(const LAS f4*)(WtL + n * 1028 + 256 * j + 4 * lane); s += v[j].x * w.x + v[j].y * w.y + v[j].z * w.z + v[j].w * w.w; }
        p[n] = s; if ((n & 3) == 3) asm volatile("" : "+v"(p[n - 3]), "+v"(p[n - 2]), "+v"(p[n - 1]), "+v"(p[n]) :: "memory"); }
#pragma unroll
    for (int i = 0; i < 16; ++i) { const bool hi = (lane & 32) != 0; const float send = hi ? p[i] : p[i + 16], keep = hi ? p[i + 16] : p[i]; p[i] = keep + __shfl_xor(send, 32); }
#pragma unroll
    for (int i = 0; i < 8; ++i) { const bool hi = (lane & 16) != 0; const float send = hi ? p[i] : p[i + 8], keep = hi ? p[i + 8] : p[i]; p[i] = keep + __shfl_xor(send, 16); }
#pragma unroll
    for (int i = 0; i < 4; ++i) { const bool hi = (lane & 8) != 0; const float send = hi ? p[i] : p[i + 4], keep = hi ? p[i + 4] : p[i]; p[i] = keep + __shfl_xor(send, 8); }
#pragma unroll
    for (int i = 0; i < 2; ++i) { const bool hi = (lane & 4) != 0; const float send = hi ? p[i] : p[i + 2], keep = hi ? p[i + 2] : p[i]; p[i] = keep + __shfl_xor(send, 4); }
    { const bool hi = (lane & 2) != 0; const float send = hi ? p[0] : p[1], keep = hi ? p[1] : p[0]; p[0] = keep + __shfl_xor(send, 2); }
    p[0] += __shfl_xor(p[0], 1);
    return p[0];
}

__device__ __forceinline__ void phase_p1(Frame& F, const Args& AR) {
    const float* x = AR.in[0]; const float* norm1_w = AR.in[4]; const float* mod = (const float*)(F.ws + WS_MOD);
    LAS float* WtL = (LAS float*)F.lds;
    LAS float* A1 = (LAS float*)(F.lds + 131584);
    LAS float* B1 = A1 + 2048;
    stage_wt(WtL, (const float*)(F.ws + WS_WSM_T), F.tid);
    for (int idx = F.tid; idx < 2048; idx += NTHR) { const int b = idx >> 10, k = idx & 1023; A1[idx] = norm1_w[k] * (1.0f + mod[b * 6144 + 1024 + k]); B1[idx] = mod[b * 6144 + k]; }
    __syncthreads();
    bf16* h = (bf16*)(F.ws + WS_H); float* psm = (float*)(F.ws + WS_PSM);
    const int gw = blockIdx.x * NWAVES + F.wave, NGW = F.G * NWAVES;
    for (int m = gw; m < NTOK; m += NGW) {
        const f4* xr = (const f4*)(x + (size_t)m * D) + F.lane; f4 v[4]; float ss = 0.f;
#pragma unroll
        for (int j = 0; j < 4; ++j) { v[j] = xr[64 * j]; ss += (v[j].x * v[j].x + v[j].y * v[j].y) + (v[j].z * v[j].z + v[j].w * v[j].w); }
        const float rstd = 1.0f / sqrtf(wave_sum(ss) * (1.0f / D) + EPS);
        const int b = m >> 13;
#pragma unroll
        for (int j = 0; j < 4; ++j) { const f4 a = *(const LAS f4*)(A1 + b * 1024 + 256 * j + 4 * F.lane), bb = *(const LAS f4*)(B1 + b * 1024 + 256 * j + 4 * F.lane);
            v[j] = v[j] * rstd * a + bb;
            u2 o; o.x = pk2(v[j].x, v[j].y); o.y = pk2(v[j].z, v[j].w); ((u2*)(h + (size_t)m * D))[F.lane + 64 * j] = o; }
        const float tot = dot32(v, WtL, F.lane);
        if (!(F.lane & 1)) psm[(size_t)m * 32 + (F.lane >> 1)] = tot;
    }
}

struct EpiStoreBf16 {
    static constexpr bool PERM = true, AFTER_DRAIN = false;
    bf16* O; int ldc;
    __device__ __forceinline__ void operator()(const pg8::f32x4 (&acc)[2][2][4][2], const pg8::Unit& u, int wr, int wc, int fr, int fq) const {
        const int row0 = u.pm * 256 + wr * 64 + fr, col0 = u.pn * 256 + wc * 32 + 8 * fq;
#pragma unroll
        for (int ai = 0; ai < 2; ++ai)
#pragma unroll
            for (int m = 0; m < 4; ++m) { bf16* rowp = O + (size_t)(row0 + ai * 128 + m * 16) * ldc + col0;
#pragma unroll
                for (int bj = 0; bj < 2; ++bj) { const pg8::f32x4 v0 = acc[ai][bj][m][0], v1 = acc[ai][bj][m][1];
                    u4 w; w.x = cvtpk(v0[0], v0[1]); w.y = cvtpk(v0[2], v0[3]); w.z = cvtpk(v1[0], v1[1]); w.w = cvtpk(v1[2], v1[3]);
                    __builtin_nontemporal_store(w, (u4*)(rowp + bj * 128)); } }
    }
};
struct EpiGate {
    static constexpr bool PERM = true, AFTER_DRAIN = false;
    const bf16* P; float* M1; bf16* Mo; int gcolb, second;
    __device__ __forceinline__ void operator()(const pg8::f32x4 (&acc)[2][2][4][2], const pg8::Unit& u, int wr, int wc, int fr, int fq) const {
        const int s = second;
        const int row0 = u.pm * 256 + wr * 64 + fr, col0 = u.pn * 256 + wc * 32 + 8 * fq, gcol = gcolb + col0;
#pragma unroll
        for (int am = 0; am < 4; ++am) { const int ai = am >> 1, mb = (am & 1) * 2;
            u4 gw[2][2]; f4 p0[2][2], p1[2][2];
#pragma unroll
            for (int mm = 0; mm < 2; ++mm)
#pragma unroll
                for (int bj = 0; bj < 2; ++bj) { const int row = row0 + ai * 128 + (mb + mm) * 16;
                    gw[mm][bj] = *(const u4*)(P + (size_t)row * PW + gcol + bj * 128);
                    if (s) { const float* mp = M1 + (size_t)row * D + col0 + bj * 128; p0[mm][bj] = *(const f4*)mp; p1[mm][bj] = *(const f4*)(mp + 4); } }
#pragma unroll
            for (int mm = 0; mm < 2; ++mm)
#pragma unroll
                for (int bj = 0; bj < 2; ++bj) { const int m = mb + mm; const int row = row0 + ai * 128 + m * 16, col = col0 + bj * 128;
                    float g[8]; unpack8(gw[mm][bj], g);
                    const pg8::f32x4 v0 = acc[ai][bj][m][0], v1 = acc[ai][bj][m][1];
                    float o[8];
#pragma unroll
                    for (int e = 0; e < 4; ++e) { o[e] = sigm(g[e]) * v0[e]; o[4 + e] = sigm(g[4 + e]) * v1[e]; }
                    if (s == 0) { float* mp = M1 + (size_t)row * D + col; *(f4*)mp = (f4){o[0], o[1], o[2], o[3]}; *(f4*)(mp + 4) = (f4){o[4], o[5], o[6], o[7]}; }
                    else { const f4 q0 = p0[mm][bj], q1 = p1[mm][bj];
                        u4 w; w.x = cvtpk(q0.x + o[0], q0.y + o[1]); w.y = cvtpk(q0.z + o[2], q0.w + o[3]); w.z = cvtpk(q1.x + o[4], q1.y + o[5]); w.w = cvtpk(q1.z + o[6], q1.w + o[7]);
                        *(u4*)(Mo + (size_t)row * D + col) = w; } }
        }
    }
};
struct EpiG4 {
    static constexpr bool PERM = false, AFTER_DRAIN = false;
    const float* X; const float* mod; float* X1;
    __device__ __forceinline__ void operator()(const pg8::f32x4 (&acc)[2][2][4][2], const pg8::Unit& u, int wr, int wc, int fr, int fq) const {
        const int row0 = u.pm * 256 + wr * 64 + fr, col0 = u.pn * 256 + wc * 32 + 4 * fq; const int b = u.pm >> 5;
        f4 gt[2][2];
#pragma unroll
        for (int bj = 0; bj < 2; ++bj)
#pragma unroll
            for (int n = 0; n < 2; ++n) gt[bj][n] = *(const f4*)(mod + b * 6144 + 2048 + col0 + bj * 128 + n * 16);
#pragma unroll
        for (int ai = 0; ai < 2; ++ai) {
            f4 xv[4][2][2];
#pragma unroll
            for (int m = 0; m < 4; ++m)
#pragma unroll
                for (int bj = 0; bj < 2; ++bj)
#pragma unroll
                    for (int n = 0; n < 2; ++n) xv[m][bj][n] = *(const f4*)(X + (size_t)(row0 + ai * 128 + m * 16) * D + col0 + bj * 128 + n * 16);
#pragma unroll
            for (int m = 0; m < 4; ++m) { const size_t off = (size_t)(row0 + ai * 128 + m * 16) * D + col0;
#pragma unroll
                for (int bj = 0; bj < 2; ++bj)
#pragma unroll
                    for (int n = 0; n < 2; ++n) { const f4 x = xv[m][bj][n]; const pg8::f32x4 a = acc[ai][bj][m][n];
                        *(f4*)(X1 + off + bj * 128 + n * 16) = (f4){x.x + gt[bj][n].x * a[0], x.y + gt[bj][n].y * a[1], x.z + gt[bj][n].z * a[2], x.w + gt[bj][n].w * a[3]}; } }
        }
    }
};
struct MoeOrder {
    int nM, nN, nwg, G, c; const LAS int* blk_exp; const LAS int* tab; const int* list;
    __device__ __forceinline__ void init(int nblk, int nN_, int G_, int c_, const LAS int* tab_, const int* list_) { nM = nblk; nN = nN_; nwg = nM * nN; G = G_; c = c_; tab = tab_; blk_exp = tab_ + 64; list = list_; }
    __device__ __forceinline__ int row_token(const pg8::Unit& u, int r) const { const int e = u.pn / nN, cn = tab[512 + e]; int idx = 256 * (u.pm - (tab[e] >> 8)) + r; idx = idx < cn ? idx : cn - 1; return list[e * 16384 + idx]; }
    __device__ __forceinline__ bool next(int i, pg8::Unit& u) const {
        const long L = (long)i * G + c; if (L >= nwg) return false;
        int wgid = (int)L; { const int q = nwg / 8, r = nwg % 8, xcd = wgid % 8, off = wgid / 8; wgid = (xcd < r ? xcd * (q + 1) : r * (q + 1) + (xcd - r) * q) + off; }
        const int nig = 8 * nN, gid = wgid / nig, fm = gid * 8, gsz = (nM - fm) < 8 ? (nM - fm) : 8;
        const int pm = fm + ((wgid % nig) % gsz), pnl = (wgid % nig) / gsz;
        u.pm = pm; u.pn = blk_exp[pm] * nN + pnl; return true;
    }
    __device__ __forceinline__ void a_ready(const pg8::Unit&) const {}
    __device__ __forceinline__ void done(const pg8::Unit&) const {}
};
struct EpiMoe1 {
    static constexpr bool PERM = true, AFTER_DRAIN = false;
    const float* b1; bf16* ACT;
    __device__ __forceinline__ void operator()(const pg8::f32x4 (&acc)[2][2][4][2], const pg8::Unit& u, int wr, int wc, int fr, int fq) const {
        const int e = u.pn >> 3, pnl = u.pn & 7; const int row0 = u.pm * 256 + wr * 64 + fr, j0 = pnl * 128 + wc * 32 + 8 * fq;
        const float* bg = b1 + (size_t)e * 2048 + j0; const float* bu = bg + 1024;
        const f4 bg0 = *(const f4*)bg, bg1 = *(const f4*)(bg + 4), bu0 = *(const f4*)bu, bu1 = *(const f4*)(bu + 4);
        const float bgv[8] = {bg0.x, bg0.y, bg0.z, bg0.w, bg1.x, bg1.y, bg1.z, bg1.w}, buv[8] = {bu0.x, bu0.y, bu0.z, bu0.w, bu1.x, bu1.y, bu1.z, bu1.w};
#pragma unroll
        for (int ai = 0; ai < 2; ++ai)
#pragma unroll
            for (int m = 0; m < 4; ++m) { float o[8];
#pragma unroll
                for (int e8 = 0; e8 < 8; ++e8) { const int n = e8 >> 2, q = e8 & 3;
                    float g = acc[ai][0][m][n][q] + bgv[e8], up = acc[ai][1][m][n][q] + buv[e8];
                    g = fminf(g, 7.0f); up = fminf(fmaxf(up, -7.0f), 7.0f);
                    o[e8] = g * sigm(1.702f * g) * (up + 1.0f); }
                u4 w; w.x = cvtpk(o[0], o[1]); w.y = cvtpk(o[2], o[3]); w.z = cvtpk(o[4], o[5]); w.w = cvtpk(o[6], o[7]);
                *(u4*)(ACT + (size_t)(row0 + ai * 128 + m * 16) * D + j0) = w; }
    }
};
struct EpiMoe2 {
    static constexpr bool PERM = true, AFTER_DRAIN = false;
    const float* b2; bf16* YS;
    __device__ __forceinline__ void operator()(const pg8::f32x4 (&acc)[2][2][4][2], const pg8::Unit& u, int wr, int wc, int fr, int fq) const {
        const int e = u.pn >> 2, pnl = u.pn & 3; const int row0 = u.pm * 256 + wr * 64 + fr, col0 = pnl * 256 + wc * 32 + 8 * fq;
        f4 bv[2][2];
#pragma unroll
        for (int bj = 0; bj < 2; ++bj)
#pragma unroll
            for (int n = 0; n < 2; ++n) bv[bj][n] = *(const f4*)(b2 + (size_t)e * D + col0 + bj * 128 + 4 * n);
#pragma unroll
        for (int ai = 0; ai < 2; ++ai)
#pragma unroll
            for (int m = 0; m < 4; ++m) { bf16* rowp = YS + (size_t)(row0 + ai * 128 + m * 16) * D + col0;
#pragma unroll
                for (int bj = 0; bj < 2; ++bj) { const pg8::f32x4 v0 = acc[ai][bj][m][0], v1 = acc[ai][bj][m][1];
                    u4 w; w.x = cvtpk(v0[0] + bv[bj][0].x, v0[1] + bv[bj][0].y); w.y = cvtpk(v0[2] + bv[bj][0].z, v0[3] + bv[bj][0].w);
                    w.z = cvtpk(v1[0] + bv[bj][1].x, v1[1] + bv[bj][1].y); w.w = cvtpk(v1[2] + bv[bj][1].z, v1[3] + bv[bj][1].w);
                    __builtin_nontemporal_store(w, (u4*)(rowp + bj * 128)); } }
    }
};

constexpr int QS = 129;
constexpr int QB = 136;
typedef short bf16x8 __attribute__((ext_vector_type(8)));
__device__ __forceinline__ bf16x8 pack_frag(const pg8::f32x4 a, const pg8::f32x4 b) {
    u4 w; w.x = cvtpk(a[0], a[1]); w.y = cvtpk(a[2], a[3]); w.z = cvtpk(b[0], b[1]); w.w = cvtpk(b[2], b[3]); return __builtin_bit_cast(bf16x8, w);
}
__device__ __forceinline__ void phase_p3(Frame& F, const Args& AR) {
    const bf16* P = (const bf16*)(F.ws + WS_P); const float* psm = (const float*)(F.ws + WS_PSM);
    const float* convw = AR.in[6]; const float* a_log = AR.in[7]; const float* dt_bias = AR.in[8];
    LAS bf16* qb = (LAS bf16*)F.lds;
    LAS bf16* kb = qb + 64 * QB;
    LAS float* vs = (LAS float*)(kb + 64 * QB);
    LAS float* Lm = vs + 64 * QS;
    LAS float* betaL = Lm + 2 * 4096;
    LAS float* GL = betaL + 128;
    LAS float* Tm = GL + 128;
    LAS bf16* wb = (LAS bf16*)(Tm + 2048);
    u4 raw[12]; f4 wjv[10]; float braw = 0.f, araw = 0.f, alog_p = 0.f, dtb_p = 0.f;
#define P3_LOAD(unit_) do { const int b_ = (unit_) >> 10, h_ = ((unit_) >> 7) & 7, c_ = (unit_) & 127, t0_ = c_ * 64; const size_t tb_ = (size_t)b_ * SEQ; const int tid_ = F.tid; \
        if (tid_ < 384) { const int cv_ = tid_ % 48, rg_ = tid_ / 48, pcol_ = (cv_ >> 4) * 1024 + h_ * 128 + (cv_ & 15) * 8; \
            _Pragma("unroll") for (int j_ = 0; j_ < 5; ++j_) { wjv[2 * j_] = *(const f4*)(convw + j_ * 3072 + pcol_); wjv[2 * j_ + 1] = *(const f4*)(convw + j_ * 3072 + pcol_ + 4); } \
            _Pragma("unroll") for (int r_ = 0; r_ < 12; ++r_) { const int t_ = t0_ + 8 * rg_ - 2 + r_; raw[r_] = (t_ >= 0 && t_ < SEQ) ? *(const u4*)(P + (tb_ + t_) * PW + pcol_) : (u4){0u, 0u, 0u, 0u}; } } \
        if (tid_ >= 384) { const int dir_ = (tid_ - 384) >> 6, ii_ = tid_ & 63, io_ = dir_ ? 63 - ii_ : ii_; const size_t tok_ = tb_ + t0_ + io_; braw = psm[tok_ * 32 + dir_ * 8 + h_]; araw = psm[tok_ * 32 + 16 + dir_ * 8 + h_]; alog_p = a_log[dir_ * 8 + h_]; dtb_p = dt_bias[dir_ * 8 + h_]; } } while (0)
    if ((int)blockIdx.x < 2 * NH * NCHUNK) P3_LOAD((int)blockIdx.x);
    for (int unit = blockIdx.x; unit < 2 * NH * NCHUNK; unit += F.G) {
        const int b = unit >> 10, h = (unit >> 7) & 7, c = unit & 127;
        int tid = F.tid; asm volatile("" : "+v"(tid));
        const int lane = tid & 63;
        unsigned char* const ubase = F.ws + WS_DD + ((size_t)((b * 8 + h) * 2) * 128) * DD_UNIT;
        if (tid < 384) {
            const int cv = tid % 48, rg = tid / 48, part = cv >> 4, ch = (cv & 15) * 8;
#pragma unroll
            for (int i = 0; i < 8; ++i) { float acc[8];
#pragma unroll
                for (int e = 0; e < 8; ++e) acc[e] = 0.f;
#pragma unroll
                for (int j = 0; j < 5; ++j) { float xin[8]; unpack8(raw[i + j], xin); const f4 w0 = wjv[2 * j], w1 = wjv[2 * j + 1];
                    acc[0] += w0.x * xin[0]; acc[1] += w0.y * xin[1]; acc[2] += w0.z * xin[2]; acc[3] += w0.w * xin[3]; acc[4] += w1.x * xin[4]; acc[5] += w1.y * xin[5]; acc[6] += w1.z * xin[6]; acc[7] += w1.w * xin[7]; }
                float ssq = 0.f;
#pragma unroll
                for (int e = 0; e < 8; ++e) { acc[e] = silu(acc[e]); ssq += acc[e] * acc[e]; }
                ssq += __shfl_xor(ssq, 1); ssq += __shfl_xor(ssq, 2); ssq += __shfl_xor(ssq, 4); ssq += __shfl_xor(ssq, 8);
                if (part == 2) {
#pragma unroll
                    for (int e = 0; e < 8; ++e) vs[(8 * rg + i) * QS + ch + e] = acc[e];
                } else {
                    float sc = 1.0f / sqrtf(ssq + EPS); if (part == 0) sc *= 0.08838834764831845f;
#pragma unroll
                    for (int e = 0; e < 8; ++e) acc[e] *= sc;
                    *(LAS u4*)((part ? kb : qb) + (8 * rg + i) * QB + ch) = pack8(acc); }
            }
        }
        if (tid >= 384) {
            const int dir = (tid - 384) >> 6, ii = lane;
            float g = -expf(alog_p) * softplus(araw + dtb_p);
#pragma unroll
            for (int o = 1; o < 64; o <<= 1) { const float t = __shfl_up(g, o); if (lane >= o) g += t; }
            betaL[dir * 64 + ii] = sigm(braw); GL[dir * 64 + ii] = g;
        }
        if (unit + F.G < 2 * NH * NCHUNK) P3_LOAD(unit + F.G);
        LDS_BARRIER();
        asm volatile("" : "+v"(tid));
        {
            const int w = tid >> 6, dir = w >> 2, mi = w & 3, r = lane & 15, q = lane >> 4;
            const int ipos = 16 * mi + r, io = dir ? 63 - ipos : ipos;
            const float Gi = GL[dir * 64 + ipos], bi = betaL[dir * 64 + ipos];
            bf16x8 ki[4], qi[4];
#pragma unroll
            for (int s = 0; s < 4; ++s) { ki[s] = *(const LAS bf16x8*)(kb + io * QB + 32 * s + 8 * q); qi[s] = *(const LAS bf16x8*)(qb + io * QB + 32 * s + 8 * q); }
            unsigned char* dbase = ubase + ((size_t)dir * 128 + (dir ? 127 - c : c)) * DD_UNIT;
#pragma unroll
            for (int s2 = 0; s2 < 2; ++s2) { float av[8];
#pragma unroll
                for (int t = 0; t < 2; ++t) { const int mj = 2 * s2 + t;
                    if (mj <= mi) {
                        const int jp = 16 * mj + r, jo = dir ? 63 - jp : jp;
                        pg8::f32x4 kk = {0.f, 0.f, 0.f, 0.f}, qk = {0.f, 0.f, 0.f, 0.f};
#pragma unroll
                        for (int s = 0; s < 4; ++s) { const bf16x8 kj = *(const LAS bf16x8*)(kb + jo * QB + 32 * s + 8 * q);
                            kk = __builtin_amdgcn_mfma_f32_16x16x32_bf16(kj, ki[s], kk, 0, 0, 0); qk = __builtin_amdgcn_mfma_f32_16x16x32_bf16(kj, qi[s], qk, 0, 0, 0); }
                        f4 lv;
#pragma unroll
                        for (int jj = 0; jj < 4; ++jj) { const int jpos = 16 * mj + 4 * q + jj; const float dec = __expf(Gi - GL[dir * 64 + jpos]);
                            const float l = (ipos > jpos) ? bi * kk[jj] * dec : 0.f; av[4 * t + jj] = (ipos >= jpos) ? qk[jj] * dec : 0.f;
                            if (jj == 0) lv.x = l; else if (jj == 1) lv.y = l; else if (jj == 2) lv.z = l; else lv.w = l; }
                        *(LAS f4*)(Lm + dir * 4096 + ipos * 64 + 16 * mj + 4 * q) = lv;
                    } else {
#pragma unroll
                        for (int jj = 0; jj < 4; ++jj) av[4 * t + jj] = 0.f;
                    } }
                __builtin_nontemporal_store(pack8(av), (u4*)(dbase + DD_A + (size_t)((mi * 2 + s2) * 64 + lane) * 16)); }
        }
        LDS_BARRIER();
        asm volatile("" : "+v"(tid));
        if (tid < 128) {
            const int dir = tid >> 6, blk = (tid >> 4) & 3, cc = tid & 15;
            const LAS float* Lb = Lm + dir * 4096 + (16 * blk) * 64 + 16 * blk;
            float t[16];
#pragma unroll
            for (int i = 0; i < 16; ++i) { float sv = (i == cc) ? 1.0f : 0.0f;
#pragma unroll
                for (int j = 0; j < i; ++j) sv -= Lb[i * 64 + j] * t[j];
                t[i] = sv; Tm[(dir * 4 + blk) * 256 + i * 16 + cc] = sv; }
        }
        LDS_BARRIER();
        asm volatile("" : "+v"(tid));
        {
            const int w = tid >> 6, dir = w >> 2, g4 = w & 3, n = lane & 15, q = lane >> 4; const bool isw = g4 >= 2;
            const LAS float* Lr = Lm + dir * 4096; const LAS float* Tr = Tm + dir * 1024;
            const f4 z4 = {0.f, 0.f, 0.f, 0.f};
            bf16x8 fT[4], fL10, fL2, fL3a, fL3b;
#pragma unroll
            for (int i = 0; i < 4; ++i) fT[i] = pack_frag(*(const LAS f4*)(Tr + i * 256 + n * 16 + 4 * q), z4);
            fL10 = pack_frag(-*(const LAS f4*)(Lr + (16 + n) * 64 + 4 * q), z4);
            fL2 = pack_frag(-*(const LAS f4*)(Lr + (32 + n) * 64 + 4 * q), -*(const LAS f4*)(Lr + (32 + n) * 64 + 16 + 4 * q));
            fL3a = pack_frag(-*(const LAS f4*)(Lr + (48 + n) * 64 + 4 * q), -*(const LAS f4*)(Lr + (48 + n) * 64 + 16 + 4 * q));
            fL3b = pack_frag(-*(const LAS f4*)(Lr + (48 + n) * 64 + 32 + 4 * q), z4);
            float bE[4][4];
#pragma unroll
            for (int i = 0; i < 4; ++i)
#pragma unroll
                for (int jj = 0; jj < 4; ++jj) { const int row = 16 * i + 4 * q + jj; bE[i][jj] = betaL[dir * 64 + row] * (isw ? __expf(GL[dir * 64 + row]) : 1.0f); }
            unsigned char* dbase = ubase + ((size_t)dir * 128 + (dir ? 127 - c : c)) * DD_UNIT;
#pragma unroll
            for (int e = 0; e < 4; ++e) { const int nt = 4 * g4 + e;
                pg8::f32x4 R[4];
#pragma unroll
                for (int i = 0; i < 4; ++i)
#pragma unroll
                    for (int jj = 0; jj < 4; ++jj) { const int row = 16 * i + 4 * q + jj, io = dir ? 63 - row : row;
                        R[i][jj] = bE[i][jj] * (isw ? bf1(kb[io * QB + 16 * (nt - 8) + n]) : vs[io * QS + 16 * nt + n]); }
                const pg8::f32x4 x0 = __builtin_amdgcn_mfma_f32_16x16x32_bf16(fT[0], pack_frag(R[0], z4), z4, 0, 0, 0);
                const pg8::f32x4 y1 = __builtin_amdgcn_mfma_f32_16x16x32_bf16(fL10, pack_frag(x0, z4), R[1], 0, 0, 0);
                const pg8::f32x4 x1 = __builtin_amdgcn_mfma_f32_16x16x32_bf16(fT[1], pack_frag(y1, z4), z4, 0, 0, 0);
                const bf16x8 x01 = pack_frag(x0, x1);
                const pg8::f32x4 y2 = __builtin_amdgcn_mfma_f32_16x16x32_bf16(fL2, x01, R[2], 0, 0, 0);
                const pg8::f32x4 x2 = __builtin_amdgcn_mfma_f32_16x16x32_bf16(fT[2], pack_frag(y2, z4), z4, 0, 0, 0);
                pg8::f32x4 y3 = __builtin_amdgcn_mfma_f32_16x16x32_bf16(fL3a, x01, R[3], 0, 0, 0);
                y3 = __builtin_amdgcn_mfma_f32_16x16x32_bf16(fL3b, pack_frag(x2, z4), y3, 0, 0, 0);
                const pg8::f32x4 x3 = __builtin_amdgcn_mfma_f32_16x16x32_bf16(fT[3], pack_frag(y3, z4), z4, 0, 0, 0);
                const pg8::f32x4 X[4] = {x0, x1, x2, x3};
                if (!isw) {
#pragma unroll
                    for (int i = 0; i < 4; ++i) { u2 o; o.x = cvtpk(X[i][0], X[i][1]); o.y = cvtpk(X[i][2], X[i][3]); __builtin_nontemporal_store(o, (u2*)(dbase + DD_U + (size_t)((nt * 4 + i) * 64 + lane) * 8)); }
                } else { LAS bf16* wp = wb + dir * 64 * QB + 16 * (nt - 8) + n;
#pragma unroll
                    for (int i = 0; i < 4; ++i)
#pragma unroll
                        for (int jj = 0; jj < 4; ++jj) wp[(16 * i + 4 * q + jj) * QB] = (bf16)f2bf(X[i][jj]); }
            }
        }
        LDS_BARRIER();
        asm volatile("" : "+v"(tid));
#pragma unroll
        for (int it = 0; it < 4; ++it) { const int item = it * NTHR + tid, dir = item >> 10, fidx = (item >> 6) & 15, fl = item & 63, r = fl & 15, q = fl >> 4;
            const int mt = fidx >> 2, s = fidx & 3, pos = 16 * mt + r; const LAS bf16* wr = wb + (dir * 64 + pos) * QB + 32 * s + 4 * q;
            const u2 lo = *(const LAS u2*)wr, hi = *(const LAS u2*)(wr + 16);
            __builtin_nontemporal_store((u4){lo.x, lo.y, hi.x, hi.y}, (u4*)(ubase + ((size_t)dir * 128 + (dir ? 127 - c : c)) * DD_UNIT + DD_W + (size_t)(fidx * 64 + fl) * 16)); }
#pragma unroll
        for (int it = 0; it < 8; ++it) { const int item = it * NTHR + tid, dir = item >> 11, arr = (item >> 10) & 1, fidx = (item >> 6) & 15, fl = item & 63, r = fl & 15, q = fl >> 4;
            unsigned char* dbase = ubase + ((size_t)dir * 128 + (dir ? 127 - c : c)) * DD_UNIT;
            float o[8];
            if (arr == 0) { const int mt = fidx >> 2, s = fidx & 3, pos = 16 * mt + r, io = dir ? 63 - pos : pos; const float f = __expf(GL[dir * 64 + pos]);
                const u2 lo = *(const LAS u2*)(qb + io * QB + 32 * s + 4 * q), hi = *(const LAS u2*)(qb + io * QB + 32 * s + 16 + 4 * q);
                o[0] = bflo(lo.x) * f; o[1] = bfhi(lo.x) * f; o[2] = bflo(lo.y) * f; o[3] = bfhi(lo.y) * f; o[4] = bflo(hi.x) * f; o[5] = bfhi(hi.x) * f; o[6] = bflo(hi.y) * f; o[7] = bfhi(hi.y) * f;
                __builtin_nontemporal_store(pack8(o), (u4*)(dbase + DD_Q + (size_t)(fidx * 64 + fl) * 16));
            } else { const int m = fidx >> 1, s2 = fidx & 1, dk = 16 * m + r; const float gl = GL[dir * 64 + 63];
#pragma unroll
                for (int j = 0; j < 8; ++j) { const int pos = 32 * s2 + (j < 4 ? 4 * q + j : 16 + 4 * q + j - 4), io = dir ? 63 - pos : pos; o[j] = bf1(kb[io * QB + dk]) * __expf(gl - GL[dir * 64 + pos]); }
                __builtin_nontemporal_store(pack8(o), (u4*)(dbase + DD_K + (size_t)(fidx * 64 + fl) * 16)); } }
        if (tid < 2) ((float*)(F.ws + WS_GL))[((b * 8 + h) * 2 + tid) * 128 + (tid ? 127 - c : c)] = __expf(GL[tid * 64 + 63]);
        LDS_BARRIER();
    }
#undef P3_LOAD
}

constexpr int P4_BUF = 61440;
__device__ __forceinline__ void phase_p4(Frame& F, const Args& AR) {
    volatile LAS int* uq = (volatile LAS int*)(F.lds + LDS_TAB + 4096);
    unsigned* qctr = (unsigned*)(F.ws + WS_CTL) + CW_Q;
    const unsigned myx = xb_xcc_id() & 7u;
    for (;;) {
        __syncthreads();
        if (F.tid == 0) { int got = -1;
            for (unsigned t = 0; t < 8 && got < 0; ++t) { const unsigned x = (myx + t) & 7u; const unsigned sl = __hip_atomic_fetch_add(qctr + 64 * x, 1u, __ATOMIC_RELAXED, __HIP_MEMORY_SCOPE_AGENT); if (sl < 16u) got = (int)(x * 16u + sl); }
            uq[0] = got; }
        __syncthreads();
        const int unit = uq[0];
        if (unit < 0) break;
        const int chain = unit >> 2, pair = unit & 3, dir = chain & 1, bh = chain >> 1, b = bh >> 3, h = bh & 7;
        const unsigned char* cbase = F.ws + WS_DD + (size_t)chain * 128 * DD_UNIT;
        __syncthreads();
        if (F.wave >= 2) {
            const int l = F.tid - 128; u4 ra[10], rb[10], rc[10];
#define P4_SRC(step, i) ((const u4*)(cbase + (size_t)(step) * DD_UNIT + (((i) * 384 + l) < 3584 ? (size_t)((i) * 384 + l) * 16 : (size_t)DD_U + (size_t)pair * 4096 + (size_t)((i) * 384 + l - 3584) * 16)))
#define P4_LD(R, step) do { const int st_ = (step) < NCHUNK ? (step) : NCHUNK - 1; _Pragma("unroll") for (int i = 0; i < 10; ++i) R[i] = *P4_SRC(st_, i); } while (0)
#define P4_ST(R, step) do { _Pragma("unroll") for (int i = 0; i < 10; ++i) *(LAS u4*)(F.lds + ((step) & 1) * P4_BUF + (size_t)(i * 384 + l) * 16) = R[i]; } while (0)
            P4_LD(ra, 0); P4_ST(ra, 0);
            P4_LD(ra, 1); P4_LD(rb, 2); P4_LD(rc, 3);
            asm volatile("s_waitcnt lgkmcnt(0)" ::: "memory"); __builtin_amdgcn_s_barrier(); asm volatile("" ::: "memory");
            for (int k = 0; k < 129; k += 3) {
                P4_ST(ra, k + 1); P4_LD(ra, k + 4);
                asm volatile("s_waitcnt lgkmcnt(0)" ::: "memory"); __builtin_amdgcn_s_barrier(); asm volatile("" ::: "memory");
                P4_ST(rb, k + 2); P4_LD(rb, k + 5);
                asm volatile("s_waitcnt lgkmcnt(0)" ::: "memory"); __builtin_amdgcn_s_barrier(); asm volatile("" ::: "memory");
                P4_ST(rc, k + 3); P4_LD(rc, k + 6);
                asm volatile("s_waitcnt lgkmcnt(0)" ::: "memory"); __builtin_amdgcn_s_barrier(); asm volatile("" ::: "memory");
            }
#undef P4_SRC
#undef P4_LD
#undef P4_ST
        } else {
            const int lane = F.lane, r = lane & 15, q = lane >> 4, sl = 2 * pair + F.wave;
            const float* glp = (const float*)(F.ws + WS_GL) + chain * 128;
            bf16* od = (bf16*)(F.ws + WS_OD) + (size_t)dir * NTOK * D + (size_t)b * SEQ * D + h * 128 + 16 * sl + 4 * q;
            pg8::f32x4 S[8]; bf16x8 SB[4];
#pragma unroll
            for (int m = 0; m < 8; ++m) S[m] = (pg8::f32x4){0.f, 0.f, 0.f, 0.f};
#pragma unroll
            for (int s = 0; s < 4; ++s) SB[s] = (bf16x8){0, 0, 0, 0, 0, 0, 0, 0};
            const float glv0 = glp[lane], glv1 = glp[64 + lane];
            asm volatile("s_waitcnt lgkmcnt(0)" ::: "memory"); __builtin_amdgcn_s_barrier(); asm volatile("" ::: "memory");
            for (int k = 0; k < NCHUNK; ++k) {
                const LAS unsigned char* bp = F.lds + (k & 1) * P4_BUF + lane * 16;
                const float egl = __builtin_bit_cast(float, __builtin_amdgcn_readlane(__builtin_bit_cast(int, k < 64 ? glv0 : glv1), k & 63));
                pg8::f32x4 WS[4], OT[4];
#pragma unroll
                for (int mt = 0; mt < 4; ++mt) { WS[mt] = (pg8::f32x4){0.f, 0.f, 0.f, 0.f}; OT[mt] = (pg8::f32x4){0.f, 0.f, 0.f, 0.f}; }
#pragma unroll
                for (int mt = 0; mt < 4; ++mt)
#pragma unroll
                    for (int s = 0; s < 4; ++s) WS[mt] = __builtin_amdgcn_mfma_f32_16x16x32_bf16(*(const LAS bf16x8*)(bp + (mt * 4 + s) * 1024), SB[s], WS[mt], 0, 0, 0);
#pragma unroll
                for (int mt = 0; mt < 4; ++mt)
#pragma unroll
                    for (int s = 0; s < 4; ++s) OT[mt] = __builtin_amdgcn_mfma_f32_16x16x32_bf16(SB[s], *(const LAS bf16x8*)(bp + 16384 + (mt * 4 + s) * 1024), OT[mt], 0, 0, 0);
                pg8::f32x4 vn[4];
#pragma unroll
                for (int mt = 0; mt < 4; ++mt) { const u2 uu = *(const LAS u2*)(F.lds + (k & 1) * P4_BUF + 57344 + (F.wave * 4 + mt) * 512 + lane * 8);
                    vn[mt] = (pg8::f32x4){bflo(uu.x) - WS[mt][0], bfhi(uu.x) - WS[mt][1], bflo(uu.y) - WS[mt][2], bfhi(uu.y) - WS[mt][3]}; }
                bf16x8 VB[2]; VB[0] = pack_frag(vn[0], vn[1]); VB[1] = pack_frag(vn[2], vn[3]);
#pragma unroll
                for (int mt = 0; mt < 4; ++mt)
#pragma unroll
                    for (int s2 = 0; s2 < 2; ++s2) OT[mt] = __builtin_amdgcn_mfma_f32_16x16x32_bf16(VB[s2], *(const LAS bf16x8*)(bp + 49152 + (mt * 2 + s2) * 1024), OT[mt], 0, 0, 0);
#pragma unroll
                for (int m = 0; m < 8; ++m) { S[m] = S[m] * egl;
#pragma unroll
                    for (int s2 = 0; s2 < 2; ++s2) S[m] = __builtin_amdgcn_mfma_f32_16x16x32_bf16(*(const LAS bf16x8*)(bp + 32768 + (m * 2 + s2) * 1024), VB[s2], S[m], 0, 0, 0); }
#pragma unroll
                for (int s = 0; s < 4; ++s) SB[s] = pack_frag(S[2 * s], S[2 * s + 1]);
                const int co = dir ? 127 - k : k;
#pragma unroll
                for (int mt = 0; mt < 4; ++mt) { const int pos = 16 * mt + r, ro = dir ? 63 - pos : pos;
                    u2 ov; ov.x = cvtpk(OT[mt][0], OT[mt][1]); ov.y = cvtpk(OT[mt][2], OT[mt][3]);
                    *(u2*)(od + (size_t)(co * 64 + ro) * D) = ov; }
                asm volatile("s_waitcnt lgkmcnt(0)" ::: "memory"); __builtin_amdgcn_s_barrier(); asm volatile("" ::: "memory");
            }
            __builtin_amdgcn_s_barrier();
        }
        __syncthreads();
    }
    {
        __syncthreads();
        if (F.tid == 0) uq[0] = (int)__hip_atomic_fetch_add((unsigned*)(F.ws + WS_CTL) + CW_RANK, 1u, __ATOMIC_RELAXED, __HIP_MEMORY_SCOPE_AGENT);
        __syncthreads();
        const int rank = uq[0];
        pg8::Gemm g{(const bf16*)(F.ws + WS_SB), (const bf16*)(F.ws + WS_WUO_T) + (size_t)1024 * 1024, NTOK, D, D}; pg8::StaticOrder S; S.init(NTOK, D, 128, rank); if (rank >= 128) S.nwg = 0;
        EpiGate E{(const bf16*)(F.ws + WS_P), (float*)(F.ws + WS_M1X), (bf16*)nullptr, PC_GB, 0};
        pg8::gemm_phase<EpiGate, pg8::StaticOrder, true, true>((PG8_LAS unsigned char*)F.lds, g, S, E);
        __syncthreads();
    }
    moe_convert(F, AR);
}

__device__ __forceinline__ void phase_p5_sb(Frame& F, const Args& AR) {
    const bf16* P = (const bf16*)(F.ws + WS_P); bf16* sbp = (bf16*)(F.ws + WS_SB);
    const float* convs = AR.in[11];
    const int lane = F.lane, ch = 16 * lane;
    float cw[3][16];
#pragma unroll
    for (int e = 0; e < 16; ++e)
#pragma unroll
        for (int j = 0; j < 3; ++j) cw[j][e] = convs[j * 1024 + ch + e];
    const int gw = blockIdx.x * NWAVES + F.wave, NGW = F.G * NWAVES;
    for (int m = gw; m < NTOK; m += NGW) {
        const int t = m & (SEQ - 1);
        float acc[16], r[8];
#pragma unroll
        for (int e = 0; e < 16; ++e) acc[e] = 0.f;
#pragma unroll
        for (int j = 0; j < 3; ++j) { const int tt = t + j - 1;
            if (tt >= 0 && tt < SEQ) { const bf16* rowp = P + (size_t)(m + j - 1) * PW; float cg[8], ui[8];
                unpack8(*(const u4*)(rowp + PC_CG + ch), cg); unpack8(*(const u4*)(rowp + PC_UI + ch), ui);
#pragma unroll
                for (int e = 0; e < 8; ++e) acc[e] += cw[j][e] * (cg[e] * ui[e]);
                unpack8(*(const u4*)(rowp + PC_CG + ch + 8), cg); unpack8(*(const u4*)(rowp + PC_UI + ch + 8), ui);
#pragma unroll
                for (int e = 0; e < 8; ++e) acc[8 + e] += cw[j][8 + e] * (cg[e] * ui[e]); } }
        float bg[8];
        unpack8(*(const u4*)(P + (size_t)m * PW + PC_BG + ch), bg);
#pragma unroll
        for (int e = 0; e < 8; ++e) r[e] = bg[e] * acc[e];
        *(u4*)(sbp + (size_t)m * D + ch) = pack8(r);
        unpack8(*(const u4*)(P + (size_t)m * PW + PC_BG + ch + 8), bg);
#pragma unroll
        for (int e = 0; e < 8; ++e) r[e] = bg[e] * acc[8 + e];
        *(u4*)(sbp + (size_t)m * D + ch + 8) = pack8(r);
    }
}
__device__ __forceinline__ void phase_p5(Frame& F, const Args& AR) {
    const bf16* P = (const bf16*)(F.ws + WS_P); const bf16* od = (const bf16*)(F.ws + WS_OD); bf16* oap = (bf16*)(F.ws + WS_OASB);
    const float* onorm_w = AR.in[9];
    const int lane = F.lane, ch = 16 * lane;
    float onw[16];
#pragma unroll
    for (int e = 0; e < 16; ++e) onw[e] = onorm_w[(ch + e) & 127];
    const int gw = blockIdx.x * NWAVES + F.wave, NGW = F.G * NWAVES;
    for (int m0 = gw; m0 < NTOK; m0 += 2 * NGW) {
        u4 ld[2][6];
#pragma unroll
        for (int rr = 0; rr < 2; ++rr) { const int m = (m0 + rr * NGW < NTOK) ? m0 + rr * NGW : m0;
            ld[rr][0] = *(const u4*)(od + (size_t)m * D + ch); ld[rr][1] = *(const u4*)(od + (size_t)m * D + ch + 8);
            ld[rr][2] = *(const u4*)(od + (size_t)(NTOK + m) * D + ch); ld[rr][3] = *(const u4*)(od + (size_t)(NTOK + m) * D + ch + 8);
            ld[rr][4] = *(const u4*)(P + (size_t)m * PW + PC_Z + ch); ld[rr][5] = *(const u4*)(P + (size_t)m * PW + PC_Z + ch + 8); }
#pragma unroll
        for (int rr = 0; rr < 2; ++rr) { const int m = m0 + rr * NGW; if (m >= NTOK) break;
            float o[16], z[16], t8[8];
            unpack8(ld[rr][0], t8);
#pragma unroll
            for (int e = 0; e < 8; ++e) o[e] = t8[e];
            unpack8(ld[rr][1], t8);
#pragma unroll
            for (int e = 0; e < 8; ++e) o[8 + e] = t8[e];
            unpack8(ld[rr][2], t8);
#pragma unroll
            for (int e = 0; e < 8; ++e) o[e] += t8[e];
            unpack8(ld[rr][3], t8);
#pragma unroll
            for (int e = 0; e < 8; ++e) o[8 + e] += t8[e];
            unpack8(ld[rr][4], t8);
#pragma unroll
            for (int e = 0; e < 8; ++e) z[e] = t8[e];
            unpack8(ld[rr][5], t8);
#pragma unroll
            for (int e = 0; e < 8; ++e) z[8 + e] = t8[e];
            float ss = 0.f;
#pragma unroll
            for (int e = 0; e < 16; ++e) ss += o[e] * o[e];
            ss += __shfl_xor(ss, 1); ss += __shfl_xor(ss, 2); ss += __shfl_xor(ss, 4);
            const float rstd = 1.0f / sqrtf(ss * (1.0f / 128.0f) + EPS);
            float r[8];
#pragma unroll
            for (int e = 0; e < 8; ++e) r[e] = o[e] * rstd * onw[e] * silu(z[e]);
            *(u4*)(oap + (size_t)m * D + ch) = pack8(r);
#pragma unroll
            for (int e = 0; e < 8; ++e) r[e] = o[8 + e] * rstd * onw[8 + e] * silu(z[8 + e]);
            *(u4*)(oap + (size_t)m * D + ch + 8) = pack8(r); }
    }
}

constexpr int P7_MAXIT = 16;
__device__ __forceinline__ void phase_p7(Frame& F, const Args& AR) {
    const float* x1 = (const float*)(F.ws + WS_OD); const float* norm2_w = AR.in[14]; const float* router_b = AR.in[16]; const float* mod = (const float*)(F.ws + WS_MOD);
    LAS float* WtL = (LAS float*)F.lds;
    LAS float* A1 = (LAS float*)(F.lds + 131584);
    LAS float* B1 = A1 + 2048;
    stage_wt(WtL, (const float*)(F.ws + WS_WR_T), F.tid);
    for (int idx = F.tid; idx < 2048; idx += NTHR) { const int b = idx >> 10, k = idx & 1023; A1[idx] = norm2_w[k] * (1.0f + mod[b * 6144 + 4096 + k]); B1[idx] = mod[b * 6144 + 3072 + k]; }
    LAS unsigned* lcnt = (LAS unsigned*)(B1 + 2048);
    LAS unsigned* rec = lcnt + 64;
    if (F.tid < 64) lcnt[F.tid] = 0u;
    __syncthreads();
    bf16* h2 = (bf16*)(F.ws + WS_H); int* topi = (int*)(F.ws + WS_TOPI); float* topg = (float*)(F.ws + WS_TOPG); int* topp = (int*)(F.ws + WS_TOPP);
    unsigned* cnt = (unsigned*)(F.ws + WS_CTL) + CW_CNT; int* elist = (int*)(F.ws + WS_LIST);
    const int lane = F.lane; const float rb = router_b[lane >> 1];
    const int gw = blockIdx.x * NWAVES + F.wave, NGW = F.G * NWAVES;
    int it = 0;
    for (int m = gw; m < NTOK; m += NGW, ++it) {
        const f4* xr = (const f4*)(x1 + (size_t)m * D) + lane; f4 v[4]; float ss = 0.f;
#pragma unroll
        for (int j = 0; j < 4; ++j) { v[j] = xr[64 * j]; ss += (v[j].x * v[j].x + v[j].y * v[j].y) + (v[j].z * v[j].z + v[j].w * v[j].w); }
        const float rstd = 1.0f / sqrtf(wave_sum(ss) * (1.0f / D) + EPS);
        const int b = m >> 13;
#pragma unroll
        for (int j = 0; j < 4; ++j) { const f4 a = *(const LAS f4*)(A1 + b * 1024 + 256 * j + 4 * lane), bb = *(const LAS f4*)(B1 + b * 1024 + 256 * j + 4 * lane);
            v[j] = v[j] * rstd * a + bb;
            u2 o; o.x = pk2(v[j].x, v[j].y); o.y = pk2(v[j].z, v[j].w); ((u2*)(h2 + (size_t)m * D))[lane + 64 * j] = o; }
        float val = dot32(v, WtL, lane) + rb; const int myn = lane >> 1;
        float tv[4]; int ti[4];
#pragma unroll
        for (int r = 0; r < 4; ++r) { float bv = val; int bi = myn;
#pragma unroll
            for (int o = 1; o < 64; o <<= 1) { const float ov = __shfl_xor(bv, o); const int oi = __shfl_xor(bi, o); if (ov > bv || (ov == bv && oi < bi)) { bv = ov; bi = oi; } }
            tv[r] = bv; ti[r] = bi; if (myn == bi) val = -__builtin_inff(); }
        const float e1 = __expf(tv[1] - tv[0]), e2 = __expf(tv[2] - tv[0]), e3 = __expf(tv[3] - tv[0]), inv = 1.0f / (1.0f + e1 + e2 + e3);
        if (lane < 4) { const int e = lane == 0 ? ti[0] : (lane == 1 ? ti[1] : (lane == 2 ? ti[2] : ti[3]));
            const float g = (lane == 0 ? 1.0f : (lane == 1 ? e1 : (lane == 2 ? e2 : e3))) * inv;
            topi[(size_t)m * 4 + lane] = e; topg[(size_t)m * 4 + lane] = g;
            if (it < P7_MAXIT) { const unsigned lp = __hip_atomic_fetch_add(lcnt + e, 1u, __ATOMIC_RELAXED, __HIP_MEMORY_SCOPE_WORKGROUP); rec[(F.wave * P7_MAXIT + it) * 4 + lane] = (unsigned)e | (lp << 8); }
            else { const unsigned pos = __hip_atomic_fetch_add(cnt + 64 * e, 1u, __ATOMIC_RELAXED, __HIP_MEMORY_SCOPE_AGENT); topp[(size_t)m * 4 + lane] = (int)pos; elist[e * 16384 + pos] = m; } }
    }
    __syncthreads();
    if (F.tid < 32) lcnt[32 + F.tid] = __hip_atomic_fetch_add(cnt + 64 * F.tid, lcnt[F.tid], __ATOMIC_RELAXED, __HIP_MEMORY_SCOPE_AGENT);
    __syncthreads();
    { int it = 0;
        for (int m = gw; m < NTOK && it < P7_MAXIT; m += NGW, ++it)
            if (lane < 4) { const unsigned rc = rec[(F.wave * P7_MAXIT + it) * 4 + lane]; const unsigned e = rc & 255u, pos = lcnt[32 + e] + (rc >> 8); topp[(size_t)m * 4 + lane] = (int)pos; elist[e * 16384 + pos] = m; } }
}

__device__ __forceinline__ int build_moe_tables(Frame& F, LAS int* tab  ) {
    const unsigned* cnt = (const unsigned*)(F.ws + WS_CTL) + CW_CNT;
    if (F.tid == 0) { int start = 0;
        for (int e = 0; e < NEXP; ++e) { const int n = (int)__hip_atomic_load(cnt + 64 * e, __ATOMIC_RELAXED, __HIP_MEMORY_SCOPE_AGENT); const int nb = (n + 255) >> 8; tab[e] = start * 256; tab[512 + e] = n;
            for (int k = 0; k < nb; ++k) tab[64 + start + k] = e; start += nb; }
        tab[32] = start; }
    __syncthreads();
    return tab[32];
}

__device__ __forceinline__ void phase_p9(Frame& F, const Args& AR, float* out) {
    const float* x1 = (const float*)(F.ws + WS_OD); const bf16* ys = (const bf16*)(F.ws + WS_YS); const float* mod = (const float*)(F.ws + WS_MOD); const float* fnw = AR.in[21];
    const float* topg = (const float*)(F.ws + WS_TOPG); const int* topp = (const int*)(F.ws + WS_TOPP); const int* topi = (const int*)(F.ws + WS_TOPI);
    LAS int* tab = (LAS int*)(F.lds + LDS_TAB); build_moe_tables(F, tab);
    const int lane = F.lane;
    const int gw = blockIdx.x * NWAVES + F.wave, NGW = F.G * NWAVES;
    for (int m = gw; m < NTOK; m += NGW) {
        const int b = m >> 13;
        const f4 gk = *(const f4*)(topg + (size_t)m * 4); const int r0 = tab[topi[(size_t)m * 4]] + topp[(size_t)m * 4], r1 = tab[topi[(size_t)m * 4 + 1]] + topp[(size_t)m * 4 + 1], r2 = tab[topi[(size_t)m * 4 + 2]] + topp[(size_t)m * 4 + 2], r3 = tab[topi[(size_t)m * 4 + 3]] + topp[(size_t)m * 4 + 3];
        f4 v[4]; float ss = 0.f;
#pragma unroll
        for (int j = 0; j < 4; ++j) {
            const u2 y0 = __builtin_nontemporal_load((const u2*)(ys + (size_t)r0 * D) + lane + 64 * j), y1 = __builtin_nontemporal_load((const u2*)(ys + (size_t)r1 * D) + lane + 64 * j), y2 = __builtin_nontemporal_load((const u2*)(ys + (size_t)r2 * D) + lane + 64 * j), y3 = __builtin_nontemporal_load((const u2*)(ys + (size_t)r3 * D) + lane + 64 * j);
            f4 mo;
            mo.x = gk.x * bflo(y0.x) + gk.y * bflo(y1.x) + gk.z * bflo(y2.x) + gk.w * bflo(y3.x);
            mo.y = gk.x * bfhi(y0.x) + gk.y * bfhi(y1.x) + gk.z * bfhi(y2.x) + gk.w * bfhi(y3.x);
            mo.z = gk.x * bflo(y0.y) + gk.y * bflo(y1.y) + gk.z * bflo(y2.y) + gk.w * bflo(y3.y);
            mo.w = gk.x * bfhi(y0.y) + gk.y * bfhi(y1.y) + gk.z * bfhi(y2.y) + gk.w * bfhi(y3.y);
            const f4 xv = ((const f4*)(x1 + (size_t)m * D))[lane + 64 * j], gt = ((const f4*)(mod + b * 6144 + 5120))[lane + 64 * j];
            v[j] = xv + gt * mo; ss += (v[j].x * v[j].x + v[j].y * v[j].y) + (v[j].z * v[j].z + v[j].w * v[j].w); }
        const float rstd = 1.0f / sqrtf(wave_sum(ss) * (1.0f / D) + EPS);
#pragma unroll
        for (int j = 0; j < 4; ++j) { const f4 w = ((const f4*)fnw)[lane + 64 * j]; __builtin_nontemporal_store(v[j] * rstd * w, (f4*)(out + (size_t)m * D) + lane + 64 * j); }
    }
}

__global__ void __launch_bounds__(NTHR, 2) fwd_kernel(Args args) {
    const Args& AR = args;
    extern __shared__ __attribute__((aligned(16))) unsigned char lds_raw[];
    Frame F;
    F.lds = (LAS unsigned char*)lds_raw;
    F.tid = threadIdx.x; F.lane = F.tid & 63; F.wave = __builtin_amdgcn_readfirstlane(F.tid >> 6); F.G = gridDim.x;
    F.ws = args.ws;
    volatile LAS unsigned* misc = (volatile LAS unsigned*)(F.lds + LDS_MISC);
    if (F.tid < 4) misc[F.tid] = 0u;
    __syncthreads();
    XcdBarrier bar; bar.bar = (unsigned*)(F.ws + WS_CTL) + CW_BAR; bar.x = 0; bar.st = nullptr;
    if (MK_N_LAUNCHES == 1) bar = xcd_barrier_post((unsigned*)(F.ws + WS_CTL) + CW_BAR, misc);
    const int lo = args.ph_lo, hi = args.ph_hi;
#ifndef PH_MASK
#define PH_MASK 0x1fff
#endif
#define IN(k) (((PH_MASK >> (k)) & 1) && lo <= (k) && (k) < hi)
#ifndef PROBE_PH
#define PROBE_PH -1
#define PROBE_REP 1
#endif
#define REPS(k) for (int rep_ = 0; rep_ < ((k) == PROBE_PH ? PROBE_REP : 1); ++rep_)
#define SEAM(k) do { if (IN(k) && IN((k) + 1)) xcd_barrier(bar); } while (0)
    PG8_LAS unsigned char* glds = (PG8_LAS unsigned char*)lds_raw;

    if (IN(0)) REPS(0) { phase_p0(F, AR); } SEAM(0);
    if (IN(1)) REPS(1) { phase_p1(F, AR); } SEAM(1);
    if (IN(2)) REPS(2) {
        pg8::Gemm g{(const bf16*)(F.ws + WS_H), (const bf16*)(F.ws + WS_WIN_T), NTOK, PW, D}; pg8::StaticOrder S; S.init(NTOK, PW, F.G, (int)blockIdx.x);
        EpiStoreBf16 E{(bf16*)(F.ws + WS_P), PW};
        pg8::gemm_phase<EpiStoreBf16, pg8::StaticOrder, true, true>(glds, g, S, E);
    } SEAM(2);
    if (IN(3)) REPS(3) { phase_p3(F, AR); __syncthreads(); phase_p5_sb(F, AR); } SEAM(3);
    if (IN(4)) REPS(4) { phase_p4(F, AR); } SEAM(4);
    if (IN(5)) REPS(5) { phase_p5(F, AR); } SEAM(5);
    if (IN(6)) REPS(6) {
        pg8::Gemm g{(const bf16*)(F.ws + WS_OASB), (const bf16*)(F.ws + WS_WUO_T), NTOK, D, D}; pg8::StaticOrder S; S.init(NTOK, D, F.G, (int)blockIdx.x);
        EpiGate E{(const bf16*)(F.ws + WS_P), (float*)(F.ws + WS_M1X), (bf16*)(F.ws + WS_M), PC_GA, 1};
        pg8::gemm_phase<EpiGate, pg8::StaticOrder, true, true>(glds, g, S, E);
    } SEAM(6);
    if (IN(7)) REPS(7) {
        pg8::Gemm g{(const bf16*)(F.ws + WS_M), (const bf16*)(F.ws + WS_WO_T), NTOK, D, D}; pg8::StaticOrder S; S.init(NTOK, D, F.G, (int)blockIdx.x);
        EpiG4 E{AR.in[0], (const float*)(F.ws + WS_MOD), (float*)(F.ws + WS_OD)};
        pg8::gemm_phase<EpiG4, pg8::StaticOrder, true, true>(glds, g, S, E);
    } SEAM(7);
    if (IN(8)) REPS(8) { phase_p7(F, AR); } SEAM(8);
    if (IN(9)) REPS(9) {
        __syncthreads();
        LAS int* tab = (LAS int*)(F.lds + LDS_TAB); const int nblk = build_moe_tables(F, tab);
        pg8::Gemm g{(const bf16*)(F.ws + WS_H), (const bf16*)(F.ws + WS_W1T), NTOK, NEXP * 2048, D}; MoeOrder S; S.init(nblk, 8, F.G, (int)blockIdx.x, tab, (const int*)(F.ws + WS_LIST));
        EpiMoe1 E{AR.in[18], (bf16*)(F.ws + WS_ACT)};
        pg8::gemm_phase<EpiMoe1, MoeOrder, true, true, true>(glds, g, S, E);
    } SEAM(9);
    if (IN(10)) REPS(10) {
        __syncthreads();
        LAS int* tab = (LAS int*)(F.lds + LDS_TAB); const int nblk = build_moe_tables(F, tab);
        pg8::Gemm g{(const bf16*)(F.ws + WS_ACT), (const bf16*)(F.ws + WS_W2T), MROWS, NEXP * 1024, D}; MoeOrder S; S.init(nblk, 4, F.G, (int)blockIdx.x, tab, (const int*)(F.ws + WS_LIST));
        EpiMoe2 E{AR.in[20], (bf16*)(F.ws + WS_YS)};
        pg8::gemm_phase<EpiMoe2, MoeOrder, true, true>(glds, g, S, E);
    } SEAM(10);
    if (IN(11)) REPS(11) { phase_p9(F, AR, args.out); }
#undef IN
#undef SEAM
}

extern "C" void kernel_launch(void* const* d_in, const int* in_sizes, int n_in, void* d_out, int out_size, void* d_ws, size_t ws_size, hipStream_t stream) {
    static int grid = 0;
    if (grid == 0) {
        if (n_in != 22 || out_size != NTOK * D || ws_size < WS_END) { fprintf(stderr, "kernel_launch: unexpected shapes (n_in %d out %d ws %zu)\n", n_in, out_size, ws_size); grid = -1; return; }
        int dev = 0, cus = 0, per_cu = 0;
        if (hipGetDevice(&dev) != hipSuccess || hipDeviceGetAttribute(&cus, hipDeviceAttributeMultiprocessorCount, dev) != hipSuccess) { grid = -1; return; }
        if (hipFuncSetAttribute((const void*)fwd_kernel, hipFuncAttributeMaxDynamicSharedMemorySize, LDS_BYTES) != hipSuccess) { fprintf(stderr, "kernel_launch: hipFuncSetAttribute failed\n"); grid = -1; return; }
        if (hipOccupancyMaxActiveBlocksPerMultiprocessor(&per_cu, (const void*)fwd_kernel, NTHR, LDS_BYTES) != hipSuccess || per_cu < 1) { fprintf(stderr, "kernel_launch: occupancy query says %d\n", per_cu); }
        (void)hipGetLastError();
        grid = cus;
        if (grid > 256) grid = 256;
    }
    if (grid < 0) return;
    if (hipMemsetAsync((char*)d_ws + WS_CTL, 0, CTL_ZERO_BYTES, stream) != hipSuccess) return;
    Args a{};
    for (int i = 0; i < 22; ++i) a.in[i] = (const float*)d_in[i];
    a.out = (float*)d_out; a.ws = (unsigned char*)d_ws;
#if MK_N_LAUNCHES == 1
    a.ph_lo = 0; a.ph_hi = NPHASE;
    hipLaunchKernelGGL(fwd_kernel, dim3(grid), dim3(NTHR), LDS_BYTES, stream, a);
#else
    for (int ph = 0; ph < NPHASE; ++ph) { a.ph_lo = ph; a.ph_hi = ph + 1; hipLaunchKernelGGL(fwd_kernel, dim3(grid), dim3(NTHR), LDS_BYTES, stream, a); }
#endif
}
```

```cpp
#include <hip/hip_runtime.h>
#include <cstdio>
#include <cstdint>
namespace pg8 {
#define PG8_LAS __attribute__((address_space(3)))
typedef unsigned short bf16_t;
typedef short bf16x8 __attribute__((ext_vector_type(8)));
typedef float f32x4 __attribute__((ext_vector_type(4)));
typedef unsigned u32x4 __attribute__((ext_vector_type(4)));
constexpr int BM = 256, BK = 64, HALF = 128, HTB = HALF * BK * 2  , STAGE_BYTES = 8 * HTB, NXCD = 8, WGM = 8;

__host__ __device__ __forceinline__ int lds_byte(int r, int c) { const int st = (r >> 4) * 2 + (c >> 5), rr = r & 15, cc = c & 31, ob = rr * 64 + cc * 2; return st * 1024 + (ob ^ (((ob >> 9) & 1) << 5)); }
__host__ __device__ __forceinline__ void stage_rc(int b, int& R, int& C) { const int st = b / 1024, sb = b % 1024, swz = sb ^ (((sb >> 9) & 1) << 5); R = (st >> 1) * 16 + swz / 64; C = (st & 1) * 32 + (swz % 64) / 2; }
__host__ __device__ __forceinline__ int perm32(int rho) { const int n = rho >> 4, i = rho & 15; return 8 * (i >> 2) + 4 * n + (i & 3); }

struct Unit { int pm, pn; };
struct Gemm { const bf16_t* A; const bf16_t* Bt; int M, N, K; };

struct StaticOrder {
    int nM, nN, nwg, G, c;
    __host__ __device__ void init(int M, int N, int G_, int c_) { nM = M / BM; nN = N / BM; nwg = nM * nN; G = G_; c = c_; }
    __host__ __device__ bool next(int i, Unit& u) const {
        const long L = (long)i * G + c; if (L >= nwg) return false;
        int wgid = (int)L; { const int q = nwg / NXCD, r = nwg % NXCD, xcd = wgid % NXCD, off = wgid / NXCD; wgid = (xcd < r ? xcd * (q + 1) : r * (q + 1) + (xcd - r) * q) + off; }
        const int nig = WGM * nN, gid = wgid / nig, fm = gid * WGM, gsz = (nM - fm) < WGM ? (nM - fm) : WGM;
        u.pm = fm + ((wgid % nig) % gsz); u.pn = (wgid % nig) / gsz; return true;
    }
    __device__ __forceinline__ void a_ready(const Unit&) const {}
    __device__ __forceinline__ void done(const Unit&) const {}
};

__device__ __forceinline__ unsigned cvt_pk_bf16(float lo, float hi) { unsigned r; asm volatile("v_cvt_pk_bf16_f32 %0, %1, %2" : "=v"(r) : "v"(lo), "v"(hi)); return r; }
template <class Epi, class Sched, bool ALIGN_EPI = false, bool SP2 = false, bool GATHER = false>
__device__ __forceinline__ void gemm_phase(PG8_LAS unsigned char* lds, const Gemm g, const Sched& S, const Epi& E) {
    const int tid = threadIdx.x, wid = __builtin_amdgcn_readfirstlane(tid >> 6), lane = tid & 63, wr = wid >> 2, wc = wid & 3, fr = lane & 15, fq = lane >> 4;
    const int K = g.K, nt = K / BK;
    unsigned voffA[2], voffB[2];
#pragma unroll
    for (int i = 0; i < 2; ++i) { int R, C; stage_rc(tid * 16 + i * 8192, R, C); const int Rb = Epi::PERM ? ((R & ~31) + perm32(R & 31)) : R;
        voffA[i] = (unsigned)(R * K + C) * 2u; voffB[i] = (unsigned)(Rb * K + C) * 2u; }
    unsigned vA[2][2], vN[2][2];
#pragma unroll
    for (int h = 0; h < 2; ++h)
#pragma unroll
        for (int i = 0; i < 2; ++i) { vA[h][i] = voffA[i] + (unsigned)(h * HALF * K * 2); vN[h][i] = vA[h][i]; }
#define PG8_TOKS(u, tq) do { _Pragma("unroll") for (int _h = 0; _h < 2; ++_h) _Pragma("unroll") for (int _i = 0; _i < 2; ++_i) { int _R, _C; stage_rc(tid * 16 + _i * 8192, _R, _C); tq[_h][_i] = S.row_token(u, _h * HALF + _R); } } while (0)
#define PG8_OFFS(tq, v) do { _Pragma("unroll") for (int _h = 0; _h < 2; ++_h) _Pragma("unroll") for (int _i = 0; _i < 2; ++_i) { int _R, _C; stage_rc(tid * 16 + _i * 8192, _R, _C); v[_h][_i] = (unsigned)(tq[_h][_i] * K + _C) * 2u; } } while (0)
    const size_t kstep = (size_t)(BK * 2);
    const size_t hstep = (size_t)HALF * K * 2;
    const size_t tstep = 2 * hstep;
    const unsigned ldsw = (unsigned)wid * 1024u;
    const int aoff = lds_byte(wr * 64 + fr, fq * 8), boff = lds_byte(wc * 32 + fr, fq * 8);
#define PG8_SA(b, h) (((b) * 2 + (h)) * HTB)
#define PG8_SB(b, h) ((4 + (b) * 2 + (h)) * HTB)
#define PG8_STAGE(bufoff, gbase, voff) do { _Pragma("unroll") for (int _i = 0; _i < 2; ++_i) \
        __builtin_amdgcn_global_load_lds((const unsigned*)((const char*)(gbase) + (voff)[_i]), (PG8_LAS unsigned*)(lds + (bufoff) + ldsw + _i * 8192), 16, 0, 0); } while (0)
#define PG8_LDA(dst, b, h) do { _Pragma("unroll") for (int m = 0; m < 4; ++m) _Pragma("unroll") for (int k = 0; k < 2; ++k) dst[m][k] = *(const PG8_LAS bf16x8*)(lds + PG8_SA(b, h) + aoff + m * 2048 + k * 1024); } while (0)
#define PG8_LDB(dst, b, h) do { _Pragma("unroll") for (int n = 0; n < 2; ++n) _Pragma("unroll") for (int k = 0; k < 2; ++k) dst[n][k] = *(const PG8_LAS bf16x8*)(lds + PG8_SB(b, h) + boff + n * 2048 + k * 1024); } while (0)
#define PG8_MMA(ai, bj, At, Bt) do { __builtin_amdgcn_s_setprio(1); _Pragma("unroll") for (int m = 0; m < 4; ++m) _Pragma("unroll") for (int n = 0; n < 2; ++n) _Pragma("unroll") for (int k = 0; k < 2; ++k) \
        acc[ai][bj][m][n] = __builtin_amdgcn_mfma_f32_16x16x32_bf16(Bt[n][k], At[m][k], acc[ai][bj][m][n], 0, 0, 0); __builtin_amdgcn_s_setprio(0); } while (0)
#define PG8_WAIT_V(n) asm volatile("s_waitcnt vmcnt(" #n ")" ::: "memory")
#define PG8_WAIT_L(n) asm volatile("s_waitcnt lgkmcnt(" #n ")" ::: "memory")
#define PG8_BAR __builtin_amdgcn_s_barrier()
#define PG8_SCHED __builtin_amdgcn_sched_barrier(0)
    Unit cur, nxt; int ui = 0;
    if (!S.next(0, cur)) return;
    f32x4 acc[2][2][4][2];
#pragma unroll
    for (int a = 0; a < 2; ++a)
#pragma unroll
        for (int b = 0; b < 2; ++b)
#pragma unroll
            for (int m = 0; m < 4; ++m)
#pragma unroll
                for (int n = 0; n < 2; ++n) acc[a][b][m][n] = (f32x4){0.f, 0.f, 0.f, 0.f};
    bf16x8 At[4][2], B0[2][2], B1[2][2];
    const char* cA = (const char*)g.A + (GATHER ? (size_t)0 : (size_t)cur.pm * tstep); const char* cB = (const char*)g.Bt + (size_t)cur.pn * tstep;
    if constexpr (GATHER) { int tq0[2][2]; PG8_TOKS(cur, tq0); PG8_OFFS(tq0, vA); Unit n1; if (S.next(1, n1)) { PG8_TOKS(n1, tq0); PG8_OFFS(tq0, vN); } else { vN[0][0] = vA[0][0]; vN[0][1] = vA[0][1]; vN[1][0] = vA[1][0]; vN[1][1] = vA[1][1]; } }
    S.a_ready(cur);
    if constexpr (SP2) {
        PG8_STAGE(PG8_SB(0, 0), cB, voffB); PG8_STAGE(PG8_SB(0, 1), cB + hstep, voffB); PG8_STAGE(PG8_SA(0, 0), cA, vA[0]); PG8_STAGE(PG8_SA(0, 1), cA, vA[1]);
        if (wr == 1) PG8_BAR;
        PG8_WAIT_V(2); PG8_BAR;
        PG8_STAGE(PG8_SB(1, 0), cB + kstep, voffB); PG8_STAGE(PG8_SA(1, 0), cA + kstep, vA[0]); PG8_STAGE(PG8_SB(1, 1), cB + hstep + kstep, voffB);
        PG8_WAIT_V(6); PG8_BAR;
    } else {
        PG8_STAGE(PG8_SB(0, 0), cB, voffB); PG8_STAGE(PG8_SA(0, 0), cA, voffA); PG8_STAGE(PG8_SB(0, 1), cB + hstep, voffB); PG8_STAGE(PG8_SA(0, 1), cA + hstep, voffA);
        if (wr == 1) PG8_BAR;
        PG8_WAIT_V(4); PG8_BAR;
        PG8_STAGE(PG8_SB(1, 0), cB + kstep, voffB); PG8_STAGE(PG8_SA(1, 0), cA + kstep, voffA); PG8_STAGE(PG8_SB(1, 1), cB + hstep + kstep, voffB);
        PG8_WAIT_V(6); PG8_BAR;
    }
    for (;;) {
        const bool has_next = S.next(ui + 1, nxt);
        const char* nA = (has_next && !GATHER) ? (const char*)g.A + (size_t)nxt.pm * tstep : cA; const char* nB = has_next ? (const char*)g.Bt + (size_t)nxt.pn * tstep : cB;
        for (int t = 0; t < nt; t += 2) {
            const bool last = (t == nt - 2);
            const char* a1 = cA + (size_t)(t + 1) * kstep;
            const char* a2 = last ? nA : cA + (size_t)(t + 2) * kstep; const char* b2 = last ? nB : cB + (size_t)(t + 2) * kstep;
            const char* a3 = a2 + kstep; const char* b3 = b2 + kstep;
            if (last && has_next) S.a_ready(nxt);
            unsigned o0[2] = {vA[0][0], vA[0][1]}, o1[2] = {vA[1][0], vA[1][1]};
            if (last) { o0[0] = vN[0][0]; o0[1] = vN[0][1]; o1[0] = vN[1][0]; o1[1] = vN[1][1]; }
            if constexpr (SP2) {
            PG8_LDB(B0, 0, 0); PG8_LDB(B1, 0, 1); PG8_SCHED; PG8_LDA(At, 0, 0); PG8_STAGE(PG8_SA(1, 1), a1, vA[1]);
            PG8_WAIT_V(8); PG8_WAIT_L(0); PG8_BAR; PG8_MMA(0, 0, At, B0); PG8_MMA(0, 1, At, B1); PG8_BAR; PG8_SCHED;
            PG8_LDA(At, 0, 1); PG8_STAGE(PG8_SB(0, 0), b2, voffB); PG8_STAGE(PG8_SB(0, 1), b2 + hstep, voffB); PG8_STAGE(PG8_SA(0, 0), a2, o0);
            PG8_WAIT_V(8); PG8_WAIT_L(0); PG8_BAR; PG8_MMA(1, 0, At, B0); PG8_MMA(1, 1, At, B1); PG8_BAR; PG8_SCHED;
            PG8_LDB(B0, 1, 0); PG8_LDB(B1, 1, 1); PG8_SCHED; PG8_LDA(At, 1, 0); PG8_STAGE(PG8_SA(0, 1), a2, o1);
            PG8_WAIT_V(8); PG8_WAIT_L(0); PG8_BAR; PG8_MMA(0, 0, At, B0); PG8_MMA(0, 1, At, B1); PG8_BAR; PG8_SCHED;
            PG8_LDA(At, 1, 1); PG8_STAGE(PG8_SB(1, 0), b3, voffB); PG8_STAGE(PG8_SB(1, 1), b3 + hstep, voffB); PG8_STAGE(PG8_SA(1, 0), a3, o0);
            PG8_WAIT_V(8); PG8_WAIT_L(0); PG8_BAR; PG8_MMA(1, 0, At, B0); PG8_MMA(1, 1, At, B1); PG8_BAR; PG8_SCHED;
            } else {
            PG8_LDB(B0, 0, 0); PG8_SCHED; PG8_LDA(At, 0, 0); PG8_STAGE(PG8_SA(1, 1), a1 + hstep, voffA);
            PG8_WAIT_L(8); PG8_BAR; PG8_WAIT_L(0); PG8_MMA(0, 0, At, B0); PG8_BAR; PG8_SCHED;
            PG8_LDB(B1, 0, 1); PG8_STAGE(PG8_SB(0, 0), b2, voffB);
            PG8_BAR; PG8_WAIT_L(0); PG8_MMA(0, 1, At, B1); PG8_BAR;
            PG8_LDA(At, 0, 1); PG8_STAGE(PG8_SA(0, 0), a2, voffA);
            PG8_BAR; PG8_WAIT_L(0); PG8_MMA(1, 0, At, B0); PG8_BAR; PG8_SCHED;
            PG8_STAGE(PG8_SB(0, 1), b2 + hstep, voffB);
            PG8_WAIT_V(6); PG8_BAR; PG8_MMA(1, 1, At, B1); PG8_BAR;
            PG8_LDB(B0, 1, 0); PG8_SCHED; PG8_LDA(At, 1, 0); PG8_STAGE(PG8_SA(0, 1), a2 + hstep, voffA);
            PG8_WAIT_L(8); PG8_BAR; PG8_WAIT_L(0); PG8_MMA(0, 0, At, B0); PG8_BAR; PG8_SCHED;
            PG8_LDB(B1, 1, 1); PG8_STAGE(PG8_SB(1, 0), b3, voffB);
            PG8_BAR; PG8_WAIT_L(0); PG8_MMA(0, 1, At, B1); PG8_BAR;
            PG8_LDA(At, 1, 1); PG8_STAGE(PG8_SA(1, 0), a3, voffA);
            PG8_BAR; PG8_WAIT_L(0); PG8_MMA(1, 0, At, B0); PG8_BAR; PG8_SCHED;
            PG8_STAGE(PG8_SB(1, 1), b3 + hstep, voffB);
            PG8_WAIT_V(6); PG8_BAR; PG8_MMA(1, 1, At, B1); PG8_BAR;
            }
        }
        if constexpr (ALIGN_EPI) { if (wr == 0) PG8_BAR; }
        int tq[2][2] = {{0, 0}, {0, 0}}; bool has2 = false;
        if constexpr (GATHER) { Unit nx2; has2 = S.next(ui + 2, nx2); if (has2) PG8_TOKS(nx2, tq); }
        if constexpr (!Epi::AFTER_DRAIN) { E(acc, cur, wr, wc, fr, fq); S.done(cur); }
        if constexpr (GATHER) { asm volatile("" : "+v"(tq[0][0]), "+v"(tq[0][1]), "+v"(tq[1][0]), "+v"(tq[1][1])); }
        if (!has_next) break;
#pragma unroll
        for (int a = 0; a < 2; ++a)
#pragma unroll
            for (int b = 0; b < 2; ++b)
#pragma unroll
                for (int m = 0; m < 4; ++m)
#pragma unroll
                    for (int n = 0; n < 2; ++n) acc[a][b][m][n] = (f32x4){0.f, 0.f, 0.f, 0.f};
        cur = nxt; cA = nA; cB = nB; ++ui; vA[0][0] = vN[0][0]; vA[0][1] = vN[0][1]; vA[1][0] = vN[1][0]; vA[1][1] = vN[1][1];
        if constexpr (GATHER) { if (has2) PG8_OFFS(tq, vN); }
        if constexpr (ALIGN_EPI) { if (wr == 1) PG8_BAR; }
    }
    PG8_WAIT_V(0);
    if constexpr (!ALIGN_EPI) { if (wr == 0) PG8_BAR; }
    PG8_BAR;
    if constexpr (Epi::AFTER_DRAIN) { E.fused(acc, cur, wr, wc, fr, fq, lds, wid, lane); S.done(cur); }
#undef PG8_TOKS
#undef PG8_OFFS
#undef PG8_SA
#undef PG8_SB
#undef PG8_STAGE
#undef PG8_LDA
#undef PG8_LDB
#undef PG8_MMA
#undef PG8_WAIT_V
#undef PG8_WAIT_L
#undef PG8_BAR
#undef PG8_SCHED
}
}

#define XB_TMO      128
#define XB_XCNT(j)  (256  + 64 * (j))
#define XB_XSUB(j)  (1280 + 64 * (j))
#define XB_XGEN(j)  (2304 + 64 * (j))
#define XB_TOP      3328
#define XB_TOPGEN   3392
#define XCD_BAR_WORDS 3456
#define XB_SPIN_CAP (1u << 18)
#define LAS __attribute__((address_space(3)))

__device__ __forceinline__ unsigned xb_ld(unsigned* p)              { return __hip_atomic_load(p, __ATOMIC_RELAXED, __HIP_MEMORY_SCOPE_AGENT); }
__device__ __forceinline__ unsigned xb_add(unsigned* p, unsigned v) { return __hip_atomic_fetch_add(p, v, __ATOMIC_RELAXED, __HIP_MEMORY_SCOPE_AGENT); }
__device__ __forceinline__ unsigned xb_xcc_id() { return (unsigned)__builtin_amdgcn_s_getreg((3 << 11) | 20) & 0xFu; }
#define XB_SPIN(cond, bar) do { unsigned _sp = 0; while (cond) { __builtin_amdgcn_s_sleep(1); \
    if ((++_sp & 255u) == 0u) { if (xb_ld(&(bar)[XB_TMO])) break; if (_sp > XB_SPIN_CAP) { atomicAdd(&(bar)[XB_TMO], 1u); break; } } } } while (0)

struct XcdBarrier {
    unsigned* bar; unsigned x;
    volatile LAS unsigned* st;
};

__device__ __forceinline__ XcdBarrier xcd_barrier_post(unsigned* bar, volatile LAS unsigned* st) {
    XcdBarrier b; b.bar = bar; b.x = xb_xcc_id(); b.st = st;
    if (threadIdx.x == 0) (void)xb_add(&bar[XB_XCNT(b.x)], 1u);
    return b;
}
__device__ __forceinline__ void xcd_barrier_complete(unsigned* bar, unsigned x, unsigned& nloc, unsigned& nx) {
    const unsigned G = gridDim.x * gridDim.y * gridDim.z;
    unsigned sum, cnt, mine, sp = 0u;
    for (;;) {
        sum = 0u; cnt = 0u; mine = 0u;
#pragma unroll
        for (unsigned j = 0; j < 16; ++j) { const unsigned c = xb_ld(&bar[XB_XCNT(j)]); sum += c; cnt += (c > 0u) ? 1u : 0u; mine = (j == x) ? c : mine; }
        if (sum == G) break;
        __builtin_amdgcn_s_sleep(1);
        if ((++sp & 255u) == 0u) { if (xb_ld(&bar[XB_TMO])) break; if (sp > XB_SPIN_CAP) { atomicAdd(&bar[XB_TMO], 1u); break; } }
    }
    nloc = mine > 0u ? mine : 1u; nx = cnt > 0u ? cnt : 1u;
}

__device__ __forceinline__ void xcd_barrier(const XcdBarrier& b) {
    asm volatile("s_waitcnt vmcnt(0)" ::: "memory");
    __syncthreads();
    if (threadIdx.x == 0) {
        unsigned* bar = b.bar;
        __builtin_amdgcn_s_waitcnt(0);
        unsigned nloc = b.st[0], nx = b.st[1];
        if (nloc == 0u) { xcd_barrier_complete(bar, b.x, nloc, nx); b.st[0] = nloc; b.st[1] = nx; }
        const unsigned old = xb_add(&bar[XB_XSUB(b.x)], 1u);
        const unsigned gen = old / nloc;
        if (old + 1u == (gen + 1u) * nloc) {
            __builtin_amdgcn_fence(__ATOMIC_RELEASE, "agent");
            asm volatile("s_waitcnt vmcnt(0)" ::: "memory");
            const unsigned og = xb_add(&bar[XB_TOP], 1u);
            const unsigned tg = og / nx;
            if (og + 1u == (tg + 1u) * nx) xb_add(&bar[XB_TOPGEN], 1u);
            else XB_SPIN(xb_ld(&bar[XB_TOPGEN]) == tg, bar);
            __builtin_amdgcn_fence(__ATOMIC_ACQUIRE, "agent");
            xb_add(&bar[XB_XGEN(b.x)], 1u);
            asm volatile("s_waitcnt vmcnt(0)" ::: "memory");
        } else {
            XB_SPIN(xb_ld(&bar[XB_XGEN(b.x)]) == gen, bar);
            __builtin_amdgcn_fence(__ATOMIC_ACQUIRE, "agent");
            asm volatile("s_waitcnt vmcnt(0)" ::: "memory");
        }
    }
    __syncthreads();
}

#ifndef MK_N_LAUNCHES
#define MK_N_LAUNCHES 1
#endif
constexpr int NPHASE = 12;
constexpr int NWAVES = 8, NTHR = 512;
constexpr int D = 1024, SEQ = 8192, NTOK = 16384, NH = 8, HD = 128, CH = 64, NCHUNK = 128;
constexpr int PW = 9216;
constexpr int PC_Q = 0, PC_K = 1024, PC_V = 2048, PC_Z = 3072, PC_BG = 4096, PC_CG = 5120, PC_UI = 6144, PC_GA = 7168, PC_GB = 8192;
constexpr int INW = 9248;
constexpr int NEXP = 32, TOPK = 4, MROWS = 73728;
constexpr float EPS = 1e-6f;

constexpr size_t MiB = 1u << 20;
constexpr size_t WS_CTL = 0, CTL_ZERO_BYTES = 1 * MiB;
constexpr size_t WS_MOD = 1 * MiB;
constexpr size_t WS_WSM_T = 1 * MiB + 64 * 1024;
constexpr size_t WS_WR_T = 1 * MiB + 192 * 1024;
constexpr size_t WS_TOPI = 2 * MiB;
constexpr size_t WS_TOPG = 2 * MiB + 256 * 1024;
constexpr size_t WS_TOPP = 2 * MiB + 512 * 1024;
constexpr size_t WS_PSM = 3 * MiB;
constexpr size_t WS_GL = 5 * MiB;
constexpr size_t WS_LIST = 6 * MiB;
constexpr size_t WS_WIN_T = 8 * MiB;
constexpr size_t WS_WUO_T = 26 * MiB;
constexpr size_t WS_WO_T = 30 * MiB;
constexpr size_t WS_W1T = 32 * MiB;
constexpr size_t WS_W2T = 160 * MiB;
constexpr size_t WS_H = 224 * MiB;
constexpr size_t WS_OD = 256 * MiB;
constexpr size_t WS_P = 320 * MiB;
constexpr size_t WS_DD = 608 * MiB;
constexpr size_t WS_SB = WS_H;
constexpr size_t WS_M1X = 896 * MiB;
constexpr size_t WS_END = 960 * MiB;
constexpr size_t DD_UNIT = 73728;
constexpr size_t DD_W = 0, DD_Q = 16384, DD_K = 32768, DD_A = 49152, DD_U = 57344;
constexpr size_t WS_OASB = WS_DD, WS_M1 = WS_DD + 64 * MiB, WS_M = WS_DD + 128 * MiB;
constexpr size_t WS_XS = WS_P, WS_ACT = WS_P + 144 * MiB, WS_YS = WS_DD;
constexpr int CW_BAR = 4096;
constexpr int CW_RANK = 30720;
constexpr int CW_CVT = 28672;
constexpr int CW_Q = 24576;
constexpr int CW_CNT = 16384;

constexpr int LDS_BYTES = 155648;
constexpr int LDS_MISC = 152 * 1024 - 256;
constexpr int LDS_TAB = 131072;

#define GAS __attribute__((address_space(1)))
#define LAS __attribute__((address_space(3)))
typedef unsigned short bf16;
typedef float f4 __attribute__((ext_vector_type(4)));
typedef unsigned u4 __attribute__((ext_vector_type(4)));
typedef unsigned u2 __attribute__((ext_vector_type(2)));

typedef __bf16 hwbf2 __attribute__((ext_vector_type(2)));
typedef float hwf2 __attribute__((ext_vector_type(2)));
__device__ __forceinline__ unsigned cvtpk(float lo, float hi) { const hwf2 v = {lo, hi}; return __builtin_bit_cast(unsigned, __builtin_convertvector(v, hwbf2)); }
__device__ __forceinline__ unsigned f2bf(float f) { unsigned u = __float_as_uint(f); return (u + 0x7fffu + ((u >> 16) & 1u)) >> 16; }
__device__ __forceinline__ unsigned pk2(float lo, float hi) { return cvtpk(lo, hi); }
__device__ __forceinline__ float bflo(unsigned w) { return __uint_as_float(w << 16); }
__device__ __forceinline__ float bfhi(unsigned w) { return __uint_as_float(w & 0xffff0000u); }
__device__ __forceinline__ float bf1(bf16 b) { return __uint_as_float(((unsigned)b) << 16); }
__device__ __forceinline__ void unpack8(const u4 w, float (&o)[8]) { o[0] = bflo(w.x); o[1] = bfhi(w.x); o[2] = bflo(w.y); o[3] = bfhi(w.y); o[4] = bflo(w.z); o[5] = bfhi(w.z); o[6] = bflo(w.w); o[7] = bfhi(w.w); }
__device__ __forceinline__ u4 pack8(const float (&o)[8]) { u4 w; w.x = pk2(o[0], o[1]); w.y = pk2(o[2], o[3]); w.z = pk2(o[4], o[5]); w.w = pk2(o[6], o[7]); return w; }
#define DPP_ADD(x, ctrl) ((x) + __builtin_bit_cast(float, __builtin_amdgcn_mov_dpp(__builtin_bit_cast(int, (x)), (ctrl), 0xf, 0xf, true)))
__device__ __forceinline__ float sum8(float x) { x = DPP_ADD(x, 0xB1); x = DPP_ADD(x, 0x4E); x = DPP_ADD(x, 0x141); return x; }
__device__ __forceinline__ float sum16(float x) { x = DPP_ADD(x, 0xB1); x = DPP_ADD(x, 0x4E); x = DPP_ADD(x, 0x141); x = DPP_ADD(x, 0x140); return x; }
__device__ __forceinline__ float wave_sum(float v) {
#pragma unroll
    for (int o = 1; o < 64; o <<= 1) v += __shfl_xor(v, o);
    return v;
}
#define LDS_BARRIER() do { asm volatile("s_waitcnt lgkmcnt(0)" ::: "memory"); __builtin_amdgcn_s_barrier(); asm volatile("" ::: "memory"); } while (0)
__device__ __forceinline__ float sigm(float x) { return __builtin_amdgcn_rcpf(1.0f + __expf(-x)); }
__device__ __forceinline__ float silu(float x) { return x * __builtin_amdgcn_rcpf(1.0f + __expf(-x)); }
__device__ __forceinline__ float softplus(float x) { return x > 20.f ? x : log1pf(expf(x)); }

struct Args { const float* in[22]; float* out; unsigned char* ws; int ph_lo, ph_hi; };

struct Frame {
    LAS unsigned char* lds;
    int tid, lane, wave, G;
    unsigned char* ws;
};

__device__ __forceinline__ void p0_transpose_item(const float* W, int ldw, int k0, int n0s, bf16* WT, size_t drow0, LAS float* scr, int lane) {
    { const int kq = lane >> 3, n4 = (lane & 7) * 4; f4 v[8];
#pragma unroll
        for (int i = 0; i < 8; ++i) v[i] = __builtin_nontemporal_load((const f4*)(W + (size_t)(k0 + 8 * i + kq) * ldw + n0s + n4));
#pragma unroll
        for (int i = 0; i < 8; ++i) { LAS float* d = scr + (8 * i + kq) * 33 + n4; d[0] = v[i].x; d[1] = v[i].y; d[2] = v[i].z; d[3] = v[i].w; } }
    asm volatile("s_waitcnt lgkmcnt(0)" ::: "memory");
    const int c = lane & 7;
#pragma unroll
    for (int j = 0; j < 4; ++j) { const int n = (lane >> 3) + 8 * j; const LAS float* s = scr + (8 * c) * 33 + n;
        u4 o; o.x = pk2(s[0 * 33], s[1 * 33]); o.y = pk2(s[2 * 33], s[3 * 33]); o.z = pk2(s[4 * 33], s[5 * 33]); o.w = pk2(s[6 * 33], s[7 * 33]);
        *(u4*)(WT + (drow0 + n) * 1024 + k0 + 8 * c) = o; }
    asm volatile("s_waitcnt lgkmcnt(0)" ::: "memory");
}

__device__ __forceinline__ void phase_p0(Frame& F, const Args& AR) {
    const float* c_in = AR.in[1]; const float* ada_w = AR.in[2]; const float* ada_b = AR.in[3];
    const float* w_in = AR.in[5];
    for (int task = blockIdx.x; task < 192; task += F.G) {
        LAS float* red = (LAS float*)(F.lds + 131072);
        const int j0 = 32 * task, col = j0 + (F.lane & 31), kh = F.lane >> 5;
        float a0 = 0.f, a1 = 0.f;
        const float c0 = c_in[128 * F.wave + F.lane], c1 = c_in[128 * F.wave + 64 + F.lane], d0 = c_in[1024 + 128 * F.wave + F.lane], d1 = c_in[1024 + 128 * F.wave + 64 + F.lane];
        const float s0 = silu(c0), s1 = silu(c1), t0 = silu(d0), t1 = silu(d1);
#pragma unroll
        for (int hb = 0; hb < 2; ++hb) { float wv[32];
#pragma unroll
            for (int i = 0; i < 32; ++i) wv[i] = __builtin_nontemporal_load(ada_w + (size_t)(128 * F.wave + 2 * (32 * hb + i) + kh) * 6144 + col);
#pragma unroll
            for (int i = 0; i < 32; ++i) { const int kl = 2 * (32 * hb + i) + kh;
                const float ca = __shfl(hb == 0 ? s0 : s1, kl & 63), cb = __shfl(hb == 0 ? t0 : t1, kl & 63);
                a0 += ca * wv[i]; a1 += cb * wv[i]; } }
        a0 += __shfl_xor(a0, 32); a1 += __shfl_xor(a1, 32);
        if (F.lane < 32) { red[(F.wave * 2 + 0) * 32 + F.lane] = a0; red[(F.wave * 2 + 1) * 32 + F.lane] = a1; }
        __syncthreads();
        if (F.tid < 64) { const int b = F.tid >> 5, cc = F.tid & 31; float s = 0.f;
#pragma unroll
            for (int w = 0; w < 8; ++w) s += red[(w * 2 + b) * 32 + cc];
            ((float*)(F.ws + WS_MOD))[b * 6144 + j0 + cc] = s + ada_b[j0 + cc]; }
        __syncthreads();
    }
    {
        const float* router_w = AR.in[15]; float* wsm = (float*)(F.ws + WS_WSM_T); float* wr = (float*)(F.ws + WS_WR_T);
        for (int idx = blockIdx.x * NTHR + F.tid; idx < 65536; idx += F.G * NTHR) { const int which = idx >> 15, r = idx & 32767, k = r >> 5, n = r & 31;
            if (which == 0) wsm[n * 1024 + k] = w_in[(size_t)k * INW + 4096 + n]; else wr[n * 1024 + k] = router_w[k * 32 + n]; }
    }
    LAS float* scr = (LAS float*)(F.lds + F.wave * 16384);
    const int gw = blockIdx.x * NWAVES + F.wave, NGW = F.G * NWAVES;
    constexpr int I_IN = 16 * 288, I_SQ = 16 * 32;
    constexpr int NITEMS = I_IN + 3 * I_SQ;
    for (int it = gw; it < NITEMS; it += NGW) {
        int r = it;
        if (r < I_IN) { const int kb = r / 288, nb = r % 288, n0 = 32 * nb; p0_transpose_item(w_in, INW, 64 * kb, n0 + (n0 >= 4096 ? 32 : 0), (bf16*)(F.ws + WS_WIN_T), (size_t)n0, scr, F.lane); continue; } r -= I_IN;
        if (r < I_SQ) { const int kb = r / 32, nb = r % 32; p0_transpose_item(AR.in[10], 1024, 64 * kb, 32 * nb, (bf16*)(F.ws + WS_WUO_T), (size_t)(32 * nb), scr, F.lane); continue; } r -= I_SQ;
        if (r < I_SQ) { const int kb = r / 32, nb = r % 32; p0_transpose_item(AR.in[12], 1024, 64 * kb, 32 * nb, (bf16*)(F.ws + WS_WUO_T), (size_t)(1024 + 32 * nb), scr, F.lane); continue; } r -= I_SQ;
        { const int kb = r / 32, nb = r % 32; p0_transpose_item(AR.in[13], 1024, 64 * kb, 32 * nb, (bf16*)(F.ws + WS_WO_T), (size_t)(32 * nb), scr, F.lane); }
    }
}
struct CvtItem { const float* W; bf16* WT; size_t drow0; int ldw, k0, n0s; };
__device__ __forceinline__ CvtItem moe_item(const Args& AR, unsigned char* ws, int r) {
    constexpr int I_W1 = 32 * 16 * 64; CvtItem c;
    if (r < I_W1) { const int e = r / 1024, q = r % 1024, kb = q / 64, nb = q % 64, n0 = 32 * nb, half = n0 >> 10, j = n0 & 1023;
        c.W = AR.in[17] + (size_t)e * 1024 * 2048; c.ldw = 2048; c.k0 = 64 * kb; c.n0s = n0; c.WT = (bf16*)(ws + WS_W1T); c.drow0 = (size_t)e * 2048 + (size_t)((j >> 7) * 256 + half * 128 + (j & 127)); }
    else { r -= I_W1; const int e = r / 512, q = r % 512, kb = q / 32, nb = q % 32;
        c.W = AR.in[19] + (size_t)e * 1024 * 1024; c.ldw = 1024; c.k0 = 64 * kb; c.n0s = 32 * nb; c.WT = (bf16*)(ws + WS_W2T); c.drow0 = (size_t)e * 1024 + (size_t)(32 * nb); }
    return c;
}
__device__ __forceinline__ void cvt_load(const CvtItem& c, int lane, f4 (&v)[8]) {
    const int kq = lane >> 3, n4 = (lane & 7) * 4;
#pragma unroll
    for (int i = 0; i < 8; ++i) v[i] = __builtin_nontemporal_load((const f4*)(c.W + (size_t)(c.k0 + 8 * i + kq) * c.ldw + c.n0s + n4));
}
__device__ __forceinline__ void cvt_store(const CvtItem& c, int lane, const f4 (&v)[8], LAS float* scr) {
    const int kq = lane >> 3, n4 = (lane & 7) * 4;
#pragma unroll
    for (int i = 0; i < 8; ++i) { LAS float* d = scr + (8 * i + kq) * 33 + n4; d[0] = v[i].x; d[1] = v[i].y; d[2] = v[i].z; d[3] = v[i].w; }
    asm volatile("s_waitcnt lgkmcnt(0)" ::: "memory");
    const int cc = lane & 7;
#pragma unroll
    for (int j = 0; j < 4; ++j) { const int n = (lane >> 3) + 8 * j; const LAS float* sp = scr + (8 * cc) * 33 + n;
        u4 o; o.x = pk2(sp[0 * 33], sp[1 * 33]); o.y = pk2(sp[2 * 33], sp[3 * 33]); o.z = pk2(sp[4 * 33], sp[5 * 33]); o.w = pk2(sp[6 * 33], sp[7 * 33]);
        __builtin_nontemporal_store(o, (u4*)(c.WT + (c.drow0 + n) * 1024 + c.k0 + 8 * cc)); }
    asm volatile("s_waitcnt lgkmcnt(0)" ::: "memory");
}
__device__ __forceinline__ void moe_convert(Frame& F, const Args& AR) {
    constexpr int NIT = 32 * 16 * 64 + 32 * 16 * 32;
    LAS float* scr = (LAS float*)(F.lds + F.wave * 16384);
    unsigned* ctr = (unsigned*)(F.ws + WS_CTL) + CW_CVT;
    for (;;) {
        unsigned base = 0u;
        if (F.lane == 0) base = __hip_atomic_fetch_add(ctr, 8u, __ATOMIC_RELAXED, __HIP_MEMORY_SCOPE_AGENT);
        base = (unsigned)__builtin_amdgcn_readfirstlane((int)base);
        if (base >= (unsigned)NIT) break;
        f4 va[8], vb[8];
        CvtItem ca = moe_item(AR, F.ws, (int)base), cb = ca;
        cvt_load(ca, F.lane, va);
#pragma unroll 1
        for (int t = 0; t < 8; t += 2) {
            cb = moe_item(AR, F.ws, (int)base + t + 1); cvt_load(cb, F.lane, vb);
            cvt_store(ca, F.lane, va, scr);
            if (t + 2 < 8) { ca = moe_item(AR, F.ws, (int)base + t + 2); cvt_load(ca, F.lane, va); }
            cvt_store(cb, F.lane, vb, scr);
        }
    }
}
__device__ __forceinline__ void stage_wt(LAS float* WtL, const float* WT, int tid) {
    for (int idx = tid; idx < 32 * 256; idx += NTHR) { const int n = idx >> 8, k4 = idx & 255; const f4 v = *(const f4*)(WT + n * 1024 + 4 * k4); *(LAS f4*)(WtL + n * 1028 + 4 * k4) = v; }
}
__device__ __forceinline__ float dot32(const f4 (&v)[4], const LAS float* WtL, int lane) {
    float p[32];
#pragma unroll
    for (int g = 0; g < 8; ++g) {
        f4 w[4][4];
#pragma unroll
        for (int nn = 0; nn < 4; ++nn)
#pragma unroll
            for (int j = 0; j < 4; ++j) w[nn][j] = *(const LAS f4*)(WtL + (4 * g + nn) * 1028 + 256 * j + 4 * lane);
        asm volatile("" :: "v"(w[0][0]), "v"(w[0][1]), "v"(w[0][2]), "v"(w[0][3]), "v"(w[1][0]), "v"(w[1][1]), "v"(w[1][2]), "v"(w[1][3]),
                           "v"(w[2][0]), "v"(w[2][1]), "v"(w[2][2]), "v"(w[2][3]), "v"(w[3][0]), "v"(w[3][1]), "v"(w[3][2]), "v"(w[3][3]) : "memory");
#pragma unroll
        for (int nn = 0; nn < 4; ++nn) { float sv = 0.f;
#pragma unroll
            for (int j = 0; j < 4; ++j) sv += v[j].x * w[nn][j].x + v[j].y * w[nn][j].y + v[j].z * w[nn][j].z + v[j].w * w[nn][j].w;
            p[4 * g + nn] = sv; }
        asm volatile("" : "+v"(p[4 * g]), "+v"(p[4 * g + 1]), "+v"(p[4 * g + 2]), "+v"(p[4 * g + 3]) :: "memory");
    }
#pragma unroll
    for (int i = 0; i < 16; ++i) { const bool hi = (lane & 32) != 0; const float send = hi ? p[i] : p[i + 16], keep = hi ? p[i + 16] : p[i]; p[i] = keep + __shfl_xor(send, 32); }
#pragma unroll
    for (int i = 0; i < 8; ++i) { const bool hi = (lane & 16) != 0; const float send = hi ? p[i] : p[i + 8], keep = hi ? p[i + 8] : p[i]; p[i] = keep + __shfl_xor(send, 16); }
#pragma unroll
    for (int i = 0; i < 4; ++i) { const bool hi = (lane & 8) != 0; const float send = hi ? p[i] : p[i + 4], keep = hi ? p[i + 4] : p[i]; p[i] = keep + __shfl_xor(send, 8); }
#pragma unroll
    for (int i = 0; i < 2; ++i) { const bool hi = (lane & 4) != 0; const float send = hi ? p[i] : p[i + 2], keep = hi ? p[i + 2] : p[i]; p[i] = keep + __shfl_xor(send, 4); }
    { const bool hi = (lane & 2) != 0; const float send = hi ? p[0] : p[1], keep = hi ? p[1] : p[0]; p[0] = keep + __shfl_xor(send, 2); }
    p[0] += __shfl_xor(p[0], 1);
    return p[0];
}

__device__ __forceinline__ void phase_p1(Frame& F, const Args& AR) {
    const float* x = AR.in[0]; const float* norm1_w = AR.in[4]; const float* mod = (const float*)(F.ws + WS_MOD);
    LAS float* WtL = (LAS float*)F.lds;
    LAS float* A1 = (LAS float*)(F.lds + 131584);
    LAS float* B1 = A1 + 2048;
    stage_wt(WtL, (const float*)(F.ws + WS_WSM_T), F.tid);
    for (int idx = F.tid; idx < 2048; idx += NTHR) { const int b = idx >> 10, k = idx & 1023; A1[idx] = norm1_w[k] * (1.0f + mod[b * 6144 + 1024 + k]); B1[idx] = mod[b * 6144 + k]; }
    __syncthreads();
    bf16* h = (bf16*)(F.ws + WS_H); float* psm = (float*)(F.ws + WS_PSM);
    const int gw = blockIdx.x * NWAVES + F.wave, NGW = F.G * NWAVES;
    for (int m = gw; m < NTOK; m += NGW) {
        const f4* xr = (const f4*)(x + (size_t)m * D) + F.lane; f4 v[4]; float ss = 0.f;
#pragma unroll
        for (int j = 0; j < 4; ++j) { v[j] = xr[64 * j]; ss += (v[j].x * v[j].x + v[j].y * v[j].y) + (v[j].z * v[j].z + v[j].w * v[j].w); }
        const float rstd = __builtin_amdgcn_rsqf(wave_sum(ss) * (1.0f / D) + EPS);
        const int b = m >> 13;
#pragma unroll
        for (int j = 0; j < 4; ++j) { const f4 a = *(const LAS f4*)(A1 + b * 1024 + 256 * j + 4 * F.lane), bb = *(const LAS f4*)(B1 + b * 1024 + 256 * j + 4 * F.lane);
            v[j] = v[j] * rstd * a + bb;
            u2 o; o.x = pk2(v[j].x, v[j].y); o.y = pk2(v[j].z, v[j].w); ((u2*)(h + (size_t)m * D))[F.lane + 64 * j] = o; }
        const float tot = dot32(v, WtL, F.lane);
        if (!(F.lane & 1)) psm[(size_t)m * 32 + (F.lane >> 1)] = tot;
    }
}

struct EpiStoreBf16 {
    static constexpr bool PERM = true, AFTER_DRAIN = false;
    bf16* O; int ldc;
    __device__ __forceinline__ void operator()(const pg8::f32x4 (&acc)[2][2][4][2], const pg8::Unit& u, int wr, int wc, int fr, int fq) const {
        const int row0 = u.pm * 256 + wr * 64 + fr, col0 = u.pn * 256 + wc * 32 + 8 * fq;
#pragma unroll
        for (int ai = 0; ai < 2; ++ai)
#pragma unroll
            for (int m = 0; m < 4; ++m) { bf16* rowp = O + (size_t)(row0 + ai * 128 + m * 16) * ldc + col0;
#pragma unroll
                for (int bj = 0; bj < 2; ++bj) { const pg8::f32x4 v0 = acc[ai][bj][m][0], v1 = acc[ai][bj][m][1];
                    u4 w; w.x = cvtpk(v0[0], v0[1]); w.y = cvtpk(v0[2], v0[3]); w.z = cvtpk(v1[0], v1[1]); w.w = cvtpk(v1[2], v1[3]);
                    __builtin_nontemporal_store(w, (u4*)(rowp + bj * 128)); } }
    }
};
struct EpiGate {
    static constexpr bool PERM = true, AFTER_DRAIN = false;
    const bf16* P; float* M1; bf16* Mo; int gcolb, second;
    __device__ __forceinline__ void operator()(const pg8::f32x4 (&acc)[2][2][4][2], const pg8::Unit& u, int wr, int wc, int fr, int fq) const {
        const int s = second;
        const int row0 = u.pm * 256 + wr * 64 + fr, col0 = u.pn * 256 + wc * 32 + 8 * fq, gcol = gcolb + col0;
#pragma unroll
        for (int am = 0; am < 4; ++am) { const int ai = am >> 1, mb = (am & 1) * 2;
            u4 gw[2][2]; f4 p0[2][2], p1[2][2];
#pragma unroll
            for (int mm = 0; mm < 2; ++mm)
#pragma unroll
                for (int bj = 0; bj < 2; ++bj) { const int row = row0 + ai * 128 + (mb + mm) * 16;
                    gw[mm][bj] = *(const u4*)(P + (size_t)row * PW + gcol + bj * 128);
                    if (s) { const float* mp = M1 + (size_t)row * D + col0 + bj * 128; p0[mm][bj] = *(const f4*)mp; p1[mm][bj] = *(const f4*)(mp + 4); } }
#pragma unroll
            for (int mm = 0; mm < 2; ++mm)
#pragma unroll
                for (int bj = 0; bj < 2; ++bj) { const int m = mb + mm; const int row = row0 + ai * 128 + m * 16, col = col0 + bj * 128;
                    float g[8]; unpack8(gw[mm][bj], g);
                    const pg8::f32x4 v0 = acc[ai][bj][m][0], v1 = acc[ai][bj][m][1];
                    float o[8];
#pragma unroll
                    for (int e = 0; e < 4; ++e) { o[e] = sigm(g[e]) * v0[e]; o[4 + e] = sigm(g[4 + e]) * v1[e]; }
                    if (s == 0) { float* mp = M1 + (size_t)row * D + col; *(f4*)mp = (f4){o[0], o[1], o[2], o[3]}; *(f4*)(mp + 4) = (f4){o[4], o[5], o[6], o[7]}; }
                    else { const f4 q0 = p0[mm][bj], q1 = p1[mm][bj];
                        u4 w; w.x = cvtpk(q0.x + o[0], q0.y + o[1]); w.y = cvtpk(q0.z + o[2], q0.w + o[3]); w.z = cvtpk(q1.x + o[4], q1.y + o[5]); w.w = cvtpk(q1.z + o[6], q1.w + o[7]);
                        *(u4*)(Mo + (size_t)row * D + col) = w; } }
        }
    }
};
struct EpiG4 {
    static constexpr bool PERM = false, AFTER_DRAIN = false;
    const float* X; const float* mod; float* X1;
    __device__ __forceinline__ void operator()(const pg8::f32x4 (&acc)[2][2][4][2], const pg8::Unit& u, int wr, int wc, int fr, int fq) const {
        const int row0 = u.pm * 256 + wr * 64 + fr, col0 = u.pn * 256 + wc * 32 + 4 * fq; const int b = u.pm >> 5;
        f4 gt[2][2];
#pragma unroll
        for (int bj = 0; bj < 2; ++bj)
#pragma unroll
            for (int n = 0; n < 2; ++n) gt[bj][n] = *(const f4*)(mod + b * 6144 + 2048 + col0 + bj * 128 + n * 16);
#pragma unroll
        for (int ai = 0; ai < 2; ++ai) {
            f4 xv[4][2][2];
#pragma unroll
            for (int m = 0; m < 4; ++m)
#pragma unroll
                for (int bj = 0; bj < 2; ++bj)
#pragma unroll
                    for (int n = 0; n < 2; ++n) xv[m][bj][n] = *(const f4*)(X + (size_t)(row0 + ai * 128 + m * 16) * D + col0 + bj * 128 + n * 16);
#pragma unroll
            for (int m = 0; m < 4; ++m) { const size_t off = (size_t)(row0 + ai * 128 + m * 16) * D + col0;
#pragma unroll
                for (int bj = 0; bj < 2; ++bj)
#pragma unroll
                    for (int n = 0; n < 2; ++n) { const f4 x = xv[m][bj][n]; const pg8::f32x4 a = acc[ai][bj][m][n];
                        *(f4*)(X1 + off + bj * 128 + n * 16) = (f4){x.x + gt[bj][n].x * a[0], x.y + gt[bj][n].y * a[1], x.z + gt[bj][n].z * a[2], x.w + gt[bj][n].w * a[3]}; } }
        }
    }
};
struct MoeOrder {
    int nM, nN, nwg, G, c; const LAS int* blk_exp; const LAS int* tab; const int* list;
    __device__ __forceinline__ void init(int nblk, int nN_, int G_, int c_, const LAS int* tab_, const int* list_) { nM = nblk; nN = nN_; nwg = nM * nN; G = G_; c = c_; tab = tab_; blk_exp = tab_ + 64; list = list_; }
    __device__ __forceinline__ int row_token(const pg8::Unit& u, int r) const { const int e = u.pn / nN, cn = tab[512 + e]; int idx = 256 * (u.pm - (tab[e] >> 8)) + r; idx = idx < cn ? idx : cn - 1; return list[e * 16384 + idx]; }
    __device__ __forceinline__ bool next(int i, pg8::Unit& u) const {
        const long L = (long)i * G + c; if (L >= nwg) return false;
        int wgid = (int)L; { const int q = nwg / 8, r = nwg % 8, xcd = wgid % 8, off = wgid / 8; wgid = (xcd < r ? xcd * (q + 1) : r * (q + 1) + (xcd - r) * q) + off; }
        const int nig = 8 * nN, gid = wgid / nig, fm = gid * 8, gsz = (nM - fm) < 8 ? (nM - fm) : 8;
        const int pm = fm + ((wgid % nig) % gsz), pnl = (wgid % nig) / gsz;
        u.pm = pm; u.pn = blk_exp[pm] * nN + pnl; return true;
    }
    __device__ __forceinline__ void a_ready(const pg8::Unit&) const {}
    __device__ __forceinline__ void done(const pg8::Unit&) const {}
};
struct EpiMoe1 {
    static constexpr bool PERM = true, AFTER_DRAIN = false;
    const float* b1; bf16* ACT;
    __device__ __forceinline__ void operator()(const pg8::f32x4 (&acc)[2][2][4][2], const pg8::Unit& u, int wr, int wc, int fr, int fq) const {
        const int e = u.pn >> 3, pnl = u.pn & 7; const int row0 = u.pm * 256 + wr * 64 + fr, j0 = pnl * 128 + wc * 32 + 8 * fq;
        const float* bg = b1 + (size_t)e * 2048 + j0; const float* bu = bg + 1024;
        const f4 bg0 = *(const f4*)bg, bg1 = *(const f4*)(bg + 4), bu0 = *(const f4*)bu, bu1 = *(const f4*)(bu + 4);
        const float bgv[8] = {bg0.x, bg0.y, bg0.z, bg0.w, bg1.x, bg1.y, bg1.z, bg1.w}, buv[8] = {bu0.x, bu0.y, bu0.z, bu0.w, bu1.x, bu1.y, bu1.z, bu1.w};
#pragma unroll
        for (int ai = 0; ai < 2; ++ai)
#pragma unroll
            for (int m = 0; m < 4; ++m) { float o[8];
#pragma unroll
                for (int e8 = 0; e8 < 8; ++e8) { const int n = e8 >> 2, q = e8 & 3;
                    float g = acc[ai][0][m][n][q] + bgv[e8], up = acc[ai][1][m][n][q] + buv[e8];
                    g = fminf(g, 7.0f); up = fminf(fmaxf(up, -7.0f), 7.0f);
                    o[e8] = g * sigm(1.702f * g) * (up + 1.0f); }
                u4 w; w.x = cvtpk(o[0], o[1]); w.y = cvtpk(o[2], o[3]); w.z = cvtpk(o[4], o[5]); w.w = cvtpk(o[6], o[7]);
                *(u4*)(ACT + (size_t)(row0 + ai * 128 + m * 16) * D + j0) = w; }
    }
};
struct EpiMoe2 {
    static constexpr bool PERM = true, AFTER_DRAIN = false;
    const float* b2; bf16* YS;
    __device__ __forceinline__ void operator()(const pg8::f32x4 (&acc)[2][2][4][2], const pg8::Unit& u, int wr, int wc, int fr, int fq) const {
        const int e = u.pn >> 2, pnl = u.pn & 3; const int row0 = u.pm * 256 + wr * 64 + fr, col0 = pnl * 256 + wc * 32 + 8 * fq;
        f4 bv[2][2];
#pragma unroll
        for (int bj = 0; bj < 2; ++bj)
#pragma unroll
            for (int n = 0; n < 2; ++n) bv[bj][n] = *(const f4*)(b2 + (size_t)e * D + col0 + bj * 128 + 4 * n);
#pragma unroll
        for (int ai = 0; ai < 2; ++ai)
#pragma unroll
            for (int m = 0; m < 4; ++m) { bf16* rowp = YS + (size_t)(row0 + ai * 128 + m * 16) * D + col0;
#pragma unroll
                for (int bj = 0; bj < 2; ++bj) { const pg8::f32x4 v0 = acc[ai][bj][m][0], v1 = acc[ai][bj][m][1];
                    u4 w; w.x = cvtpk(v0[0] + bv[bj][0].x, v0[1] + bv[bj][0].y); w.y = cvtpk(v0[2] + bv[bj][0].z, v0[3] + bv[bj][0].w);
                    w.z = cvtpk(v1[0] + bv[bj][1].x, v1[1] + bv[bj][1].y); w.w = cvtpk(v1[2] + bv[bj][1].z, v1[3] + bv[bj][1].w);
                    __builtin_nontemporal_store(w, (u4*)(rowp + bj * 128)); } }
    }
};

constexpr int QS = 129;
constexpr int QB = 136;
typedef short bf16x8 __attribute__((ext_vector_type(8)));
__device__ __forceinline__ bf16x8 pack_frag(const pg8::f32x4 a, const pg8::f32x4 b) {
    u4 w; w.x = cvtpk(a[0], a[1]); w.y = cvtpk(a[2], a[3]); w.z = cvtpk(b[0], b[1]); w.w = cvtpk(b[2], b[3]); return __builtin_bit_cast(bf16x8, w);
}
__device__ __forceinline__ void phase_p3(Frame& F, const Args& AR) {
    const bf16* P = (const bf16*)(F.ws + WS_P); const float* psm = (const float*)(F.ws + WS_PSM);
    const float* convw = AR.in[6]; const float* a_log = AR.in[7]; const float* dt_bias = AR.in[8];
    LAS bf16* qb = (LAS bf16*)F.lds;
    LAS bf16* kb = qb + 64 * QB;
    LAS float* vs = (LAS float*)(kb + 64 * QB);
    LAS float* Lm = vs + 64 * QS;
    LAS float* betaL = Lm + 2 * 4096;
    LAS float* GL = betaL + 128;
    LAS float* Tm = GL + 128;
    LAS bf16* wb = (LAS bf16*)(Tm + 2048);
    u4 raw[12]; f4 wjv[10]; float braw = 0.f, araw = 0.f, alog_p = 0.f, dtb_p = 0.f;
#define P3_LOAD(unit_) do { const int b_ = (unit_) >> 10, h_ = ((unit_) >> 7) & 7, c_ = (unit_) & 127, t0_ = c_ * 64; const size_t tb_ = (size_t)b_ * SEQ; const int tid_ = F.tid; \
        if (tid_ < 384) { const int cv_ = tid_ % 48, rg_ = tid_ / 48, pcol_ = (cv_ >> 4) * 1024 + h_ * 128 + (cv_ & 15) * 8; \
            _Pragma("unroll") for (int j_ = 0; j_ < 5; ++j_) { wjv[2 * j_] = *(const f4*)(convw + j_ * 3072 + pcol_); wjv[2 * j_ + 1] = *(const f4*)(convw + j_ * 3072 + pcol_ + 4); } \
            _Pragma("unroll") for (int r_ = 0; r_ < 12; ++r_) { const int t_ = t0_ + 8 * rg_ - 2 + r_; raw[r_] = (t_ >= 0 && t_ < SEQ) ? *(const u4*)(P + (tb_ + t_) * PW + pcol_) : (u4){0u, 0u, 0u, 0u}; } } \
        if (tid_ >= 384) { const int dir_ = (tid_ - 384) >> 6, ii_ = tid_ & 63, io_ = dir_ ? 63 - ii_ : ii_; const size_t tok_ = tb_ + t0_ + io_; braw = psm[tok_ * 32 + dir_ * 8 + h_]; araw = psm[tok_ * 32 + 16 + dir_ * 8 + h_]; alog_p = a_log[dir_ * 8 + h_]; dtb_p = dt_bias[dir_ * 8 + h_]; } } while (0)
    if ((int)blockIdx.x < 2 * NH * NCHUNK) P3_LOAD((int)blockIdx.x);
    for (int unit = blockIdx.x; unit < 2 * NH * NCHUNK; unit += F.G) {
        const int b = unit >> 10, h = (unit >> 7) & 7, c = unit & 127;
        int tid = F.tid; asm volatile("" : "+v"(tid));
        const int lane = tid & 63;
        unsigned char* const ubase = F.ws + WS_DD + ((size_t)((b * 8 + h) * 2) * 128) * DD_UNIT;
        if (tid < 384) {
            const int cv = tid % 48, rg = tid / 48, part = cv >> 4, ch = (cv & 15) * 8;
#pragma unroll
            for (int i = 0; i < 8; ++i) { float acc[8];
#pragma unroll
                for (int e = 0; e < 8; ++e) acc[e] = 0.f;
#pragma unroll
                for (int j = 0; j < 5; ++j) { float xin[8]; unpack8(raw[i + j], xin); const f4 w0 = wjv[2 * j], w1 = wjv[2 * j + 1];
                    acc[0] += w0.x * xin[0]; acc[1] += w0.y * xin[1]; acc[2] += w0.z * xin[2]; acc[3] += w0.w * xin[3]; acc[4] += w1.x * xin[4]; acc[5] += w1.y * xin[5]; acc[6] += w1.z * xin[6]; acc[7] += w1.w * xin[7]; }
                float ssq = 0.f;
#pragma unroll
                for (int e = 0; e < 8; ++e) { acc[e] = silu(acc[e]); ssq += acc[e] * acc[e]; }
                ssq = sum16(ssq);
                if (part == 2) {
#pragma unroll
                    for (int e = 0; e < 8; ++e) vs[(8 * rg + i) * QS + ch + e] = acc[e];
                } else {
                    float sc = __builtin_amdgcn_rsqf(ssq + EPS); if (part == 0) sc *= 0.08838834764831845f;
#pragma unroll
                    for (int e = 0; e < 8; ++e) acc[e] *= sc;
                    *(LAS u4*)((part ? kb : qb) + (8 * rg + i) * QB + ch) = pack8(acc); }
            }
        }
        if (tid >= 384) {
            const int dir = (tid - 384) >> 6, ii = lane;
            float g = -expf(alog_p) * softplus(araw + dtb_p);
#pragma unroll
            for (int o = 1; o < 64; o <<= 1) { const float t = __shfl_up(g, o); if (lane >= o) g += t; }
            betaL[dir * 64 + ii] = sigm(braw); GL[dir * 64 + ii] = g;
        }
        if (unit + F.G < 2 * NH * NCHUNK) P3_LOAD(unit + F.G);
        LDS_BARRIER();
        asm volatile("" : "+v"(tid));
        {
            const int w = tid >> 6, dir = w >> 2, mi = w & 3, r = lane & 15, q = lane >> 4;
            const int ipos = 16 * mi + r, io = dir ? 63 - ipos : ipos;
            const float Gi = GL[dir * 64 + ipos], bi = betaL[dir * 64 + ipos];
            bf16x8 ki[4], qi[4];
#pragma unroll
            for (int s = 0; s < 4; ++s) { ki[s] = *(const LAS bf16x8*)(kb + io * QB + 32 * s + 8 * q); qi[s] = *(const LAS bf16x8*)(qb + io * QB + 32 * s + 8 * q); }
            unsigned char* dbase = ubase + ((size_t)dir * 128 + (dir ? 127 - c : c)) * DD_UNIT;
#pragma unroll
            for (int s2 = 0; s2 < 2; ++s2) { float av[8];
#pragma unroll
                for (int t = 0; t < 2; ++t) { const int mj = 2 * s2 + t;
                    if (mj <= mi) {
                        const int jp = 16 * mj + r, jo = dir ? 63 - jp : jp;
                        pg8::f32x4 kk = {0.f, 0.f, 0.f, 0.f}, qk = {0.f, 0.f, 0.f, 0.f};
#pragma unroll
                        for (int s = 0; s < 4; ++s) { const bf16x8 kj = *(const LAS bf16x8*)(kb + jo * QB + 32 * s + 8 * q);
                            kk = __builtin_amdgcn_mfma_f32_16x16x32_bf16(kj, ki[s], kk, 0, 0, 0); qk = __builtin_amdgcn_mfma_f32_16x16x32_bf16(kj, qi[s], qk, 0, 0, 0); }
                        f4 lv;
#pragma unroll
                        for (int jj = 0; jj < 4; ++jj) { const int jpos = 16 * mj + 4 * q + jj; const float dec = __expf(Gi - GL[dir * 64 + jpos]);
                            const float l = (ipos > jpos) ? bi * kk[jj] * dec : 0.f; av[4 * t + jj] = (ipos >= jpos) ? qk[jj] * dec : 0.f;
                            if (jj == 0) lv.x = l; else if (jj == 1) lv.y = l; else if (jj == 2) lv.z = l; else lv.w = l; }
                        *(LAS f4*)(Lm + dir * 4096 + ipos * 64 + 16 * mj + 4 * q) = lv;
                    } else {
#pragma unroll
                        for (int jj = 0; jj < 4; ++jj) av[4 * t + jj] = 0.f;
                    } }
                __builtin_nontemporal_store(pack8(av), (u4*)(dbase + DD_A + (size_t)((mi * 2 + s2) * 64 + lane) * 16)); }
        }
        LDS_BARRIER();
        asm volatile("" : "+v"(tid));
        if (tid < 128) {
            const int dir = tid >> 6, blk = (tid >> 4) & 3, cc = tid & 15;
            const LAS float* Lb = Lm + dir * 4096 + (16 * blk) * 64 + 16 * blk;
            float t[16];
#pragma unroll
            for (int i = 0; i < 16; ++i) { float sv = (i == cc) ? 1.0f : 0.0f;
#pragma unroll
                for (int j = 0; j < i; ++j) sv -= Lb[i * 64 + j] * t[j];
                t[i] = sv; Tm[(dir * 4 + blk) * 256 + i * 16 + cc] = sv; }
        }
        LDS_BARRIER();
        asm volatile("" : "+v"(tid));
        {
            const int w = tid >> 6, dir = w >> 2, g4 = w & 3, n = lane & 15, q = lane >> 4; const bool isw = g4 >= 2;
            const LAS float* Lr = Lm + dir * 4096; const LAS float* Tr = Tm + dir * 1024;
            const f4 z4 = {0.f, 0.f, 0.f, 0.f};
            bf16x8 fT[4], fL10, fL2, fL3a, fL3b;
#pragma unroll
            for (int i = 0; i < 4; ++i) fT[i] = pack_frag(*(const LAS f4*)(Tr + i * 256 + n * 16 + 4 * q), z4);
            fL10 = pack_frag(-*(const LAS f4*)(Lr + (16 + n) * 64 + 4 * q), z4);
            fL2 = pack_frag(-*(const LAS f4*)(Lr + (32 + n) * 64 + 4 * q), -*(const LAS f4*)(Lr + (32 + n) * 64 + 16 + 4 * q));
            fL3a = pack_frag(-*(const LAS f4*)(Lr + (48 + n) * 64 + 4 * q), -*(const LAS f4*)(Lr + (48 + n) * 64 + 16 + 4 * q));
            fL3b = pack_frag(-*(const LAS f4*)(Lr + (48 + n) * 64 + 32 + 4 * q), z4);
            float bE[4][4];
#pragma unroll
            for (int i = 0; i < 4; ++i)
#pragma unroll
                for (int jj = 0; jj < 4; ++jj) { const int row = 16 * i + 4 * q + jj; bE[i][jj] = betaL[dir * 64 + row] * (isw ? __expf(GL[dir * 64 + row]) : 1.0f); }
            unsigned char* dbase = ubase + ((size_t)dir * 128 + (dir ? 127 - c : c)) * DD_UNIT;
#pragma unroll
            for (int e = 0; e < 4; ++e) { const int nt = 4 * g4 + e;
                float rv[16];
#pragma unroll
                for (int i = 0; i < 4; ++i)
#pragma unroll
                    for (int jj = 0; jj < 4; ++jj) { const int row = 16 * i + 4 * q + jj, io = dir ? 63 - row : row;
                        rv[4 * i + jj] = isw ? bf1(kb[io * QB + 16 * (nt - 8) + n]) : vs[io * QS + 16 * nt + n]; }
                asm volatile("" :: "v"(rv[0]), "v"(rv[1]), "v"(rv[2]), "v"(rv[3]), "v"(rv[4]), "v"(rv[5]), "v"(rv[6]), "v"(rv[7]), "v"(rv[8]), "v"(rv[9]), "v"(rv[10]), "v"(rv[11]), "v"(rv[12]), "v"(rv[13]), "v"(rv[14]), "v"(rv[15]));
                pg8::f32x4 R[4];
#pragma unroll
                for (int i = 0; i < 4; ++i)
#pragma unroll
                    for (int jj = 0; jj < 4; ++jj) R[i][jj] = bE[i][jj] * rv[4 * i + jj];
                const pg8::f32x4 x0 = __builtin_amdgcn_mfma_f32_16x16x32_bf16(fT[0], pack_frag(R[0], z4), z4, 0, 0, 0);
                const pg8::f32x4 y1 = __builtin_amdgcn_mfma_f32_16x16x32_bf16(fL10, pack_frag(x0, z4), R[1], 0, 0, 0);
                const pg8::f32x4 x1 = __builtin_amdgcn_mfma_f32_16x16x32_bf16(fT[1], pack_frag(y1, z4), z4, 0, 0, 0);
                const bf16x8 x01 = pack_frag(x0, x1);
                const pg8::f32x4 y2 = __builtin_amdgcn_mfma_f32_16x16x32_bf16(fL2, x01, R[2], 0, 0, 0);
                const pg8::f32x4 x2 = __builtin_amdgcn_mfma_f32_16x16x32_bf16(fT[2], pack_frag(y2, z4), z4, 0, 0, 0);
                pg8::f32x4 y3 = __builtin_amdgcn_mfma_f32_16x16x32_bf16(fL3a, x01, R[3], 0, 0, 0);
                y3 = __builtin_amdgcn_mfma_f32_16x16x32_bf16(fL3b, pack_frag(x2, z4), y3, 0, 0, 0);
                const pg8::f32x4 x3 = __builtin_amdgcn_mfma_f32_16x16x32_bf16(fT[3], pack_frag(y3, z4), z4, 0, 0, 0);
                const pg8::f32x4 X[4] = {x0, x1, x2, x3};
                if (!isw) {
#pragma unroll
                    for (int i = 0; i < 4; ++i) { u2 o; o.x = cvtpk(X[i][0], X[i][1]); o.y = cvtpk(X[i][2], X[i][3]); __builtin_nontemporal_store(o, (u2*)(dbase + DD_U + (size_t)((nt * 4 + i) * 64 + lane) * 8)); }
                } else { LAS bf16* wp = wb + dir * 64 * QB + 16 * (nt - 8) + n;
#pragma unroll
                    for (int i = 0; i < 4; ++i)
#pragma unroll
                        for (int jj = 0; jj < 4; ++jj) wp[(16 * i + 4 * q + jj) * QB] = (bf16)f2bf(X[i][jj]); }
            }
        }
        LDS_BARRIER();
        asm volatile("" : "+v"(tid));
#pragma unroll
        for (int it = 0; it < 4; ++it) { const int item = it * NTHR + tid, dir = item >> 10, fidx = (item >> 6) & 15, fl = item & 63, r = fl & 15, q = fl >> 4;
            const int mt = fidx >> 2, s = fidx & 3, pos = 16 * mt + r; const LAS bf16* wr = wb + (dir * 64 + pos) * QB + 32 * s + 4 * q;
            const u2 lo = *(const LAS u2*)wr, hi = *(const LAS u2*)(wr + 16);
            __builtin_nontemporal_store((u4){lo.x, lo.y, hi.x, hi.y}, (u4*)(ubase + ((size_t)dir * 128 + (dir ? 127 - c : c)) * DD_UNIT + DD_W + (size_t)(fidx * 64 + fl) * 16)); }
#pragma unroll
        for (int it = 0; it < 8; ++it) { const int item = it * NTHR + tid, dir = item >> 11, arr = (item >> 10) & 1, fidx = (item >> 6) & 15, fl = item & 63, r = fl & 15, q = fl >> 4;
            unsigned char* dbase = ubase + ((size_t)dir * 128 + (dir ? 127 - c : c)) * DD_UNIT;
            float o[8];
            if (arr == 0) { const int mt = fidx >> 2, s = fidx & 3, pos = 16 * mt + r, io = dir ? 63 - pos : pos; const float f = __expf(GL[dir * 64 + pos]);
                const u2 lo = *(const LAS u2*)(qb + io * QB + 32 * s + 4 * q), hi = *(const LAS u2*)(qb + io * QB + 32 * s + 16 + 4 * q);
                o[0] = bflo(lo.x) * f; o[1] = bfhi(lo.x) * f; o[2] = bflo(lo.y) * f; o[3] = bfhi(lo.y) * f; o[4] = bflo(hi.x) * f; o[5] = bfhi(hi.x) * f; o[6] = bflo(hi.y) * f; o[7] = bfhi(hi.y) * f;
                __builtin_nontemporal_store(pack8(o), (u4*)(dbase + DD_Q + (size_t)(fidx * 64 + fl) * 16));
            } else { const int m = fidx >> 1, s2 = fidx & 1, dk = 16 * m + r; const float gl = GL[dir * 64 + 63];
#pragma unroll
                for (int j = 0; j < 8; ++j) { const int pos = 32 * s2 + (j < 4 ? 4 * q + j : 16 + 4 * q + j - 4), io = dir ? 63 - pos : pos; o[j] = bf1(kb[io * QB + dk]) * __expf(gl - GL[dir * 64 + pos]); }
                __builtin_nontemporal_store(pack8(o), (u4*)(dbase + DD_K + (size_t)(fidx * 64 + fl) * 16)); } }
        if (tid < 2) ((float*)(F.ws + WS_GL))[((b * 8 + h) * 2 + tid) * 128 + (tid ? 127 - c : c)] = __expf(GL[tid * 64 + 63]);
        LDS_BARRIER();
    }
#undef P3_LOAD
}

constexpr int P4_BUF = 61440;
__device__ __forceinline__ void phase_p4(Frame& F, const Args& AR) {
    volatile LAS int* uq = (volatile LAS int*)(F.lds + LDS_TAB + 4096);
    unsigned* qctr = (unsigned*)(F.ws + WS_CTL) + CW_Q;
    const unsigned myx = xb_xcc_id() & 7u;
    for (;;) {
        __syncthreads();
        if (F.tid == 0) { int got = -1;
            for (unsigned t = 0; t < 8 && got < 0; ++t) { const unsigned x = (myx + t) & 7u; const unsigned sl = __hip_atomic_fetch_add(qctr + 64 * x, 1u, __ATOMIC_RELAXED, __HIP_MEMORY_SCOPE_AGENT); if (sl < 16u) got = (int)(x * 16u + sl); }
            uq[0] = got; }
        __syncthreads();
        const int unit = uq[0];
        if (unit < 0) break;
        const int chain = unit >> 2, pair = unit & 3, dir = chain & 1, bh = chain >> 1, b = bh >> 3, h = bh & 7;
        const unsigned char* cbase = F.ws + WS_DD + (size_t)chain * 128 * DD_UNIT;
        __syncthreads();
        if (F.wave >= 2) {
            const int l = F.tid - 128; u4 ra[10], rb[10], rc[10];
#define P4_SRC(step, i) ((const u4*)(cbase + (size_t)(step) * DD_UNIT + (((i) * 384 + l) < 3584 ? (size_t)((i) * 384 + l) * 16 : (size_t)DD_U + (size_t)pair * 4096 + (size_t)((i) * 384 + l - 3584) * 16)))
#define P4_LD(R, step) do { const int st_ = (step) < NCHUNK ? (step) : NCHUNK - 1; _Pragma("unroll") for (int i = 0; i < 10; ++i) R[i] = *P4_SRC(st_, i); } while (0)
#define P4_ST(R, step) do { _Pragma("unroll") for (int i = 0; i < 10; ++i) *(LAS u4*)(F.lds + ((step) & 1) * P4_BUF + (size_t)(i * 384 + l) * 16) = R[i]; } while (0)
            P4_LD(ra, 0); P4_ST(ra, 0);
            P4_LD(ra, 1); P4_LD(rb, 2); P4_LD(rc, 3);
            asm volatile("s_waitcnt lgkmcnt(0)" ::: "memory"); __builtin_amdgcn_s_barrier(); asm volatile("" ::: "memory");
            for (int k = 0; k < 129; k += 3) {
                P4_ST(ra, k + 1); P4_LD(ra, k + 4);
                asm volatile("s_waitcnt lgkmcnt(0)" ::: "memory"); __builtin_amdgcn_s_barrier(); asm volatile("" ::: "memory");
                P4_ST(rb, k + 2); P4_LD(rb, k + 5);
                asm volatile("s_waitcnt lgkmcnt(0)" ::: "memory"); __builtin_amdgcn_s_barrier(); asm volatile("" ::: "memory");
                P4_ST(rc, k + 3); P4_LD(rc, k + 6);
                asm volatile("s_waitcnt lgkmcnt(0)" ::: "memory"); __builtin_amdgcn_s_barrier(); asm volatile("" ::: "memory");
            }
#undef P4_SRC
#undef P4_LD
#undef P4_ST
        } else {
            const int lane = F.lane, r = lane & 15, q = lane >> 4, sl = 2 * pair + F.wave;
            const float* glp = (const float*)(F.ws + WS_GL) + chain * 128;
            bf16* od = (bf16*)(F.ws + WS_OD) + (size_t)dir * NTOK * D + (size_t)b * SEQ * D + h * 128 + 16 * sl + 4 * q;
            pg8::f32x4 S[8]; bf16x8 SB[4];
#pragma unroll
            for (int m = 0; m < 8; ++m) S[m] = (pg8::f32x4){0.f, 0.f, 0.f, 0.f};
#pragma unroll
            for (int s = 0; s < 4; ++s) SB[s] = (bf16x8){0, 0, 0, 0, 0, 0, 0, 0};
            const float glv0 = glp[lane], glv1 = glp[64 + lane];
            asm volatile("s_waitcnt lgkmcnt(0)" ::: "memory"); __builtin_amdgcn_s_barrier(); asm volatile("" ::: "memory");
            for (int k = 0; k < NCHUNK; ++k) {
                const LAS unsigned char* bp = F.lds + (k & 1) * P4_BUF + lane * 16;
                const float egl = __builtin_bit_cast(float, __builtin_amdgcn_readlane(__builtin_bit_cast(int, k < 64 ? glv0 : glv1), k & 63));
                pg8::f32x4 WS[4], OT[4];
#pragma unroll
                for (int mt = 0; mt < 4; ++mt) { WS[mt] = (pg8::f32x4){0.f, 0.f, 0.f, 0.f}; OT[mt] = (pg8::f32x4){0.f, 0.f, 0.f, 0.f}; }
#pragma unroll
                for (int mt = 0; mt < 4; ++mt)
#pragma unroll
                    for (int s = 0; s < 4; ++s) WS[mt] = __builtin_amdgcn_mfma_f32_16x16x32_bf16(*(const LAS bf16x8*)(bp + (mt * 4 + s) * 1024), SB[s], WS[mt], 0, 0, 0);
#pragma unroll
                for (int mt = 0; mt < 4; ++mt)
#pragma unroll
                    for (int s = 0; s < 4; ++s) OT[mt] = __builtin_amdgcn_mfma_f32_16x16x32_bf16(SB[s], *(const LAS bf16x8*)(bp + 16384 + (mt * 4 + s) * 1024), OT[mt], 0, 0, 0);
                pg8::f32x4 vn[4];
#pragma unroll
                for (int mt = 0; mt < 4; ++mt) { const u2 uu = *(const LAS u2*)(F.lds + (k & 1) * P4_BUF + 57344 + (F.wave * 4 + mt) * 512 + lane * 8);
                    vn[mt] = (pg8::f32x4){bflo(uu.x) - WS[mt][0], bfhi(uu.x) - WS[mt][1], bflo(uu.y) - WS[mt][2], bfhi(uu.y) - WS[mt][3]}; }
                bf16x8 VB[2]; VB[0] = pack_frag(vn[0], vn[1]); VB[1] = pack_frag(vn[2], vn[3]);
#pragma unroll
                for (int mt = 0; mt < 4; ++mt)
#pragma unroll
                    for (int s2 = 0; s2 < 2; ++s2) OT[mt] = __builtin_amdgcn_mfma_f32_16x16x32_bf16(VB[s2], *(const LAS bf16x8*)(bp + 49152 + (mt * 2 + s2) * 1024), OT[mt], 0, 0, 0);
#pragma unroll
                for (int m = 0; m < 8; ++m) { S[m] = S[m] * egl;
#pragma unroll
                    for (int s2 = 0; s2 < 2; ++s2) S[m] = __builtin_amdgcn_mfma_f32_16x16x32_bf16(*(const LAS bf16x8*)(bp + 32768 + (m * 2 + s2) * 1024), VB[s2], S[m], 0, 0, 0); }
#pragma unroll
                for (int s = 0; s < 4; ++s) SB[s] = pack_frag(S[2 * s], S[2 * s + 1]);
                const int co = dir ? 127 - k : k;
#pragma unroll
                for (int mt = 0; mt < 4; ++mt) { const int pos = 16 * mt + r, ro = dir ? 63 - pos : pos;
                    u2 ov; ov.x = cvtpk(OT[mt][0], OT[mt][1]); ov.y = cvtpk(OT[mt][2], OT[mt][3]);
                    *(u2*)(od + (size_t)(co * 64 + ro) * D) = ov; }
                asm volatile("s_waitcnt lgkmcnt(0)" ::: "memory"); __builtin_amdgcn_s_barrier(); asm volatile("" ::: "memory");
            }
            __builtin_amdgcn_s_barrier();
        }
        __syncthreads();
    }
    {
        __syncthreads();
        if (F.tid == 0) uq[0] = (int)__hip_atomic_fetch_add((unsigned*)(F.ws + WS_CTL) + CW_RANK, 1u, __ATOMIC_RELAXED, __HIP_MEMORY_SCOPE_AGENT);
        __syncthreads();
        const int rank = uq[0];
        pg8::Gemm g{(const bf16*)(F.ws + WS_SB), (const bf16*)(F.ws + WS_WUO_T) + (size_t)1024 * 1024, NTOK, D, D}; pg8::StaticOrder S; S.init(NTOK, D, 128, rank); if (rank >= 128) S.nwg = 0;
        EpiGate E{(const bf16*)(F.ws + WS_P), (float*)(F.ws + WS_M1X), (bf16*)nullptr, PC_GB, 0};
        pg8::gemm_phase<EpiGate, pg8::StaticOrder, true, true>((PG8_LAS unsigned char*)F.lds, g, S, E);
        __syncthreads();
    }
    moe_convert(F, AR);
}

__device__ __forceinline__ void phase_p5_sb(Frame& F, const Args& AR) {
    const bf16* P = (const bf16*)(F.ws + WS_P); bf16* sbp = (bf16*)(F.ws + WS_SB);
    const float* convs = AR.in[11];
    const int lane = F.lane, ch = 16 * lane;
    float cw[3][16];
#pragma unroll
    for (int e = 0; e < 16; ++e)
#pragma unroll
        for (int j = 0; j < 3; ++j) cw[j][e] = convs[j * 1024 + ch + e];
    const int gw = blockIdx.x * NWAVES + F.wave, NGW = F.G * NWAVES;
    for (int m = gw; m < NTOK; m += NGW) {
        const int t = m & (SEQ - 1);
        u4 cgl[3][2], uil[3][2], bgl[2];
#pragma unroll
        for (int j = 0; j < 3; ++j) { const int tt = t + j - 1; const bool ok = tt >= 0 && tt < SEQ; const bf16* rowp = P + (size_t)(ok ? m + j - 1 : m) * PW;
            cgl[j][0] = *(const u4*)(rowp + PC_CG + ch); cgl[j][1] = *(const u4*)(rowp + PC_CG + ch + 8); uil[j][0] = *(const u4*)(rowp + PC_UI + ch); uil[j][1] = *(const u4*)(rowp + PC_UI + ch + 8); }
        bgl[0] = *(const u4*)(P + (size_t)m * PW + PC_BG + ch); bgl[1] = *(const u4*)(P + (size_t)m * PW + PC_BG + ch + 8);
        float acc[16], r[8];
#pragma unroll
        for (int e = 0; e < 16; ++e) acc[e] = 0.f;
#pragma unroll
        for (int j = 0; j < 3; ++j) { const int tt = t + j - 1;
            if (tt >= 0 && tt < SEQ) { float cg[8], ui[8];
                unpack8(cgl[j][0], cg); unpack8(uil[j][0], ui);
#pragma unroll
                for (int e = 0; e < 8; ++e) acc[e] += cw[j][e] * (cg[e] * ui[e]);
                unpack8(cgl[j][1], cg); unpack8(uil[j][1], ui);
#pragma unroll
                for (int e = 0; e < 8; ++e) acc[8 + e] += cw[j][8 + e] * (cg[e] * ui[e]); } }
        float bg[8];
        unpack8(bgl[0], bg);
#pragma unroll
        for (int e = 0; e < 8; ++e) r[e] = bg[e] * acc[e];
        *(u4*)(sbp + (size_t)m * D + ch) = pack8(r);
        unpack8(bgl[1], bg);
#pragma unroll
        for (int e = 0; e < 8; ++e) r[e] = bg[e] * acc[8 + e];
        *(u4*)(sbp + (size_t)m * D + ch + 8) = pack8(r);
    }
}
__device__ __forceinline__ void phase_p5(Frame& F, const Args& AR) {
    const bf16* P = (const bf16*)(F.ws + WS_P); const bf16* od = (const bf16*)(F.ws + WS_OD); bf16* oap = (bf16*)(F.ws + WS_OASB);
    const float* onorm_w = AR.in[9];
    const int lane = F.lane, ch = 16 * lane;
    float onw[16];
#pragma unroll
    for (int e = 0; e < 16; ++e) onw[e] = onorm_w[(ch + e) & 127];
    const int gw = blockIdx.x * NWAVES + F.wave, NGW = F.G * NWAVES;
    for (int m0 = gw; m0 < NTOK; m0 += 2 * NGW) {
        u4 ld[2][6];
#pragma unroll
        for (int rr = 0; rr < 2; ++rr) { const int m = (m0 + rr * NGW < NTOK) ? m0 + rr * NGW : m0;
            ld[rr][0] = *(const u4*)(od + (size_t)m * D + ch); ld[rr][1] = *(const u4*)(od + (size_t)m * D + ch + 8);
            ld[rr][2] = *(const u4*)(od + (size_t)(NTOK + m) * D + ch); ld[rr][3] = *(const u4*)(od + (size_t)(NTOK + m) * D + ch + 8);
            ld[rr][4] = *(const u4*)(P + (size_t)m * PW + PC_Z + ch); ld[rr][5] = *(const u4*)(P + (size_t)m * PW + PC_Z + ch + 8); }
#pragma unroll
        for (int rr = 0; rr < 2; ++rr) { const int m = m0 + rr * NGW; if (m >= NTOK) break;
            float o[16], z[16], t8[8];
            unpack8(ld[rr][0], t8);
#pragma unroll
            for (int e = 0; e < 8; ++e) o[e] = t8[e];
            unpack8(ld[rr][1], t8);
#pragma unroll
            for (int e = 0; e < 8; ++e) o[8 + e] = t8[e];
            unpack8(ld[rr][2], t8);
#pragma unroll
            for (int e = 0; e < 8; ++e) o[e] += t8[e];
            unpack8(ld[rr][3], t8);
#pragma unroll
            for (int e = 0; e < 8; ++e) o[8 + e] += t8[e];
            unpack8(ld[rr][4], t8);
#pragma unroll
            for (int e = 0; e < 8; ++e) z[e] = t8[e];
            unpack8(ld[rr][5], t8);
#pragma unroll
            for (int e = 0; e < 8; ++e) z[8 + e] = t8[e];
            float ss = 0.f;
#pragma unroll
            for (int e = 0; e < 16; ++e) ss += o[e] * o[e];
            ss = sum8(ss);
            const float rstd = __builtin_amdgcn_rsqf(ss * (1.0f / 128.0f) + EPS);
            float r[8];
#pragma unroll
            for (int e = 0; e < 8; ++e) r[e] = o[e] * rstd * onw[e] * silu(z[e]);
            *(u4*)(oap + (size_t)m * D + ch) = pack8(r);
#pragma unroll
            for (int e = 0; e < 8; ++e) r[e] = o[8 + e] * rstd * onw[8 + e] * silu(z[8 + e]);
            *(u4*)(oap + (size_t)m * D + ch + 8) = pack8(r); }
    }
}

constexpr int P7_MAXIT = 16;
__device__ __forceinline__ void phase_p7(Frame& F, const Args& AR) {
    const float* x1 = (const float*)(F.ws + WS_OD); const float* norm2_w = AR.in[14]; const float* router_b = AR.in[16]; const float* mod = (const float*)(F.ws + WS_MOD);
    LAS float* WtL = (LAS float*)F.lds;
    LAS float* A1 = (LAS float*)(F.lds + 131584);
    LAS float* B1 = A1 + 2048;
    stage_wt(WtL, (const float*)(F.ws + WS_WR_T), F.tid);
    for (int idx = F.tid; idx < 2048; idx += NTHR) { const int b = idx >> 10, k = idx & 1023; A1[idx] = norm2_w[k] * (1.0f + mod[b * 6144 + 4096 + k]); B1[idx] = mod[b * 6144 + 3072 + k]; }
    LAS unsigned* lcnt = (LAS unsigned*)(B1 + 2048);
    LAS unsigned* rec = lcnt + 64;
    if (F.tid < 64) lcnt[F.tid] = 0u;
    __syncthreads();
    bf16* h2 = (bf16*)(F.ws + WS_H); int* topi = (int*)(F.ws + WS_TOPI); float* topg = (float*)(F.ws + WS_TOPG); int* topp = (int*)(F.ws + WS_TOPP);
    unsigned* cnt = (unsigned*)(F.ws + WS_CTL) + CW_CNT; int* elist = (int*)(F.ws + WS_LIST);
    const int lane = F.lane; const float rb = router_b[lane >> 1];
    const int gw = blockIdx.x * NWAVES + F.wave, NGW = F.G * NWAVES;
    int it = 0;
    for (int m = gw; m < NTOK; m += NGW, ++it) {
        const f4* xr = (const f4*)(x1 + (size_t)m * D) + lane; f4 v[4]; float ss = 0.f;
#pragma unroll
        for (int j = 0; j < 4; ++j) { v[j] = xr[64 * j]; ss += (v[j].x * v[j].x + v[j].y * v[j].y) + (v[j].z * v[j].z + v[j].w * v[j].w); }
        const float rstd = __builtin_amdgcn_rsqf(wave_sum(ss) * (1.0f / D) + EPS);
        const int b = m >> 13;
#pragma unroll
        for (int j = 0; j < 4; ++j) { const f4 a = *(const LAS f4*)(A1 + b * 1024 + 256 * j + 4 * lane), bb = *(const LAS f4*)(B1 + b * 1024 + 256 * j + 4 * lane);
            v[j] = v[j] * rstd * a + bb;
            u2 o; o.x = pk2(v[j].x, v[j].y); o.y = pk2(v[j].z, v[j].w); ((u2*)(h2 + (size_t)m * D))[lane + 64 * j] = o; }
        float val = dot32(v, WtL, lane) + rb; const int myn = lane >> 1;
        float tv[4]; int ti[4];
#pragma unroll
        for (int r = 0; r < 4; ++r) { float bv = val; int bi = myn;
#define TK_STEP(ctrl) { const float ov = __builtin_bit_cast(float, __builtin_amdgcn_mov_dpp(__builtin_bit_cast(int, bv), (ctrl), 0xf, 0xf, true)); const int oi = __builtin_amdgcn_mov_dpp(bi, (ctrl), 0xf, 0xf, true); if (ov > bv || (ov == bv && oi < bi)) { bv = ov; bi = oi; } }
            TK_STEP(0xB1) TK_STEP(0x4E) TK_STEP(0x141) TK_STEP(0x140)
#undef TK_STEP
#pragma unroll
            for (int o = 16; o < 64; o <<= 1) { const float ov = __shfl_xor(bv, o); const int oi = __shfl_xor(bi, o); if (ov > bv || (ov == bv && oi < bi)) { bv = ov; bi = oi; } }
            tv[r] = bv; ti[r] = bi; if (myn == bi) val = -__builtin_inff(); }
        const float e1 = __expf(tv[1] - tv[0]), e2 = __expf(tv[2] - tv[0]), e3 = __expf(tv[3] - tv[0]), inv = 1.0f / (1.0f + e1 + e2 + e3);
        if (lane < 4) { const int e = lane == 0 ? ti[0] : (lane == 1 ? ti[1] : (lane == 2 ? ti[2] : ti[3]));
            const float g = (lane == 0 ? 1.0f : (lane == 1 ? e1 : (lane == 2 ? e2 : e3))) * inv;
            topi[(size_t)m * 4 + lane] = e; topg[(size_t)m * 4 + lane] = g;
            if (it < P7_MAXIT) { const unsigned lp = __hip_atomic_fetch_add(lcnt + e, 1u, __ATOMIC_RELAXED, __HIP_MEMORY_SCOPE_WORKGROUP); rec[(F.wave * P7_MAXIT + it) * 4 + lane] = (unsigned)e | (lp << 8); }
            else { const unsigned pos = __hip_atomic_fetch_add(cnt + 64 * e, 1u, __ATOMIC_RELAXED, __HIP_MEMORY_SCOPE_AGENT); topp[(size_t)m * 4 + lane] = (int)pos; elist[e * 16384 + pos] = m; } }
    }
    __syncthreads();
    if (F.tid < 32) lcnt[32 + F.tid] = __hip_atomic_fetch_add(cnt + 64 * F.tid, lcnt[F.tid], __ATOMIC_RELAXED, __HIP_MEMORY_SCOPE_AGENT);
    __syncthreads();
    { int it = 0;
        for (int m = gw; m < NTOK && it < P7_MAXIT; m += NGW, ++it)
            if (lane < 4) { const unsigned rc = rec[(F.wave * P7_MAXIT + it) * 4 + lane]; const unsigned e = rc & 255u, pos = lcnt[32 + e] + (rc >> 8); topp[(size_t)m * 4 + lane] = (int)pos; elist[e * 16384 + pos] = m; } }
}

__device__ __forceinline__ int build_moe_tables(Frame& F, LAS int* tab  ) {
    const unsigned* cnt = (const unsigned*)(F.ws + WS_CTL) + CW_CNT;
    if (F.tid < 64) {
        const int e = F.lane & 31;
        const int n = (int)__hip_atomic_load(cnt + 64 * e, __ATOMIC_RELAXED, __HIP_MEMORY_SCOPE_AGENT);
        const int nb = (F.lane < 32) ? ((n + 255) >> 8) : 0;
        int inc = nb;
#pragma unroll
        for (int o = 1; o < 32; o <<= 1) { const int t = __shfl_up(inc, o); if (F.lane >= o) inc += t; }
        const int start = inc - nb;
        if (F.lane < 32) { tab[e] = start * 256; tab[512 + e] = n; for (int k = 0; k < nb; ++k) tab[64 + start + k] = e; }
        if (F.lane == 31) tab[32] = inc;
    }
    __syncthreads();
    return tab[32];
}

__device__ __forceinline__ void phase_p9(Frame& F, const Args& AR, float* out) {
    const float* x1 = (const float*)(F.ws + WS_OD); const bf16* ys = (const bf16*)(F.ws + WS_YS); const float* mod = (const float*)(F.ws + WS_MOD); const float* fnw = AR.in[21];
    const float* topg = (const float*)(F.ws + WS_TOPG); const int* topp = (const int*)(F.ws + WS_TOPP); const int* topi = (const int*)(F.ws + WS_TOPI);
    LAS int* tab = (LAS int*)(F.lds + LDS_TAB); build_moe_tables(F, tab);
    const int lane = F.lane;
    f4 fw[4];
#pragma unroll
    for (int j = 0; j < 4; ++j) fw[j] = ((const f4*)fnw)[lane + 64 * j];
    const int gw = blockIdx.x * NWAVES + F.wave, NGW = F.G * NWAVES;
    for (int m = gw; m < NTOK; m += NGW) {
        const int b = m >> 13;
        const f4 gk = *(const f4*)(topg + (size_t)m * 4); const int r0 = tab[topi[(size_t)m * 4]] + topp[(size_t)m * 4], r1 = tab[topi[(size_t)m * 4 + 1]] + topp[(size_t)m * 4 + 1], r2 = tab[topi[(size_t)m * 4 + 2]] + topp[(size_t)m * 4 + 2], r3 = tab[topi[(size_t)m * 4 + 3]] + topp[(size_t)m * 4 + 3];
        f4 v[4]; float ss = 0.f;
#pragma unroll
        for (int j = 0; j < 4; ++j) {
            const u2 y0 = __builtin_nontemporal_load((const u2*)(ys + (size_t)r0 * D) + lane + 64 * j), y1 = __builtin_nontemporal_load((const u2*)(ys + (size_t)r1 * D) + lane + 64 * j), y2 = __builtin_nontemporal_load((const u2*)(ys + (size_t)r2 * D) + lane + 64 * j), y3 = __builtin_nontemporal_load((const u2*)(ys + (size_t)r3 * D) + lane + 64 * j);
            f4 mo;
            mo.x = gk.x * bflo(y0.x) + gk.y * bflo(y1.x) + gk.z * bflo(y2.x) + gk.w * bflo(y3.x);
            mo.y = gk.x * bfhi(y0.x) + gk.y * bfhi(y1.x) + gk.z * bfhi(y2.x) + gk.w * bfhi(y3.x);
            mo.z = gk.x * bflo(y0.y) + gk.y * bflo(y1.y) + gk.z * bflo(y2.y) + gk.w * bflo(y3.y);
            mo.w = gk.x * bfhi(y0.y) + gk.y * bfhi(y1.y) + gk.z * bfhi(y2.y) + gk.w * bfhi(y3.y);
            const f4 xv = ((const f4*)(x1 + (size_t)m * D))[lane + 64 * j], gt = ((const f4*)(mod + b * 6144 + 5120))[lane + 64 * j];
            v[j] = xv + gt * mo; ss += (v[j].x * v[j].x + v[j].y * v[j].y) + (v[j].z * v[j].z + v[j].w * v[j].w); }
        const float rstd = __builtin_amdgcn_rsqf(wave_sum(ss) * (1.0f / D) + EPS);
#pragma unroll
        for (int j = 0; j < 4; ++j) __builtin_nontemporal_store(v[j] * rstd * fw[j], (f4*)(out + (size_t)m * D) + lane + 64 * j);
    }
}

__global__ void __launch_bounds__(NTHR, 2) fwd_kernel(Args args) {
    const Args& AR = args;
    extern __shared__ __attribute__((aligned(16))) unsigned char lds_raw[];
    Frame F;
    F.lds = (LAS unsigned char*)lds_raw;
    F.tid = threadIdx.x; F.lane = F.tid & 63; F.wave = __builtin_amdgcn_readfirstlane(F.tid >> 6); F.G = gridDim.x;
    F.ws = args.ws;
    volatile LAS unsigned* misc = (volatile LAS unsigned*)(F.lds + LDS_MISC);
    if (F.tid < 4) misc[F.tid] = 0u;
    __syncthreads();
    XcdBarrier bar; bar.bar = (unsigned*)(F.ws + WS_CTL) + CW_BAR; bar.x = 0; bar.st = nullptr;
    if (MK_N_LAUNCHES == 1) bar = xcd_barrier_post((unsigned*)(F.ws + WS_CTL) + CW_BAR, misc);
    const int lo = args.ph_lo, hi = args.ph_hi;
#ifndef PH_MASK
#define PH_MASK 0x1fff
#endif
#define IN(k) (((PH_MASK >> (k)) & 1) && lo <= (k) && (k) < hi)
#ifndef PROBE_PH
#define PROBE_PH -1
#define PROBE_REP 1
#endif
#define REPS(k) for (int rep_ = 0; rep_ < ((k) == PROBE_PH ? PROBE_REP : 1); ++rep_)
#define SEAM(k) do { if (IN(k) && IN((k) + 1)) xcd_barrier(bar); } while (0)
    PG8_LAS unsigned char* glds = (PG8_LAS unsigned char*)lds_raw;

    if (IN(0)) REPS(0) { phase_p0(F, AR); } SEAM(0);
    if (IN(1)) REPS(1) { phase_p1(F, AR); } SEAM(1);
    if (IN(2)) REPS(2) {
        pg8::Gemm g{(const bf16*)(F.ws + WS_H), (const bf16*)(F.ws + WS_WIN_T), NTOK, PW, D}; pg8::StaticOrder S; S.init(NTOK, PW, F.G, (int)blockIdx.x);
        EpiStoreBf16 E{(bf16*)(F.ws + WS_P), PW};
        pg8::gemm_phase<EpiStoreBf16, pg8::StaticOrder, true, true>(glds, g, S, E);
    } SEAM(2);
    if (IN(3)) REPS(3) { phase_p3(F, AR); __syncthreads(); phase_p5_sb(F, AR); } SEAM(3);
    if (IN(4)) REPS(4) { phase_p4(F, AR); } SEAM(4);
    if (IN(5)) REPS(5) { phase_p5(F, AR); } SEAM(5);
    if (IN(6)) REPS(6) {
        pg8::Gemm g{(const bf16*)(F.ws + WS_OASB), (const bf16*)(F.ws + WS_WUO_T), NTOK, D, D}; pg8::StaticOrder S; S.init(NTOK, D, F.G, (int)blockIdx.x);
        EpiGate E{(const bf16*)(F.ws + WS_P), (float*)(F.ws + WS_M1X), (bf16*)(F.ws + WS_M), PC_GA, 1};
        pg8::gemm_phase<EpiGate, pg8::StaticOrder, true, true>(glds, g, S, E);
    } SEAM(6);
    if (IN(7)) REPS(7) {
        pg8::Gemm g{(const bf16*)(F.ws + WS_M), (const bf16*)(F.ws + WS_WO_T), NTOK, D, D}; pg8::StaticOrder S; S.init(NTOK, D, F.G, (int)blockIdx.x);
        EpiG4 E{AR.in[0], (const float*)(F.ws + WS_MOD), (float*)(F.ws + WS_OD)};
        pg8::gemm_phase<EpiG4, pg8::StaticOrder, true, true>(glds, g, S, E);
    } SEAM(7);
    if (IN(8)) REPS(8) { phase_p7(F, AR); } SEAM(8);
    if (IN(9)) REPS(9) {
        __syncthreads();
        LAS int* tab = (LAS int*)(F.lds + LDS_TAB); const int nblk = build_moe_tables(F, tab);
        pg8::Gemm g{(const bf16*)(F.ws + WS_H), (const bf16*)(F.ws + WS_W1T), NTOK, NEXP * 2048, D}; MoeOrder S; S.init(nblk, 8, F.G, (int)blockIdx.x, tab, (const int*)(F.ws + WS_LIST));
        EpiMoe1 E{AR.in[18], (bf16*)(F.ws + WS_ACT)};
        pg8::gemm_phase<EpiMoe1, MoeOrder, true, true, true>(glds, g, S, E);
    } SEAM(9);
    if (IN(10)) REPS(10) {
        __syncthreads();
        LAS int* tab = (LAS int*)(F.lds + LDS_TAB); const int nblk = build_moe_tables(F, tab);
        pg8::Gemm g{(const bf16*)(F.ws + WS_ACT), (const bf16*)(F.ws + WS_W2T), MROWS, NEXP * 1024, D}; MoeOrder S; S.init(nblk, 4, F.G, (int)blockIdx.x, tab, (const int*)(F.ws + WS_LIST));
        EpiMoe2 E{AR.in[20], (bf16*)(F.ws + WS_YS)};
        pg8::gemm_phase<EpiMoe2, MoeOrder, true, true>(glds, g, S, E);
    } SEAM(10);
    if (IN(11)) REPS(11) { phase_p9(F, AR, args.out); }
#undef IN
#undef SEAM
}

extern "C" void kernel_launch(void* const* d_in, const int* in_sizes, int n_in, void* d_out, int out_size, void* d_ws, size_t ws_size, hipStream_t stream) {
    static int grid = 0;
    if (grid == 0) {
        if (n_in != 22 || out_size != NTOK * D || ws_size < WS_END) { fprintf(stderr, "kernel_launch: unexpected shapes (n_in %d out %d ws %zu)\n", n_in, out_size, ws_size); grid = -1; return; }
        int dev = 0, cus = 0, per_cu = 0;
        if (hipGetDevice(&dev) != hipSuccess || hipDeviceGetAttribute(&cus, hipDeviceAttributeMultiprocessorCount, dev) != hipSuccess) { grid = -1; return; }
        if (hipFuncSetAttribute((const void*)fwd_kernel, hipFuncAttributeMaxDynamicSharedMemorySize, LDS_BYTES) != hipSuccess) { fprintf(stderr, "kernel_launch: hipFuncSetAttribute failed\n"); grid = -1; return; }
        if (hipOccupancyMaxActiveBlocksPerMultiprocessor(&per_cu, (const void*)fwd_kernel, NTHR, LDS_BYTES) != hipSuccess || per_cu < 1) { fprintf(stderr, "kernel_launch: occupancy query says %d\n", per_cu); }
        (void)hipGetLastError();
        grid = cus;
        if (grid > 256) grid = 256;
    }
    if (grid < 0) return;
    if (hipMemsetAsync((char*)d_ws + WS_CTL, 0, CTL_ZERO_BYTES, stream) != hipSuccess) return;
    Args a{};
    for (int i = 0; i < 22; ++i) a.in[i] = (const float*)d_in[i];
    a.out = (float*)d_out; a.ws = (unsigned char*)d_ws;
#if MK_N_LAUNCHES == 1
    a.ph_lo = 0; a.ph_hi = NPHASE;
    hipLaunchKernelGGL(fwd_kernel, dim3(grid), dim3(NTHR), LDS_BYTES, stream, a);
#else
    for (int ph = 0; ph < NPHASE; ++ph) { a.ph_lo = ph; a.ph_hi = ph + 1; hipLaunchKernelGGL(fwd_kernel, dim3(grid), dim3(NTHR), LDS_BYTES, stream, a); }
#endif
}
```

```cpp
#include <hip/hip_runtime.h>
#include <cstdio>
#include <cstdint>
namespace pg8 {
#define PG8_LAS __attribute__((address_space(3)))
typedef unsigned short bf16_t;
typedef short bf16x8 __attribute__((ext_vector_type(8)));
typedef float f32x4 __attribute__((ext_vector_type(4)));
typedef unsigned u32x4 __attribute__((ext_vector_type(4)));
constexpr int BM = 256, BK = 64, HALF = 128, HTB = HALF * BK * 2  , STAGE_BYTES = 8 * HTB, NXCD = 8, WGM = 8;

__host__ __device__ __forceinline__ int lds_byte(int r, int c) { const int st = (r >> 4) * 2 + (c >> 5), rr = r & 15, cc = c & 31, ob = rr * 64 + cc * 2; return st * 1024 + (ob ^ (((ob >> 9) & 1) << 5)); }
__host__ __device__ __forceinline__ void stage_rc(int b, int& R, int& C) { const int st = b / 1024, sb = b % 1024, swz = sb ^ (((sb >> 9) & 1) << 5); R = (st >> 1) * 16 + swz / 64; C = (st & 1) * 32 + (swz % 64) / 2; }
__host__ __device__ __forceinline__ int perm32(int rho) { const int n = rho >> 4, i = rho & 15; return 8 * (i >> 2) + 4 * n + (i & 3); }

struct Unit { int pm, pn; };
struct Gemm { const bf16_t* A; const bf16_t* Bt; int M, N, K; };

struct StaticOrder {
    int nM, nN, nwg, G, c;
    __host__ __device__ void init(int M, int N, int G_, int c_) { nM = M / BM; nN = N / BM; nwg = nM * nN; G = G_; c = c_; }
    __host__ __device__ bool next(int i, Unit& u) const {
        const long L = (long)i * G + c; if (L >= nwg) return false;
        int wgid = (int)L; { const int q = nwg / NXCD, r = nwg % NXCD, xcd = wgid % NXCD, off = wgid / NXCD; wgid = (xcd < r ? xcd * (q + 1) : r * (q + 1) + (xcd - r) * q) + off; }
        const int nig = WGM * nN, gid = wgid / nig, fm = gid * WGM, gsz = (nM - fm) < WGM ? (nM - fm) : WGM;
        u.pm = fm + ((wgid % nig) % gsz); u.pn = (wgid % nig) / gsz; return true;
    }
    __device__ __forceinline__ void a_ready(const Unit&) const {}
    __device__ __forceinline__ void done(const Unit&) const {}
};

__device__ __forceinline__ unsigned cvt_pk_bf16(float lo, float hi) { unsigned r; asm volatile("v_cvt_pk_bf16_f32 %0, %1, %2" : "=v"(r) : "v"(lo), "v"(hi)); return r; }
template <class Epi, class Sched, bool ALIGN_EPI = false, bool SP2 = false, bool GATHER = false>
__device__ __forceinline__ void gemm_phase(PG8_LAS unsigned char* lds, const Gemm g, const Sched& S, const Epi& E) {
    const int tid = threadIdx.x, wid = __builtin_amdgcn_readfirstlane(tid >> 6), lane = tid & 63, wr = wid >> 2, wc = wid & 3, fr = lane & 15, fq = lane >> 4;
    const int K = g.K, nt = K / BK;
    unsigned voffA[2], voffB[2];
#pragma unroll
    for (int i = 0; i < 2; ++i) { int R, C; stage_rc(tid * 16 + i * 8192, R, C); const int Rb = Epi::PERM ? ((R & ~31) + perm32(R & 31)) : R;
        voffA[i] = (unsigned)(R * K + C) * 2u; voffB[i] = (unsigned)(Rb * K + C) * 2u; }
    unsigned vA[2][2], vN[2][2];
#pragma unroll
    for (int h = 0; h < 2; ++h)
#pragma unroll
        for (int i = 0; i < 2; ++i) { vA[h][i] = voffA[i] + (unsigned)(h * HALF * K * 2); vN[h][i] = vA[h][i]; }
#define PG8_TOKS(u, tq) do { _Pragma("unroll") for (int _h = 0; _h < 2; ++_h) _Pragma("unroll") for (int _i = 0; _i < 2; ++_i) { int _R, _C; stage_rc(tid * 16 + _i * 8192, _R, _C); tq[_h][_i] = S.row_token(u, _h * HALF + _R); } } while (0)
#define PG8_OFFS(tq, v) do { _Pragma("unroll") for (int _h = 0; _h < 2; ++_h) _Pragma("unroll") for (int _i = 0; _i < 2; ++_i) { int _R, _C; stage_rc(tid * 16 + _i * 8192, _R, _C); v[_h][_i] = (unsigned)(tq[_h][_i] * K + _C) * 2u; } } while (0)
    const size_t kstep = (size_t)(BK * 2);
    const size_t hstep = (size_t)HALF * K * 2;
    const size_t tstep = 2 * hstep;
    const unsigned ldsw = (unsigned)wid * 1024u;
    const int aoff = lds_byte(wr * 64 + fr, fq * 8), boff = lds_byte(wc * 32 + fr, fq * 8);
#define PG8_SA(b, h) (((b) * 2 + (h)) * HTB)
#define PG8_SB(b, h) ((4 + (b) * 2 + (h)) * HTB)
#define PG8_STAGE(bufoff, gbase, voff) do { _Pragma("unroll") for (int _i = 0; _i < 2; ++_i) \
        __builtin_amdgcn_global_load_lds((const unsigned*)((const char*)(gbase) + (voff)[_i]), (PG8_LAS unsigned*)(lds + (bufoff) + ldsw + _i * 8192), 16, 0, 0); } while (0)
#define PG8_LDA(dst, b, h) do { _Pragma("unroll") for (int m = 0; m < 4; ++m) _Pragma("unroll") for (int k = 0; k < 2; ++k) dst[m][k] = *(const PG8_LAS bf16x8*)(lds + PG8_SA(b, h) + aoff + m * 2048 + k * 1024); } while (0)
#define PG8_LDB(dst, b, h) do { _Pragma("unroll") for (int n = 0; n < 2; ++n) _Pragma("unroll") for (int k = 0; k < 2; ++k) dst[n][k] = *(const PG8_LAS bf16x8*)(lds + PG8_SB(b, h) + boff + n * 2048 + k * 1024); } while (0)
#define PG8_MMA(ai, bj, At, Bt) do { __builtin_amdgcn_s_setprio(1); _Pragma("unroll") for (int m = 0; m < 4; ++m) _Pragma("unroll") for (int n = 0; n < 2; ++n) _Pragma("unroll") for (int k = 0; k < 2; ++k) \
        acc[ai][bj][m][n] = __builtin_amdgcn_mfma_f32_16x16x32_bf16(Bt[n][k], At[m][k], acc[ai][bj][m][n], 0, 0, 0); __builtin_amdgcn_s_setprio(0); } while (0)
#define PG8_WAIT_V(n) asm volatile("s_waitcnt vmcnt(" #n ")" ::: "memory")
#define PG8_WAIT_L(n) asm volatile("s_waitcnt lgkmcnt(" #n ")" ::: "memory")
#define PG8_BAR __builtin_amdgcn_s_barrier()
#define PG8_SCHED __builtin_amdgcn_sched_barrier(0)
    Unit cur, nxt; int ui = 0;
    if (!S.next(0, cur)) return;
    f32x4 acc[2][2][4][2];
#pragma unroll
    for (int a = 0; a < 2; ++a)
#pragma unroll
        for (int b = 0; b < 2; ++b)
#pragma unroll
            for (int m = 0; m < 4; ++m)
#pragma unroll
                for (int n = 0; n < 2; ++n) acc[a][b][m][n] = (f32x4){0.f, 0.f, 0.f, 0.f};
    bf16x8 At[4][2], B0[2][2], B1[2][2];
    const char* cA = (const char*)g.A + (GATHER ? (size_t)0 : (size_t)cur.pm * tstep); const char* cB = (const char*)g.Bt + (size_t)cur.pn * tstep;
    if constexpr (GATHER) { int tq0[2][2]; PG8_TOKS(cur, tq0); PG8_OFFS(tq0, vA); Unit n1; if (S.next(1, n1)) { PG8_TOKS(n1, tq0); PG8_OFFS(tq0, vN); } else { vN[0][0] = vA[0][0]; vN[0][1] = vA[0][1]; vN[1][0] = vA[1][0]; vN[1][1] = vA[1][1]; } }
    S.a_ready(cur);
    if constexpr (SP2) {
        PG8_STAGE(PG8_SB(0, 0), cB, voffB); PG8_STAGE(PG8_SB(0, 1), cB + hstep, voffB); PG8_STAGE(PG8_SA(0, 0), cA, vA[0]); PG8_STAGE(PG8_SA(0, 1), cA, vA[1]);
        if (wr == 1) PG8_BAR;
        PG8_WAIT_V(2); PG8_BAR;
        PG8_STAGE(PG8_SB(1, 0), cB + kstep, voffB); PG8_STAGE(PG8_SA(1, 0), cA + kstep, vA[0]); PG8_STAGE(PG8_SB(1, 1), cB + hstep + kstep, voffB);
        PG8_WAIT_V(6); PG8_BAR;
    } else {
        PG8_STAGE(PG8_SB(0, 0), cB, voffB); PG8_STAGE(PG8_SA(0, 0), cA, voffA); PG8_STAGE(PG8_SB(0, 1), cB + hstep, voffB); PG8_STAGE(PG8_SA(0, 1), cA + hstep, voffA);
        if (wr == 1) PG8_BAR;
        PG8_WAIT_V(4); PG8_BAR;
        PG8_STAGE(PG8_SB(1, 0), cB + kstep, voffB); PG8_STAGE(PG8_SA(1, 0), cA + kstep, voffA); PG8_STAGE(PG8_SB(1, 1), cB + hstep + kstep, voffB);
        PG8_WAIT_V(6); PG8_BAR;
    }
    for (;;) {
        const bool has_next = S.next(ui + 1, nxt);
        const char* nA = (has_next && !GATHER) ? (const char*)g.A + (size_t)nxt.pm * tstep : cA; const char* nB = has_next ? (const char*)g.Bt + (size_t)nxt.pn * tstep : cB;
        for (int t = 0; t < nt; t += 2) {
            const bool last = (t == nt - 2);
            const char* a1 = cA + (size_t)(t + 1) * kstep;
            const char* a2 = last ? nA : cA + (size_t)(t + 2) * kstep; const char* b2 = last ? nB : cB + (size_t)(t + 2) * kstep;
            const char* a3 = a2 + kstep; const char* b3 = b2 + kstep;
            if (last && has_next) S.a_ready(nxt);
            unsigned o0[2] = {vA[0][0], vA[0][1]}, o1[2] = {vA[1][0], vA[1][1]};
            if (last) { o0[0] = vN[0][0]; o0[1] = vN[0][1]; o1[0] = vN[1][0]; o1[1] = vN[1][1]; }
            if constexpr (SP2) {
            PG8_LDB(B0, 0, 0); PG8_LDB(B1, 0, 1); PG8_SCHED; PG8_LDA(At, 0, 0); PG8_STAGE(PG8_SA(1, 1), a1, vA[1]);
            PG8_WAIT_V(8); PG8_WAIT_L(0); PG8_BAR; PG8_MMA(0, 0, At, B0); PG8_MMA(0, 1, At, B1); PG8_BAR; PG8_SCHED;
            PG8_LDA(At, 0, 1); PG8_STAGE(PG8_SB(0, 0), b2, voffB); PG8_STAGE(PG8_SB(0, 1), b2 + hstep, voffB); PG8_STAGE(PG8_SA(0, 0), a2, o0);
            PG8_WAIT_V(8); PG8_WAIT_L(0); PG8_BAR; PG8_MMA(1, 0, At, B0); PG8_MMA(1, 1, At, B1); PG8_BAR; PG8_SCHED;
            PG8_LDB(B0, 1, 0); PG8_LDB(B1, 1, 1); PG8_SCHED; PG8_LDA(At, 1, 0); PG8_STAGE(PG8_SA(0, 1), a2, o1);
            PG8_WAIT_V(8); PG8_WAIT_L(0); PG8_BAR; PG8_MMA(0, 0, At, B0); PG8_MMA(0, 1, At, B1); PG8_BAR; PG8_SCHED;
            PG8_LDA(At, 1, 1); PG8_STAGE(PG8_SB(1, 0), b3, voffB); PG8_STAGE(PG8_SB(1, 1), b3 + hstep, voffB); PG8_STAGE(PG8_SA(1, 0), a3, o0);
            PG8_WAIT_V(8); PG8_WAIT_L(0); PG8_BAR; PG8_MMA(1, 0, At, B0); PG8_MMA(1, 1, At, B1); PG8_BAR; PG8_SCHED;
            } else {
            PG8_LDB(B0, 0, 0); PG8_SCHED; PG8_LDA(At, 0, 0); PG8_STAGE(PG8_SA(1, 1), a1 + hstep, voffA);
            PG8_WAIT_L(8); PG8_BAR; PG8_WAIT_L(0); PG8_MMA(0, 0, At, B0); PG8_BAR; PG8_SCHED;
            PG8_LDB(B1, 0, 1); PG8_STAGE(PG8_SB(0, 0), b2, voffB);
            PG8_BAR; PG8_WAIT_L(0); PG8_MMA(0, 1, At, B1); PG8_BAR;
            PG8_LDA(At, 0, 1); PG8_STAGE(PG8_SA(0, 0), a2, voffA);
            PG8_BAR; PG8_WAIT_L(0); PG8_MMA(1, 0, At, B0); PG8_BAR; PG8_SCHED;
            PG8_STAGE(PG8_SB(0, 1), b2 + hstep, voffB);
            PG8_WAIT_V(6); PG8_BAR; PG8_MMA(1, 1, At, B1); PG8_BAR;
            PG8_LDB(B0, 1, 0); PG8_SCHED; PG8_LDA(At, 1, 0); PG8_STAGE(PG8_SA(0, 1), a2 + hstep, voffA);
            PG8_WAIT_L(8); PG8_BAR; PG8_WAIT_L(0); PG8_MMA(0, 0, At, B0); PG8_BAR; PG8_SCHED;
            PG8_LDB(B1, 1, 1); PG8_STAGE(PG8_SB(1, 0), b3, voffB);
            PG8_BAR; PG8_WAIT_L(0); PG8_MMA(0, 1, At, B1); PG8_BAR;
            PG8_LDA(At, 1, 1); PG8_STAGE(PG8_SA(1, 0), a3, voffA);
            PG8_BAR; PG8_WAIT_L(0); PG8_MMA(1, 0, At, B0); PG8_BAR; PG8_SCHED;
            PG8_STAGE(PG8_SB(1, 1), b3 + hstep, voffB);
            PG8_WAIT_V(6); PG8_BAR; PG8_MMA(1, 1, At, B1); PG8_BAR;
            }
        }
        if constexpr (ALIGN_EPI) { if (wr == 0) PG8_BAR; }
        int tq[2][2] = {{0, 0}, {0, 0}}; bool has2 = false;
        if constexpr (GATHER) { Unit nx2; has2 = S.next(ui + 2, nx2); if (has2) PG8_TOKS(nx2, tq); }
        if constexpr (!Epi::AFTER_DRAIN) { E(acc, cur, wr, wc, fr, fq); S.done(cur); }
        if constexpr (GATHER) { asm volatile("" : "+v"(tq[0][0]), "+v"(tq[0][1]), "+v"(tq[1][0]), "+v"(tq[1][1])); }
        if (!has_next) break;
#pragma unroll
        for (int a = 0; a < 2; ++a)
#pragma unroll
            for (int b = 0; b < 2; ++b)
#pragma unroll
                for (int m = 0; m < 4; ++m)
#pragma unroll
                    for (int n = 0; n < 2; ++n) acc[a][b][m][n] = (f32x4){0.f, 0.f, 0.f, 0.f};
        cur = nxt; cA = nA; cB = nB; ++ui; vA[0][0] = vN[0][0]; vA[0][1] = vN[0][1]; vA[1][0] = vN[1][0]; vA[1][1] = vN[1][1];
        if constexpr (GATHER) { if (has2) PG8_OFFS(tq, vN); }
        if constexpr (ALIGN_EPI) { if (wr == 1) PG8_BAR; }
    }
    PG8_WAIT_V(0);
    if constexpr (!ALIGN_EPI) { if (wr == 0) PG8_BAR; }
    PG8_BAR;
    if constexpr (Epi::AFTER_DRAIN) { E.fused(acc, cur, wr, wc, fr, fq, lds, wid, lane); S.done(cur); }
#undef PG8_TOKS
#undef PG8_OFFS
#undef PG8_SA
#undef PG8_SB
#undef PG8_STAGE
#undef PG8_LDA
#undef PG8_LDB
#undef PG8_MMA
#undef PG8_WAIT_V
#undef PG8_WAIT_L
#undef PG8_BAR
#undef PG8_SCHED
}
}

#define XB_TMO      128
#define XB_XCNT(j)  (256  + 64 * (j))
#define XB_XSUB(j)  (1280 + 64 * (j))
#define XB_XGEN(j)  (2304 + 64 * (j))
#define XB_TOP      3328
#define XB_TOPGEN   3392
#define XCD_BAR_WORDS 3456
#define XB_SPIN_CAP (1u << 18)
#define LAS __attribute__((address_space(3)))

__device__ __forceinline__ unsigned xb_ld(unsigned* p)              { return __hip_atomic_load(p, __ATOMIC_RELAXED, __HIP_MEMORY_SCOPE_AGENT); }
__device__ __forceinline__ unsigned xb_add(unsigned* p, unsigned v) { return __hip_atomic_fetch_add(p, v, __ATOMIC_RELAXED, __HIP_MEMORY_SCOPE_AGENT); }
__device__ __forceinline__ unsigned xb_xcc_id() { return (unsigned)__builtin_amdgcn_s_getreg((3 << 11) | 20) & 0xFu; }
#define XB_SPIN(cond, bar) do { unsigned _sp = 0; while (cond) { __builtin_amdgcn_s_sleep(1); \
    if ((++_sp & 255u) == 0u) { if (xb_ld(&(bar)[XB_TMO])) break; if (_sp > XB_SPIN_CAP) { atomicAdd(&(bar)[XB_TMO], 1u); break; } } } } while (0)

struct XcdBarrier {
    unsigned* bar; unsigned x;
    volatile LAS unsigned* st;
};

__device__ __forceinline__ XcdBarrier xcd_barrier_post(unsigned* bar, volatile LAS unsigned* st) {
    XcdBarrier b; b.bar = bar; b.x = xb_xcc_id(); b.st = st;
    if (threadIdx.x == 0) (void)xb_add(&bar[XB_XCNT(b.x)], 1u);
    return b;
}
__device__ __forceinline__ void xcd_barrier_complete(unsigned* bar, unsigned x, unsigned& nloc, unsigned& nx) {
    const unsigned G = gridDim.x * gridDim.y * gridDim.z;
    unsigned sum, cnt, mine, sp = 0u;
    for (;;) {
        sum = 0u; cnt = 0u; mine = 0u;
#pragma unroll
        for (unsigned j = 0; j < 16; ++j) { const unsigned c = xb_ld(&bar[XB_XCNT(j)]); sum += c; cnt += (c > 0u) ? 1u : 0u; mine = (j == x) ? c : mine; }
        if (sum == G) break;
        __builtin_amdgcn_s_sleep(1);
        if ((++sp & 255u) == 0u) { if (xb_ld(&bar[XB_TMO])) break; if (sp > XB_SPIN_CAP) { atomicAdd(&bar[XB_TMO], 1u); break; } }
    }
    nloc = mine > 0u ? mine : 1u; nx = cnt > 0u ? cnt : 1u;
}

__device__ __forceinline__ void xcd_barrier(const XcdBarrier& b) {
    asm volatile("s_waitcnt vmcnt(0)" ::: "memory");
    __syncthreads();
    if (threadIdx.x == 0) {
        unsigned* bar = b.bar;
        __builtin_amdgcn_s_waitcnt(0);
        unsigned nloc = b.st[0], nx = b.st[1];
        if (nloc == 0u) { xcd_barrier_complete(bar, b.x, nloc, nx); b.st[0] = nloc; b.st[1] = nx; }
        const unsigned old = xb_add(&bar[XB_XSUB(b.x)], 1u);
        const unsigned gen = old / nloc;
        if (old + 1u == (gen + 1u) * nloc) {
            __builtin_amdgcn_fence(__ATOMIC_RELEASE, "agent");
            asm volatile("s_waitcnt vmcnt(0)" ::: "memory");
            const unsigned og = xb_add(&bar[XB_TOP], 1u);
            const unsigned tg = og / nx;
            if (og + 1u == (tg + 1u) * nx) xb_add(&bar[XB_TOPGEN], 1u);
            else XB_SPIN(xb_ld(&bar[XB_TOPGEN]) == tg, bar);
            __builtin_amdgcn_fence(__ATOMIC_ACQUIRE, "agent");
            xb_add(&bar[XB_XGEN(b.x)], 1u);
            asm volatile("s_waitcnt vmcnt(0)" ::: "memory");
        } else {
            XB_SPIN(xb_ld(&bar[XB_XGEN(b.x)]) == gen, bar);
            __builtin_amdgcn_fence(__ATOMIC_ACQUIRE, "agent");
            asm volatile("s_waitcnt vmcnt(0)" ::: "memory");
        }
    }
    __syncthreads();
}

#ifndef MK_N_LAUNCHES
#define MK_N_LAUNCHES 1
#endif
constexpr int NPHASE = 12;
constexpr int NWAVES = 8, NTHR = 512;
constexpr int D = 1024, SEQ = 8192, NTOK = 16384, NH = 8, HD = 128, CH = 64, NCHUNK = 128;
constexpr int PW = 9216;
constexpr int PC_Q = 0, PC_K = 1024, PC_V = 2048, PC_Z = 3072, PC_BG = 4096, PC_CG = 5120, PC_UI = 6144, PC_GA = 7168, PC_GB = 8192;
constexpr int INW = 9248;
constexpr int NEXP = 32, TOPK = 4, MROWS = 73728;
constexpr float EPS = 1e-6f;

constexpr size_t MiB = 1u << 20;
constexpr size_t WS_CTL = 0, CTL_ZERO_BYTES = 1 * MiB;
constexpr size_t WS_MOD = 1 * MiB;
constexpr size_t WS_WSM_T = 1 * MiB + 64 * 1024;
constexpr size_t WS_WR_T = 1 * MiB + 192 * 1024;
constexpr size_t WS_TOPI = 2 * MiB;
constexpr size_t WS_TOPG = 2 * MiB + 256 * 1024;
constexpr size_t WS_TOPP = 2 * MiB + 512 * 1024;
constexpr size_t WS_PSM = 3 * MiB;
constexpr size_t WS_GL = 5 * MiB;
constexpr size_t WS_LIST = 6 * MiB;
constexpr size_t WS_WIN_T = 8 * MiB;
constexpr size_t WS_WUO_T = 26 * MiB;
constexpr size_t WS_WO_T = 30 * MiB;
constexpr size_t WS_W1T = 32 * MiB;
constexpr size_t WS_W2T = 160 * MiB;
constexpr size_t WS_H = 224 * MiB;
constexpr size_t WS_OD = 256 * MiB;
constexpr size_t WS_P = 320 * MiB;
constexpr size_t WS_DD = 608 * MiB;
constexpr size_t WS_SB = WS_H;
constexpr size_t WS_M1X = 896 * MiB;
constexpr size_t WS_END = 960 * MiB;
constexpr size_t DD_UNIT = 73728;
constexpr size_t DD_W = 0, DD_Q = 16384, DD_K = 32768, DD_A = 49152, DD_U = 57344;
constexpr size_t WS_OASB = WS_DD, WS_M1 = WS_DD + 64 * MiB, WS_M = WS_DD + 128 * MiB;
constexpr size_t WS_XS = WS_P, WS_ACT = WS_P + 144 * MiB, WS_YS = WS_DD;
constexpr int CW_BAR = 4096;
constexpr int CW_RANK = 30720;
constexpr int CW_CVT = 28672;
constexpr int CW_Q = 24576;
constexpr int CW_CNT = 16384;

constexpr int LDS_BYTES = 155648;
constexpr int LDS_MISC = 152 * 1024 - 256;
constexpr int LDS_TAB = 131072;

#define GAS __attribute__((address_space(1)))
#define LAS __attribute__((address_space(3)))
typedef unsigned short bf16;
typedef float f4 __attribute__((ext_vector_type(4)));
typedef unsigned u4 __attribute__((ext_vector_type(4)));
typedef unsigned u2 __attribute__((ext_vector_type(2)));

typedef __bf16 hwbf2 __attribute__((ext_vector_type(2)));
typedef float hwf2 __attribute__((ext_vector_type(2)));
__device__ __forceinline__ unsigned cvtpk(float lo, float hi) { const hwf2 v = {lo, hi}; return __builtin_bit_cast(unsigned, __builtin_convertvector(v, hwbf2)); }
__device__ __forceinline__ unsigned f2bf(float f) { unsigned u = __float_as_uint(f); return (u + 0x7fffu + ((u >> 16) & 1u)) >> 16; }
__device__ __forceinline__ unsigned pk2(float lo, float hi) { return cvtpk(lo, hi); }
__device__ __forceinline__ float bflo(unsigned w) { return __uint_as_float(w << 16); }
__device__ __forceinline__ float bfhi(unsigned w) { return __uint_as_float(w & 0xffff0000u); }
__device__ __forceinline__ float bf1(bf16 b) { return __uint_as_float(((unsigned)b) << 16); }
__device__ __forceinline__ void unpack8(const u4 w, float (&o)[8]) { o[0] = bflo(w.x); o[1] = bfhi(w.x); o[2] = bflo(w.y); o[3] = bfhi(w.y); o[4] = bflo(w.z); o[5] = bfhi(w.z); o[6] = bflo(w.w); o[7] = bfhi(w.w); }
__device__ __forceinline__ u4 pack8(const float (&o)[8]) { u4 w; w.x = pk2(o[0], o[1]); w.y = pk2(o[2], o[3]); w.z = pk2(o[4], o[5]); w.w = pk2(o[6], o[7]); return w; }
#define DPP_ADD(x, ctrl) ((x) + __builtin_bit_cast(float, __builtin_amdgcn_mov_dpp(__builtin_bit_cast(int, (x)), (ctrl), 0xf, 0xf, true)))
__device__ __forceinline__ float sum8(float x) { x = DPP_ADD(x, 0xB1); x = DPP_ADD(x, 0x4E); x = DPP_ADD(x, 0x141); return x; }
__device__ __forceinline__ float sum16(float x) { x = DPP_ADD(x, 0xB1); x = DPP_ADD(x, 0x4E); x = DPP_ADD(x, 0x141); x = DPP_ADD(x, 0x140); return x; }
__device__ __forceinline__ float wave_sum(float v) {
#pragma unroll
    for (int o = 1; o < 64; o <<= 1) v += __shfl_xor(v, o);
    return v;
}
#define LDS_BARRIER() do { asm volatile("s_waitcnt lgkmcnt(0)" ::: "memory"); __builtin_amdgcn_s_barrier(); asm volatile("" ::: "memory"); } while (0)
__device__ __forceinline__ float sigm(float x) { return __builtin_amdgcn_rcpf(1.0f + __expf(-x)); }
__device__ __forceinline__ float silu(float x) { return x * __builtin_amdgcn_rcpf(1.0f + __expf(-x)); }
__device__ __forceinline__ float softplus(float x) { return x > 20.f ? x : log1pf(expf(x)); }

struct Args { const float* in[22]; float* out; unsigned char* ws; int ph_lo, ph_hi; };

struct Frame {
    LAS unsigned char* lds;
    int tid, lane, wave, G;
    unsigned char* ws;
};

__device__ __forceinline__ void p0_transpose_item(const float* W, int ldw, int k0, int n0s, bf16* WT, size_t drow0, LAS float* scr, int lane) {
    { const int kq = lane >> 3, n4 = (lane & 7) * 4; f4 v[8];
#pragma unroll
        for (int i = 0; i < 8; ++i) v[i] = __builtin_nontemporal_load((const f4*)(W + (size_t)(k0 + 8 * i + kq) * ldw + n0s + n4));
#pragma unroll
        for (int i = 0; i < 8; ++i) { LAS float* d = scr + (8 * i + kq) * 33 + n4; d[0] = v[i].x; d[1] = v[i].y; d[2] = v[i].z; d[3] = v[i].w; } }
    asm volatile("s_waitcnt lgkmcnt(0)" ::: "memory");
    const int c = lane & 7;
#pragma unroll
    for (int j = 0; j < 4; ++j) { const int n = (lane >> 3) + 8 * j; const LAS float* s = scr + (8 * c) * 33 + n;
        u4 o; o.x = pk2(s[0 * 33], s[1 * 33]); o.y = pk2(s[2 * 33], s[3 * 33]); o.z = pk2(s[4 * 33], s[5 * 33]); o.w = pk2(s[6 * 33], s[7 * 33]);
        *(u4*)(WT + (drow0 + n) * 1024 + k0 + 8 * c) = o; }
    asm volatile("s_waitcnt lgkmcnt(0)" ::: "memory");
}

__device__ __forceinline__ void phase_p0(Frame& F, const Args& AR) {
    const float* c_in = AR.in[1]; const float* ada_w = AR.in[2]; const float* ada_b = AR.in[3];
    const float* w_in = AR.in[5];
    for (int task = blockIdx.x; task < 192; task += F.G) {
        LAS float* red = (LAS float*)(F.lds + 131072);
        const int j0 = 32 * task, col = j0 + (F.lane & 31), kh = F.lane >> 5;
        float a0 = 0.f, a1 = 0.f;
        const float c0 = c_in[128 * F.wave + F.lane], c1 = c_in[128 * F.wave + 64 + F.lane], d0 = c_in[1024 + 128 * F.wave + F.lane], d1 = c_in[1024 + 128 * F.wave + 64 + F.lane];
        const float s0 = silu(c0), s1 = silu(c1), t0 = silu(d0), t1 = silu(d1);
#pragma unroll
        for (int hb = 0; hb < 2; ++hb) { float wv[32];
#pragma unroll
            for (int i = 0; i < 32; ++i) wv[i] = __builtin_nontemporal_load(ada_w + (size_t)(128 * F.wave + 2 * (32 * hb + i) + kh) * 6144 + col);
#pragma unroll
            for (int i = 0; i < 32; ++i) { const int kl = 2 * (32 * hb + i) + kh;
                const float ca = __shfl(hb == 0 ? s0 : s1, kl & 63), cb = __shfl(hb == 0 ? t0 : t1, kl & 63);
                a0 += ca * wv[i]; a1 += cb * wv[i]; } }
        a0 += __shfl_xor(a0, 32); a1 += __shfl_xor(a1, 32);
        if (F.lane < 32) { red[(F.wave * 2 + 0) * 32 + F.lane] = a0; red[(F.wave * 2 + 1) * 32 + F.lane] = a1; }
        __syncthreads();
        if (F.tid < 64) { const int b = F.tid >> 5, cc = F.tid & 31; float s = 0.f;
#pragma unroll
            for (int w = 0; w < 8; ++w) s += red[(w * 2 + b) * 32 + cc];
            ((float*)(F.ws + WS_MOD))[b * 6144 + j0 + cc] = s + ada_b[j0 + cc]; }
        __syncthreads();
    }
    {
        const float* router_w = AR.in[15]; float* wsm = (float*)(F.ws + WS_WSM_T); float* wr = (float*)(F.ws + WS_WR_T);
        for (int idx = blockIdx.x * NTHR + F.tid; idx < 65536; idx += F.G * NTHR) { const int which = idx >> 15, r = idx & 32767, k = r >> 5, n = r & 31;
            if (which == 0) wsm[n * 1024 + k] = w_in[(size_t)k * INW + 4096 + n]; else wr[n * 1024 + k] = router_w[k * 32 + n]; }
    }
    LAS float* scr = (LAS float*)(F.lds + F.wave * 16384);
    const int gw = blockIdx.x * NWAVES + F.wave, NGW = F.G * NWAVES;
    constexpr int I_IN = 16 * 288, I_SQ = 16 * 32;
    constexpr int NITEMS = I_IN + 3 * I_SQ;
    for (int it = gw; it < NITEMS; it += NGW) {
        int r = it;
        if (r < I_IN) { const int kb = r / 288, nb = r % 288, n0 = 32 * nb; p0_transpose_item(w_in, INW, 64 * kb, n0 + (n0 >= 4096 ? 32 : 0), (bf16*)(F.ws + WS_WIN_T), (size_t)n0, scr, F.lane); continue; } r -= I_IN;
        if (r < I_SQ) { const int kb = r / 32, nb = r % 32; p0_transpose_item(AR.in[10], 1024, 64 * kb, 32 * nb, (bf16*)(F.ws + WS_WUO_T), (size_t)(32 * nb), scr, F.lane); continue; } r -= I_SQ;
        if (r < I_SQ) { const int kb = r / 32, nb = r % 32; p0_transpose_item(AR.in[12], 1024, 64 * kb, 32 * nb, (bf16*)(F.ws + WS_WUO_T), (size_t)(1024 + 32 * nb), scr, F.lane); continue; } r -= I_SQ;
        { const int kb = r / 32, nb = r % 32; p0_transpose_item(AR.in[13], 1024, 64 * kb, 32 * nb, (bf16*)(F.ws + WS_WO_T), (size_t)(32 * nb), scr, F.lane); }
    }
}
struct CvtItem { const float* W; bf16* WT; size_t drow0; int ldw, k0, n0s; };
__device__ __forceinline__ CvtItem moe_item(const Args& AR, unsigned char* ws, int r) {
    constexpr int I_W1 = 32 * 16 * 64; CvtItem c;
    if (r < I_W1) { const int e = r / 1024, q = r % 1024, kb = q / 64, nb = q % 64, n0 = 32 * nb, half = n0 >> 10, j = n0 & 1023;
        c.W = AR.in[17] + (size_t)e * 1024 * 2048; c.ldw = 2048; c.k0 = 64 * kb; c.n0s = n0; c.WT = (bf16*)(ws + WS_W1T); c.drow0 = (size_t)e * 2048 + (size_t)((j >> 7) * 256 + half * 128 + (j & 127)); }
    else { r -= I_W1; const int e = r / 512, q = r % 512, kb = q / 32, nb = q % 32;
        c.W = AR.in[19] + (size_t)e * 1024 * 1024; c.ldw = 1024; c.k0 = 64 * kb; c.n0s = 32 * nb; c.WT = (bf16*)(ws + WS_W2T); c.drow0 = (size_t)e * 1024 + (size_t)(32 * nb); }
    return c;
}
__device__ __forceinline__ void cvt_load(const CvtItem& c, int lane, f4 (&v)[8]) {
    const int kq = lane >> 3, n4 = (lane & 7) * 4;
#pragma unroll
    for (int i = 0; i < 8; ++i) v[i] = __builtin_nontemporal_load((const f4*)(c.W + (size_t)(c.k0 + 8 * i + kq) * c.ldw + c.n0s + n4));
}
__device__ __forceinline__ void cvt_store(const CvtItem& c, int lane, const f4 (&v)[8], LAS float* scr) {
    const int kq = lane >> 3, n4 = (lane & 7) * 4;
#pragma unroll
    for (int i = 0; i < 8; ++i) { LAS float* d = scr + (8 * i + kq) * 33 + n4; d[0] = v[i].x; d[1] = v[i].y; d[2] = v[i].z; d[3] = v[i].w; }
    asm volatile("s_waitcnt lgkmcnt(0)" ::: "memory");
    const int cc = lane & 7;
#pragma unroll
    for (int j = 0; j < 4; ++j) { const int n = (lane >> 3) + 8 * j; const LAS float* sp = scr + (8 * cc) * 33 + n;
        u4 o; o.x = pk2(sp[0 * 33], sp[1 * 33]); o.y = pk2(sp[2 * 33], sp[3 * 33]); o.z = pk2(sp[4 * 33], sp[5 * 33]); o.w = pk2(sp[6 * 33], sp[7 * 33]);
        __builtin_nontemporal_store(o, (u4*)(c.WT + (c.drow0 + n) * 1024 + c.k0 + 8 * cc)); }
    asm volatile("s_waitcnt lgkmcnt(0)" ::: "memory");
}
__device__ __forceinline__ void moe_convert(Frame& F, const Args& AR) {
    constexpr int NIT = 32 * 16 * 64 + 32 * 16 * 32;
    LAS float* scr = (LAS float*)(F.lds + F.wave * 16384);
    unsigned* ctr = (unsigned*)(F.ws + WS_CTL) + CW_CVT;
    constexpr int GRAB = 32;
    for (;;) {
        unsigned base = 0u;
        if (F.lane == 0) base = __hip_atomic_fetch_add(ctr, (unsigned)GRAB, __ATOMIC_RELAXED, __HIP_MEMORY_SCOPE_AGENT);
        base = (unsigned)__builtin_amdgcn_readfirstlane((int)base);
        if (base >= (unsigned)NIT) break;
        f4 va[8], vb[8], vc[8], vd[8];
        CvtItem ca = moe_item(AR, F.ws, (int)base), cb = moe_item(AR, F.ws, (int)base + 1), cc = moe_item(AR, F.ws, (int)base + 2), cd = ca;
        cvt_load(ca, F.lane, va); cvt_load(cb, F.lane, vb); cvt_load(cc, F.lane, vc);
#pragma unroll 1
        for (int t = 0; t < GRAB; t += 4) {
            cd = moe_item(AR, F.ws, (int)base + t + 3); cvt_load(cd, F.lane, vd);
            cvt_store(ca, F.lane, va, scr);
            if (t + 4 < GRAB) { ca = moe_item(AR, F.ws, (int)base + t + 4); cvt_load(ca, F.lane, va); }
            cvt_store(cb, F.lane, vb, scr);
            if (t + 5 < GRAB) { cb = moe_item(AR, F.ws, (int)base + t + 5); cvt_load(cb, F.lane, vb); }
            cvt_store(cc, F.lane, vc, scr);
            if (t + 6 < GRAB) { cc = moe_item(AR, F.ws, (int)base + t + 6); cvt_load(cc, F.lane, vc); }
            cvt_store(cd, F.lane, vd, scr);
        }
    }
}
__device__ __forceinline__ void stage_wt(LAS float* WtL, const float* WT, int tid) {
    f4 v[16];
#pragma unroll
    for (int i = 0; i < 16; ++i) { const int idx = tid + i * NTHR, n = idx >> 8, k4 = idx & 255; v[i] = *(const f4*)(WT + n * 1024 + 4 * k4); }
#pragma unroll
    for (int i = 0; i < 16; ++i) { const int idx = tid + i * NTHR, n = idx >> 8, k4 = idx & 255; *(LAS f4*)(WtL + n * 1028 + 4 * k4) = v[i]; }
}
__device__ __forceinline__ void stage_ab(LAS float* A1, LAS float* B1, const float* w, const float* mod, int sc_off, int sh_off, int tid) {
    float wv[4], sc[4], sh[4];
#pragma unroll
    for (int i = 0; i < 4; ++i) { const int idx = tid + i * NTHR, b = idx >> 10, k = idx & 1023; wv[i] = w[k]; sc[i] = mod[b * 6144 + sc_off + k]; sh[i] = mod[b * 6144 + sh_off + k]; }
#pragma unroll
    for (int i = 0; i < 4; ++i) { const int idx = tid + i * NTHR; A1[idx] = wv[i] * (1.0f + sc[i]); B1[idx] = sh[i]; }
}
__device__ __forceinline__ float dot32(const f4 (&v)[4], const LAS float* WtL, int lane) {
    float p[32];
#pragma unroll
    for (int g = 0; g < 8; ++g) {
        f4 w[4][4];
#pragma unroll
        for (int nn = 0; nn < 4; ++nn)
#pragma unroll
            for (int j = 0; j < 4; ++j) w[nn][j] = *(const LAS f4*)(WtL + (4 * g + nn) * 1028 + 256 * j + 4 * lane);
        asm volatile("" :: "v"(w[0][0]), "v"(w[0][1]), "v"(w[0][2]), "v"(w[0][3]), "v"(w[1][0]), "v"(w[1][1]), "v"(w[1][2]), "v"(w[1][3]),
                           "v"(w[2][0]), "v"(w[2][1]), "v"(w[2][2]), "v"(w[2][3]), "v"(w[3][0]), "v"(w[3][1]), "v"(w[3][2]), "v"(w[3][3]) : "memory");
#pragma unroll
        for (int nn = 0; nn < 4; ++nn) { float sv = 0.f;
#pragma unroll
            for (int j = 0; j < 4; ++j) sv += v[j].x * w[nn][j].x + v[j].y * w[nn][j].y + v[j].z * w[nn][j].z + v[j].w * w[nn][j].w;
            p[4 * g + nn] = sv; }
        asm volatile("" : "+v"(p[4 * g]), "+v"(p[4 * g + 1]), "+v"(p[4 * g + 2]), "+v"(p[4 * g + 3]) :: "memory");
    }
#pragma unroll
    for (int i = 0; i < 16; ++i) { const bool hi = (lane & 32) != 0; const float send = hi ? p[i] : p[i + 16], keep = hi ? p[i + 16] : p[i]; p[i] = keep + __shfl_xor(send, 32); }
#pragma unroll
    for (int i = 0; i < 8; ++i) { const bool hi = (lane & 16) != 0; const float send = hi ? p[i] : p[i + 8], keep = hi ? p[i + 8] : p[i]; p[i] = keep + __shfl_xor(send, 16); }
#pragma unroll
    for (int i = 0; i < 4; ++i) { const bool hi = (lane & 8) != 0; const float send = hi ? p[i] : p[i + 4], keep = hi ? p[i + 4] : p[i]; p[i] = keep + __shfl_xor(send, 8); }
#pragma unroll
    for (int i = 0; i < 2; ++i) { const bool hi = (lane & 4) != 0; const float send = hi ? p[i] : p[i + 2], keep = hi ? p[i + 2] : p[i]; p[i] = keep + __shfl_xor(send, 4); }
    { const bool hi = (lane & 2) != 0; const float send = hi ? p[0] : p[1], keep = hi ? p[1] : p[0]; p[0] = keep + __shfl_xor(send, 2); }
    p[0] += __shfl_xor(p[0], 1);
    return p[0];
}

__device__ __forceinline__ void phase_p1(Frame& F, const Args& AR) {
    const float* x = AR.in[0]; const float* norm1_w = AR.in[4]; const float* mod = (const float*)(F.ws + WS_MOD);
    LAS float* WtL = (LAS float*)F.lds;
    LAS float* A1 = (LAS float*)(F.lds + 131584);
    LAS float* B1 = A1 + 2048;
    stage_wt(WtL, (const float*)(F.ws + WS_WSM_T), F.tid);
    stage_ab(A1, B1, norm1_w, mod, 1024, 0, F.tid);
    __syncthreads();
    bf16* h = (bf16*)(F.ws + WS_H); float* psm = (float*)(F.ws + WS_PSM);
    const int gw = blockIdx.x * NWAVES + F.wave, NGW = F.G * NWAVES;
    for (int m = gw; m < NTOK; m += NGW) {
        const f4* xr = (const f4*)(x + (size_t)m * D) + F.lane; f4 v[4]; float ss = 0.f;
#pragma unroll
        for (int j = 0; j < 4; ++j) { v[j] = xr[64 * j]; ss += (v[j].x * v[j].x + v[j].y * v[j].y) + (v[j].z * v[j].z + v[j].w * v[j].w); }
        const float rstd = __builtin_amdgcn_rsqf(wave_sum(ss) * (1.0f / D) + EPS);
        const int b = m >> 13;
#pragma unroll
        for (int j = 0; j < 4; ++j) { const f4 a = *(const LAS f4*)(A1 + b * 1024 + 256 * j + 4 * F.lane), bb = *(const LAS f4*)(B1 + b * 1024 + 256 * j + 4 * F.lane);
            v[j] = v[j] * rstd * a + bb;
            u2 o; o.x = pk2(v[j].x, v[j].y); o.y = pk2(v[j].z, v[j].w); ((u2*)(h + (size_t)m * D))[F.lane + 64 * j] = o; }
        const float tot = dot32(v, WtL, F.lane);
        if (!(F.lane & 1)) psm[(size_t)m * 32 + (F.lane >> 1)] = tot;
    }
}

struct EpiStoreBf16 {
    static constexpr bool PERM = true, AFTER_DRAIN = false;
    bf16* O; int ldc;
    __device__ __forceinline__ void operator()(const pg8::f32x4 (&acc)[2][2][4][2], const pg8::Unit& u, int wr, int wc, int fr, int fq) const {
        const int row0 = u.pm * 256 + wr * 64 + fr, col0 = u.pn * 256 + wc * 32 + 8 * fq;
#pragma unroll
        for (int ai = 0; ai < 2; ++ai)
#pragma unroll
            for (int m = 0; m < 4; ++m) { bf16* rowp = O + (size_t)(row0 + ai * 128 + m * 16) * ldc + col0;
#pragma unroll
                for (int bj = 0; bj < 2; ++bj) { const pg8::f32x4 v0 = acc[ai][bj][m][0], v1 = acc[ai][bj][m][1];
                    u4 w; w.x = cvtpk(v0[0], v0[1]); w.y = cvtpk(v0[2], v0[3]); w.z = cvtpk(v1[0], v1[1]); w.w = cvtpk(v1[2], v1[3]);
                    __builtin_nontemporal_store(w, (u4*)(rowp + bj * 128)); } }
    }
};
struct EpiGate {
    static constexpr bool PERM = true, AFTER_DRAIN = false;
    const bf16* P; float* M1; bf16* Mo; int gcolb, second;
    __device__ __forceinline__ void operator()(const pg8::f32x4 (&acc)[2][2][4][2], const pg8::Unit& u, int wr, int wc, int fr, int fq) const {
        const int s = second;
        const int row0 = u.pm * 256 + wr * 64 + fr, col0 = u.pn * 256 + wc * 32 + 8 * fq, gcol = gcolb + col0;
#pragma unroll
        for (int am = 0; am < 4; ++am) { const int ai = am >> 1, mb = (am & 1) * 2;
            u4 gw[2][2]; f4 p0[2][2], p1[2][2];
#pragma unroll
            for (int mm = 0; mm < 2; ++mm)
#pragma unroll
                for (int bj = 0; bj < 2; ++bj) { const int row = row0 + ai * 128 + (mb + mm) * 16;
                    gw[mm][bj] = *(const u4*)(P + (size_t)row * PW + gcol + bj * 128);
                    if (s) { const float* mp = M1 + (size_t)row * D + col0 + bj * 128; p0[mm][bj] = *(const f4*)mp; p1[mm][bj] = *(const f4*)(mp + 4); } }
#pragma unroll
            for (int mm = 0; mm < 2; ++mm)
#pragma unroll
                for (int bj = 0; bj < 2; ++bj) { const int m = mb + mm; const int row = row0 + ai * 128 + m * 16, col = col0 + bj * 128;
                    float g[8]; unpack8(gw[mm][bj], g);
                    const pg8::f32x4 v0 = acc[ai][bj][m][0], v1 = acc[ai][bj][m][1];
                    float o[8];
#pragma unroll
                    for (int e = 0; e < 4; ++e) { o[e] = sigm(g[e]) * v0[e]; o[4 + e] = sigm(g[4 + e]) * v1[e]; }
                    if (s == 0) { float* mp = M1 + (size_t)row * D + col; *(f4*)mp = (f4){o[0], o[1], o[2], o[3]}; *(f4*)(mp + 4) = (f4){o[4], o[5], o[6], o[7]}; }
                    else { const f4 q0 = p0[mm][bj], q1 = p1[mm][bj];
                        u4 w; w.x = cvtpk(q0.x + o[0], q0.y + o[1]); w.y = cvtpk(q0.z + o[2], q0.w + o[3]); w.z = cvtpk(q1.x + o[4], q1.y + o[5]); w.w = cvtpk(q1.z + o[6], q1.w + o[7]);
                        *(u4*)(Mo + (size_t)row * D + col) = w; } }
        }
    }
};
struct EpiG4 {
    static constexpr bool PERM = false, AFTER_DRAIN = false;
    const float* X; const float* mod; float* X1;
    __device__ __forceinline__ void operator()(const pg8::f32x4 (&acc)[2][2][4][2], const pg8::Unit& u, int wr, int wc, int fr, int fq) const {
        const int row0 = u.pm * 256 + wr * 64 + fr, col0 = u.pn * 256 + wc * 32 + 4 * fq; const int b = u.pm >> 5;
        f4 gt[2][2];
#pragma unroll
        for (int bj = 0; bj < 2; ++bj)
#pragma unroll
            for (int n = 0; n < 2; ++n) gt[bj][n] = *(const f4*)(mod + b * 6144 + 2048 + col0 + bj * 128 + n * 16);
#pragma unroll
        for (int ai = 0; ai < 2; ++ai) {
            f4 xv[4][2][2];
#pragma unroll
            for (int m = 0; m < 4; ++m)
#pragma unroll
                for (int bj = 0; bj < 2; ++bj)
#pragma unroll
                    for (int n = 0; n < 2; ++n) xv[m][bj][n] = *(const f4*)(X + (size_t)(row0 + ai * 128 + m * 16) * D + col0 + bj * 128 + n * 16);
#pragma unroll
            for (int m = 0; m < 4; ++m) { const size_t off = (size_t)(row0 + ai * 128 + m * 16) * D + col0;
#pragma unroll
                for (int bj = 0; bj < 2; ++bj)
#pragma unroll
                    for (int n = 0; n < 2; ++n) { const f4 x = xv[m][bj][n]; const pg8::f32x4 a = acc[ai][bj][m][n];
                        *(f4*)(X1 + off + bj * 128 + n * 16) = (f4){x.x + gt[bj][n].x * a[0], x.y + gt[bj][n].y * a[1], x.z + gt[bj][n].z * a[2], x.w + gt[bj][n].w * a[3]}; } }
        }
    }
};
struct MoeOrder {
    int nM, nN, nwg, G, c; const LAS int* blk_exp; const LAS int* tab; const int* list;
    __device__ __forceinline__ void init(int nblk, int nN_, int G_, int c_, const LAS int* tab_, const int* list_) { nM = nblk; nN = nN_; nwg = nM * nN; G = G_; c = c_; tab = tab_; blk_exp = tab_ + 64; list = list_; }
    __device__ __forceinline__ int row_token(const pg8::Unit& u, int r) const { const int e = u.pn / nN, cn = tab[512 + e]; int idx = 256 * (u.pm - (tab[e] >> 8)) + r; idx = idx < cn ? idx : cn - 1; return list[e * 16384 + idx]; }
    __device__ __forceinline__ bool next(int i, pg8::Unit& u) const {
        const long L = (long)i * G + c; if (L >= nwg) return false;
        int wgid = (int)L; { const int q = nwg / 8, r = nwg % 8, xcd = wgid % 8, off = wgid / 8; wgid = (xcd < r ? xcd * (q + 1) : r * (q + 1) + (xcd - r) * q) + off; }
        const int nig = 8 * nN, gid = wgid / nig, fm = gid * 8, gsz = (nM - fm) < 8 ? (nM - fm) : 8;
        const int pm = fm + ((wgid % nig) % gsz), pnl = (wgid % nig) / gsz;
        u.pm = pm; u.pn = blk_exp[pm] * nN + pnl; return true;
    }
    __device__ __forceinline__ void a_ready(const pg8::Unit&) const {}
    __device__ __forceinline__ void done(const pg8::Unit&) const {}
};
struct EpiMoe1 {
    static constexpr bool PERM = true, AFTER_DRAIN = false;
    const float* b1; bf16* ACT;
    __device__ __forceinline__ void operator()(const pg8::f32x4 (&acc)[2][2][4][2], const pg8::Unit& u, int wr, int wc, int fr, int fq) const {
        const int e = u.pn >> 3, pnl = u.pn & 7; const int row0 = u.pm * 256 + wr * 64 + fr, j0 = pnl * 128 + wc * 32 + 8 * fq;
        const float* bg = b1 + (size_t)e * 2048 + j0; const float* bu = bg + 1024;
        const f4 bg0 = *(const f4*)bg, bg1 = *(const f4*)(bg + 4), bu0 = *(const f4*)bu, bu1 = *(const f4*)(bu + 4);
        const float bgv[8] = {bg0.x, bg0.y, bg0.z, bg0.w, bg1.x, bg1.y, bg1.z, bg1.w}, buv[8] = {bu0.x, bu0.y, bu0.z, bu0.w, bu1.x, bu1.y, bu1.z, bu1.w};
#pragma unroll
        for (int ai = 0; ai < 2; ++ai)
#pragma unroll
            for (int m = 0; m < 4; ++m) { float o[8];
#pragma unroll
                for (int e8 = 0; e8 < 8; ++e8) { const int n = e8 >> 2, q = e8 & 3;
                    float g = acc[ai][0][m][n][q] + bgv[e8], up = acc[ai][1][m][n][q] + buv[e8];
                    g = fminf(g, 7.0f); up = fminf(fmaxf(up, -7.0f), 7.0f);
                    o[e8] = g * sigm(1.702f * g) * (up + 1.0f); }
                u4 w; w.x = cvtpk(o[0], o[1]); w.y = cvtpk(o[2], o[3]); w.z = cvtpk(o[4], o[5]); w.w = cvtpk(o[6], o[7]);
                *(u4*)(ACT + (size_t)(row0 + ai * 128 + m * 16) * D + j0) = w; }
    }
};
struct EpiMoe2 {
    static constexpr bool PERM = true, AFTER_DRAIN = false;
    const float* b2; bf16* YS;
    __device__ __forceinline__ void operator()(const pg8::f32x4 (&acc)[2][2][4][2], const pg8::Unit& u, int wr, int wc, int fr, int fq) const {
        const int e = u.pn >> 2, pnl = u.pn & 3; const int row0 = u.pm * 256 + wr * 64 + fr, col0 = pnl * 256 + wc * 32 + 8 * fq;
        f4 bv[2][2];
#pragma unroll
        for (int bj = 0; bj < 2; ++bj)
#pragma unroll
            for (int n = 0; n < 2; ++n) bv[bj][n] = *(const f4*)(b2 + (size_t)e * D + col0 + bj * 128 + 4 * n);
#pragma unroll
        for (int ai = 0; ai < 2; ++ai)
#pragma unroll
            for (int m = 0; m < 4; ++m) { bf16* rowp = YS + (size_t)(row0 + ai * 128 + m * 16) * D + col0;
#pragma unroll
                for (int bj = 0; bj < 2; ++bj) { const pg8::f32x4 v0 = acc[ai][bj][m][0], v1 = acc[ai][bj][m][1];
                    u4 w; w.x = cvtpk(v0[0] + bv[bj][0].x, v0[1] + bv[bj][0].y); w.y = cvtpk(v0[2] + bv[bj][0].z, v0[3] + bv[bj][0].w);
                    w.z = cvtpk(v1[0] + bv[bj][1].x, v1[1] + bv[bj][1].y); w.w = cvtpk(v1[2] + bv[bj][1].z, v1[3] + bv[bj][1].w);
                    __builtin_nontemporal_store(w, (u4*)(rowp + bj * 128)); } }
    }
};

constexpr int QS = 129;
constexpr int QB = 136;
typedef short bf16x8 __attribute__((ext_vector_type(8)));
__device__ __forceinline__ bf16x8 pack_frag(const pg8::f32x4 a, const pg8::f32x4 b) {
    u4 w; w.x = cvtpk(a[0], a[1]); w.y = cvtpk(a[2], a[3]); w.z = cvtpk(b[0], b[1]); w.w = cvtpk(b[2], b[3]); return __builtin_bit_cast(bf16x8, w);
}
__device__ __forceinline__ void phase_p3(Frame& F, const Args& AR) {
    const bf16* P = (const bf16*)(F.ws + WS_P); const float* psm = (const float*)(F.ws + WS_PSM);
    const float* convw = AR.in[6]; const float* a_log = AR.in[7]; const float* dt_bias = AR.in[8];
    LAS bf16* qb = (LAS bf16*)F.lds;
    LAS bf16* kb = qb + 64 * QB;
    LAS float* vs = (LAS float*)(kb + 64 * QB);
    LAS float* Lm = vs + 64 * QS;
    LAS float* betaL = Lm + 2 * 4096;
    LAS float* GL = betaL + 128;
    LAS float* Tm = GL + 128;
    LAS bf16* wb = (LAS bf16*)(Tm + 2048);
    u4 raw[12]; f4 wjv[10]; float braw = 0.f, araw = 0.f, alog_p = 0.f, dtb_p = 0.f;
#define P3_LOAD(unit_) do { const int b_ = (unit_) >> 10, h_ = ((unit_) >> 7) & 7, c_ = (unit_) & 127, t0_ = c_ * 64; const size_t tb_ = (size_t)b_ * SEQ; const int tid_ = F.tid; \
        if (tid_ < 384) { const int cv_ = tid_ % 48, rg_ = tid_ / 48, pcol_ = (cv_ >> 4) * 1024 + h_ * 128 + (cv_ & 15) * 8; \
            _Pragma("unroll") for (int j_ = 0; j_ < 5; ++j_) { wjv[2 * j_] = *(const f4*)(convw + j_ * 3072 + pcol_); wjv[2 * j_ + 1] = *(const f4*)(convw + j_ * 3072 + pcol_ + 4); } \
            _Pragma("unroll") for (int r_ = 0; r_ < 12; ++r_) { const int t_ = t0_ + 8 * rg_ - 2 + r_; raw[r_] = (t_ >= 0 && t_ < SEQ) ? *(const u4*)(P + (tb_ + t_) * PW + pcol_) : (u4){0u, 0u, 0u, 0u}; } } \
        if (tid_ >= 384) { const int dir_ = (tid_ - 384) >> 6, ii_ = tid_ & 63, io_ = dir_ ? 63 - ii_ : ii_; const size_t tok_ = tb_ + t0_ + io_; braw = psm[tok_ * 32 + dir_ * 8 + h_]; araw = psm[tok_ * 32 + 16 + dir_ * 8 + h_]; alog_p = a_log[dir_ * 8 + h_]; dtb_p = dt_bias[dir_ * 8 + h_]; } } while (0)
    if ((int)blockIdx.x < 2 * NH * NCHUNK) P3_LOAD((int)blockIdx.x);
    for (int unit = blockIdx.x; unit < 2 * NH * NCHUNK; unit += F.G) {
        const int b = unit >> 10, h = (unit >> 7) & 7, c = unit & 127;
        int tid = F.tid; asm volatile("" : "+v"(tid));
        const int lane = tid & 63;
        unsigned char* const ubase = F.ws + WS_DD + ((size_t)((b * 8 + h) * 2) * 128) * DD_UNIT;
        if (tid < 384) {
            const int cv = tid % 48, rg = tid / 48, part = cv >> 4, ch = (cv & 15) * 8;
#pragma unroll
            for (int i = 0; i < 8; ++i) { float acc[8];
#pragma unroll
                for (int e = 0; e < 8; ++e) acc[e] = 0.f;
#pragma unroll
                for (int j = 0; j < 5; ++j) { float xin[8]; unpack8(raw[i + j], xin); const f4 w0 = wjv[2 * j], w1 = wjv[2 * j + 1];
                    acc[0] += w0.x * xin[0]; acc[1] += w0.y * xin[1]; acc[2] += w0.z * xin[2]; acc[3] += w0.w * xin[3]; acc[4] += w1.x * xin[4]; acc[5] += w1.y * xin[5]; acc[6] += w1.z * xin[6]; acc[7] += w1.w * xin[7]; }
                float ssq = 0.f;
#pragma unroll
                for (int e = 0; e < 8; ++e) { acc[e] = silu(acc[e]); ssq += acc[e] * acc[e]; }
                ssq = sum16(ssq);
                if (part == 2) {
#pragma unroll
                    for (int e = 0; e < 8; ++e) vs[(8 * rg + i) * QS + ch + e] = acc[e];
                } else {
                    float sc = __builtin_amdgcn_rsqf(ssq + EPS); if (part == 0) sc *= 0.08838834764831845f;
#pragma unroll
                    for (int e = 0; e < 8; ++e) acc[e] *= sc;
                    *(LAS u4*)((part ? kb : qb) + (8 * rg + i) * QB + ch) = pack8(acc); }
            }
        }
        if (tid >= 384) {
            const int dir = (tid - 384) >> 6, ii = lane;
            float g = -expf(alog_p) * softplus(araw + dtb_p);
#pragma unroll
            for (int o = 1; o < 64; o <<= 1) { const float t = __shfl_up(g, o); if (lane >= o) g += t; }
            betaL[dir * 64 + ii] = sigm(braw); GL[dir * 64 + ii] = g;
        }
        if (unit + F.G < 2 * NH * NCHUNK) P3_LOAD(unit + F.G);
        LDS_BARRIER();
        asm volatile("" : "+v"(tid));
        {
            const int w = tid >> 6, dir = w >> 2, mi = w & 3, r = lane & 15, q = lane >> 4;
            const int ipos = 16 * mi + r, io = dir ? 63 - ipos : ipos;
            const float Gi = GL[dir * 64 + ipos], bi = betaL[dir * 64 + ipos];
            bf16x8 ki[4], qi[4];
#pragma unroll
            for (int s = 0; s < 4; ++s) { ki[s] = *(const LAS bf16x8*)(kb + io * QB + 32 * s + 8 * q); qi[s] = *(const LAS bf16x8*)(qb + io * QB + 32 * s + 8 * q); }
            unsigned char* dbase = ubase + ((size_t)dir * 128 + (dir ? 127 - c : c)) * DD_UNIT;
#pragma unroll
            for (int s2 = 0; s2 < 2; ++s2) { float av[8];
#pragma unroll
                for (int t = 0; t < 2; ++t) { const int mj = 2 * s2 + t;
                    if (mj <= mi) {
                        const int jp = 16 * mj + r, jo = dir ? 63 - jp : jp;
                        pg8::f32x4 kk = {0.f, 0.f, 0.f, 0.f}, qk = {0.f, 0.f, 0.f, 0.f};
#pragma unroll
                        for (int s = 0; s < 4; ++s) { const bf16x8 kj = *(const LAS bf16x8*)(kb + jo * QB + 32 * s + 8 * q);
                            kk = __builtin_amdgcn_mfma_f32_16x16x32_bf16(kj, ki[s], kk, 0, 0, 0); qk = __builtin_amdgcn_mfma_f32_16x16x32_bf16(kj, qi[s], qk, 0, 0, 0); }
                        f4 lv;
#pragma unroll
                        for (int jj = 0; jj < 4; ++jj) { const int jpos = 16 * mj + 4 * q + jj; const float dec = __expf(Gi - GL[dir * 64 + jpos]);
                            const float l = (ipos > jpos) ? bi * kk[jj] * dec : 0.f; av[4 * t + jj] = (ipos >= jpos) ? qk[jj] * dec : 0.f;
                            if (jj == 0) lv.x = l; else if (jj == 1) lv.y = l; else if (jj == 2) lv.z = l; else lv.w = l; }
                        *(LAS f4*)(Lm + dir * 4096 + ipos * 64 + 16 * mj + 4 * q) = lv;
                    } else {
#pragma unroll
                        for (int jj = 0; jj < 4; ++jj) av[4 * t + jj] = 0.f;
                    } }
                __builtin_nontemporal_store(pack8(av), (u4*)(dbase + DD_A + (size_t)((mi * 2 + s2) * 64 + lane) * 16)); }
        }
        LDS_BARRIER();
        asm volatile("" : "+v"(tid));
        if (tid < 128) {
            const int dir = tid >> 6, blk = (tid >> 4) & 3, cc = tid & 15;
            const LAS float* Lb = Lm + dir * 4096 + (16 * blk) * 64 + 16 * blk;
            float t[16];
#pragma unroll
            for (int i = 0; i < 16; ++i) { float sv = (i == cc) ? 1.0f : 0.0f;
#pragma unroll
                for (int j = 0; j < i; ++j) sv -= Lb[i * 64 + j] * t[j];
                t[i] = sv; Tm[(dir * 4 + blk) * 256 + i * 16 + cc] = sv; }
        }
        LDS_BARRIER();
        asm volatile("" : "+v"(tid));
        {
            const int w = tid >> 6, dir = w >> 2, g4 = w & 3, n = lane & 15, q = lane >> 4; const bool isw = g4 >= 2;
            const LAS float* Lr = Lm + dir * 4096; const LAS float* Tr = Tm + dir * 1024;
            const f4 z4 = {0.f, 0.f, 0.f, 0.f};
            bf16x8 fT[4], fL10, fL2, fL3a, fL3b;
#pragma unroll
            for (int i = 0; i < 4; ++i) fT[i] = pack_frag(*(const LAS f4*)(Tr + i * 256 + n * 16 + 4 * q), z4);
            fL10 = pack_frag(-*(const LAS f4*)(Lr + (16 + n) * 64 + 4 * q), z4);
            fL2 = pack_frag(-*(const LAS f4*)(Lr + (32 + n) * 64 + 4 * q), -*(const LAS f4*)(Lr + (32 + n) * 64 + 16 + 4 * q));
            fL3a = pack_frag(-*(const LAS f4*)(Lr + (48 + n) * 64 + 4 * q), -*(const LAS f4*)(Lr + (48 + n) * 64 + 16 + 4 * q));
            fL3b = pack_frag(-*(const LAS f4*)(Lr + (48 + n) * 64 + 32 + 4 * q), z4);
            float bE[4][4];
#pragma unroll
            for (int i = 0; i < 4; ++i)
#pragma unroll
                for (int jj = 0; jj < 4; ++jj) { const int row = 16 * i + 4 * q + jj; bE[i][jj] = betaL[dir * 64 + row] * (isw ? __expf(GL[dir * 64 + row]) : 1.0f); }
            unsigned char* dbase = ubase + ((size_t)dir * 128 + (dir ? 127 - c : c)) * DD_UNIT;
#pragma unroll
            for (int e = 0; e < 4; ++e) { const int nt = 4 * g4 + e;
                float rv[16];
#pragma unroll
                for (int i = 0; i < 4; ++i)
#pragma unroll
                    for (int jj = 0; jj < 4; ++jj) { const int row = 16 * i + 4 * q + jj, io = dir ? 63 - row : row;
                        rv[4 * i + jj] = isw ? bf1(kb[io * QB + 16 * (nt - 8) + n]) : vs[io * QS + 16 * nt + n]; }
                asm volatile("" :: "v"(rv[0]), "v"(rv[1]), "v"(rv[2]), "v"(rv[3]), "v"(rv[4]), "v"(rv[5]), "v"(rv[6]), "v"(rv[7]), "v"(rv[8]), "v"(rv[9]), "v"(rv[10]), "v"(rv[11]), "v"(rv[12]), "v"(rv[13]), "v"(rv[14]), "v"(rv[15]));
                pg8::f32x4 R[4];
#pragma unroll
                for (int i = 0; i < 4; ++i)
#pragma unroll
                    for (int jj = 0; jj < 4; ++jj) R[i][jj] = bE[i][jj] * rv[4 * i + jj];
                const pg8::f32x4 x0 = __builtin_amdgcn_mfma_f32_16x16x32_bf16(fT[0], pack_frag(R[0], z4), z4, 0, 0, 0);
                const pg8::f32x4 y1 = __builtin_amdgcn_mfma_f32_16x16x32_bf16(fL10, pack_frag(x0, z4), R[1], 0, 0, 0);
                const pg8::f32x4 x1 = __builtin_amdgcn_mfma_f32_16x16x32_bf16(fT[1], pack_frag(y1, z4), z4, 0, 0, 0);
                const bf16x8 x01 = pack_frag(x0, x1);
                const pg8::f32x4 y2 = __builtin_amdgcn_mfma_f32_16x16x32_bf16(fL2, x01, R[2], 0, 0, 0);
                const pg8::f32x4 x2 = __builtin_amdgcn_mfma_f32_16x16x32_bf16(fT[2], pack_frag(y2, z4), z4, 0, 0, 0);
                pg8::f32x4 y3 = __builtin_amdgcn_mfma_f32_16x16x32_bf16(fL3a, x01, R[3], 0, 0, 0);
                y3 = __builtin_amdgcn_mfma_f32_16x16x32_bf16(fL3b, pack_frag(x2, z4), y3, 0, 0, 0);
                const pg8::f32x4 x3 = __builtin_amdgcn_mfma_f32_16x16x32_bf16(fT[3], pack_frag(y3, z4), z4, 0, 0, 0);
                const pg8::f32x4 X[4] = {x0, x1, x2, x3};
                if (!isw) {
#pragma unroll
                    for (int i = 0; i < 4; ++i) { u2 o; o.x = cvtpk(X[i][0], X[i][1]); o.y = cvtpk(X[i][2], X[i][3]); __builtin_nontemporal_store(o, (u2*)(dbase + DD_U + (size_t)((nt * 4 + i) * 64 + lane) * 8)); }
                } else { LAS bf16* wp = wb + dir * 64 * QB + 16 * (nt - 8) + n;
#pragma unroll
                    for (int i = 0; i < 4; ++i)
#pragma unroll
                        for (int jj = 0; jj < 4; ++jj) wp[(16 * i + 4 * q + jj) * QB] = (bf16)f2bf(X[i][jj]); }
            }
        }
        LDS_BARRIER();
        asm volatile("" : "+v"(tid));
#pragma unroll
        for (int it = 0; it < 4; ++it) { const int item = it * NTHR + tid, dir = item >> 10, fidx = (item >> 6) & 15, fl = item & 63, r = fl & 15, q = fl >> 4;
            const int mt = fidx >> 2, s = fidx & 3, pos = 16 * mt + r; const LAS bf16* wr = wb + (dir * 64 + pos) * QB + 32 * s + 4 * q;
            const u2 lo = *(const LAS u2*)wr, hi = *(const LAS u2*)(wr + 16);
            __builtin_nontemporal_store((u4){lo.x, lo.y, hi.x, hi.y}, (u4*)(ubase + ((size_t)dir * 128 + (dir ? 127 - c : c)) * DD_UNIT + DD_W + (size_t)(fidx * 64 + fl) * 16)); }
#pragma unroll
        for (int it = 0; it < 8; ++it) { const int item = it * NTHR + tid, dir = item >> 11, arr = (item >> 10) & 1, fidx = (item >> 6) & 15, fl = item & 63, r = fl & 15, q = fl >> 4;
            unsigned char* dbase = ubase + ((size_t)dir * 128 + (dir ? 127 - c : c)) * DD_UNIT;
            float o[8];
            if (arr == 0) { const int mt = fidx >> 2, s = fidx & 3, pos = 16 * mt + r, io = dir ? 63 - pos : pos; const float f = __expf(GL[dir * 64 + pos]);
                const u2 lo = *(const LAS u2*)(qb + io * QB + 32 * s + 4 * q), hi = *(const LAS u2*)(qb + io * QB + 32 * s + 16 + 4 * q);
                o[0] = bflo(lo.x) * f; o[1] = bfhi(lo.x) * f; o[2] = bflo(lo.y) * f; o[3] = bfhi(lo.y) * f; o[4] = bflo(hi.x) * f; o[5] = bfhi(hi.x) * f; o[6] = bflo(hi.y) * f; o[7] = bfhi(hi.y) * f;
                __builtin_nontemporal_store(pack8(o), (u4*)(dbase + DD_Q + (size_t)(fidx * 64 + fl) * 16));
            } else { const int m = fidx >> 1, s2 = fidx & 1, dk = 16 * m + r; const float gl = GL[dir * 64 + 63];
#pragma unroll
                for (int j = 0; j < 8; ++j) { const int pos = 32 * s2 + (j < 4 ? 4 * q + j : 16 + 4 * q + j - 4), io = dir ? 63 - pos : pos; o[j] = bf1(kb[io * QB + dk]) * __expf(gl - GL[dir * 64 + pos]); }
                __builtin_nontemporal_store(pack8(o), (u4*)(dbase + DD_K + (size_t)(fidx * 64 + fl) * 16)); } }
        if (tid < 2) ((float*)(F.ws + WS_GL))[((b * 8 + h) * 2 + tid) * 128 + (tid ? 127 - c : c)] = __expf(GL[tid * 64 + 63]);
        LDS_BARRIER();
    }
#undef P3_LOAD
}

constexpr int P4_BUF = 61440;
__device__ __forceinline__ void phase_p4(Frame& F, const Args& AR) {
    volatile LAS int* uq = (volatile LAS int*)(F.lds + LDS_TAB + 4096);
    unsigned* qctr = (unsigned*)(F.ws + WS_CTL) + CW_Q;
    const unsigned myx = xb_xcc_id() & 7u;
    for (;;) {
        __syncthreads();
        if (F.tid == 0) { int got = -1;
            for (unsigned t = 0; t < 8 && got < 0; ++t) { const unsigned x = (myx + t) & 7u; const unsigned sl = __hip_atomic_fetch_add(qctr + 64 * x, 1u, __ATOMIC_RELAXED, __HIP_MEMORY_SCOPE_AGENT); if (sl < 16u) got = (int)(x * 16u + sl); }
            uq[0] = got; }
        __syncthreads();
        const int unit = uq[0];
        if (unit < 0) break;
        const int chain = unit >> 2, pair = unit & 3, dir = chain & 1, bh = chain >> 1, b = bh >> 3, h = bh & 7;
        const unsigned char* cbase = F.ws + WS_DD + (size_t)chain * 128 * DD_UNIT;
        __syncthreads();
        if (F.wave >= 2) {
            const int l = F.tid - 128; u4 ra[10], rb[10], rc[10];
#define P4_SRC(step, i) ((const u4*)(cbase + (size_t)(step) * DD_UNIT + (((i) * 384 + l) < 3584 ? (size_t)((i) * 384 + l) * 16 : (size_t)DD_U + (size_t)pair * 4096 + (size_t)((i) * 384 + l - 3584) * 16)))
#define P4_LD(R, step) do { const int st_ = (step) < NCHUNK ? (step) : NCHUNK - 1; _Pragma("unroll") for (int i = 0; i < 10; ++i) R[i] = *P4_SRC(st_, i); } while (0)
#define P4_ST(R, step) do { _Pragma("unroll") for (int i = 0; i < 10; ++i) *(LAS u4*)(F.lds + ((step) & 1) * P4_BUF + (size_t)(i * 384 + l) * 16) = R[i]; } while (0)
            P4_LD(ra, 0); P4_ST(ra, 0);
            P4_LD(ra, 1); P4_LD(rb, 2); P4_LD(rc, 3);
            asm volatile("s_waitcnt lgkmcnt(0)" ::: "memory"); __builtin_amdgcn_s_barrier(); asm volatile("" ::: "memory");
            for (int k = 0; k < 129; k += 3) {
                P4_ST(ra, k + 1); P4_LD(ra, k + 4);
                asm volatile("s_waitcnt lgkmcnt(0)" ::: "memory"); __builtin_amdgcn_s_barrier(); asm volatile("" ::: "memory");
                P4_ST(rb, k + 2); P4_LD(rb, k + 5);
                asm volatile("s_waitcnt lgkmcnt(0)" ::: "memory"); __builtin_amdgcn_s_barrier(); asm volatile("" ::: "memory");
                P4_ST(rc, k + 3); P4_LD(rc, k + 6);
                asm volatile("s_waitcnt lgkmcnt(0)" ::: "memory"); __builtin_amdgcn_s_barrier(); asm volatile("" ::: "memory");
            }
#undef P4_SRC
#undef P4_LD
#undef P4_ST
        } else {
            const int lane = F.lane, r = lane & 15, q = lane >> 4, sl = 2 * pair + F.wave;
            const float* glp = (const float*)(F.ws + WS_GL) + chain * 128;
            bf16* od = (bf16*)(F.ws + WS_OD) + (size_t)dir * NTOK * D + (size_t)b * SEQ * D + h * 128 + 16 * sl + 4 * q;
            pg8::f32x4 S[8]; bf16x8 SB[4];
#pragma unroll
            for (int m = 0; m < 8; ++m) S[m] = (pg8::f32x4){0.f, 0.f, 0.f, 0.f};
#pragma unroll
            for (int s = 0; s < 4; ++s) SB[s] = (bf16x8){0, 0, 0, 0, 0, 0, 0, 0};
            const float glv0 = glp[lane], glv1 = glp[64 + lane];
            asm volatile("s_waitcnt lgkmcnt(0)" ::: "memory"); __builtin_amdgcn_s_barrier(); asm volatile("" ::: "memory");
            for (int k = 0; k < NCHUNK; ++k) {
                const LAS unsigned char* bp = F.lds + (k & 1) * P4_BUF + lane * 16;
                const float egl = __builtin_bit_cast(float, __builtin_amdgcn_readlane(__builtin_bit_cast(int, k < 64 ? glv0 : glv1), k & 63));
                pg8::f32x4 WS[4], OT[4];
#pragma unroll
                for (int mt = 0; mt < 4; ++mt) { WS[mt] = (pg8::f32x4){0.f, 0.f, 0.f, 0.f}; OT[mt] = (pg8::f32x4){0.f, 0.f, 0.f, 0.f}; }
#pragma unroll
                for (int mt = 0; mt < 4; ++mt)
#pragma unroll
                    for (int s = 0; s < 4; ++s) WS[mt] = __builtin_amdgcn_mfma_f32_16x16x32_bf16(*(const LAS bf16x8*)(bp + (mt * 4 + s) * 1024), SB[s], WS[mt], 0, 0, 0);
#pragma unroll
                for (int mt = 0; mt < 4; ++mt)
#pragma unroll
                    for (int s = 0; s < 4; ++s) OT[mt] = __builtin_amdgcn_mfma_f32_16x16x32_bf16(SB[s], *(const LAS bf16x8*)(bp + 16384 + (mt * 4 + s) * 1024), OT[mt], 0, 0, 0);
                pg8::f32x4 vn[4];
#pragma unroll
                for (int mt = 0; mt < 4; ++mt) { const u2 uu = *(const LAS u2*)(F.lds + (k & 1) * P4_BUF + 57344 + (F.wave * 4 + mt) * 512 + lane * 8);
                    vn[mt] = (pg8::f32x4){bflo(uu.x) - WS[mt][0], bfhi(uu.x) - WS[mt][1], bflo(uu.y) - WS[mt][2], bfhi(uu.y) - WS[mt][3]}; }
                bf16x8 VB[2]; VB[0] = pack_frag(vn[0], vn[1]); VB[1] = pack_frag(vn[2], vn[3]);
#pragma unroll
                for (int mt = 0; mt < 4; ++mt)
#pragma unroll
                    for (int s2 = 0; s2 < 2; ++s2) OT[mt] = __builtin_amdgcn_mfma_f32_16x16x32_bf16(VB[s2], *(const LAS bf16x8*)(bp + 49152 + (mt * 2 + s2) * 1024), OT[mt], 0, 0, 0);
#pragma unroll
                for (int m = 0; m < 8; ++m) { S[m] = S[m] * egl;
#pragma unroll
                    for (int s2 = 0; s2 < 2; ++s2) S[m] = __builtin_amdgcn_mfma_f32_16x16x32_bf16(*(const LAS bf16x8*)(bp + 32768 + (m * 2 + s2) * 1024), VB[s2], S[m], 0, 0, 0); }
#pragma unroll
                for (int s = 0; s < 4; ++s) SB[s] = pack_frag(S[2 * s], S[2 * s + 1]);
                const int co = dir ? 127 - k : k;
#pragma unroll
                for (int mt = 0; mt < 4; ++mt) { const int pos = 16 * mt + r, ro = dir ? 63 - pos : pos;
                    u2 ov; ov.x = cvtpk(OT[mt][0], OT[mt][1]); ov.y = cvtpk(OT[mt][2], OT[mt][3]);
                    *(u2*)(od + (size_t)(co * 64 + ro) * D) = ov; }
                asm volatile("s_waitcnt lgkmcnt(0)" ::: "memory"); __builtin_amdgcn_s_barrier(); asm volatile("" ::: "memory");
            }
            __builtin_amdgcn_s_barrier();
        }
        __syncthreads();
    }
    {
        __syncthreads();
        if (F.tid == 0) uq[0] = (int)__hip_atomic_fetch_add((unsigned*)(F.ws + WS_CTL) + CW_RANK, 1u, __ATOMIC_RELAXED, __HIP_MEMORY_SCOPE_AGENT);
        __syncthreads();
        const int rank = uq[0];
        pg8::Gemm g{(const bf16*)(F.ws + WS_SB), (const bf16*)(F.ws + WS_WUO_T) + (size_t)1024 * 1024, NTOK, D, D}; pg8::StaticOrder S; S.init(NTOK, D, 128, rank); if (rank >= 128) S.nwg = 0;
        EpiGate E{(const bf16*)(F.ws + WS_P), (float*)(F.ws + WS_M1X), (bf16*)nullptr, PC_GB, 0};
        pg8::gemm_phase<EpiGate, pg8::StaticOrder, true, true>((PG8_LAS unsigned char*)F.lds, g, S, E);
        __syncthreads();
    }
    moe_convert(F, AR);
}

__device__ __forceinline__ void phase_p5_sb(Frame& F, const Args& AR) {
    const bf16* P = (const bf16*)(F.ws + WS_P); bf16* sbp = (bf16*)(F.ws + WS_SB);
    const float* convs = AR.in[11];
    const int lane = F.lane, ch = 16 * lane;
    float cw[3][16];
#pragma unroll
    for (int e = 0; e < 16; ++e)
#pragma unroll
        for (int j = 0; j < 3; ++j) cw[j][e] = convs[j * 1024 + ch + e];
    const int gw = blockIdx.x * NWAVES + F.wave, NGW = F.G * NWAVES;
    for (int m = gw; m < NTOK; m += NGW) {
        const int t = m & (SEQ - 1);
        u4 cgl[3][2], uil[3][2], bgl[2];
#pragma unroll
        for (int j = 0; j < 3; ++j) { const int tt = t + j - 1; const bool ok = tt >= 0 && tt < SEQ; const bf16* rowp = P + (size_t)(ok ? m + j - 1 : m) * PW;
            cgl[j][0] = *(const u4*)(rowp + PC_CG + ch); cgl[j][1] = *(const u4*)(rowp + PC_CG + ch + 8); uil[j][0] = *(const u4*)(rowp + PC_UI + ch); uil[j][1] = *(const u4*)(rowp + PC_UI + ch + 8); }
        bgl[0] = *(const u4*)(P + (size_t)m * PW + PC_BG + ch); bgl[1] = *(const u4*)(P + (size_t)m * PW + PC_BG + ch + 8);
        float acc[16], r[8];
#pragma unroll
        for (int e = 0; e < 16; ++e) acc[e] = 0.f;
#pragma unroll
        for (int j = 0; j < 3; ++j) { const int tt = t + j - 1;
            if (tt >= 0 && tt < SEQ) { float cg[8], ui[8];
                unpack8(cgl[j][0], cg); unpack8(uil[j][0], ui);
#pragma unroll
                for (int e = 0; e < 8; ++e) acc[e] += cw[j][e] * (cg[e] * ui[e]);
                unpack8(cgl[j][1], cg); unpack8(uil[j][1], ui);
#pragma unroll
                for (int e = 0; e < 8; ++e) acc[8 + e] += cw[j][8 + e] * (cg[e] * ui[e]); } }
        float bg[8];
        unpack8(bgl[0], bg);
#pragma unroll
        for (int e = 0; e < 8; ++e) r[e] = bg[e] * acc[e];
        *(u4*)(sbp + (size_t)m * D + ch) = pack8(r);
        unpack8(bgl[1], bg);
#pragma unroll
        for (int e = 0; e < 8; ++e) r[e] = bg[e] * acc[8 + e];
        *(u4*)(sbp + (size_t)m * D + ch + 8) = pack8(r);
    }
}
__device__ __forceinline__ void phase_p5(Frame& F, const Args& AR) {
    const bf16* P = (const bf16*)(F.ws + WS_P); const bf16* od = (const bf16*)(F.ws + WS_OD); bf16* oap = (bf16*)(F.ws + WS_OASB);
    const float* onorm_w = AR.in[9];
    const int lane = F.lane, ch = 16 * lane;
    float onw[16];
#pragma unroll
    for (int e = 0; e < 16; ++e) onw[e] = onorm_w[(ch + e) & 127];
    const int gw = blockIdx.x * NWAVES + F.wave, NGW = F.G * NWAVES;
    for (int m0 = gw; m0 < NTOK; m0 += 2 * NGW) {
        u4 ld[2][6];
#pragma unroll
        for (int rr = 0; rr < 2; ++rr) { const int m = (m0 + rr * NGW < NTOK) ? m0 + rr * NGW : m0;
            ld[rr][0] = *(const u4*)(od + (size_t)m * D + ch); ld[rr][1] = *(const u4*)(od + (size_t)m * D + ch + 8);
            ld[rr][2] = *(const u4*)(od + (size_t)(NTOK + m) * D + ch); ld[rr][3] = *(const u4*)(od + (size_t)(NTOK + m) * D + ch + 8);
            ld[rr][4] = *(const u4*)(P + (size_t)m * PW + PC_Z + ch); ld[rr][5] = *(const u4*)(P + (size_t)m * PW + PC_Z + ch + 8); }
#pragma unroll
        for (int rr = 0; rr < 2; ++rr) { const int m = m0 + rr * NGW; if (m >= NTOK) break;
            float o[16], z[16], t8[8];
            unpack8(ld[rr][0], t8);
#pragma unroll
            for (int e = 0; e < 8; ++e) o[e] = t8[e];
            unpack8(ld[rr][1], t8);
#pragma unroll
            for (int e = 0; e < 8; ++e) o[8 + e] = t8[e];
            unpack8(ld[rr][2], t8);
#pragma unroll
            for (int e = 0; e < 8; ++e) o[e] += t8[e];
            unpack8(ld[rr][3], t8);
#pragma unroll
            for (int e = 0; e < 8; ++e) o[8 + e] += t8[e];
            unpack8(ld[rr][4], t8);
#pragma unroll
            for (int e = 0; e < 8; ++e) z[e] = t8[e];
            unpack8(ld[rr][5], t8);
#pragma unroll
            for (int e = 0; e < 8; ++e) z[8 + e] = t8[e];
            float ss = 0.f;
#pragma unroll
            for (int e = 0; e < 16; ++e) ss += o[e] * o[e];
            ss = sum8(ss);
            const float rstd = __builtin_amdgcn_rsqf(ss * (1.0f / 128.0f) + EPS);
            float r[8];
#pragma unroll
            for (int e = 0; e < 8; ++e) r[e] = o[e] * rstd * onw[e] * silu(z[e]);
            *(u4*)(oap + (size_t)m * D + ch) = pack8(r);
#pragma unroll
            for (int e = 0; e < 8; ++e) r[e] = o[8 + e] * rstd * onw[8 + e] * silu(z[8 + e]);
            *(u4*)(oap + (size_t)m * D + ch + 8) = pack8(r); }
    }
}

constexpr int P7_MAXIT = 16;
__device__ __forceinline__ void phase_p7(Frame& F, const Args& AR) {
    const float* x1 = (const float*)(F.ws + WS_OD); const float* norm2_w = AR.in[14]; const float* router_b = AR.in[16]; const float* mod = (const float*)(F.ws + WS_MOD);
    LAS float* WtL = (LAS float*)F.lds;
    LAS float* A1 = (LAS float*)(F.lds + 131584);
    LAS float* B1 = A1 + 2048;
    stage_wt(WtL, (const float*)(F.ws + WS_WR_T), F.tid);
    stage_ab(A1, B1, norm2_w, mod, 4096, 3072, F.tid);
    LAS unsigned* lcnt = (LAS unsigned*)(B1 + 2048);
    LAS unsigned* rec = lcnt + 64;
    if (F.tid < 64) lcnt[F.tid] = 0u;
    __syncthreads();
    bf16* h2 = (bf16*)(F.ws + WS_H); int* topi = (int*)(F.ws + WS_TOPI); float* topg = (float*)(F.ws + WS_TOPG); int* topp = (int*)(F.ws + WS_TOPP);
    unsigned* cnt = (unsigned*)(F.ws + WS_CTL) + CW_CNT; int* elist = (int*)(F.ws + WS_LIST);
    const int lane = F.lane; const float rb = router_b[lane >> 1];
    const int gw = blockIdx.x * NWAVES + F.wave, NGW = F.G * NWAVES;
    int it = 0;
    for (int m = gw; m < NTOK; m += NGW, ++it) {
        const f4* xr = (const f4*)(x1 + (size_t)m * D) + lane; f4 v[4]; float ss = 0.f;
#pragma unroll
        for (int j = 0; j < 4; ++j) { v[j] = xr[64 * j]; ss += (v[j].x * v[j].x + v[j].y * v[j].y) + (v[j].z * v[j].z + v[j].w * v[j].w); }
        const float rstd = __builtin_amdgcn_rsqf(wave_sum(ss) * (1.0f / D) + EPS);
        const int b = m >> 13;
#pragma unroll
        for (int j = 0; j < 4; ++j) { const f4 a = *(const LAS f4*)(A1 + b * 1024 + 256 * j + 4 * lane), bb = *(const LAS f4*)(B1 + b * 1024 + 256 * j + 4 * lane);
            v[j] = v[j] * rstd * a + bb;
            u2 o; o.x = pk2(v[j].x, v[j].y); o.y = pk2(v[j].z, v[j].w); ((u2*)(h2 + (size_t)m * D))[lane + 64 * j] = o; }
        float val = dot32(v, WtL, lane) + rb; const int myn = lane >> 1;
        float tv[4]; int ti[4];
#pragma unroll
        for (int r = 0; r < 4; ++r) { float bv = val; int bi = myn;
#define TK_STEP(ctrl) { const float ov = __builtin_bit_cast(float, __builtin_amdgcn_mov_dpp(__builtin_bit_cast(int, bv), (ctrl), 0xf, 0xf, true)); const int oi = __builtin_amdgcn_mov_dpp(bi, (ctrl), 0xf, 0xf, true); if (ov > bv || (ov == bv && oi < bi)) { bv = ov; bi = oi; } }
            TK_STEP(0xB1) TK_STEP(0x4E) TK_STEP(0x141) TK_STEP(0x140)
#undef TK_STEP
#pragma unroll
            for (int o = 16; o < 64; o <<= 1) { const float ov = __shfl_xor(bv, o); const int oi = __shfl_xor(bi, o); if (ov > bv || (ov == bv && oi < bi)) { bv = ov; bi = oi; } }
            tv[r] = bv; ti[r] = bi; if (myn == bi) val = -__builtin_inff(); }
        const float e1 = __expf(tv[1] - tv[0]), e2 = __expf(tv[2] - tv[0]), e3 = __expf(tv[3] - tv[0]), inv = 1.0f / (1.0f + e1 + e2 + e3);
        if (lane < 4) { const int e = lane == 0 ? ti[0] : (lane == 1 ? ti[1] : (lane == 2 ? ti[2] : ti[3]));
            const float g = (lane == 0 ? 1.0f : (lane == 1 ? e1 : (lane == 2 ? e2 : e3))) * inv;
            topi[(size_t)m * 4 + lane] = e; topg[(size_t)m * 4 + lane] = g;
            if (it < P7_MAXIT) { const unsigned lp = __hip_atomic_fetch_add(lcnt + e, 1u, __ATOMIC_RELAXED, __HIP_MEMORY_SCOPE_WORKGROUP); rec[(F.wave * P7_MAXIT + it) * 4 + lane] = (unsigned)e | (lp << 8); }
            else { const unsigned pos = __hip_atomic_fetch_add(cnt + 64 * e, 1u, __ATOMIC_RELAXED, __HIP_MEMORY_SCOPE_AGENT); topp[(size_t)m * 4 + lane] = (int)pos; elist[e * 16384 + pos] = m; } }
    }
    __syncthreads();
    if (F.tid < 32) lcnt[32 + F.tid] = __hip_atomic_fetch_add(cnt + 64 * F.tid, lcnt[F.tid], __ATOMIC_RELAXED, __HIP_MEMORY_SCOPE_AGENT);
    __syncthreads();
    { int it = 0;
        for (int m = gw; m < NTOK && it < P7_MAXIT; m += NGW, ++it)
            if (lane < 4) { const unsigned rc = rec[(F.wave * P7_MAXIT + it) * 4 + lane]; const unsigned e = rc & 255u, pos = lcnt[32 + e] + (rc >> 8); topp[(size_t)m * 4 + lane] = (int)pos; elist[e * 16384 + pos] = m; } }
}

__device__ __forceinline__ int build_moe_tables(Frame& F, LAS int* tab  ) {
    const unsigned* cnt = (const unsigned*)(F.ws + WS_CTL) + CW_CNT;
    if (F.tid < 64) {
        const int e = F.lane & 31;
        const int n = (int)__hip_atomic_load(cnt + 64 * e, __ATOMIC_RELAXED, __HIP_MEMORY_SCOPE_AGENT);
        const int nb = (F.lane < 32) ? ((n + 255) >> 8) : 0;
        int inc = nb;
#pragma unroll
        for (int o = 1; o < 32; o <<= 1) { const int t = __shfl_up(inc, o); if (F.lane >= o) inc += t; }
        const int start = inc - nb;
        if (F.lane < 32) { tab[e] = start * 256; tab[512 + e] = n; for (int k = 0; k < nb; ++k) tab[64 + start + k] = e; }
        if (F.lane == 31) tab[32] = inc;
    }
    __syncthreads();
    return tab[32];
}

__device__ __forceinline__ void phase_p9(Frame& F, const Args& AR, float* out) {
    const float* x1 = (const float*)(F.ws + WS_OD); const bf16* ys = (const bf16*)(F.ws + WS_YS); const float* mod = (const float*)(F.ws + WS_MOD); const float* fnw = AR.in[21];
    const float* topg = (const float*)(F.ws + WS_TOPG); const int* topp = (const int*)(F.ws + WS_TOPP); const int* topi = (const int*)(F.ws + WS_TOPI);
    LAS int* tab = (LAS int*)(F.lds + LDS_TAB); build_moe_tables(F, tab);
    const int lane = F.lane;
    f4 fw[4];
#pragma unroll
    for (int j = 0; j < 4; ++j) fw[j] = ((const f4*)fnw)[lane + 64 * j];
    const int gw = blockIdx.x * NWAVES + F.wave, NGW = F.G * NWAVES;
    for (int m = gw; m < NTOK; m += NGW) {
        const int b = m >> 13;
        const f4 gk = *(const f4*)(topg + (size_t)m * 4); const int r0 = tab[topi[(size_t)m * 4]] + topp[(size_t)m * 4], r1 = tab[topi[(size_t)m * 4 + 1]] + topp[(size_t)m * 4 + 1], r2 = tab[topi[(size_t)m * 4 + 2]] + topp[(size_t)m * 4 + 2], r3 = tab[topi[(size_t)m * 4 + 3]] + topp[(size_t)m * 4 + 3];
        f4 v[4]; float ss = 0.f;
#pragma unroll
        for (int j = 0; j < 4; ++j) {
            const u2 y0 = __builtin_nontemporal_load((const u2*)(ys + (size_t)r0 * D) + lane + 64 * j), y1 = __builtin_nontemporal_load((const u2*)(ys + (size_t)r1 * D) + lane + 64 * j), y2 = __builtin_nontemporal_load((const u2*)(ys + (size_t)r2 * D) + lane + 64 * j), y3 = __builtin_nontemporal_load((const u2*)(ys + (size_t)r3 * D) + lane + 64 * j);
            f4 mo;
            mo.x = gk.x * bflo(y0.x) + gk.y * bflo(y1.x) + gk.z * bflo(y2.x) + gk.w * bflo(y3.x);
            mo.y = gk.x * bfhi(y0.x) + gk.y * bfhi(y1.x) + gk.z * bfhi(y2.x) + gk.w * bfhi(y3.x);
            mo.z = gk.x * bflo(y0.y) + gk.y * bflo(y1.y) + gk.z * bflo(y2.y) + gk.w * bflo(y3.y);
            mo.w = gk.x * bfhi(y0.y) + gk.y * bfhi(y1.y) + gk.z * bfhi(y2.y) + gk.w * bfhi(y3.y);
            const f4 xv = ((const f4*)(x1 + (size_t)m * D))[lane + 64 * j], gt = ((const f4*)(mod + b * 6144 + 5120))[lane + 64 * j];
            v[j] = xv + gt * mo; ss += (v[j].x * v[j].x + v[j].y * v[j].y) + (v[j].z * v[j].z + v[j].w * v[j].w); }
        const float rstd = __builtin_amdgcn_rsqf(wave_sum(ss) * (1.0f / D) + EPS);
#pragma unroll
        for (int j = 0; j < 4; ++j) __builtin_nontemporal_store(v[j] * rstd * fw[j], (f4*)(out + (size_t)m * D) + lane + 64 * j);
    }
}

__global__ void __launch_bounds__(NTHR, 2) fwd_kernel(Args args) {
    const Args& AR = args;
    extern __shared__ __attribute__((aligned(16))) unsigned char lds_raw[];
    Frame F;
    F.lds = (LAS unsigned char*)lds_raw;
    F.tid = threadIdx.x; F.lane = F.tid & 63; F.wave = __builtin_amdgcn_readfirstlane(F.tid >> 6); F.G = gridDim.x;
    F.ws = args.ws;
    volatile LAS unsigned* misc = (volatile LAS unsigned*)(F.lds + LDS_MISC);
    if (F.tid < 4) misc[F.tid] = 0u;
    __syncthreads();
    XcdBarrier bar; bar.bar = (unsigned*)(F.ws + WS_CTL) + CW_BAR; bar.x = 0; bar.st = nullptr;
    if (MK_N_LAUNCHES == 1) bar = xcd_barrier_post((unsigned*)(F.ws + WS_CTL) + CW_BAR, misc);
    const int lo = args.ph_lo, hi = args.ph_hi;
#ifndef PH_MASK
#define PH_MASK 0x1fff
#endif
#define IN(k) (((PH_MASK >> (k)) & 1) && lo <= (k) && (k) < hi)
#ifndef PROBE_PH
#define PROBE_PH -1
#define PROBE_REP 1
#endif
#define REPS(k) for (int rep_ = 0; rep_ < ((k) == PROBE_PH ? PROBE_REP : 1); ++rep_)
#define SEAM(k) do { if (IN(k) && IN((k) + 1)) xcd_barrier(bar); } while (0)
    PG8_LAS unsigned char* glds = (PG8_LAS unsigned char*)lds_raw;

    if (IN(0)) REPS(0) { phase_p0(F, AR); } SEAM(0);
    if (IN(1)) REPS(1) { phase_p1(F, AR); } SEAM(1);
    if (IN(2)) REPS(2) {
        pg8::Gemm g{(const bf16*)(F.ws + WS_H), (const bf16*)(F.ws + WS_WIN_T), NTOK, PW, D}; pg8::StaticOrder S; S.init(NTOK, PW, F.G, (int)blockIdx.x);
        EpiStoreBf16 E{(bf16*)(F.ws + WS_P), PW};
        pg8::gemm_phase<EpiStoreBf16, pg8::StaticOrder, true, true>(glds, g, S, E);
    } SEAM(2);
    if (IN(3)) REPS(3) { phase_p3(F, AR); __syncthreads(); phase_p5_sb(F, AR); } SEAM(3);
    if (IN(4)) REPS(4) { phase_p4(F, AR); } SEAM(4);
    if (IN(5)) REPS(5) { phase_p5(F, AR); } SEAM(5);
    if (IN(6)) REPS(6) {
        pg8::Gemm g{(const bf16*)(F.ws + WS_OASB), (const bf16*)(F.ws + WS_WUO_T), NTOK, D, D}; pg8::StaticOrder S; S.init(NTOK, D, F.G, (int)blockIdx.x);
        EpiGate E{(const bf16*)(F.ws + WS_P), (float*)(F.ws + WS_M1X), (bf16*)(F.ws + WS_M), PC_GA, 1};
        pg8::gemm_phase<EpiGate, pg8::StaticOrder, true, true>(glds, g, S, E);
    } SEAM(6);
    if (IN(7)) REPS(7) {
        pg8::Gemm g{(const bf16*)(F.ws + WS_M), (const bf16*)(F.ws + WS_WO_T), NTOK, D, D}; pg8::StaticOrder S; S.init(NTOK, D, F.G, (int)blockIdx.x);
        EpiG4 E{AR.in[0], (const float*)(F.ws + WS_MOD), (float*)(F.ws + WS_OD)};
        pg8::gemm_phase<EpiG4, pg8::StaticOrder, true, true>(glds, g, S, E);
    } SEAM(7);
    if (IN(8)) REPS(8) { phase_p7(F, AR); } SEAM(8);
    if (IN(9)) REPS(9) {
        __syncthreads();
        LAS int* tab = (LAS int*)(F.lds + LDS_TAB); const int nblk = build_moe_tables(F, tab);
        pg8::Gemm g{(const bf16*)(F.ws + WS_H), (const bf16*)(F.ws + WS_W1T), NTOK, NEXP * 2048, D}; MoeOrder S; S.init(nblk, 8, F.G, (int)blockIdx.x, tab, (const int*)(F.ws + WS_LIST));
        EpiMoe1 E{AR.in[18], (bf16*)(F.ws + WS_ACT)};
        pg8::gemm_phase<EpiMoe1, MoeOrder, true, true, true>(glds, g, S, E);
    } SEAM(9);
    if (IN(10)) REPS(10) {
        __syncthreads();
        LAS int* tab = (LAS int*)(F.lds + LDS_TAB); const int nblk = build_moe_tables(F, tab);
        pg8::Gemm g{(const bf16*)(F.ws + WS_ACT), (const bf16*)(F.ws + WS_W2T), MROWS, NEXP * 1024, D}; MoeOrder S; S.init(nblk, 4, F.G, (int)blockIdx.x, tab, (const int*)(F.ws + WS_LIST));
        EpiMoe2 E{AR.in[20], (bf16*)(F.ws + WS_YS)};
        pg8::gemm_phase<EpiMoe2, MoeOrder, true, true>(glds, g, S, E);
    } SEAM(10);
    if (IN(11)) REPS(11) { phase_p9(F, AR, args.out); }
#undef IN
#undef SEAM
}

extern "C" void kernel_launch(void* const* d_in, const int* in_sizes, int n_in, void* d_out, int out_size, void* d_ws, size_t ws_size, hipStream_t stream) {
    static int grid = 0;
    if (grid == 0) {
        if (n_in != 22 || out_size != NTOK * D || ws_size < WS_END) { fprintf(stderr, "kernel_launch: unexpected shapes (n_in %d out %d ws %zu)\n", n_in, out_size, ws_size); grid = -1; return; }
        int dev = 0, cus = 0, per_cu = 0;
        if (hipGetDevice(&dev) != hipSuccess || hipDeviceGetAttribute(&cus, hipDeviceAttributeMultiprocessorCount, dev) != hipSuccess) { grid = -1; return; }
        if (hipFuncSetAttribute((const void*)fwd_kernel, hipFuncAttributeMaxDynamicSharedMemorySize, LDS_BYTES) != hipSuccess) { fprintf(stderr, "kernel_launch: hipFuncSetAttribute failed\n"); grid = -1; return; }
        if (hipOccupancyMaxActiveBlocksPerMultiprocessor(&per_cu, (const void*)fwd_kernel, NTHR, LDS_BYTES) != hipSuccess || per_cu < 1) { fprintf(stderr, "kernel_launch: occupancy query says %d\n", per_cu); }
        (void)hipGetLastError();
        grid = cus;
        if (grid > 256) grid = 256;
    }
    if (grid < 0) return;
    if (hipMemsetAsync((char*)d_ws + WS_CTL, 0, CTL_ZERO_BYTES, stream) != hipSuccess) return;
    Args a{};
    for (int i = 0; i < 22; ++i) a.in[i] = (const float*)d_in[i];
    a.out = (float*)d_out; a.ws = (unsigned char*)d_ws;
#if MK_N_LAUNCHES == 1
    a.ph_lo = 0; a.ph_hi = NPHASE;
    hipLaunchKernelGGL(fwd_kernel, dim3(grid), dim3(NTHR), LDS_BYTES, stream, a);
#else
    for (int ph = 0; ph < NPHASE; ++ph) { a.ph_lo = ph; a.ph_hi = ph + 1; hipLaunchKernelGGL(fwd_kernel, dim3(grid), dim3(NTHR), LDS_BYTES, stream, a); }
#endif
}
```
